# Optimizing an MI355X kernel written in HIP

```python
import math
import jax
import jax.numpy as jnp
from jax import lax
import numpy as np

D_MODEL = 1024
BATCH = 8
SEQ = 2048
DEPTH = 4

PLE_DIM = 256
MIX_WIDTH = 256
N_BRANCH = 4
S5_WIDTH = MIX_WIDTH
S5_GROUP = 16
S5_GROUPS = S5_WIDTH // S5_GROUP
S5_STATE = 64
MLA_HEADS = 4
MLA_NOPE = 64
MLA_ROPE = 32
MLA_V = 64
MLA_Q_LORA = 192
MLA_KV_LORA = 128
Q_BLOCK = 128
HG_HEADS = 4
HG_K = 64
HG_V = 64
HG_CHUNK = 16
RET_HEADS = 4
RET_K = 64
RET_V = 64
RET_CHUNK = 64
D_FF = 3584
N_EXPERTS = 8
TOP_K = 2
D_FF_EXPERT = 3584
MOE_BLOCK = 128
N_DENSE = (DEPTH + 1) // 2
N_MOE = DEPTH // 2
ROPE_BASE = 10000.0
EPS = 1e-5
NEG_INF = -1e30
ALPHA = (2 * DEPTH) ** 0.25
BETA = (8 * DEPTH) ** -0.25
IN_SPLITS = (S5_WIDTH, MLA_Q_LORA, MLA_KV_LORA, MLA_ROPE,
             HG_HEADS * HG_K, HG_HEADS * HG_K, HG_HEADS * HG_V, HG_HEADS * HG_V,
             RET_HEADS * RET_K, RET_HEADS * RET_K, RET_HEADS * RET_V, RET_HEADS * RET_V,
             N_BRANCH * D_MODEL)
D_IN = sum(IN_SPLITS)

kernel_name = 'hybrid_gated_s5_mla_hgrn2_retnet_deepnorm'


def layer_norm(x, g, b):
    xf = x.astype(jnp.float32)
    mu = jnp.mean(xf, axis=-1, keepdims=True)
    var = jnp.mean(jnp.square(xf - mu), axis=-1, keepdims=True)
    return ((xf - mu) * lax.rsqrt(var + EPS) * g + b).astype(x.dtype)


def rms_norm(x, g):
    xf = x.astype(jnp.float32)
    return (xf * lax.rsqrt(jnp.mean(xf * xf, axis=-1, keepdims=True) + EPS) * g).astype(x.dtype)


def split_columns(h, sizes):
    out, start = [], 0
    for n in sizes:
        out.append(h[..., start:start + n])
        start += n
    return out


def rope_tables(positions, dim):
    half = dim // 2
    inv_freq = ROPE_BASE ** (-jnp.arange(half, dtype=jnp.float32) / half)
    ang = positions.astype(jnp.float32)[..., None] * inv_freq
    return jnp.cos(ang)[:, :, None, :], jnp.sin(ang)[:, :, None, :]


def apply_rope(x, cos, sin):
    half = x.shape[-1] // 2
    x1, x2 = x[..., :half], x[..., half:]
    return jnp.concatenate([x1 * cos - x2 * sin, x2 * cos + x1 * sin], axis=-1).astype(x.dtype)


def _complex_affine_combine(left, right):
    a1r, a1i, b1r, b1i = left
    a2r, a2i, b2r, b2i = right
    return (a2r * a1r - a2i * a1i, a2r * a1i + a2i * a1r,
            a2r * b1r - a2i * b1i + b2r, a2r * b1i + a2i * b1r + b2i)


def s5_mixer(u, a_re, a_im, log_dt, b_re, b_im, c_re, c_im, d_skip, w_glu):
    f32 = jnp.float32
    bsz, s, _ = u.shape
    uf = u.astype(f32)
    ug = uf.reshape(bsz, s, S5_GROUPS, S5_GROUP)
    dt = jnp.exp(log_dt.astype(f32))[:, None]
    lr, li = a_re.astype(f32), a_im.astype(f32)
    mag = jnp.exp(lr * dt)
    abar_re, abar_im = mag * jnp.cos(li * dt), mag * jnp.sin(li * dt)
    den = lr * lr + li * li
    num_re, num_im = abar_re - 1.0, abar_im
    coef_re = (num_re * lr + num_im * li) / den
    coef_im = (num_im * lr - num_re * li) / den
    br, bi = b_re.astype(f32), b_im.astype(f32)
    bbar_re = coef_re[..., None] * br - coef_im[..., None] * bi
    bbar_im = coef_re[..., None] * bi + coef_im[..., None] * br
    bu_re = jnp.einsum('bsgc,gpc->bsgp', ug, bbar_re)
    bu_im = jnp.einsum('bsgc,gpc->bsgp', ug, bbar_im)
    ar = jnp.broadcast_to(abar_re, bu_re.shape)
    ai = jnp.broadcast_to(abar_im, bu_re.shape)
    _, _, s_re, s_im = lax.associative_scan(_complex_affine_combine, (ar, ai, bu_re, bu_im), axis=1)
    y = (jnp.einsum('bsgp,gcp->bsgc', s_re, c_re.astype(f32))
         - jnp.einsum('bsgp,gcp->bsgc', s_im, c_im.astype(f32)))
    y = y.reshape(bsz, s, S5_WIDTH) + d_skip.astype(f32) * uf
    y = jax.nn.gelu(y)
    return (y * jax.nn.sigmoid(y @ w_glu.astype(f32))).astype(u.dtype)


def causal_mla_attention(q_nope, q_pe, k_nope, k_pe, v):
    bsz, s, h, _ = q_nope.shape
    nb = s // Q_BLOCK
    scale = (MLA_NOPE + MLA_ROPE) ** -0.5
    qn = q_nope.reshape(bsz, nb, Q_BLOCK, h, MLA_NOPE).swapaxes(0, 1)
    qp = q_pe.reshape(bsz, nb, Q_BLOCK, h, MLA_ROPE).swapaxes(0, 1)
    k_idx = jnp.arange(s)

    def one_block(args):
        blk, qn_b, qp_b = args
        sc = (jnp.einsum('bqhd,bkhd->bhqk', qn_b, k_nope)
              + jnp.einsum('bqhr,bkr->bhqk', qp_b, k_pe)).astype(jnp.float32) * scale
        q_idx = blk * Q_BLOCK + jnp.arange(Q_BLOCK)
        sc = jnp.where(k_idx[None, :] <= q_idx[:, None], sc, NEG_INF)
        w = jax.nn.softmax(sc, axis=-1).astype(v.dtype)
        return jnp.einsum('bhqk,bkhd->bqhd', w, v)

    out = lax.map(one_block, (jnp.arange(nb), qn, qp))
    return out.swapaxes(0, 1).reshape(bsz, s, h * MLA_V)


def mla_mixer(c_q, c_kv, k_rope, cos, sin, q_norm_g, kv_norm_g, w_uq, w_ukv):
    bsz, s, _ = c_q.shape
    q = (rms_norm(c_q, q_norm_g) @ w_uq).reshape(bsz, s, MLA_HEADS, MLA_NOPE + MLA_ROPE)
    q_nope, q_pe = q[..., :MLA_NOPE], apply_rope(q[..., MLA_NOPE:], cos, sin)
    kv = (rms_norm(c_kv, kv_norm_g) @ w_ukv).reshape(bsz, s, MLA_HEADS, MLA_NOPE + MLA_V)
    k_nope, v = kv[..., :MLA_NOPE], kv[..., MLA_NOPE:]
    k_pe = apply_rope(k_rope[:, :, None, :], cos, sin)[:, :, 0, :]
    return causal_mla_attention(q_nope, q_pe, k_nope, k_pe, v).astype(c_q.dtype)


def hgrn2_mixer(q, f, i_in, g, lb, norm_g):
    f32 = jnp.float32
    bsz, s, _ = q.shape
    n = s // HG_CHUNK
    lb = lb.astype(f32)
    ff = f.astype(f32)
    log_f = jnp.logaddexp(jnp.log(lb), jnp.log1p(-lb) + jax.nn.log_sigmoid(ff))
    k = (1.0 - lb) * jax.nn.sigmoid(-ff)
    qf = jax.nn.silu(q.astype(f32))

    def chunks(t, d):
        return t.reshape(bsz, n, HG_CHUNK, HG_HEADS, d).transpose(0, 3, 1, 2, 4)

    qc, kc, lfc = chunks(qf, HG_K), chunks(k, HG_K), chunks(log_f, HG_K)
    vc = chunks(i_in.astype(f32), HG_V)
    bcum = jnp.cumsum(lfc, axis=3)
    tri = jnp.tril(jnp.ones((HG_CHUNK, HG_CHUNK), dtype=bool))
    diff = bcum[..., :, None, :] - bcum[..., None, :, :]
    decay = jnp.exp(jnp.where(tri[:, :, None], diff, -jnp.inf))
    attn = jnp.einsum('bhntk,bhnsk,bhntsk->bhnts', qc, kc, decay)
    o_intra = jnp.einsum('bhnts,bhnsv->bhntv', attn, vc)
    b_last = bcum[..., -1:, :]
    kv_chunk = jnp.einsum('bhnck,bhncv->bhnkv', kc * jnp.exp(b_last - bcum), vc)
    chunk_decay = jnp.exp(b_last[..., 0, :])

    def step(state, inp):
        dec, kv = inp
        return dec[..., None] * state + kv, state

    init = jnp.zeros((bsz, HG_HEADS, HG_K, HG_V), f32)
    _, s_prev = lax.scan(step, init, (jnp.moveaxis(chunk_decay, 2, 0), jnp.moveaxis(kv_chunk, 2, 0)))
    s_prev = jnp.moveaxis(s_prev, 0, 2)
    o_inter = jnp.einsum('bhnck,bhnkv->bhncv', qc * jnp.exp(bcum), s_prev)
    o = (o_intra + o_inter).transpose(0, 2, 3, 1, 4).reshape(bsz, s, HG_HEADS, HG_V)
    o = rms_norm(o, norm_g.astype(f32).reshape(HG_HEADS, HG_V)).reshape(bsz, s, HG_HEADS * HG_V)
    return (o * jax.nn.silu(g.astype(f32))).astype(q.dtype)


def retention_mixer(q, k, v, g, cos, sin, gn_g, gn_b):
    f32 = jnp.float32
    bsz, s, _ = q.shape
    n = s // RET_CHUNK
    qh = apply_rope(q.astype(f32).reshape(bsz, s, RET_HEADS, RET_K), cos, sin) * RET_K ** -0.5
    kh = apply_rope(k.astype(f32).reshape(bsz, s, RET_HEADS, RET_K), cos, sin)
    vh = v.astype(f32).reshape(bsz, s, RET_HEADS, RET_V)

    def chunks(t):
        return t.reshape(bsz, n, RET_CHUNK, RET_HEADS, t.shape[-1]).transpose(0, 3, 1, 2, 4)

    qc, kc, vc = chunks(qh), chunks(kh), chunks(vh)
    log_gamma = jnp.log(1.0 - 2.0 ** (-5.0 - jnp.arange(RET_HEADS, dtype=f32)))
    t_idx = jnp.arange(RET_CHUNK, dtype=f32)
    rel = t_idx[:, None] - t_idx[None, :]
    dmat = jnp.where(rel >= 0, jnp.exp(jnp.maximum(rel, 0.0)[None] * log_gamma[:, None, None]), 0.0)
    scores = jnp.einsum('bhntd,bhnsd->bhnts', qc, kc) * dmat[None, :, None]
    o_intra = jnp.einsum('bhnts,bhnsv->bhntv', scores, vc)
    k_decay = jnp.exp((RET_CHUNK - 1 - t_idx)[None, :] * log_gamma[:, None])
    kv_chunk = jnp.einsum('bhnck,bhncv->bhnkv', kc * k_decay[None, :, None, :, None], vc)
    chunk_decay = jnp.exp(RET_CHUNK * log_gamma)[None, :, None, None]

    def step(state, kv):
        return chunk_decay * state + kv, state

    init = jnp.zeros((bsz, RET_HEADS, RET_K, RET_V), f32)
    _, s_prev = lax.scan(step, init, jnp.moveaxis(kv_chunk, 2, 0))
    s_prev = jnp.moveaxis(s_prev, 0, 2)
    q_decay = jnp.exp((t_idx + 1.0)[None, :] * log_gamma[:, None])
    o_inter = jnp.einsum('bhnck,bhnkv->bhncv', qc * q_decay[None, :, None, :, None], s_prev)
    o = (o_intra + o_inter).transpose(0, 2, 3, 1, 4).reshape(bsz, s, RET_HEADS, RET_V)
    o = layer_norm(o, gn_g.astype(f32).reshape(RET_HEADS, RET_V), gn_b.astype(f32).reshape(RET_HEADS, RET_V))
    return (jax.nn.silu(g.astype(f32)) * o.reshape(bsz, s, RET_HEADS * RET_V)).astype(q.dtype)


def swiglu(x, w_gate, w_up, w_down):
    return (jax.nn.silu(x @ w_gate) * (x @ w_up)) @ w_down


def moe_swiglu(x, w_router, w_gate, w_up, w_down):
    bsz, s, d = x.shape
    t = bsz * s
    xf = x.reshape(t, d)
    logits = (xf @ w_router).astype(jnp.float32)
    top_val, top_idx = lax.top_k(logits, TOP_K)
    top_w = jax.nn.softmax(top_val, axis=-1)
    m = t * TOP_K
    e_flat = top_idx.reshape(m)
    tok_flat = jnp.repeat(jnp.arange(t, dtype=jnp.int32), TOP_K)
    w_flat = top_w.reshape(m)
    order = jnp.argsort(e_flat)
    e_sorted = e_flat[order]
    counts = jnp.bincount(e_flat, length=N_EXPERTS)
    padded = (counts + MOE_BLOCK - 1) // MOE_BLOCK * MOE_BLOCK
    pad_end = jnp.cumsum(padded)
    pad_start = pad_end - padded
    start = jnp.cumsum(counts) - counts
    dest = pad_start[e_sorted] + jnp.arange(m) - start[e_sorted]
    n_blk = (m + MOE_BLOCK - 1) // MOE_BLOCK + N_EXPERTS
    p_len = n_blk * MOE_BLOCK
    slot_tok = jnp.full((p_len,), t, jnp.int32).at[dest].set(tok_flat[order])
    slot_w = jnp.zeros((p_len,), jnp.float32).at[dest].set(w_flat[order])
    blk_start = jnp.arange(n_blk) * MOE_BLOCK
    blk_expert = jnp.minimum(jnp.sum(pad_end[None, :] <= blk_start[:, None], axis=1), N_EXPERTS - 1)
    x_pad = jnp.concatenate([xf, jnp.zeros((1, d), xf.dtype)], axis=0)
    xb = x_pad[slot_tok].reshape(n_blk, MOE_BLOCK, d)

    def expert_block(args):
        xe, e = args
        return (jax.nn.silu(xe @ w_gate[e]) * (xe @ w_up[e])) @ w_down[e]

    yb = lax.map(expert_block, (xb, blk_expert)).reshape(p_len, d)
    y = jnp.zeros((t + 1, d), yb.dtype).at[slot_tok].add(yb * slot_w[:, None].astype(yb.dtype))
    return y[:t].reshape(bsz, s, d).astype(x.dtype)


def setup_inputs(seed: int = 0) -> dict:
    key = jax.random.key(seed)
    ks = iter(jax.random.split(key, 40))
    f32 = jnp.float32

    def nrm(shape, scale):
        return jax.random.normal(next(ks), shape, f32) * scale

    def gain(shape):
        return 1.0 + nrm(shape, 0.01)

    x = nrm((BATCH, SEQ, D_MODEL), 1.0)
    p = nrm((DEPTH, BATCH, SEQ, PLE_DIM), 1.0)
    positions = (jax.random.randint(next(ks), (BATCH, 1), 0, 1024, dtype=jnp.int32)
                 + jnp.arange(SEQ, dtype=jnp.int32)[None, :])
    w_in = nrm((DEPTH, D_MODEL, D_IN), D_MODEL ** -0.5)
    s5_a_re = -0.5 + nrm((DEPTH, S5_GROUPS, S5_STATE), 0.01)
    s5_a_im = math.pi * jnp.arange(S5_STATE, dtype=f32) + nrm((DEPTH, S5_GROUPS, S5_STATE), 0.01)
    s5_log_dt = jax.random.uniform(next(ks), (DEPTH, S5_GROUPS), f32, math.log(0.001), math.log(0.1))
    s5_b_re = nrm((DEPTH, S5_GROUPS, S5_STATE, S5_GROUP), (2 * S5_GROUP) ** -0.5)
    s5_b_im = nrm((DEPTH, S5_GROUPS, S5_STATE, S5_GROUP), (2 * S5_GROUP) ** -0.5)
    s5_c_re = nrm((DEPTH, S5_GROUPS, S5_GROUP, S5_STATE), 0.5)
    s5_c_im = nrm((DEPTH, S5_GROUPS, S5_GROUP, S5_STATE), 0.5)
    s5_d = nrm((DEPTH, S5_WIDTH), 1.0)
    s5_w_glu = nrm((DEPTH, S5_WIDTH, S5_WIDTH), S5_WIDTH ** -0.5)
    mla_q_norm = gain((DEPTH, MLA_Q_LORA))
    mla_kv_norm = gain((DEPTH, MLA_KV_LORA))
    mla_w_uq = nrm((DEPTH, MLA_Q_LORA, MLA_HEADS * (MLA_NOPE + MLA_ROPE)), MLA_Q_LORA ** -0.5)
    mla_w_ukv = nrm((DEPTH, MLA_KV_LORA, MLA_HEADS * (MLA_NOPE + MLA_V)), MLA_KV_LORA ** -0.5)
    hg_lb_raw = nrm((DEPTH, HG_HEADS * HG_K), 0.1)
    hg_norm = gain((DEPTH, HG_HEADS * HG_V))
    ret_gn_g = gain((DEPTH, RET_HEADS * RET_V))
    ret_gn_b = nrm((DEPTH, RET_HEADS * RET_V), 0.01)
    w_branch = nrm((DEPTH, N_BRANCH, MIX_WIDTH, D_MODEL), BETA * MIX_WIDTH ** -0.5)
    w_o = nrm((DEPTH, D_MODEL, D_MODEL), BETA * D_MODEL ** -0.5)
    ln1_g = gain((DEPTH, D_MODEL))
    ln1_b = nrm((DEPTH, D_MODEL), 0.01)
    ff_w_gate = nrm((N_DENSE, D_MODEL, D_FF), BETA * D_MODEL ** -0.5)
    ff_w_up = nrm((N_DENSE, D_MODEL, D_FF), BETA * D_MODEL ** -0.5)
    ff_w_down = nrm((N_DENSE, D_FF, D_MODEL), BETA * D_FF ** -0.5)
    moe_router = nrm((N_MOE, D_MODEL, N_EXPERTS), D_MODEL ** -0.5)
    moe_w_gate = nrm((N_MOE, N_EXPERTS, D_MODEL, D_FF_EXPERT), BETA * D_MODEL ** -0.5)
    moe_w_up = nrm((N_MOE, N_EXPERTS, D_MODEL, D_FF_EXPERT), BETA * D_MODEL ** -0.5)
    moe_w_down = nrm((N_MOE, N_EXPERTS, D_FF_EXPERT, D_MODEL), BETA * D_FF_EXPERT ** -0.5)
    ple_w_gate = nrm((DEPTH, D_MODEL, D_MODEL), D_MODEL ** -0.5)
    ple_w_proj = nrm((DEPTH, PLE_DIM, D_MODEL), PLE_DIM ** -0.5)
    ln2_g = gain((DEPTH, D_MODEL))
    ln2_b = nrm((DEPTH, D_MODEL), 0.01)
    return {'x': x, 'p': p, 'positions': positions, 'w_in': w_in,
            's5_a_re': s5_a_re, 's5_a_im': s5_a_im, 's5_log_dt': s5_log_dt,
            's5_b_re': s5_b_re, 's5_b_im': s5_b_im, 's5_c_re': s5_c_re, 's5_c_im': s5_c_im,
            's5_d': s5_d, 's5_w_glu': s5_w_glu,
            'mla_q_norm': mla_q_norm, 'mla_kv_norm': mla_kv_norm, 'mla_w_uq': mla_w_uq, 'mla_w_ukv': mla_w_ukv,
            'hg_lb_raw': hg_lb_raw, 'hg_norm': hg_norm, 'ret_gn_g': ret_gn_g, 'ret_gn_b': ret_gn_b,
            'w_branch': w_branch, 'w_o': w_o, 'ln1_g': ln1_g, 'ln1_b': ln1_b,
            'ff_w_gate': ff_w_gate, 'ff_w_up': ff_w_up, 'ff_w_down': ff_w_down,
            'moe_router': moe_router, 'moe_w_gate': moe_w_gate, 'moe_w_up': moe_w_up, 'moe_w_down': moe_w_down,
            'ple_w_gate': ple_w_gate, 'ple_w_proj': ple_w_proj, 'ln2_g': ln2_g, 'ln2_b': ln2_b}


def reference(x, p, positions, w_in, s5_a_re, s5_a_im, s5_log_dt, s5_b_re, s5_b_im, s5_c_re, s5_c_im,
              s5_d, s5_w_glu, mla_q_norm, mla_kv_norm, mla_w_uq, mla_w_ukv, hg_lb_raw, hg_norm,
              ret_gn_g, ret_gn_b, w_branch, w_o, ln1_g, ln1_b, ff_w_gate, ff_w_up, ff_w_down,
              moe_router, moe_w_gate, moe_w_up, moe_w_down, ple_w_gate, ple_w_proj, ln2_g, ln2_b):
    bsz, s, _ = x.shape
    cos_m, sin_m = rope_tables(positions, MLA_ROPE)
    cos_r, sin_r = rope_tables(positions, RET_K)
    lb_all = jnp.cumsum(jax.nn.softmax(hg_lb_raw.astype(jnp.float32), axis=0), axis=0)
    lb_all = lb_all - lb_all[0]
    for i in range(DEPTH):
        h = x @ w_in[i]
        (u_s5, c_q, c_kv, k_rope, hq, hf, hi, hg, rq, rk, rv, rg, gate_logits) = split_columns(h, IN_SPLITS)
        y_a = s5_mixer(u_s5, s5_a_re[i], s5_a_im[i], s5_log_dt[i], s5_b_re[i], s5_b_im[i],
                       s5_c_re[i], s5_c_im[i], s5_d[i], s5_w_glu[i])
        y_b = mla_mixer(c_q, c_kv, k_rope, cos_m, sin_m, mla_q_norm[i], mla_kv_norm[i], mla_w_uq[i], mla_w_ukv[i])
        y_c = hgrn2_mixer(hq, hf, hi, hg, lb_all[i], hg_norm[i])
        y_d = retention_mixer(rq, rk, rv, rg, cos_r, sin_r, ret_gn_g[i], ret_gn_b[i])
        branches = jnp.einsum('bsnc,ncd->bsnd', jnp.stack([y_a, y_b, y_c, y_d], axis=2), w_branch[i])
        gates = jax.nn.sigmoid(gate_logits.reshape(bsz, s, N_BRANCH, D_MODEL))
        mixed = jnp.sum(gates * branches, axis=2) @ w_o[i]
        x = layer_norm(ALPHA * x + mixed, ln1_g[i], ln1_b[i])
        if i % 2 == 0:
            f = swiglu(x, ff_w_gate[i // 2], ff_w_up[i // 2], ff_w_down[i // 2])
        else:
            f = moe_swiglu(x, moe_router[i // 2], moe_w_gate[i // 2], moe_w_up[i // 2], moe_w_down[i // 2])
        ple = jax.nn.sigmoid(x @ ple_w_gate[i]) * (p[i] @ ple_w_proj[i])
        x = layer_norm(ALPHA * x + f + ple, ln2_g[i], ln2_b[i])
    return x
```

```cpp
#include <hip/hip_runtime.h>
#include <cstdio>
#include <cstdint>

#ifndef MK_N_LAUNCHES
#define MK_N_LAUNCHES 1
#endif
#ifndef PHMASK
#define PHMASK 0xFFFF
#endif
#define PHON(k) (((PHMASK) >> (k)) & 1)
#ifndef ITMASK
#define ITMASK 15
#endif

#define LAS __attribute__((address_space(3)))
typedef unsigned short bf16_t;
typedef short bf16x8 __attribute__((ext_vector_type(8)));
typedef float f32x4 __attribute__((ext_vector_type(4)));
typedef float f32x2 __attribute__((ext_vector_type(2)));
typedef unsigned u32x4 __attribute__((ext_vector_type(4)));
typedef unsigned u32x2 __attribute__((ext_vector_type(2)));

constexpr int T = 16384, D = 1024, SEQ = 2048, NBATCH = 8, DEPTH = 4, DFF = 3584, NEXP = 8;
constexpr int HP = 6912;
constexpr int C_US5 = 0, C_CQ = 256, C_CKV = 512, C_KR = 640, C_HQ = 768, C_HF = 1024, C_HI = 1280, C_HG = 1536, C_RQ = 1792, C_RK = 2048, C_RV = 2304, C_RG = 2560, C_GATE = 2816;
constexpr float ALPHA = 1.6817928305074290f;
constexpr float EPS = 1e-5f;
constexpr float QSCALE = 0.10206207261596575f * 1.4426950408889634f;
constexpr int MOE_MAXT = 136;

constexpr size_t MiB = (size_t)1 << 20;
constexpr size_t WS_CTL = 0, CTL_BYTES = 1 * MiB;
constexpr size_t WS_WIN = 1 * MiB, WS_WB = 55 * MiB, WS_WO = 63 * MiB, WS_WPG = 71 * MiB, WS_WPP = 79 * MiB, WS_WFFU = 81 * MiB, WS_WFFD = 109 * MiB;
constexpr size_t WS_WMU = 123 * MiB, WS_WMD = 347 * MiB, WS_WUQ = 459 * MiB, WS_WUKV = 460 * MiB, WS_WGLU = 461 * MiB;
constexpr size_t WS_ROPEM = 462 * MiB, WS_ROPER = 464 * MiB, WS_S5P = 468 * MiB, WS_TOK = 469 * MiB;
constexpr size_t WS_XB = 470 * MiB, WS_PB = 502 * MiB, WS_PP = 534 * MiB, WS_PLE = 566 * MiB, WS_STAGE = 598 * MiB;
constexpr size_t WS_H = WS_STAGE, WS_Y = WS_STAGE + 216 * MiB, WS_S5PRE = WS_STAGE + 248 * MiB, WS_MIXB = WS_STAGE + 256 * MiB, WS_TMP = WS_STAGE + 288 * MiB;
constexpr size_t WS_Q = WS_STAGE + 288 * MiB, WS_K = WS_STAGE + 300 * MiB, WS_VT = WS_STAGE + 312 * MiB, WS_QR = WS_STAGE + 320 * MiB, WS_KR = WS_STAGE + 328 * MiB;
constexpr size_t WS_S5E = WS_STAGE + 336 * MiB, WS_S5C = WS_STAGE + 338 * MiB, WS_HGD = WS_STAGE + 340 * MiB, WS_HGE = WS_STAGE + 341 * MiB, WS_HGI = WS_STAGE + 357 * MiB;
constexpr size_t WS_RTE = WS_STAGE + 373 * MiB, WS_RTI = WS_STAGE + 389 * MiB;
constexpr size_t WS_HFF = WS_STAGE, WS_XG = WS_STAGE, WS_HM = WS_STAGE + 68 * MiB, WS_YM = WS_STAGE + 306 * MiB;
constexpr size_t WS_END = WS_STAGE + 405 * MiB;
constexpr size_t S5P_ABAR = 0, S5P_BM = 64 * 1024, S5P_CM = 384 * 1024, S5P_LB = 704 * 1024;
constexpr size_t TOK_E = 0, TOK_POS = 128 * 1024, TOK_W = 256 * 1024, TOK_SLOT = 384 * 1024;
constexpr int CW_BAR = 4096, CW_MOE = 8192;

constexpr int LDS_BYTES = 160 * 1024;
constexpr int LDS_STAGE = 0;
constexpr int LDS_MISC = 128 * 1024;
constexpr int LDS_CTLW = 160 * 1024 - 64;

__device__ __forceinline__ float bf2f(bf16_t b) { return __uint_as_float(((unsigned)b) << 16); }
__device__ __forceinline__ unsigned cvt_pk_bf16(float lo, float hi) { unsigned r; asm volatile("v_cvt_pk_bf16_f32 %0, %1, %2" : "=v"(r) : "v"(lo), "v"(hi)); return r; }
__device__ __forceinline__ bf16_t f2bf(float f) { return (bf16_t)(cvt_pk_bf16(f, 0.f) & 0xffffu); }
__device__ __forceinline__ float sigmoidf_(float x) { return 1.0f / (1.0f + __expf(-x)); }
__device__ __forceinline__ float siluf_(float x) { return x / (1.0f + __expf(-x)); }
__device__ __forceinline__ float gelu_tanh(float v) { const float z = 0.7978845608028654f * (v + 0.044715f * v * v * v); const float th = 1.0f - 2.0f / (__expf(2.0f * z) + 1.0f); return 0.5f * v * (1.0f + th); }
__device__ __forceinline__ f32x4 mfma16(bf16x8 a, bf16x8 b, f32x4 c) { return __builtin_amdgcn_mfma_f32_16x16x32_bf16(a, b, c, 0, 0, 0); }
union Frag { bf16x8 v; unsigned u[4]; u32x2 d[2]; u32x4 q; unsigned short h[8]; };
#define WSYNC() asm volatile("s_waitcnt lgkmcnt(0)" ::: "memory")
#define VM_WAIT() asm volatile("s_waitcnt vmcnt(0)" ::: "memory")
__device__ __forceinline__ float wave_sum(float v) {
#pragma unroll
    for (int o = 1; o < 64; o <<= 1) v += __shfl_xor(v, o);
    return v;
}

namespace pg8 {
constexpr int BM = 256, BK = 64, HALF = 128, HTB = HALF * BK * 2, STAGE_BYTES = 8 * HTB, NXCD = 8, WGM = 8;
__host__ __device__ __forceinline__ int lds_byte(int r, int c) { const int st = (r >> 4) * 2 + (c >> 5), rr = r & 15, cc = c & 31, ob = rr * 64 + cc * 2; return st * 1024 + (ob ^ (((ob >> 9) & 1) << 5)); }
__host__ __device__ __forceinline__ void stage_rc(int b, int& R, int& C) { const int st = b / 1024, sb = b % 1024, swz = sb ^ (((sb >> 9) & 1) << 5); R = (st >> 1) * 16 + swz / 64; C = (st & 1) * 32 + (swz % 64) / 2; }
__host__ __device__ __forceinline__ int perm32(int rho) { const int n = rho >> 4, i = rho & 15; return 8 * (i >> 2) + 4 * n + (i & 3); }

struct Unit { int pm, pn, ak; };
struct Gemm { const bf16_t* A; const bf16_t* Bt; int lda, ldb, K; };

struct OrderStd {
    int nM, nN, nwg, G, c;
    __device__ void init(int nM_, int nN_, int G_, int c_) { nM = nM_; nN = nN_; nwg = nM * nN; G = G_; c = c_; }
    __device__ bool next(int i, Unit& u) const {
        const long L = (long)i * G + c; if (L >= nwg) return false;
        int wgid = (int)L; { const int q = nwg / NXCD, r = nwg % NXCD, xcd = wgid % NXCD, off = wgid / NXCD; wgid = (xcd < r ? xcd * (q + 1) : r * (q + 1) + (xcd - r) * q) + off; }
        const int nig = WGM * nN, gid = wgid / nig, fm = gid * WGM, gsz = (nM - fm) < WGM ? (nM - fm) : WGM;
        u.pm = fm + ((wgid % nig) % gsz); u.pn = (wgid % nig) / gsz; u.ak = 0; return true;
    }
};
struct OrderLin {
    int c, G, total, nN;
    __device__ bool next(int i, Unit& u) const { if (c < 0) return false; const int L = i * G + c; if (L >= total) return false; u.pm = L / nN; u.pn = L % nN; u.ak = 0; return true; }
};
struct OrderOne {
    int pm, pn; bool has;
    __device__ bool next(int i, Unit& u) const { if (i > 0 || !has) return false; u.pm = pm; u.pn = pn; u.ak = 0; return true; }
};
struct OrderBranch {
    int c, G;
    __device__ bool next(int i, Unit& u) const { const int t = (i >> 2) * G + c, n = i & 3; if (t >= 256) return false; u.pm = t >> 2; u.pn = n * 4 + (t & 3); u.ak = n * 256; return true; }
};
struct OrderMoe {
    int nT, ncol, G, c, t1, t2, t3, t4, t5, t6, t7;
    __device__ bool next(int i, Unit& u) const {
        const long L = (long)i * G + c; if (L >= (long)nT * ncol) return false;
        const int wg = (int)L, nig = WGM * ncol, gid = wg / nig, fm = gid * WGM, gsz = (nT - fm) < WGM ? (nT - fm) : WGM;
        const int pm = fm + ((wg % nig) % gsz), ct = (wg % nig) / gsz;
        const int e = (pm >= t1) + (pm >= t2) + (pm >= t3) + (pm >= t4) + (pm >= t5) + (pm >= t6) + (pm >= t7);
        u.pm = pm; u.pn = e * ncol + ct; u.ak = 0; return true;
    }
};

template <class Epi, class Sched, bool ALIGN_EPI = true, bool SP2 = true>
__device__ __forceinline__ void gemm_phase(LAS unsigned char* lds, const Gemm g, const Sched& S, const Epi& E) {
    int oz_; asm volatile("s_mov_b32 %0, 0" : "=s"(oz_));
    const int tid = threadIdx.x + oz_, wid = __builtin_amdgcn_readfirstlane(tid >> 6), lane = tid & 63, wr = wid >> 2, wc = wid & 3, fr = lane & 15, fq = lane >> 4;
    const int nt = (g.K + oz_) / BK;
    unsigned voffA[2], voffB[2];
#pragma unroll
    for (int i = 0; i < 2; ++i) { int R, C; stage_rc(tid * 16 + i * 8192, R, C); const int Rb = Epi::PERM ? ((R & ~31) + perm32(R & 31)) : R;
        voffA[i] = (unsigned)(R * g.lda + C) * 2u; voffB[i] = (unsigned)(Rb * g.ldb + C) * 2u; }
    const size_t kstep = (size_t)(BK * 2);
    const size_t hstepA = (size_t)HALF * g.lda * 2, hstepB = (size_t)HALF * g.ldb * 2;
    const size_t tstepA = 2 * hstepA, tstepB = 2 * hstepB;
    const unsigned ldsw = (unsigned)wid * 1024u;
    const int aoff = lds_byte(wr * 64 + fr, fq * 8), boff = lds_byte(wc * 32 + fr, fq * 8);
#define PG8_SA(b, h) (((b) * 2 + (h)) * HTB)
#define PG8_SB(b, h) ((4 + (b) * 2 + (h)) * HTB)
#define PG8_STAGE(bufoff, gbase, voff) do { _Pragma("unroll") for (int _i = 0; _i < 2; ++_i) \
        __builtin_amdgcn_global_load_lds((const unsigned*)((const char*)(gbase) + (voff)[_i]), (LAS unsigned*)(lds + (bufoff) + ldsw + _i * 8192), 16, 0, 0); } while (0)
#define PG8_LDA(dst, b, h) do { _Pragma("unroll") for (int m = 0; m < 4; ++m) _Pragma("unroll") for (int k = 0; k < 2; ++k) dst[m][k] = *(const LAS bf16x8*)(lds + PG8_SA(b, h) + aoff + m * 2048 + k * 1024); } while (0)
#define PG8_LDB(dst, b, h) do { _Pragma("unroll") for (int n = 0; n < 2; ++n) _Pragma("unroll") for (int k = 0; k < 2; ++k) dst[n][k] = *(const LAS bf16x8*)(lds + PG8_SB(b, h) + boff + n * 2048 + k * 1024); } while (0)
#define PG8_MMA(ai, bj, At, Bt) do { __builtin_amdgcn_s_setprio(1); _Pragma("unroll") for (int m = 0; m < 4; ++m) _Pragma("unroll") for (int n = 0; n < 2; ++n) _Pragma("unroll") for (int k = 0; k < 2; ++k) \
        acc[ai][bj][m][n] = __builtin_amdgcn_mfma_f32_16x16x32_bf16(Bt[n][k], At[m][k], acc[ai][bj][m][n], 0, 0, 0); __builtin_amdgcn_s_setprio(0); } while (0)
#define PG8_WAIT_V(n) asm volatile("s_waitcnt vmcnt(" #n ")" ::: "memory")
#define PG8_WAIT_L(n) asm volatile("s_waitcnt lgkmcnt(" #n ")" ::: "memory")
#define PG8_BAR __builtin_amdgcn_s_barrier()
#define PG8_SCHED __builtin_amdgcn_sched_barrier(0)
    Unit cur, nxt; int ui = 0;
    if (!S.next(0, cur)) return;
    f32x4 acc[2][2][4][2];
#pragma unroll
    for (int a = 0; a < 2; ++a)
#pragma unroll
        for (int b = 0; b < 2; ++b)
#pragma unroll
            for (int m = 0; m < 4; ++m)
#pragma unroll
                for (int n = 0; n < 2; ++n) acc[a][b][m][n] = (f32x4){0.f, 0.f, 0.f, 0.f};
    bf16x8 At[4][2], B0[2][2], B1[2][2];
    const char* cA = (const char*)g.A + (size_t)cur.pm * tstepA + (size_t)cur.ak * 2; const char* cB = (const char*)g.Bt + (size_t)cur.pn * tstepB;
    if constexpr (SP2) {
        PG8_STAGE(PG8_SB(0, 0), cB, voffB); PG8_STAGE(PG8_SB(0, 1), cB + hstepB, voffB); PG8_STAGE(PG8_SA(0, 0), cA, voffA); PG8_STAGE(PG8_SA(0, 1), cA + hstepA, voffA);
        if (wr == 1) PG8_BAR;
        PG8_WAIT_V(2); PG8_BAR;
        PG8_STAGE(PG8_SB(1, 0), cB + kstep, voffB); PG8_STAGE(PG8_SA(1, 0), cA + kstep, voffA); PG8_STAGE(PG8_SB(1, 1), cB + hstepB + kstep, voffB);
        PG8_WAIT_V(6); PG8_BAR;
    } else {
        PG8_STAGE(PG8_SB(0, 0), cB, voffB); PG8_STAGE(PG8_SA(0, 0), cA, voffA); PG8_STAGE(PG8_SB(0, 1), cB + hstepB, voffB); PG8_STAGE(PG8_SA(0, 1), cA + hstepA, voffA);
        if (wr == 1) PG8_BAR;
        PG8_WAIT_V(4); PG8_BAR;
        PG8_STAGE(PG8_SB(1, 0), cB + kstep, voffB); PG8_STAGE(PG8_SA(1, 0), cA + kstep, voffA); PG8_STAGE(PG8_SB(1, 1), cB + hstepB + kstep, voffB);
        PG8_WAIT_V(6); PG8_BAR;
    }
    for (;;) {
        const bool has_next = S.next(ui + 1, nxt);
        const char* nA = has_next ? (const char*)g.A + (size_t)nxt.pm * tstepA + (size_t)nxt.ak * 2 : cA; const char* nB = has_next ? (const char*)g.Bt + (size_t)nxt.pn * tstepB : cB;
        for (int t = 0; t < nt; t += 2) {
            const bool last = (t == nt - 2);
            const char* a1 = cA + (size_t)(t + 1) * kstep;
            const char* a2 = last ? nA : cA + (size_t)(t + 2) * kstep; const char* b2 = last ? nB : cB + (size_t)(t + 2) * kstep;
            const char* a3 = a2 + kstep; const char* b3 = b2 + kstep;
            if constexpr (SP2) {
            PG8_LDB(B0, 0, 0); PG8_LDB(B1, 0, 1); PG8_SCHED; PG8_LDA(At, 0, 0); PG8_STAGE(PG8_SA(1, 1), a1 + hstepA, voffA);
            PG8_WAIT_V(8); PG8_WAIT_L(0); PG8_BAR; PG8_MMA(0, 0, At, B0); PG8_MMA(0, 1, At, B1); PG8_BAR; PG8_SCHED;
            PG8_LDA(At, 0, 1); PG8_STAGE(PG8_SB(0, 0), b2, voffB); PG8_STAGE(PG8_SB(0, 1), b2 + hstepB, voffB); PG8_STAGE(PG8_SA(0, 0), a2, voffA);
            PG8_WAIT_V(8); PG8_WAIT_L(0); PG8_BAR; PG8_MMA(1, 0, At, B0); PG8_MMA(1, 1, At, B1); PG8_BAR; PG8_SCHED;
            PG8_LDB(B0, 1, 0); PG8_LDB(B1, 1, 1); PG8_SCHED; PG8_LDA(At, 1, 0); PG8_STAGE(PG8_SA(0, 1), a2 + hstepA, voffA);
            PG8_WAIT_V(8); PG8_WAIT_L(0); PG8_BAR; PG8_MMA(0, 0, At, B0); PG8_MMA(0, 1, At, B1); PG8_BAR; PG8_SCHED;
            PG8_LDA(At, 1, 1); PG8_STAGE(PG8_SB(1, 0), b3, voffB); PG8_STAGE(PG8_SB(1, 1), b3 + hstepB, voffB); PG8_STAGE(PG8_SA(1, 0), a3, voffA);
            PG8_WAIT_V(8); PG8_WAIT_L(0); PG8_BAR; PG8_MMA(1, 0, At, B0); PG8_MMA(1, 1, At, B1); PG8_BAR; PG8_SCHED;
            } else {
            PG8_LDB(B0, 0, 0); PG8_SCHED; PG8_LDA(At, 0, 0); PG8_STAGE(PG8_SA(1, 1), a1 + hstepA, voffA);
            PG8_WAIT_L(8); PG8_BAR; PG8_WAIT_L(0); PG8_MMA(0, 0, At, B0); PG8_BAR; PG8_SCHED;
            PG8_LDB(B1, 0, 1); PG8_STAGE(PG8_SB(0, 0), b2, voffB);
            PG8_BAR; PG8_WAIT_L(0); PG8_MMA(0, 1, At, B1); PG8_BAR;
            PG8_LDA(At, 0, 1); PG8_STAGE(PG8_SA(0, 0), a2, voffA);
            PG8_BAR; PG8_WAIT_L(0); PG8_MMA(1, 0, At, B0); PG8_BAR; PG8_SCHED;
            PG8_STAGE(PG8_SB(0, 1), b2 + hstepB, voffB);
            PG8_WAIT_V(6); PG8_BAR; PG8_MMA(1, 1, At, B1); PG8_BAR;
            PG8_LDB(B0, 1, 0); PG8_SCHED; PG8_LDA(At, 1, 0); PG8_STAGE(PG8_SA(0, 1), a2 + hstepA, voffA);
            PG8_WAIT_L(8); PG8_BAR; PG8_WAIT_L(0); PG8_MMA(0, 0, At, B0); PG8_BAR; PG8_SCHED;
            PG8_LDB(B1, 1, 1); PG8_STAGE(PG8_SB(1, 0), b3, voffB);
            PG8_BAR; PG8_WAIT_L(0); PG8_MMA(0, 1, At, B1); PG8_BAR;
            PG8_LDA(At, 1, 1); PG8_STAGE(PG8_SA(1, 0), a3, voffA);
            PG8_BAR; PG8_WAIT_L(0); PG8_MMA(1, 0, At, B0); PG8_BAR; PG8_SCHED;
            PG8_STAGE(PG8_SB(1, 1), b3 + hstepB, voffB);
            PG8_WAIT_V(6); PG8_BAR; PG8_MMA(1, 1, At, B1); PG8_BAR;
            }
        }
        if constexpr (ALIGN_EPI) { if (wr == 0) PG8_BAR; }
        { int vz_; asm volatile("v_mov_b32 %0, 0" : "=v"(vz_)); E(acc, cur, wr, wc, fr + vz_, fq); }
        if (!has_next) break;
#pragma unroll
        for (int a = 0; a < 2; ++a)
#pragma unroll
            for (int b = 0; b < 2; ++b)
#pragma unroll
                for (int m = 0; m < 4; ++m)
#pragma unroll
                    for (int n = 0; n < 2; ++n) acc[a][b][m][n] = (f32x4){0.f, 0.f, 0.f, 0.f};
        cur = nxt; cA = nA; cB = nB; ++ui;
        if constexpr (ALIGN_EPI) { if (wr == 1) PG8_BAR; }
    }
    PG8_WAIT_V(0);
    if constexpr (!ALIGN_EPI) { if (wr == 0) PG8_BAR; }
    PG8_BAR;
#undef PG8_SA
#undef PG8_SB
#undef PG8_STAGE
#undef PG8_LDA
#undef PG8_LDB
#undef PG8_MMA
#undef PG8_WAIT_V
#undef PG8_WAIT_L
#undef PG8_BAR
#undef PG8_SCHED
}

typedef f32x4 Acc[2][2][4][2];
struct EpiBf16 {
    static constexpr bool PERM = true;
    bf16_t* O; int ldc; int ncol;
    __device__ __forceinline__ void operator()(const Acc& acc, const Unit& u, int wr, int wc, int fr, int fq) const {
        const int row0 = u.pm * BM + wr * 64 + fr, col0 = (u.pn % ncol) * BM + wc * 32 + 8 * fq;
#pragma unroll
        for (int ai = 0; ai < 2; ++ai)
#pragma unroll
            for (int m = 0; m < 4; ++m) { bf16_t* rowp = O + (size_t)(row0 + ai * HALF + m * 16) * ldc + col0;
#pragma unroll
                for (int bj = 0; bj < 2; ++bj) { const f32x4 v0 = acc[ai][bj][m][0], v1 = acc[ai][bj][m][1];
                    u32x4 w; w.x = cvt_pk_bf16(v0[0], v0[1]); w.y = cvt_pk_bf16(v0[2], v0[3]); w.z = cvt_pk_bf16(v1[0], v1[1]); w.w = cvt_pk_bf16(v1[2], v1[3]);
                    *(u32x4*)(rowp + bj * HALF) = w; } }
    }
};
struct EpiSwiglu {
    static constexpr bool PERM = true;
    bf16_t* O; int ldc; int ncol;
    __device__ __forceinline__ void operator()(const Acc& acc, const Unit& u, int wr, int wc, int fr, int fq) const {
        const int row0 = u.pm * BM + wr * 64 + fr, col0 = (u.pn % ncol) * HALF + wc * 32 + 8 * fq;
#pragma unroll
        for (int ai = 0; ai < 2; ++ai)
#pragma unroll
            for (int m = 0; m < 4; ++m) { bf16_t* rowp = O + (size_t)(row0 + ai * HALF + m * 16) * ldc + col0;
                float o[8];
#pragma unroll
                for (int n = 0; n < 2; ++n)
#pragma unroll
                    for (int j = 0; j < 4; ++j) o[n * 4 + j] = siluf_(acc[ai][0][m][n][j]) * acc[ai][1][m][n][j];
                u32x4 w; w.x = cvt_pk_bf16(o[0], o[1]); w.y = cvt_pk_bf16(o[2], o[3]); w.z = cvt_pk_bf16(o[4], o[5]); w.w = cvt_pk_bf16(o[6], o[7]);
                *(u32x4*)rowp = w; }
    }
};
struct EpiSigMul {
    static constexpr bool PERM = true;
    bf16_t* O; int ldc; const bf16_t* P; int ldp;
    __device__ __forceinline__ void operator()(const Acc& acc, const Unit& u, int wr, int wc, int fr, int fq) const {
        const int row0 = u.pm * BM + wr * 64 + fr, col0 = u.pn * BM + wc * 32 + 8 * fq;
#pragma unroll
        for (int ai = 0; ai < 2; ++ai)
#pragma unroll
            for (int m = 0; m < 4; ++m) { const size_t r = (size_t)(row0 + ai * HALF + m * 16);
#pragma unroll
                for (int bj = 0; bj < 2; ++bj) { const u32x4 pv = *(const u32x4*)(P + r * ldp + col0 + bj * HALF); const f32x4 v0 = acc[ai][bj][m][0], v1 = acc[ai][bj][m][1];
                    float o[8];
#pragma unroll
                    for (int j = 0; j < 4; ++j) { const unsigned pw = pv[j]; const float plo = __uint_as_float(pw << 16), phi = __uint_as_float(pw & 0xffff0000u);
                        const float a = (j < 2) ? v0[2 * j] : v1[2 * j - 4], b = (j < 2) ? v0[2 * j + 1] : v1[2 * j - 3];
                        o[2 * j] = sigmoidf_(a) * plo; o[2 * j + 1] = sigmoidf_(b) * phi; }
                    u32x4 w; w.x = cvt_pk_bf16(o[0], o[1]); w.y = cvt_pk_bf16(o[2], o[3]); w.z = cvt_pk_bf16(o[4], o[5]); w.w = cvt_pk_bf16(o[6], o[7]);
                    *(u32x4*)(O + r * ldc + col0 + bj * HALF) = w; }
                asm volatile("" ::: "memory"); }
    }
};
struct EpiBranch {
    static constexpr bool PERM = true;
    const bf16_t* Hg; float* tmp; bf16_t* mixb;
    __device__ __forceinline__ void operator()(const Acc& acc, const Unit& u, int wr, int wc, int fr, int fq) const {
        const int n4 = u.pn >> 2, ct = u.pn & 3;
        const int row0 = u.pm * BM + wr * 64 + fr, col0 = ct * BM + wc * 32 + 8 * fq;
#pragma unroll
        for (int ai = 0; ai < 2; ++ai)
#pragma unroll
            for (int m = 0; m < 4; ++m) { const size_t r = (size_t)(row0 + ai * HALF + m * 16);
#pragma unroll
                for (int bj = 0; bj < 2; ++bj) { const int c = col0 + bj * HALF;
                    const u32x4 gv = *(const u32x4*)(Hg + r * HP + n4 * 1024 + c); const f32x4 v0 = acc[ai][bj][m][0], v1 = acc[ai][bj][m][1];
                    float o[8];
#pragma unroll
                    for (int j = 0; j < 4; ++j) { const unsigned gw = gv[j]; const float glo = __uint_as_float(gw << 16), ghi = __uint_as_float(gw & 0xffff0000u);
                        const float a = (j < 2) ? v0[2 * j] : v1[2 * j - 4], b = (j < 2) ? v0[2 * j + 1] : v1[2 * j - 3];
                        o[2 * j] = sigmoidf_(glo) * a; o[2 * j + 1] = sigmoidf_(ghi) * b; }
                    float* tp = tmp + r * 1024 + c;
                    if (n4 > 0) { const f32x4 p0 = *(const f32x4*)tp, p1 = *(const f32x4*)(tp + 4);
#pragma unroll
                        for (int j = 0; j < 4; ++j) { o[j] += p0[j]; o[4 + j] += p1[j]; } }
                    if (n4 < 3) { *(f32x4*)tp = (f32x4){o[0], o[1], o[2], o[3]}; *(f32x4*)(tp + 4) = (f32x4){o[4], o[5], o[6], o[7]}; }
                    else { u32x4 w; w.x = cvt_pk_bf16(o[0], o[1]); w.y = cvt_pk_bf16(o[2], o[3]); w.z = cvt_pk_bf16(o[4], o[5]); w.w = cvt_pk_bf16(o[6], o[7]); *(u32x4*)(mixb + r * 1024 + c) = w; } }
                asm volatile("" ::: "memory"); }
    }
};
struct EpiResid {
    static constexpr bool PERM = false;
    const float* base; float* out; const bf16_t* add;
    __device__ __forceinline__ void operator()(const Acc& acc, const Unit& u, int wr, int wc, int fr, int fq) const {
        const int row0 = u.pm * BM + wr * 64 + fr, col0 = u.pn * BM + wc * 32 + 4 * fq;
#pragma unroll
        for (int ai = 0; ai < 2; ++ai)
#pragma unroll
            for (int m = 0; m < 4; ++m) { const size_t off = (size_t)(row0 + ai * HALF + m * 16) * 1024 + col0;
#pragma unroll
                for (int bj = 0; bj < 2; ++bj)
#pragma unroll
                    for (int n = 0; n < 2; ++n) { const size_t o = off + bj * HALF + n * 16; const f32x4 bs = *(const f32x4*)(base + o); f32x4 v = bs * ALPHA + acc[ai][bj][m][n];
                        if (add) { const u32x2 av = *(const u32x2*)(add + o); v[0] += __uint_as_float(av.x << 16); v[1] += __uint_as_float(av.x & 0xffff0000u); v[2] += __uint_as_float(av.y << 16); v[3] += __uint_as_float(av.y & 0xffff0000u); }
                        *(f32x4*)(out + o) = v; }
                asm volatile("" ::: "memory"); }
    }
};
struct EpiQ {
    static constexpr bool PERM = false;
    bf16_t* Qb; const float* ropeM; const LAS float* rs;
    __device__ __forceinline__ void operator()(const Acc& acc, const Unit& u, int wr, int wc, int fr, int fq) const {
#pragma unroll
        for (int bj = 0; bj < 2; ++bj) { const int gb = u.pn * BM + bj * HALF + wc * 32; if (gb >= 384) continue;
            const int hd = gb / 96, part = (gb % 96) / 32;
#pragma unroll
            for (int ai = 0; ai < 2; ++ai)
#pragma unroll
                for (int m = 0; m < 4; ++m) { const int rl = ai * HALF + wr * 64 + m * 16 + fr, t = u.pm * BM + rl, b = t >> 11, s = t & 2047; const float sc = rs[rl] * QSCALE;
                    f32x4 x1 = acc[ai][bj][m][0] * sc, x2 = acc[ai][bj][m][1] * sc;
                    if (part == 2) { const f32x4 cs = *(const f32x4*)(ropeM + (size_t)t * 32 + 4 * fq), sn = *(const f32x4*)(ropeM + (size_t)t * 32 + 16 + 4 * fq);
                        const f32x4 o1 = x1 * cs - x2 * sn, o2 = x2 * cs + x1 * sn; x1 = o1; x2 = o2; }
                    bf16_t* qp = Qb + ((size_t)((b * 4 + hd) * SEQ + s)) * 96 + part * 32 + 4 * fq;
                    u32x2 w1, w2; w1.x = cvt_pk_bf16(x1[0], x1[1]); w1.y = cvt_pk_bf16(x1[2], x1[3]); w2.x = cvt_pk_bf16(x2[0], x2[1]); w2.y = cvt_pk_bf16(x2[2], x2[3]);
                    *(u32x2*)qp = w1; *(u32x2*)(qp + 16) = w2; asm volatile("" ::: "memory"); } }
    }
};
struct EpiKV {
    static constexpr bool PERM = false;
    bf16_t* Kb; bf16_t* Vt; const LAS float* rs;
    __device__ __forceinline__ void operator()(const Acc& acc, const Unit& u, int wr, int wc, int fr, int fq) const {
#pragma unroll
        for (int bj = 0; bj < 2; ++bj) { const int gb = u.pn * BM + bj * HALF + wc * 32; const int hd = gb / 128, part = (gb % 128) / 32;
#pragma unroll
            for (int ai = 0; ai < 2; ++ai)
#pragma unroll
                for (int m = 0; m < 4; ++m) { const int rl = ai * HALF + wr * 64 + m * 16 + fr, t = u.pm * BM + rl, b = t >> 11, s = t & 2047; const float sc = rs[rl];
                    const f32x4 x1 = acc[ai][bj][m][0] * sc, x2 = acc[ai][bj][m][1] * sc;
                    if (part < 2) { bf16_t* kp = Kb + ((size_t)((b * 4 + hd) * SEQ + s)) * 96 + part * 32 + 4 * fq;
                        u32x2 w1, w2; w1.x = cvt_pk_bf16(x1[0], x1[1]); w1.y = cvt_pk_bf16(x1[2], x1[3]); w2.x = cvt_pk_bf16(x2[0], x2[1]); w2.y = cvt_pk_bf16(x2[2], x2[3]);
                        *(u32x2*)kp = w1; *(u32x2*)(kp + 16) = w2; }
                    else { bf16_t* vp = Vt + ((size_t)((b * 4 + hd) * 64 + (part - 2) * 32 + 4 * fq)) * SEQ + s;
#pragma unroll
                        for (int j = 0; j < 4; ++j) { vp[(size_t)j * SEQ] = f2bf(x1[j]); vp[(size_t)(16 + j) * SEQ] = f2bf(x2[j]); } }
                    asm volatile("" ::: "memory"); } }
    }
};
}

#define XB_TMO      128
#define XB_XCNT(j)  (256  + 64 * (j))
#define XB_XSUB(j)  (1280 + 64 * (j))
#define XB_XGEN(j)  (2304 + 64 * (j))
#define XB_TOP      3328
#define XB_TOPGEN   3392
#define XCD_BAR_WORDS 3456
#define XB_SPIN_CAP (1u << 18)
__device__ __forceinline__ unsigned xb_ld(unsigned* p)              { return __hip_atomic_load(p, __ATOMIC_RELAXED, __HIP_MEMORY_SCOPE_AGENT); }
__device__ __forceinline__ unsigned xb_add(unsigned* p, unsigned v) { return __hip_atomic_fetch_add(p, v, __ATOMIC_RELAXED, __HIP_MEMORY_SCOPE_AGENT); }
__device__ __forceinline__ unsigned xb_xcc_id() { return (unsigned)__builtin_amdgcn_s_getreg((3 << 11) | 20) & 0xFu; }
#define XB_SPIN(cond, bar) do { unsigned _sp = 0; while (cond) { __builtin_amdgcn_s_sleep(1); \
    if ((++_sp & 255u) == 0u) { if (xb_ld(&(bar)[XB_TMO])) break; if (_sp > XB_SPIN_CAP) { atomicAdd(&(bar)[XB_TMO], 1u); break; } } } } while (0)
struct XcdBarrier { unsigned* bar; unsigned x; volatile LAS unsigned* st; };
__device__ __forceinline__ XcdBarrier xcd_barrier_post(unsigned* bar, volatile LAS unsigned* st) {
    XcdBarrier b; b.bar = bar; b.x = xb_xcc_id(); b.st = st;
    if (threadIdx.x == 0) (void)xb_add(&bar[XB_XCNT(b.x)], 1u);
    return b;
}
__device__ __forceinline__ void xcd_barrier_complete(unsigned* bar, unsigned x, unsigned& nloc, unsigned& nx) {
    const unsigned G = gridDim.x * gridDim.y * gridDim.z;
    unsigned sum, cnt, mine, sp = 0u;
    for (;;) {
        sum = 0u; cnt = 0u; mine = 0u;
#pragma unroll
        for (unsigned j = 0; j < 16; ++j) { const unsigned c = xb_ld(&bar[XB_XCNT(j)]); sum += c; cnt += (c > 0u) ? 1u : 0u; mine = (j == x) ? c : mine; }
        if (sum == G) break;
        __builtin_amdgcn_s_sleep(1);
        if ((++sp & 255u) == 0u) { if (xb_ld(&bar[XB_TMO])) break; if (sp > XB_SPIN_CAP) { atomicAdd(&bar[XB_TMO], 1u); break; } }
    }
    nloc = mine > 0u ? mine : 1u; nx = cnt > 0u ? cnt : 1u;
}
__device__ __forceinline__ void xcd_barrier(const XcdBarrier& b) {
    asm volatile("s_waitcnt vmcnt(0)" ::: "memory");
    __syncthreads();
    if (threadIdx.x == 0) {
        unsigned* bar = b.bar;
        __builtin_amdgcn_s_waitcnt(0);
        unsigned nloc = b.st[0], nx = b.st[1];
        if (nloc == 0u) { xcd_barrier_complete(bar, b.x, nloc, nx); b.st[0] = nloc; b.st[1] = nx; }
        const unsigned old = xb_add(&bar[XB_XSUB(b.x)], 1u);
        const unsigned gen = old / nloc;
        if (old + 1u == (gen + 1u) * nloc) {
            __builtin_amdgcn_fence(__ATOMIC_RELEASE, "agent");
            asm volatile("s_waitcnt vmcnt(0)" ::: "memory");
            const unsigned og = xb_add(&bar[XB_TOP], 1u);
            const unsigned tg = og / nx;
            if (og + 1u == (tg + 1u) * nx) xb_add(&bar[XB_TOPGEN], 1u);
            else XB_SPIN(xb_ld(&bar[XB_TOPGEN]) == tg, bar);
            __builtin_amdgcn_fence(__ATOMIC_ACQUIRE, "agent");
            xb_add(&bar[XB_XGEN(b.x)], 1u);
            asm volatile("s_waitcnt vmcnt(0)" ::: "memory");
        } else {
            XB_SPIN(xb_ld(&bar[XB_XGEN(b.x)]) == gen, bar);
            __builtin_amdgcn_fence(__ATOMIC_ACQUIRE, "agent");
            asm volatile("s_waitcnt vmcnt(0)" ::: "memory");
        }
    }
    __syncthreads();
}

__device__ __forceinline__ int vzero() { int z; asm volatile("v_mov_b32 %0, 0" : "=v"(z)); return z; }
__device__ __forceinline__ int opaque0() { int z; asm volatile("s_mov_b32 %0, 0" : "=s"(z)); return z; }
struct Args { const void* in[36]; float* out; unsigned char* ws; int ph_lo, ph_hi; };
struct Frame {
    LAS unsigned char* lds;
    unsigned char* ws;
    const void* const* in;
    float* out;
    int tid, lane, wave, G, bid, gw, NGW;
};
__device__ __forceinline__ Frame reframe(const Frame& F) {
    Frame P = F; const int z = opaque0(), vz = vzero();
    P.ws = F.ws + z; P.out = F.out + z; P.lds = F.lds + z; P.bid = F.bid + z; P.G = F.G + z; P.wave = F.wave + z; P.gw = P.bid * 8 + P.wave; P.NGW = P.G * 8; P.tid = F.tid + vz; P.lane = F.lane + vz;
    return P;
}
#define IN_F(k) ((const float*)F.in[k])
#define WSP(T_, off) ((T_*)(F.ws + (off)))

__device__ __forceinline__ void tr_item(const float* W, int N, bf16_t* WT, int ldd, int drow0, int k0, int n0, const float* kscale, LAS float* scr, int lane) {
#pragma unroll 8
    for (int i = 0; i < 32; ++i) { const int kk = 2 * i + (lane >> 5); scr[kk * 33 + (lane & 31)] = W[(size_t)(k0 + kk) * N + n0 + (lane & 31)]; }
    WSYNC();
    const int c = lane & 7;
    float ks[8];
#pragma unroll
    for (int q = 0; q < 8; ++q) ks[q] = kscale ? kscale[k0 + 8 * c + q] : 1.0f;
#pragma unroll
    for (int j = 0; j < 4; ++j) { const int n = (lane >> 3) + 8 * j; const LAS float* s = scr + (8 * c) * 33 + n;
        u32x4 o; o.x = cvt_pk_bf16(s[0 * 33] * ks[0], s[1 * 33] * ks[1]); o.y = cvt_pk_bf16(s[2 * 33] * ks[2], s[3 * 33] * ks[3]); o.z = cvt_pk_bf16(s[4 * 33] * ks[4], s[5 * 33] * ks[5]); o.w = cvt_pk_bf16(s[6 * 33] * ks[6], s[7 * 33] * ks[7]);
        *(u32x4*)(WT + (size_t)(drow0 + n) * ldd + k0 + 8 * c) = o; }
    WSYNC();
}
__device__ __forceinline__ int win_map(int n) {
    if (n < 448) return n;
    if (n < 576) return C_CKV + (n - 448);
    if (n < 608) return C_KR + (n - 576);
    return C_HQ + (n - 608);
}
template <int MAP>
__device__ __forceinline__ bool tr_job(int& r, const float* W, int batch, int K, int N, bf16_t* dst, size_t dstride, int ldd, const float* kscale, int ksstride, LAS float* scr, int lane) {
    const int nkb = K / 64, nnb = N / 32, per = nkb * nnb, total = per * batch;
    if (r >= total) { r -= total; return false; }
    const int bi = r / per, q = r % per, kb = q / nnb, nb = q % nnb, n0 = nb * 32;
    int drow0;
    if (MAP == 0) drow0 = n0; else if (MAP == 1) drow0 = win_map(n0); else drow0 = (n0 >> 7) * 256 + (n0 & 127) + (MAP == 3 ? 128 : 0);
    tr_item(W + (size_t)bi * K * N, N, dst + (size_t)bi * dstride, ldd, drow0, kb * 64, n0, kscale ? kscale + bi * ksstride : nullptr, scr, lane);
    return true;
}
__device__ __forceinline__ void p0_prologue(const Frame& F) {
    LAS float* scr = (LAS float*)(F.lds + LDS_STAGE + F.wave * 16384);
    const int lane = F.lane;
    constexpr int NITEMS = 4 * 16 * 211 + 4 * 4 * 8 + 4 * 3 * 12 + 4 * 2 * 16 + 16 * 4 * 32 + 4 * 16 * 32 + 2 * 2 * 16 * 112 + 2 * 56 * 32 + 2 * 16 * 16 * 112 + 16 * 56 * 32 + 4 * 16 * 32 + 4 * 4 * 32;
    for (int it = F.gw; it < NITEMS; it += F.NGW) {
        int r = it;
        if (tr_job<2>(r, IN_F(29), 16, 1024, DFF, WSP(bf16_t, WS_WMU), (size_t)7168 * 1024, 1024, nullptr, 0, scr, lane)) continue;
        if (tr_job<3>(r, IN_F(30), 16, 1024, DFF, WSP(bf16_t, WS_WMU), (size_t)7168 * 1024, 1024, nullptr, 0, scr, lane)) continue;
        if (tr_job<0>(r, IN_F(31), 16, DFF, 1024, WSP(bf16_t, WS_WMD), (size_t)1024 * DFF, DFF, nullptr, 0, scr, lane)) continue;
        if (tr_job<1>(r, IN_F(3), 4, 1024, 6752, WSP(bf16_t, WS_WIN), (size_t)HP * 1024, 1024, nullptr, 0, scr, lane)) continue;
        if (tr_job<2>(r, IN_F(25), 2, 1024, DFF, WSP(bf16_t, WS_WFFU), (size_t)7168 * 1024, 1024, nullptr, 0, scr, lane)) continue;
        if (tr_job<3>(r, IN_F(26), 2, 1024, DFF, WSP(bf16_t, WS_WFFU), (size_t)7168 * 1024, 1024, nullptr, 0, scr, lane)) continue;
        if (tr_job<0>(r, IN_F(27), 2, DFF, 1024, WSP(bf16_t, WS_WFFD), (size_t)1024 * DFF, DFF, nullptr, 0, scr, lane)) continue;
        if (tr_job<0>(r, IN_F(21), 16, 256, 1024, WSP(bf16_t, WS_WB), (size_t)1024 * 256, 256, nullptr, 0, scr, lane)) continue;
        if (tr_job<0>(r, IN_F(22), 4, 1024, 1024, WSP(bf16_t, WS_WO), (size_t)1024 * 1024, 1024, nullptr, 0, scr, lane)) continue;
        if (tr_job<0>(r, IN_F(32), 4, 1024, 1024, WSP(bf16_t, WS_WPG), (size_t)1024 * 1024, 1024, nullptr, 0, scr, lane)) continue;
        if (tr_job<0>(r, IN_F(33), 4, 256, 1024, WSP(bf16_t, WS_WPP), (size_t)1024 * 256, 256, nullptr, 0, scr, lane)) continue;
        if (tr_job<0>(r, IN_F(12), 4, 256, 256, WSP(bf16_t, WS_WGLU), (size_t)256 * 256, 256, nullptr, 0, scr, lane)) continue;
        if (tr_job<0>(r, IN_F(15), 4, 192, 384, WSP(bf16_t, WS_WUQ), (size_t)512 * 256, 256, IN_F(13), 192, scr, lane)) continue;
        tr_job<0>(r, IN_F(16), 4, 128, 512, WSP(bf16_t, WS_WUKV), (size_t)512 * 256, 256, IN_F(14), 128, scr, lane);
    }
    const int gt = F.bid * 512 + F.tid, NT_ = F.G * 512;
    { bf16_t* uq = WSP(bf16_t, WS_WUQ); bf16_t* ukv = WSP(bf16_t, WS_WUKV);
      for (int i = gt; i < 4 * 512 * 256; i += NT_) { const int n = (i >> 8) & 511, k = i & 255; if (n >= 384 || k >= 192) uq[i] = 0; if (k >= 128) ukv[i] = 0; }
      bf16_t* win = WSP(bf16_t, WS_WIN);
      for (int i = gt; i < 4 * 160 * 1024; i += NT_) { const int l = i / (160 * 1024), q = i % (160 * 1024), rr = q >> 10, k = q & 1023; const int row = rr < 64 ? 448 + rr : 672 + (rr - 64); win[((size_t)l * HP + row) * 1024 + k] = 0; } }
    { const f32x4* x4 = (const f32x4*)IN_F(0); u32x2* xb = WSP(u32x2, WS_XB);
      for (int i = gt; i < T * D / 4; i += NT_) { const f32x4 v = x4[i]; u32x2 w; w.x = cvt_pk_bf16(v[0], v[1]); w.y = cvt_pk_bf16(v[2], v[3]); xb[i] = w; }
      const f32x4* p4 = (const f32x4*)IN_F(1); u32x2* pb = WSP(u32x2, WS_PB);
      for (int i = gt; i < DEPTH * T * 256 / 4; i += NT_) { const f32x4 v = p4[i]; u32x2 w; w.x = cvt_pk_bf16(v[0], v[1]); w.y = cvt_pk_bf16(v[2], v[3]); pb[i] = w; } }
    { const int* pos = (const int*)F.in[2]; float* rm = WSP(float, WS_ROPEM); float* rr = WSP(float, WS_ROPER);
      for (int i = gt; i < T * 48; i += NT_) { const int t = i / 48, j = i % 48; const bool isM = j < 16; const int jj = isM ? j : j - 16; const float half = isM ? 16.f : 32.f;
          const float inv = exp2f(-(float)jj / half * 13.287712379549449f);
          const float ang = (float)pos[t] * inv;
          const double ad = (double)ang, k2 = __builtin_rint(ad * 0.15915494309189535); const float red = (float)(ad - k2 * 6.283185307179586);
          const float c = __cosf(red), s = __sinf(red);
          if (isM) { rm[t * 32 + jj] = c; rm[t * 32 + 16 + jj] = s; } else { rr[t * 64 + jj] = c; rr[t * 64 + 32 + jj] = s; } } }
    { float* abar = (float*)(F.ws + WS_S5P + S5P_ABAR); bf16_t* Bm = (bf16_t*)(F.ws + WS_S5P + S5P_BM); bf16_t* Cm = (bf16_t*)(F.ws + WS_S5P + S5P_CM);
      for (int i = gt; i < DEPTH * 16 * 64; i += NT_) { const int lg = i >> 6, p = i & 63;
          const float dt = __expf(IN_F(6)[lg]), lr = IN_F(4)[i], li = IN_F(5)[i];
          const float mag = __expf(lr * dt); const double ad = (double)(li * dt), k2 = __builtin_rint(ad * 0.15915494309189535); const float red = (float)(ad - k2 * 6.283185307179586);
          const float are = mag * __cosf(red), aim = mag * __sinf(red);
          abar[i * 2] = are; abar[i * 2 + 1] = aim;
          const float den = lr * lr + li * li, nre = are - 1.0f, nim = aim;
          const float cre = (nre * lr + nim * li) / den, cim = (nim * lr - nre * li) / den;
          const float* br = IN_F(7) + (size_t)i * 16; const float* bi = IN_F(8) + (size_t)i * 16;
#pragma unroll
          for (int c = 0; c < 16; ++c) { Bm[((size_t)lg * 128 + p) * 16 + c] = f2bf(cre * br[c] - cim * bi[c]); Bm[((size_t)lg * 128 + 64 + p) * 16 + c] = f2bf(cre * bi[c] + cim * br[c]); }
#pragma unroll
          for (int c = 0; c < 16; ++c) { Cm[((size_t)lg * 16 + c) * 128 + p] = f2bf(IN_F(9)[((size_t)lg * 16 + c) * 64 + p]); Cm[((size_t)lg * 16 + c) * 128 + 64 + p] = f2bf(-IN_F(10)[((size_t)lg * 16 + c) * 64 + p]); } }
      float* lb = (float*)(F.ws + WS_S5P + S5P_LB);
      for (int i = gt; i < 256; i += NT_) { float r0 = IN_F(17)[i], r1 = IN_F(17)[256 + i], r2 = IN_F(17)[512 + i], r3 = IN_F(17)[768 + i]; const float mx = fmaxf(fmaxf(r0, r1), fmaxf(r2, r3));
          const float e0 = __expf(r0 - mx), e1 = __expf(r1 - mx), e2 = __expf(r2 - mx), e3 = __expf(r3 - mx), s = e0 + e1 + e2 + e3;
          lb[i] = 0.f; lb[256 + i] = e1 / s; lb[512 + i] = (e1 + e2) / s; lb[768 + i] = (e1 + e2 + e3) / s; } }
}

template <bool OUT>
__device__ __forceinline__ void s5_item(const Frame& F, int layer, int idx, LAS unsigned char* scr) {
    const int lane = F.lane + vzero(), r16 = lane & 15, g4 = lane >> 4;
    const int bg = idx >> 5, n = idx & 31, b = bg >> 4, g = bg & 15;
    LAS float* bu = (LAS float*)scr;
    LAS bf16_t* xs = (LAS bf16_t*)(scr + 8448);
    const float* abar = (const float*)(F.ws + WS_S5P + S5P_ABAR) + ((size_t)(layer * 16 + g) * 64 + lane) * 2;
    const float ar = abar[0], ai = abar[1];
    const bf16_t* Bm = (const bf16_t*)(F.ws + WS_S5P + S5P_BM) + (size_t)(layer * 16 + g) * 128 * 16;
    const bf16_t* Cm = (const bf16_t*)(F.ws + WS_S5P + S5P_CM) + (size_t)(layer * 16 + g) * 16 * 128;
    const bf16_t* H = WSP(const bf16_t, WS_H);
    Frag zf; zf.q = (u32x4){0u, 0u, 0u, 0u};
    bf16x8 bfr[8];
#pragma unroll
    for (int nb = 0; nb < 8; ++nb) bfr[nb] = (g4 < 2) ? *(const bf16x8*)(Bm + (nb * 16 + r16) * 16 + 8 * g4) : zf.v;
    bf16x8 cfr[4];
    if (OUT) {
#pragma unroll
        for (int ks = 0; ks < 4; ++ks) cfr[ks] = *(const bf16x8*)(Cm + r16 * 128 + 32 * ks + 8 * g4); }
    float xr = 0.f, xi = 0.f;
    if (OUT) { const float* ci = WSP(const float, WS_S5C) + ((size_t)(bg * 32 + n) * 64 + lane) * 2; xr = ci[0]; xi = ci[1]; }
    const float dsk = OUT ? IN_F(11)[layer * 256 + g * 16 + r16] : 0.f;
    const size_t tok0 = (size_t)b * SEQ + n * 64;
#pragma unroll 1
    for (int sub = 0; sub < 4; ++sub) {
        const size_t t0 = tok0 + sub * 16;
        const bf16x8 afr = (g4 < 2) ? *(const bf16x8*)(H + (t0 + r16) * HP + C_US5 + g * 16 + 8 * g4) : zf.v;
#pragma unroll
        for (int nb = 0; nb < 8; ++nb) { const f32x4 c = mfma16(afr, bfr[nb], (f32x4){0.f, 0.f, 0.f, 0.f});
#pragma unroll
            for (int r = 0; r < 4; ++r) bu[(4 * g4 + r) * 132 + nb * 16 + r16] = c[r]; }
        WSYNC();
#pragma unroll
        for (int tk = 0; tk < 16; ++tk) { const float bre = bu[tk * 132 + lane], bim = bu[tk * 132 + 64 + lane];
            const float nr = ar * xr - ai * xi + bre, ni = ar * xi + ai * xr + bim; xr = nr; xi = ni;
            if (OUT) { xs[tk * 136 + lane] = f2bf(xr); xs[tk * 136 + 64 + lane] = f2bf(xi); } }
        if (OUT) {
            WSYNC();
            f32x4 y = (f32x4){0.f, 0.f, 0.f, 0.f};
#pragma unroll
            for (int ks = 0; ks < 4; ++ks) { const bf16x8 a = *(const LAS bf16x8*)(xs + r16 * 136 + 32 * ks + 8 * g4); y = mfma16(a, cfr[ks], y); }
            bf16_t* pre = WSP(bf16_t, WS_S5PRE);
#pragma unroll
            for (int r = 0; r < 4; ++r) { const size_t t = t0 + 4 * g4 + r; const float u = bf2f(H[t * HP + C_US5 + g * 16 + r16]); pre[t * 256 + g * 16 + r16] = f2bf(gelu_tanh(y[r] + dsk * u)); }
        }
        WSYNC();
    }
    if (!OUT) { float* e = WSP(float, WS_S5E) + ((size_t)(bg * 32 + n) * 64 + lane) * 2; e[0] = xr; e[1] = xi; }
}
__device__ __forceinline__ void s5_carry(const Frame& F, int layer) {
    const int gt = F.bid * 512 + F.tid;
    if (gt >= NBATCH * 16 * 64) return;
    const int bg = gt >> 6, p = gt & 63, g = bg & 15;
    const float* abar = (const float*)(F.ws + WS_S5P + S5P_ABAR) + ((size_t)(layer * 16 + g) * 64 + p) * 2;
    float pr = abar[0], pi = abar[1];
#pragma unroll
    for (int i = 0; i < 6; ++i) { const float nr = pr * pr - pi * pi, ni = 2.f * pr * pi; pr = nr; pi = ni; }
    const float* E = WSP(const float, WS_S5E); float* C = WSP(float, WS_S5C);
    float cr = 0.f, ci = 0.f;
#pragma unroll 1
    for (int n = 0; n < 32; ++n) { const size_t o = ((size_t)(bg * 32 + n) * 64 + p) * 2; C[o] = cr; C[o + 1] = ci;
        const float er = E[o], ei = E[o + 1]; const float nr = pr * cr - pi * ci + er, ni = pr * ci + pi * cr + ei; cr = nr; ci = ni; }
}

template <bool OUT>
__device__ __forceinline__ void hg_item(const Frame& F, int layer, int idx, LAS unsigned char* scr) {
    const int lane = F.lane + vzero(), r16 = lane & 15, g4 = lane >> 4;
    const int bh = idx >> 5, sc = idx & 31, b = bh >> 2, h = bh & 3;
    LAS bf16_t* Qt = (LAS bf16_t*)scr;
    LAS bf16_t* Kt = (LAS bf16_t*)(scr + 2304);
    LAS bf16_t* Kh = (LAS bf16_t*)(scr + 4608);
    LAS bf16_t* Vs = (LAS bf16_t*)(scr + 6656);
    LAS float* dec = (LAS float*)(scr + 8704);
    const bf16_t* H = WSP(const bf16_t, WS_H);
    const float lbv = ((const float*)(F.ws + WS_S5P + S5P_LB))[layer * 256 + h * 64 + lane], oml = 1.0f - lbv;
    f32x4 S[4][4];
    if (OUT) { const float* si = WSP(const float, WS_HGI) + (size_t)(bh * 32 + sc) * 4096;
#pragma unroll
        for (int mb = 0; mb < 4; ++mb)
#pragma unroll
            for (int vb = 0; vb < 4; ++vb)
#pragma unroll
                for (int r = 0; r < 4; ++r) S[mb][vb][r] = si[(16 * mb + 4 * g4 + r) * 64 + 16 * vb + r16];
    } else {
#pragma unroll
        for (int mb = 0; mb < 4; ++mb)
#pragma unroll
            for (int vb = 0; vb < 4; ++vb) S[mb][vb] = (f32x4){0.f, 0.f, 0.f, 0.f};
    }
    float ltot = 0.f;
#pragma unroll 1
    for (int ch = 0; ch < 4; ++ch) {
        const size_t t0 = (size_t)b * SEQ + sc * 64 + ch * 16;
        float kk[16], bc[16]; float bcum = 0.f;
#pragma unroll
        for (int tk = 0; tk < 16; ++tk) { const bf16_t* row = H + (t0 + tk) * HP + h * 64 + lane;
            const float fv = bf2f(row[C_HF]); const bf16_t ivb = row[C_HI];
            const float ef = __expf(-fv), sg = 1.0f / (1.0f + ef); const float forget = lbv + oml * sg; bcum += __logf(forget);
            const float kv_ = oml * (1.0f - sg) ;
            kk[tk] = kv_; bc[tk] = bcum;
            if (OUT) { const float qv = bf2f(row[C_HQ]); const float q = siluf_(qv); Qt[tk * 72 + lane] = f2bf(q * __expf(bcum)); Kt[tk * 72 + lane] = f2bf(kv_ * __expf(-bcum)); }
            Vs[tk * 64 + lane] = ivb; }
#pragma unroll
        for (int tk = 0; tk < 16; ++tk) Kh[tk * 64 + lane] = f2bf(kk[tk] * __expf(bcum - bc[tk]));
        dec[lane] = __expf(bcum); ltot += bcum;
        WSYNC();
        Frag vfr[4], kfr[4];
#pragma unroll
        for (int vb = 0; vb < 4; ++vb) { vfr[vb].q = (u32x4){0u, 0u, 0u, 0u};
#pragma unroll
            for (int j = 0; j < 4; ++j) vfr[vb].h[j] = Vs[(4 * g4 + j) * 64 + 16 * vb + r16]; }
#pragma unroll
        for (int mb = 0; mb < 4; ++mb) { kfr[mb].q = (u32x4){0u, 0u, 0u, 0u};
#pragma unroll
            for (int j = 0; j < 4; ++j) kfr[mb].h[j] = Kh[(4 * g4 + j) * 64 + 16 * mb + r16]; }
        if (OUT) {
            f32x4 at = (f32x4){0.f, 0.f, 0.f, 0.f};
#pragma unroll
            for (int ks = 0; ks < 2; ++ks) { const bf16x8 a = *(const LAS bf16x8*)(Kt + r16 * 72 + 32 * ks + 8 * g4), bq = *(const LAS bf16x8*)(Qt + r16 * 72 + 32 * ks + 8 * g4); at = mfma16(a, bq, at); }
#pragma unroll
            for (int r = 0; r < 4; ++r) if (4 * g4 + r > r16) at[r] = 0.f;
            Frag pfr; pfr.q = (u32x4){0u, 0u, 0u, 0u}; pfr.u[0] = cvt_pk_bf16(at[0], at[1]); pfr.u[1] = cvt_pk_bf16(at[2], at[3]);
            Frag qfr[2];
#pragma unroll
            for (int ks = 0; ks < 2; ++ks) { qfr[ks].d[0] = *(const LAS u32x2*)(Qt + r16 * 72 + 32 * ks + 4 * g4); qfr[ks].d[1] = *(const LAS u32x2*)(Qt + r16 * 72 + 32 * ks + 16 + 4 * g4); }
            f32x4 o[4]; float ss = 0.f;
#pragma unroll
            for (int vb = 0; vb < 4; ++vb) { f32x4 a = (f32x4){0.f, 0.f, 0.f, 0.f};
#pragma unroll
                for (int ks = 0; ks < 2; ++ks) { Frag sf; sf.u[0] = cvt_pk_bf16(S[2 * ks][vb][0], S[2 * ks][vb][1]); sf.u[1] = cvt_pk_bf16(S[2 * ks][vb][2], S[2 * ks][vb][3]);
                    sf.u[2] = cvt_pk_bf16(S[2 * ks + 1][vb][0], S[2 * ks + 1][vb][1]); sf.u[3] = cvt_pk_bf16(S[2 * ks + 1][vb][2], S[2 * ks + 1][vb][3]); a = mfma16(sf.v, qfr[ks].v, a); }
                a = mfma16(vfr[vb].v, pfr.v, a); o[vb] = a; ss += a[0] * a[0] + a[1] * a[1] + a[2] * a[2] + a[3] * a[3]; }
            ss += __shfl_xor(ss, 16); ss += __shfl_xor(ss, 32);
            const float rs = rsqrtf(ss * (1.0f / 64.0f) + EPS);
            const size_t t = t0 + r16; bf16_t* Y = WSP(bf16_t, WS_Y);
#pragma unroll
            for (int vb = 0; vb < 4; ++vb) { const int vi0 = h * 64 + 16 * vb + 4 * g4; const u32x2 gv = *(const u32x2*)(H + t * HP + C_HG + vi0); const f32x4 ng = *(const f32x4*)(IN_F(18) + layer * 256 + vi0);
                const float g0 = __uint_as_float(gv.x << 16), g1 = __uint_as_float(gv.x & 0xffff0000u), g2 = __uint_as_float(gv.y << 16), g3 = __uint_as_float(gv.y & 0xffff0000u);
                u32x2 w; w.x = cvt_pk_bf16(o[vb][0] * rs * ng[0] * siluf_(g0), o[vb][1] * rs * ng[1] * siluf_(g1)); w.y = cvt_pk_bf16(o[vb][2] * rs * ng[2] * siluf_(g2), o[vb][3] * rs * ng[3] * siluf_(g3));
                *(u32x2*)(Y + t * 1024 + 512 + vi0) = w; }
        }
#pragma unroll
        for (int mb = 0; mb < 4; ++mb) { const f32x4 dv = *(const LAS f32x4*)(dec + 16 * mb + 4 * g4);
#pragma unroll
            for (int vb = 0; vb < 4; ++vb) S[mb][vb] = mfma16(kfr[mb].v, vfr[vb].v, S[mb][vb] * dv); }
        WSYNC();
    }
    if (!OUT) { float* se = WSP(float, WS_HGE) + (size_t)(bh * 32 + sc) * 4096;
#pragma unroll
        for (int mb = 0; mb < 4; ++mb)
#pragma unroll
            for (int vb = 0; vb < 4; ++vb)
#pragma unroll
                for (int r = 0; r < 4; ++r) se[(16 * mb + 4 * g4 + r) * 64 + 16 * vb + r16] = S[mb][vb][r];
        WSP(float, WS_HGD)[(size_t)(bh * 32 + sc) * 64 + lane] = __expf(ltot); }
}
__device__ __forceinline__ void hg_carry(const Frame& F) {
    const int gt = F.bid * 512 + F.tid; if (gt >= 32 * 4096) return;
    const int bh = gt >> 12, kv = gt & 4095, k = kv >> 6;
    const float* E = WSP(const float, WS_HGE); const float* Dt = WSP(const float, WS_HGD); float* I = WSP(float, WS_HGI);
    float s = 0.f;
#pragma unroll 2
    for (int sc = 0; sc < 32; ++sc) { const size_t o = (size_t)(bh * 32 + sc) * 4096 + kv; I[o] = s; s = Dt[(size_t)(bh * 32 + sc) * 64 + k] * s + E[o]; }
}

__device__ __forceinline__ float ret_l2g(int h) { return __log2f(1.0f - exp2f(-5.0f - (float)h)); }
__device__ __forceinline__ void ret_item1(const Frame& F, int idx, LAS unsigned char* scr) {
    const int lane = F.lane + vzero(), r16 = lane & 15, g4 = lane >> 4;
    const int bh = idx >> 5, n = idx & 31, b = bh >> 2, h = bh & 3;
    LAS bf16_t* Kd = (LAS bf16_t*)scr;
    LAS bf16_t* Vs = (LAS bf16_t*)(scr + 8192);
    const bf16_t* H = WSP(const bf16_t, WS_H); const float* rope = WSP(const float, WS_ROPER);
    bf16_t* QR = WSP(bf16_t, WS_QR); bf16_t* KR = WSP(bf16_t, WS_KR);
    const float l2g = ret_l2g(h);
    const size_t t0 = (size_t)b * SEQ + n * 64;
#pragma unroll 2
    for (int tk = 0; tk < 64; ++tk) { const size_t t = t0 + tk; const bf16_t* row = H + t * HP + h * 64 + lane;
        const float kx = bf2f(row[C_RK]), qx = bf2f(row[C_RQ]); const float kp = __shfl_xor(kx, 32), qp = __shfl_xor(qx, 32);
        const float c = rope[t * 64 + (lane & 31)], s = rope[t * 64 + 32 + (lane & 31)];
        const float kh = lane < 32 ? kx * c - kp * s : kx * c + kp * s, qh = (lane < 32 ? qx * c - qp * s : qx * c + qp * s) * 0.125f;
        KR[t * 256 + h * 64 + lane] = f2bf(kh); QR[t * 256 + h * 64 + lane] = f2bf(qh);
        Kd[tk * 64 + lane] = f2bf(kh * exp2f((float)(63 - tk) * l2g)); Vs[tk * 64 + lane] = row[C_RV]; }
    WSYNC();
    Frag vfr[4][2];
#pragma unroll
    for (int vb = 0; vb < 4; ++vb)
#pragma unroll
        for (int ks = 0; ks < 2; ++ks)
#pragma unroll
            for (int j = 0; j < 8; ++j) vfr[vb][ks].h[j] = Vs[(32 * ks + 8 * g4 + j) * 64 + 16 * vb + r16];
    float* E = WSP(float, WS_RTE) + (size_t)(bh * 32 + n) * 4096;
#pragma unroll
    for (int mb = 0; mb < 4; ++mb) { Frag kf[2];
#pragma unroll
        for (int ks = 0; ks < 2; ++ks)
#pragma unroll
            for (int j = 0; j < 8; ++j) kf[ks].h[j] = Kd[(32 * ks + 8 * g4 + j) * 64 + 16 * mb + r16];
#pragma unroll
        for (int vb = 0; vb < 4; ++vb) { f32x4 a = (f32x4){0.f, 0.f, 0.f, 0.f};
#pragma unroll
            for (int ks = 0; ks < 2; ++ks) a = mfma16(kf[ks].v, vfr[vb][ks].v, a);
            *(f32x4*)(E + (16 * vb + r16) * 64 + 16 * mb + 4 * g4) = a; } }
    WSYNC();
}
__device__ __forceinline__ void ret_carry(const Frame& F) {
    const int gt = F.bid * 512 + F.tid; if (gt >= 32 * 4096) return;
    const int bh = gt >> 12, vk = gt & 4095, h = bh & 3;
    const float g64 = exp2f(64.0f * ret_l2g(h));
    const float* E = WSP(const float, WS_RTE); float* I = WSP(float, WS_RTI);
    float s = 0.f;
#pragma unroll 2
    for (int n = 0; n < 32; ++n) { const size_t o = (size_t)(bh * 32 + n) * 4096 + vk; I[o] = s; s = g64 * s + E[o]; }
}
__device__ __forceinline__ void ret_item3(const Frame& F, int layer, int idx, LAS unsigned char* scr) {
    const int lane = F.lane + vzero(), r16 = lane & 15, g4 = lane >> 4;
    const int bh = idx >> 5, n = idx & 31, b = bh >> 2, h = bh & 3;
    LAS bf16_t* Vs = (LAS bf16_t*)scr;
    const bf16_t* H = WSP(const bf16_t, WS_H); const bf16_t* QR = WSP(const bf16_t, WS_QR); const bf16_t* KR = WSP(const bf16_t, WS_KR);
    const float l2g = ret_l2g(h);
    const size_t t0 = (size_t)b * SEQ + n * 64;
#pragma unroll 8
    for (int tk = 0; tk < 64; ++tk) Vs[tk * 64 + lane] = H[(t0 + tk) * HP + C_RV + h * 64 + lane];
    WSYNC();
    Frag vfr[4][2];
#pragma unroll
    for (int vb = 0; vb < 4; ++vb)
#pragma unroll
        for (int ks = 0; ks < 2; ++ks)
#pragma unroll
            for (int j = 0; j < 8; ++j) vfr[vb][ks].h[j] = Vs[(32 * ks + 16 * (j >> 2) + 4 * g4 + (j & 3)) * 64 + 16 * vb + r16];
    Frag sfr[4][2];
    { const float* si = WSP(const float, WS_RTI) + (size_t)(bh * 32 + n) * 4096;
#pragma unroll
      for (int vb = 0; vb < 4; ++vb)
#pragma unroll
        for (int ks = 0; ks < 2; ++ks) { const f32x4 a = *(const f32x4*)(si + (16 * vb + r16) * 64 + 32 * ks + 8 * g4), c = *(const f32x4*)(si + (16 * vb + r16) * 64 + 32 * ks + 8 * g4 + 4);
            sfr[vb][ks].u[0] = cvt_pk_bf16(a[0], a[1]); sfr[vb][ks].u[1] = cvt_pk_bf16(a[2], a[3]); sfr[vb][ks].u[2] = cvt_pk_bf16(c[0], c[1]); sfr[vb][ks].u[3] = cvt_pk_bf16(c[2], c[3]); } }
    bf16_t* Y = WSP(bf16_t, WS_Y);
#pragma unroll
    for (int tb = 0; tb < 4; ++tb) {
        const int tl = 16 * tb + r16; const size_t t = t0 + tl;
        bf16x8 qfr[2];
#pragma unroll
        for (int ks = 0; ks < 2; ++ks) qfr[ks] = *(const bf16x8*)(QR + t * 256 + h * 64 + 32 * ks + 8 * g4);
        Frag pfr[2]; pfr[0].q = (u32x4){0u, 0u, 0u, 0u}; pfr[1].q = (u32x4){0u, 0u, 0u, 0u};
#pragma unroll
        for (int sb = 0; sb < 4; ++sb) { if (sb > tb) continue;
            f32x4 sc = (f32x4){0.f, 0.f, 0.f, 0.f};
#pragma unroll
            for (int ks = 0; ks < 2; ++ks) { const bf16x8 kf = *(const bf16x8*)(KR + (t0 + 16 * sb + r16) * 256 + h * 64 + 32 * ks + 8 * g4); sc = mfma16(kf, qfr[ks], sc); }
#pragma unroll
            for (int r = 0; r < 4; ++r) { const int rel = tl - (16 * sb + 4 * g4 + r); sc[r] = rel >= 0 ? sc[r] * exp2f((float)rel * l2g) : 0.f; }
            pfr[sb >> 1].u[(sb & 1) * 2] = cvt_pk_bf16(sc[0], sc[1]); pfr[sb >> 1].u[(sb & 1) * 2 + 1] = cvt_pk_bf16(sc[2], sc[3]); }
        const float qd = exp2f((float)(tl + 1) * l2g);
        f32x4 o[4]; float s1 = 0.f;
#pragma unroll
        for (int vb = 0; vb < 4; ++vb) { f32x4 a = (f32x4){0.f, 0.f, 0.f, 0.f};
#pragma unroll
            for (int ks = 0; ks < 2; ++ks) a = mfma16(sfr[vb][ks].v, qfr[ks], a);
            a = a * qd;
            a = mfma16(vfr[vb][0].v, pfr[0].v, a);
            if (tb >= 2) a = mfma16(vfr[vb][1].v, pfr[1].v, a);
            o[vb] = a; s1 += (a[0] + a[1]) + (a[2] + a[3]); }
        s1 += __shfl_xor(s1, 16); s1 += __shfl_xor(s1, 32);
        const float mean = s1 * (1.0f / 64.0f); float s2 = 0.f;
#pragma unroll
        for (int vb = 0; vb < 4; ++vb) { const f32x4 d = o[vb] - mean; s2 += d[0] * d[0] + d[1] * d[1] + d[2] * d[2] + d[3] * d[3]; }
        s2 += __shfl_xor(s2, 16); s2 += __shfl_xor(s2, 32);
        const float rstd = rsqrtf(s2 * (1.0f / 64.0f) + EPS);
#pragma unroll
        for (int vb = 0; vb < 4; ++vb) { const int vi0 = h * 64 + 16 * vb + 4 * g4; const u32x2 gv = *(const u32x2*)(H + t * HP + C_RG + vi0);
            const f32x4 gg = *(const f32x4*)(IN_F(19) + layer * 256 + vi0), gb = *(const f32x4*)(IN_F(20) + layer * 256 + vi0);
            const float g0 = __uint_as_float(gv.x << 16), g1 = __uint_as_float(gv.x & 0xffff0000u), g2 = __uint_as_float(gv.y << 16), g3 = __uint_as_float(gv.y & 0xffff0000u);
            u32x2 w; w.x = cvt_pk_bf16(((o[vb][0] - mean) * rstd * gg[0] + gb[0]) * siluf_(g0), ((o[vb][1] - mean) * rstd * gg[1] + gb[1]) * siluf_(g1));
            w.y = cvt_pk_bf16(((o[vb][2] - mean) * rstd * gg[2] + gb[2]) * siluf_(g2), ((o[vb][3] - mean) * rstd * gg[3] + gb[3]) * siluf_(g3));
            *(u32x2*)(Y + t * 1024 + 768 + vi0) = w; }
    }
    WSYNC();
}

__device__ __forceinline__ void attn_unit(const Frame& F, int bh, int qt) {
    const int vz = vzero(); const int lane = F.lane + vz, r16 = lane & 15, g4 = lane >> 4, w = F.wave, tid = F.tid + vz;
    LAS bf16_t* Kt = (LAS bf16_t*)(F.lds + LDS_STAGE);
    LAS bf16_t* Vl = (LAS bf16_t*)(F.lds + LDS_STAGE + 13312);
    const bf16_t* Qb = WSP(const bf16_t, WS_Q) + (size_t)bh * SEQ * 96; const bf16_t* Kb = WSP(const bf16_t, WS_K) + (size_t)bh * SEQ * 96; const bf16_t* Vt = WSP(const bf16_t, WS_VT) + (size_t)bh * 64 * SEQ;
    const int q0 = qt * 128, qrow = q0 + 16 * w + r16;
    bf16x8 qfr[3];
#pragma unroll
    for (int ks = 0; ks < 3; ++ks) qfr[ks] = *(const bf16x8*)(Qb + (size_t)qrow * 96 + 32 * ks + 8 * g4);
    float mrun = -1e30f, lrun = 0.f;
    f32x4 O[4];
#pragma unroll
    for (int db = 0; db < 4; ++db) O[db] = (f32x4){0.f, 0.f, 0.f, 0.f};
    const int nkt = 2 * qt + 2;
    const int kkey0 = tid / 12, kpart0 = tid % 12, kkey1 = (tid + 512) / 12, kpart1 = (tid + 512) % 12; const bool k1 = tid < 256;
    const int vdv = tid >> 3, vpart = tid & 7;
    u32x4 rk0, rk1, rv;
    rk1 = (u32x4){0u, 0u, 0u, 0u};
    rk0 = *(const u32x4*)(Kb + (size_t)kkey0 * 96 + kpart0 * 8); if (k1) rk1 = *(const u32x4*)(Kb + (size_t)kkey1 * 96 + kpart1 * 8);
    rv = *(const u32x4*)(Vt + (size_t)vdv * SEQ + vpart * 8);
#pragma unroll 1
    for (int kt = 0; kt < nkt; ++kt) {
        __syncthreads();
        *(LAS u32x4*)(Kt + kkey0 * 104 + kpart0 * 8) = rk0; if (k1) *(LAS u32x4*)(Kt + kkey1 * 104 + kpart1 * 8) = rk1;
        *(LAS u32x4*)(Vl + vdv * 72 + vpart * 8) = rv;
        __syncthreads();
        if (kt + 1 < nkt) { const size_t kb = (size_t)(kt + 1) * 64;
            rk0 = *(const u32x4*)(Kb + (kb + kkey0) * 96 + kpart0 * 8); if (k1) rk1 = *(const u32x4*)(Kb + (kb + kkey1) * 96 + kpart1 * 8);
            rv = *(const u32x4*)(Vt + (size_t)vdv * SEQ + kb + vpart * 8); }
        f32x4 sc[4]; float mx = -1e30f;
#pragma unroll
        for (int kb = 0; kb < 4; ++kb) { f32x4 s = (f32x4){0.f, 0.f, 0.f, 0.f};
#pragma unroll
            for (int ks = 0; ks < 3; ++ks) { const bf16x8 a = *(const LAS bf16x8*)(Kt + (16 * kb + r16) * 104 + 32 * ks + 8 * g4); s = mfma16(a, qfr[ks], s); }
            if (kt >= 2 * qt) {
#pragma unroll
                for (int r = 0; r < 4; ++r) if (kt * 64 + 16 * kb + 4 * g4 + r > qrow) s[r] = -1e30f; }
            sc[kb] = s; mx = fmaxf(mx, fmaxf(fmaxf(s[0], s[1]), fmaxf(s[2], s[3]))); }
        mx = fmaxf(mx, __shfl_xor(mx, 16)); mx = fmaxf(mx, __shfl_xor(mx, 32));
        const float mnew = fmaxf(mrun, mx), alpha = exp2f(mrun - mnew); mrun = mnew;
        float ls = 0.f;
#pragma unroll
        for (int kb = 0; kb < 4; ++kb)
#pragma unroll
            for (int r = 0; r < 4; ++r) { const float p = exp2f(sc[kb][r] - mnew); sc[kb][r] = p; ls += p; }
        lrun = lrun * alpha + ls;
        Frag pf[2];
#pragma unroll
        for (int ks = 0; ks < 2; ++ks) { pf[ks].u[0] = cvt_pk_bf16(sc[2 * ks][0], sc[2 * ks][1]); pf[ks].u[1] = cvt_pk_bf16(sc[2 * ks][2], sc[2 * ks][3]); pf[ks].u[2] = cvt_pk_bf16(sc[2 * ks + 1][0], sc[2 * ks + 1][1]); pf[ks].u[3] = cvt_pk_bf16(sc[2 * ks + 1][2], sc[2 * ks + 1][3]); }
#pragma unroll
        for (int db = 0; db < 4; ++db) { f32x4 o = O[db] * alpha;
#pragma unroll
            for (int ks = 0; ks < 2; ++ks) { Frag vf; vf.d[0] = *(const LAS u32x2*)(Vl + (16 * db + r16) * 72 + 32 * ks + 4 * g4); vf.d[1] = *(const LAS u32x2*)(Vl + (16 * db + r16) * 72 + 32 * ks + 16 + 4 * g4); o = mfma16(vf.v, pf[ks].v, o); }
            O[db] = o; }
    }
    lrun += __shfl_xor(lrun, 16); lrun += __shfl_xor(lrun, 32);
    const float inv = 1.0f / lrun;
    const int b = bh >> 2, h = bh & 3; bf16_t* Y = WSP(bf16_t, WS_Y) + ((size_t)b * SEQ + qrow) * 1024 + 256 + h * 64;
#pragma unroll
    for (int db = 0; db < 4; ++db) { u32x2 wv; wv.x = cvt_pk_bf16(O[db][0] * inv, O[db][1] * inv); wv.y = cvt_pk_bf16(O[db][2] * inv, O[db][3] * inv); *(u32x2*)(Y + 16 * db + 4 * g4) = wv; }
}

__device__ __forceinline__ void ln_row_write(f32x4 (&v)[4], const float* g, const float* bta, float* of, bf16_t* ob, int lane) {
    float s = 0.f;
#pragma unroll
    for (int j = 0; j < 4; ++j) s += (v[j][0] + v[j][1]) + (v[j][2] + v[j][3]);
    const float mean = wave_sum(s) * (1.0f / 1024.0f); float s2 = 0.f;
#pragma unroll
    for (int j = 0; j < 4; ++j) { v[j] = v[j] - mean; s2 += (v[j][0] * v[j][0] + v[j][1] * v[j][1]) + (v[j][2] * v[j][2] + v[j][3] * v[j][3]); }
    const float rstd = rsqrtf(wave_sum(s2) * (1.0f / 1024.0f) + EPS);
#pragma unroll
    for (int j = 0; j < 4; ++j) { const f32x4 gg = *(const f32x4*)(g + 4 * lane + 256 * j), bb = *(const f32x4*)(bta + 4 * lane + 256 * j); v[j] = v[j] * rstd * gg + bb;
        *(f32x4*)(of + 4 * lane + 256 * j) = v[j]; u32x2 w; w.x = cvt_pk_bf16(v[j][0], v[j][1]); w.y = cvt_pk_bf16(v[j][2], v[j][3]); *(u32x2*)(ob + 4 * lane + 256 * j) = w; }
}
template <bool MOE>
__device__ __forceinline__ void ln1_phase(const Frame& F, int layer) {
    const int lane = F.lane; bf16_t* XB = WSP(bf16_t, WS_XB);
    LAS int* lcnt = (LAS int*)(F.lds + LDS_MISC);
    LAS int* rinfo = (LAS int*)(F.lds + LDS_MISC + 64);
    LAS float* rw = (LAS float*)(F.lds + LDS_MISC + 64 + 4096);
    if (MOE) { if (F.tid < 16) lcnt[F.tid] = 0; __syncthreads(); }
    const int rows_per_blk = T / F.G;
    const float* wr_ = MOE ? IN_F(28) + (size_t)(layer >> 1) * 1024 * 8 : nullptr;
    for (int lr = F.wave; lr < rows_per_blk; lr += 8) { const int t = F.bid * rows_per_blk + lr;
        float* xr = F.out + (size_t)t * 1024; f32x4 v[4];
#pragma unroll
        for (int j = 0; j < 4; ++j) v[j] = *(const f32x4*)(xr + 4 * lane + 256 * j);
        ln_row_write(v, IN_F(23) + layer * 1024, IN_F(24) + layer * 1024, xr, XB + (size_t)t * 1024, lane);
        if (MOE) {
            float lg[8];
#pragma unroll
            for (int e = 0; e < 8; ++e) lg[e] = 0.f;
#pragma unroll
            for (int j = 0; j < 4; ++j)
#pragma unroll
                for (int q = 0; q < 4; ++q) { const float xv = v[j][q]; const float* wrow = wr_ + (size_t)(4 * lane + 256 * j + q) * 8; const f32x4 w0 = *(const f32x4*)wrow, w1 = *(const f32x4*)(wrow + 4);
                    lg[0] += xv * w0[0]; lg[1] += xv * w0[1]; lg[2] += xv * w0[2]; lg[3] += xv * w0[3]; lg[4] += xv * w1[0]; lg[5] += xv * w1[1]; lg[6] += xv * w1[2]; lg[7] += xv * w1[3]; }
#pragma unroll
            for (int e = 0; e < 8; ++e) lg[e] = wave_sum(lg[e]);
            int e0 = 0; float v0 = lg[0];
#pragma unroll
            for (int e = 1; e < 8; ++e) if (lg[e] > v0) { v0 = lg[e]; e0 = e; }
            int e1 = -1; float v1 = -3.0e38f;
#pragma unroll
            for (int e = 0; e < 8; ++e) if (e != e0 && lg[e] > v1) { v1 = lg[e]; e1 = e; }
            if (lane == 0) { const float w0 = 1.0f / (1.0f + __expf(v1 - v0)); const int p0 = __hip_atomic_fetch_add(&lcnt[e0], 1, __ATOMIC_RELAXED, __HIP_MEMORY_SCOPE_WORKGROUP), p1 = __hip_atomic_fetch_add(&lcnt[e1], 1, __ATOMIC_RELAXED, __HIP_MEMORY_SCOPE_WORKGROUP);
                rinfo[lr * 4 + 0] = e0; rinfo[lr * 4 + 1] = e1; rinfo[lr * 4 + 2] = p0; rinfo[lr * 4 + 3] = p1; rw[lr * 2] = w0; rw[lr * 2 + 1] = 1.0f - w0; }
        }
    }
    if (MOE) {
        __syncthreads();
        unsigned* gcnt = WSP(unsigned, WS_CTL) + CW_MOE + (layer >> 1) * 64;
        if (F.tid < 8) lcnt[8 + F.tid] = (int)__hip_atomic_fetch_add(gcnt + F.tid, (unsigned)lcnt[F.tid], __ATOMIC_RELAXED, __HIP_MEMORY_SCOPE_AGENT);
        __syncthreads();
        int* te = (int*)(F.ws + WS_TOK + TOK_E); int* tp = (int*)(F.ws + WS_TOK + TOK_POS); float* tw = (float*)(F.ws + WS_TOK + TOK_W);
        for (int i = F.tid; i < rows_per_blk * 2; i += 512) { const int lr = i >> 1, k = i & 1, t = F.bid * rows_per_blk + lr; const int e = rinfo[lr * 4 + k];
            te[t * 2 + k] = e; tp[t * 2 + k] = lcnt[8 + e] + rinfo[lr * 4 + 2 + k]; tw[t * 2 + k] = rw[lr * 2 + k]; }
    }
}
struct MoeOff { int ts0, ts1, ts2, ts3, ts4, ts5, ts6, ts7, ts8; };
__device__ __forceinline__ MoeOff moe_offsets(const Frame& F, int layer, int* cnt_out  ) {
    const unsigned* gcnt = WSP(const unsigned, WS_CTL) + CW_MOE + (layer >> 1) * 64;
    MoeOff o; int c[8];
#pragma unroll
    for (int e = 0; e < 8; ++e) c[e] = (int)__hip_atomic_load(gcnt + e, __ATOMIC_RELAXED, __HIP_MEMORY_SCOPE_AGENT);
    o.ts0 = 0; o.ts1 = o.ts0 + ((c[0] + 255) >> 8); o.ts2 = o.ts1 + ((c[1] + 255) >> 8); o.ts3 = o.ts2 + ((c[2] + 255) >> 8); o.ts4 = o.ts3 + ((c[3] + 255) >> 8);
    o.ts5 = o.ts4 + ((c[4] + 255) >> 8); o.ts6 = o.ts5 + ((c[5] + 255) >> 8); o.ts7 = o.ts6 + ((c[6] + 255) >> 8); o.ts8 = o.ts7 + ((c[7] + 255) >> 8);
    if (cnt_out) {
#pragma unroll
        for (int e = 0; e < 8; ++e) cnt_out[e] = c[e]; }
    return o;
}
__device__ __forceinline__ int moe_ts(const MoeOff& o, int e) { return e == 0 ? o.ts0 : e == 1 ? o.ts1 : e == 2 ? o.ts2 : e == 3 ? o.ts3 : e == 4 ? o.ts4 : e == 5 ? o.ts5 : e == 6 ? o.ts6 : o.ts7; }
__device__ __forceinline__ void moe_gather(const Frame& F, int layer) {
    int cnt[8]; const MoeOff o = moe_offsets(F, layer, cnt);
    const int lane = F.lane; const bf16_t* XB = WSP(const bf16_t, WS_XB); bf16_t* XG = WSP(bf16_t, WS_XG);
    const int* te = (const int*)(F.ws + WS_TOK + TOK_E); const int* tp = (const int*)(F.ws + WS_TOK + TOK_POS); int* tsl = (int*)(F.ws + WS_TOK + TOK_SLOT);
    for (int i = F.gw; i < T * 2; i += F.NGW) { const int t = i >> 1; const int e = te[i], slot = moe_ts(o, e) * 256 + tp[i];
        const u32x4* src = (const u32x4*)(XB + (size_t)t * 1024); u32x4* dst = (u32x4*)(XG + (size_t)slot * 1024);
        dst[lane] = src[lane]; dst[64 + lane] = src[64 + lane];
        if (lane == 0) tsl[i] = slot; }
    int npad_pre = 0;
#pragma unroll
    for (int e = 0; e < 8; ++e) { const int start = moe_ts(o, e) * 256 + cnt[e], end = (e == 7 ? o.ts8 : moe_ts(o, e + 1)) * 256, np = end - start;
        for (int i = F.gw; i < np; i += F.NGW) { u32x4* dst = (u32x4*)(XG + (size_t)(start + i) * 1024); dst[lane] = (u32x4){0u, 0u, 0u, 0u}; dst[64 + lane] = (u32x4){0u, 0u, 0u, 0u}; }
        npad_pre += np; }
    (void)npad_pre;
}
template <bool MOE>
__device__ __forceinline__ void ln2_phase(const Frame& F, int layer) {
    const int lane = F.lane; bf16_t* XB = WSP(bf16_t, WS_XB);
    const bf16_t* YM = WSP(const bf16_t, WS_YM); const bf16_t* PLE = WSP(const bf16_t, WS_PLE);
    const int* tsl = (const int*)(F.ws + WS_TOK + TOK_SLOT); const float* tw = (const float*)(F.ws + WS_TOK + TOK_W);
    for (int t = F.gw; t < T; t += F.NGW) { float* xr = F.out + (size_t)t * 1024; f32x4 v[4];
#pragma unroll
        for (int j = 0; j < 4; ++j) v[j] = *(const f32x4*)(xr + 4 * lane + 256 * j);
        if (MOE) { const int s0 = tsl[t * 2], s1 = tsl[t * 2 + 1]; const float w0 = tw[t * 2], w1 = tw[t * 2 + 1];
#pragma unroll
            for (int j = 0; j < 4; ++j) { const u32x2 a = *(const u32x2*)(YM + (size_t)s0 * 1024 + 4 * lane + 256 * j), c = *(const u32x2*)(YM + (size_t)s1 * 1024 + 4 * lane + 256 * j), p = *(const u32x2*)(PLE + (size_t)t * 1024 + 4 * lane + 256 * j);
                f32x4 f;
                f[0] = w0 * __uint_as_float(a.x << 16) + w1 * __uint_as_float(c.x << 16) + __uint_as_float(p.x << 16);
                f[1] = w0 * __uint_as_float(a.x & 0xffff0000u) + w1 * __uint_as_float(c.x & 0xffff0000u) + __uint_as_float(p.x & 0xffff0000u);
                f[2] = w0 * __uint_as_float(a.y << 16) + w1 * __uint_as_float(c.y << 16) + __uint_as_float(p.y << 16);
                f[3] = w0 * __uint_as_float(a.y & 0xffff0000u) + w1 * __uint_as_float(c.y & 0xffff0000u) + __uint_as_float(p.y & 0xffff0000u);
                v[j] = v[j] * ALPHA + f; } }
        ln_row_write(v, IN_F(34) + layer * 1024, IN_F(35) + layer * 1024, xr, XB + (size_t)t * 1024, lane);
    }
}

constexpr int PH_PER_LAYER = 12, N_PHASES = 1 + DEPTH * PH_PER_LAYER;
__global__ void __launch_bounds__(512, 2) hybrid_fwd(Args args) {
    extern __shared__ __attribute__((aligned(16))) unsigned char lds_raw[];
    Frame F0;
    F0.lds = (LAS unsigned char*)lds_raw; F0.ws = args.ws; F0.in = args.in; F0.out = args.out;
    F0.tid = threadIdx.x; F0.lane = F0.tid & 63; F0.wave = __builtin_amdgcn_readfirstlane(F0.tid >> 6); F0.G = gridDim.x; F0.bid = blockIdx.x; F0.gw = F0.bid * 8 + F0.wave; F0.NGW = F0.G * 8;
    volatile LAS unsigned* ctlw = (volatile LAS unsigned*)(F0.lds + LDS_CTLW);
    if (F0.tid < 16) ctlw[F0.tid] = 0u;
    __syncthreads();
    const int lo = args.ph_lo, hi = args.ph_hi;
    XcdBarrier bar; bar.bar = (unsigned*)(F0.ws + WS_CTL) + CW_BAR; bar.x = 0; bar.st = ctlw;
    if (hi - lo > 1) bar = xcd_barrier_post((unsigned*)(F0.ws + WS_CTL) + CW_BAR, ctlw);
#define IN_PH(k) (lo <= (k) && (k) < hi)
#define SEAM(k) do { if ((k) + 1 < hi) { XcdBarrier bb_ = bar; bb_.bar = bar.bar + opaque0(); xcd_barrier(bb_); } } while (0)

    if (PHON(12) && IN_PH(0)) { const Frame F = reframe(F0); p0_prologue(F); SEAM(0); }

    for (int layer = 0; layer < DEPTH; ++layer) {
        const int pb = 1 + layer * PH_PER_LAYER;
        const bool moe = (layer & 1) != 0;
        if (PHON(0) && IN_PH(pb + 0)) { const Frame F = reframe(F0); const int L = layer + opaque0(); LAS unsigned char* stage = F.lds + LDS_STAGE; LAS unsigned char* wscr = F.lds + LDS_STAGE + F.wave * 16384; (void)wscr; (void)stage;
            { pg8::Gemm g{WSP(const bf16_t, WS_XB), WSP(const bf16_t, WS_WIN) + (size_t)L * HP * 1024, 1024, 1024, 1024};
              pg8::OrderStd S; S.init(T / 256, HP / 256, F.G, F.bid); pg8::EpiBf16 E{WSP(bf16_t, WS_H), HP, HP / 256};
              pg8::gemm_phase(stage, g, S, E); }
            { const int L2 = L + opaque0(); pg8::Gemm g{WSP(const bf16_t, WS_PB) + (size_t)L2 * T * 256, WSP(const bf16_t, WS_WPP) + (size_t)L2 * 1024 * 256, 256, 256, 256};
              const int nshort = F.G - (1728 % F.G); pg8::OrderLin S{(F.G == 256) ? F.bid - 192 : F.bid, (F.G == 256) ? 64 : F.G, 256, 4}; (void)nshort;
              pg8::EpiBf16 E{WSP(bf16_t, WS_PP), 1024, 4};
              pg8::gemm_phase(stage, g, S, E); }
            SEAM(pb + 0);
        }
        if (PHON(1) && IN_PH(pb + 1)) { const Frame F = reframe(F0); const int L = layer + opaque0(); LAS unsigned char* stage = F.lds + LDS_STAGE; LAS unsigned char* wscr = F.lds + LDS_STAGE + F.wave * 16384; (void)wscr; (void)stage;
            const bf16_t* H = WSP(const bf16_t, WS_H);
            LAS float* rs = (LAS float*)(F.lds + LDS_MISC);
            if (ITMASK & 8) { const int vb = F.bid;
                const int pm = vb >> 2, kind = (vb >> 1) & 1, pn = vb & 1;
                __syncthreads();
                for (int lr = F.wave; lr < 256; lr += 8) { const bf16_t* row = H + (size_t)(pm * 256 + lr) * HP + (kind ? C_CKV : C_CQ); float ss = 0.f;
                    if (kind == 0) { const float a = bf2f(row[F.lane]), b2 = bf2f(row[64 + F.lane]), c = bf2f(row[128 + F.lane]); ss = a * a + b2 * b2 + c * c; }
                    else { const float a = bf2f(row[F.lane]), b2 = bf2f(row[64 + F.lane]); ss = a * a + b2 * b2; }
                    ss = wave_sum(ss); if (F.lane == 0) rs[lr] = rsqrtf(ss / (kind ? 128.0f : 192.0f) + EPS); }
                __syncthreads();
                if (kind == 0) { pg8::Gemm g{H + C_CQ, WSP(const bf16_t, WS_WUQ) + (size_t)L * 512 * 256, HP, 256, 256}; pg8::OrderOne S{pm, pn, true};
                    pg8::EpiQ E{WSP(bf16_t, WS_Q), WSP(const float, WS_ROPEM), rs}; pg8::gemm_phase(stage, g, S, E); }
                else { pg8::Gemm g{H + C_CKV, WSP(const bf16_t, WS_WUKV) + (size_t)L * 512 * 256, HP, 256, 256}; pg8::OrderOne S{pm, pn, true};
                    pg8::EpiKV E{WSP(bf16_t, WS_K), WSP(bf16_t, WS_VT), rs}; pg8::gemm_phase(stage, g, S, E);
                    if (pn == 0) { const float* rope = WSP(const float, WS_ROPEM); bf16_t* Kb = WSP(bf16_t, WS_K);
                        for (int i = F.tid; i < 256 * 16; i += 512) { const int lr = i >> 4, j = i & 15, t = pm * 256 + lr, b = t >> 11, s = t & 2047;
                            const float x1 = bf2f(H[(size_t)t * HP + C_KR + j]), x2 = bf2f(H[(size_t)t * HP + C_KR + 16 + j]), c = rope[t * 32 + j], sn = rope[t * 32 + 16 + j];
                            const bf16_t o1 = f2bf(x1 * c - x2 * sn), o2 = f2bf(x2 * c + x1 * sn);
#pragma unroll
                            for (int hd = 0; hd < 4; ++hd) { bf16_t* kp = Kb + ((size_t)((b * 4 + hd) * SEQ + s)) * 96; kp[64 + j] = o1; kp[80 + j] = o2; } } } }
            }
            __syncthreads();
            for (int it = F.gw; it < 1024 + 1024 + 4096; it += F.NGW) {
                if (it < 1024) { if (ITMASK & 1) hg_item<false>(F, L, it, wscr); }
                else if (it < 2048) { if (ITMASK & 2) ret_item1(F, it - 1024, wscr); }
                else { if (ITMASK & 4) s5_item<false>(F, L, it - 2048, wscr); }
            }
            SEAM(pb + 1);
        }
        if (PHON(2) && IN_PH(pb + 2)) { const Frame F = reframe(F0); const int L = layer + opaque0(); LAS unsigned char* stage = F.lds + LDS_STAGE; LAS unsigned char* wscr = F.lds + LDS_STAGE + F.wave * 16384; (void)wscr; (void)stage; s5_carry(F, L); hg_carry(F); ret_carry(F); SEAM(pb + 2); }
        if (PHON(3) && IN_PH(pb + 3)) { const Frame F = reframe(F0); const int L = layer + opaque0(); LAS unsigned char* stage = F.lds + LDS_STAGE; LAS unsigned char* wscr = F.lds + LDS_STAGE + F.wave * 16384; (void)wscr; (void)stage;
            if (ITMASK & 8) { const int vb = F.bid; const int bh = vb >> 3, j = vb & 7; attn_unit(F, bh, 15 - j); attn_unit(F, bh, j); }
            __syncthreads();
            for (int it = F.gw; it < 1024 + 1024 + 4096; it += F.NGW) {
                if (it < 1024) { if (ITMASK & 1) hg_item<true>(F, L, it, wscr); }
                else if (it < 2048) { if (ITMASK & 2) ret_item3(F, L, it - 1024, wscr); }
                else { if (ITMASK & 4) s5_item<true>(F, L, it - 2048, wscr); }
            }
            SEAM(pb + 3);
        }
        if (PHON(4) && IN_PH(pb + 4)) { const Frame F = reframe(F0); const int L = layer + opaque0(); LAS unsigned char* stage = F.lds + LDS_STAGE; LAS unsigned char* wscr = F.lds + LDS_STAGE + F.wave * 16384; (void)wscr; (void)stage;
            pg8::Gemm g{WSP(const bf16_t, WS_S5PRE), WSP(const bf16_t, WS_WGLU) + (size_t)L * 256 * 256, 256, 256, 256};
            pg8::OrderLin S{F.bid, F.G, 64, 1}; pg8::EpiSigMul E{WSP(bf16_t, WS_Y), 1024, WSP(const bf16_t, WS_S5PRE), 256};
            pg8::gemm_phase(stage, g, S, E);
            SEAM(pb + 4);
        }
        if (PHON(5) && IN_PH(pb + 5)) { const Frame F = reframe(F0); const int L = layer + opaque0(); LAS unsigned char* stage = F.lds + LDS_STAGE; LAS unsigned char* wscr = F.lds + LDS_STAGE + F.wave * 16384; (void)wscr; (void)stage;
            pg8::Gemm g{WSP(const bf16_t, WS_Y), WSP(const bf16_t, WS_WB) + (size_t)L * 4 * 1024 * 256, 1024, 256, 256};
            pg8::OrderBranch S{F.bid, F.G}; pg8::EpiBranch E{WSP(const bf16_t, WS_H) + C_GATE, WSP(float, WS_TMP), WSP(bf16_t, WS_MIXB)};
            pg8::gemm_phase(stage, g, S, E);
            SEAM(pb + 5);
        }
        if (PHON(6) && IN_PH(pb + 6)) { const Frame F = reframe(F0); const int L = layer + opaque0(); LAS unsigned char* stage = F.lds + LDS_STAGE; LAS unsigned char* wscr = F.lds + LDS_STAGE + F.wave * 16384; (void)wscr; (void)stage;
            pg8::Gemm g{WSP(const bf16_t, WS_MIXB), WSP(const bf16_t, WS_WO) + (size_t)L * 1024 * 1024, 1024, 1024, 1024};
            pg8::OrderStd S; S.init(T / 256, 4, F.G, F.bid); pg8::EpiResid E{L == 0 ? IN_F(0) : (const float*)F.out, F.out, nullptr};
            pg8::gemm_phase(stage, g, S, E);
            SEAM(pb + 6);
        }
        if (PHON(7) && IN_PH(pb + 7)) { const Frame F = reframe(F0); const int L = layer + opaque0(); LAS unsigned char* stage = F.lds + LDS_STAGE; LAS unsigned char* wscr = F.lds + LDS_STAGE + F.wave * 16384; (void)wscr; (void)stage; if (moe) ln1_phase<true>(F, L); else ln1_phase<false>(F, L); SEAM(pb + 7); }
        if (!moe) {
            if (PHON(8) && IN_PH(pb + 8)) { const Frame F = reframe(F0); const int L = layer + opaque0(); LAS unsigned char* stage = F.lds + LDS_STAGE; LAS unsigned char* wscr = F.lds + LDS_STAGE + F.wave * 16384; (void)wscr; (void)stage;
                { pg8::Gemm g{WSP(const bf16_t, WS_XB), WSP(const bf16_t, WS_WFFU) + (size_t)(L >> 1) * 7168 * 1024, 1024, 1024, 1024};
                  pg8::OrderStd S; S.init(T / 256, 28, F.G, F.bid); pg8::EpiSwiglu E{WSP(bf16_t, WS_HFF), DFF, 28};
                  pg8::gemm_phase(stage, g, S, E); }
                { const int L2 = L + opaque0(); pg8::Gemm g{WSP(const bf16_t, WS_XB), WSP(const bf16_t, WS_WPG) + (size_t)L2 * 1024 * 1024, 1024, 1024, 1024};
                  pg8::OrderStd S; S.init(T / 256, 4, F.G, F.bid); pg8::EpiSigMul E{WSP(bf16_t, WS_PLE), 1024, WSP(const bf16_t, WS_PP), 1024};
                  pg8::gemm_phase(stage, g, S, E); }
                SEAM(pb + 8);
            }
            if (PHON(9) && IN_PH(pb + 9)) { const Frame F = reframe(F0); const int L = layer + opaque0(); LAS unsigned char* stage = F.lds + LDS_STAGE; LAS unsigned char* wscr = F.lds + LDS_STAGE + F.wave * 16384; (void)wscr; (void)stage;
                pg8::Gemm g{WSP(const bf16_t, WS_HFF), WSP(const bf16_t, WS_WFFD) + (size_t)(L >> 1) * 1024 * DFF, DFF, DFF, DFF};
                pg8::OrderStd S; S.init(T / 256, 4, F.G, F.bid); pg8::EpiResid E{(const float*)F.out, F.out, WSP(const bf16_t, WS_PLE)};
                pg8::gemm_phase(stage, g, S, E);
                SEAM(pb + 9);
            }
            if (PHON(10) && IN_PH(pb + 10)) { const Frame F = reframe(F0); const int L = layer + opaque0(); LAS unsigned char* stage = F.lds + LDS_STAGE; LAS unsigned char* wscr = F.lds + LDS_STAGE + F.wave * 16384; (void)wscr; (void)stage; ln2_phase<false>(F, L); if (hi > pb + 12) { XcdBarrier bb_ = bar; bb_.bar = bar.bar + opaque0(); xcd_barrier(bb_); } }
        } else {
            if (PHON(8) && IN_PH(pb + 8)) { const Frame F = reframe(F0); const int L = layer + opaque0(); LAS unsigned char* stage = F.lds + LDS_STAGE; LAS unsigned char* wscr = F.lds + LDS_STAGE + F.wave * 16384; (void)wscr; (void)stage;
                moe_gather(F, L);
                { const int L2 = L + opaque0(); pg8::Gemm g{WSP(const bf16_t, WS_XB), WSP(const bf16_t, WS_WPG) + (size_t)L2 * 1024 * 1024, 1024, 1024, 1024};
                  pg8::OrderStd S; S.init(T / 256, 4, F.G, F.bid); pg8::EpiSigMul E{WSP(bf16_t, WS_PLE), 1024, WSP(const bf16_t, WS_PP), 1024};
                  pg8::gemm_phase(stage, g, S, E); }
                SEAM(pb + 8);
            }
            if (PHON(9) && IN_PH(pb + 9)) { const Frame F = reframe(F0); const int L = layer + opaque0(); LAS unsigned char* stage = F.lds + LDS_STAGE; LAS unsigned char* wscr = F.lds + LDS_STAGE + F.wave * 16384; (void)wscr; (void)stage;
                const MoeOff o = moe_offsets(F, L, nullptr);
                pg8::Gemm g{WSP(const bf16_t, WS_XG), WSP(const bf16_t, WS_WMU) + (size_t)(L >> 1) * 8 * 7168 * 1024, 1024, 1024, 1024};
                pg8::OrderMoe S{o.ts8, 28, F.G, F.bid, o.ts1, o.ts2, o.ts3, o.ts4, o.ts5, o.ts6, o.ts7}; pg8::EpiSwiglu E{WSP(bf16_t, WS_HM), DFF, 28};
                pg8::gemm_phase(stage, g, S, E);
                SEAM(pb + 9);
            }
            if (PHON(10) && IN_PH(pb + 10)) { const Frame F = reframe(F0); const int L = layer + opaque0(); LAS unsigned char* stage = F.lds + LDS_STAGE; LAS unsigned char* wscr = F.lds + LDS_STAGE + F.wave * 16384; (void)wscr; (void)stage;
                const MoeOff o = moe_offsets(F, L, nullptr);
                pg8::Gemm g{WSP(const bf16_t, WS_HM), WSP(const bf16_t, WS_WMD) + (size_t)(L >> 1) * 8 * 1024 * DFF, DFF, DFF, DFF};
                pg8::OrderMoe S{o.ts8, 4, F.G, F.bid, o.ts1, o.ts2, o.ts3, o.ts4, o.ts5, o.ts6, o.ts7}; pg8::EpiBf16 E{WSP(bf16_t, WS_YM), 1024, 4};
                pg8::gemm_phase(stage, g, S, E);
                SEAM(pb + 10);
            }
            if (PHON(11) && IN_PH(pb + 11)) { const Frame F = reframe(F0); const int L = layer + opaque0(); LAS unsigned char* stage = F.lds + LDS_STAGE; LAS unsigned char* wscr = F.lds + LDS_STAGE + F.wave * 16384; (void)wscr; (void)stage; ln2_phase<true>(F, L); SEAM(pb + 11); }
        }
    }
#undef IN_PH
#undef SEAM
}

extern "C" void kernel_launch(void* const* d_in, const int* in_sizes, int n_in, void* d_out, int out_size, void* d_ws, size_t ws_size, hipStream_t stream) {
    static int grid = 0;
    if (grid == 0) {
        if (n_in != 36 || out_size != T * D || ws_size < WS_END) { fprintf(stderr, "kernel_launch: unexpected problem (n_in %d, out %d, ws %zu < %zu)\n", n_in, out_size, ws_size, (size_t)WS_END); grid = -1; return; }
        int dev = 0, cus = 0, per_cu = 0;
        if (hipGetDevice(&dev) != hipSuccess || hipDeviceGetAttribute(&cus, hipDeviceAttributeMultiprocessorCount, dev) != hipSuccess) { grid = -1; return; }
        if (hipFuncSetAttribute((const void*)hybrid_fwd, hipFuncAttributeMaxDynamicSharedMemorySize, LDS_BYTES) != hipSuccess) { fprintf(stderr, "kernel_launch: hipFuncSetAttribute failed\n"); grid = -1; return; }
        if (hipOccupancyMaxActiveBlocksPerMultiprocessor(&per_cu, (const void*)hybrid_fwd, 512, LDS_BYTES) != hipSuccess || per_cu < 1) fprintf(stderr, "kernel_launch: occupancy query says %d\n", per_cu);
        (void)hipGetLastError();
        if (cus != 256) { fprintf(stderr, "kernel_launch: built for 256 CUs, device has %d\n", cus); }
        grid = 256;
    }
    if (grid < 0) return;
    (void)hipMemsetAsync((char*)d_ws + WS_CTL, 0, CTL_BYTES, stream);
    Args a{};
    for (int i = 0; i < 36; ++i) a.in[i] = d_in[i];
    a.out = (float*)d_out; a.ws = (unsigned char*)d_ws;
    if (MK_N_LAUNCHES == 1) {
        a.ph_lo = 0; a.ph_hi = N_PHASES;
        hipLaunchKernelGGL(hybrid_fwd, dim3(grid), dim3(512), LDS_BYTES, stream, a);
    } else {
        for (int p = 0; p < N_PHASES; ++p) { a.ph_lo = p; a.ph_hi = p + 1; hipLaunchKernelGGL(hybrid_fwd, dim3(grid), dim3(512), LDS_BYTES, stream, a); }
    }
    const hipError_t le = hipPeekAtLastError();
    if (le != hipSuccess) fprintf(stderr, "kernel_launch: launch failed: %s\n", hipGetErrorName(le));
}
```

```cpp
#include <hip/hip_runtime.h>
#include <cstdio>
#include <cstdint>

#ifndef MK_N_LAUNCHES
#define MK_N_LAUNCHES 1
#endif
#ifndef DUP_PHASE
#define DUP_PHASE -1
#endif
#define DUP_N 4
#ifndef DUP_VARIANT
#define DUP_VARIANT 0
#endif
#ifndef PHMASK
#define PHMASK 0xFFFF
#endif
#define PHON(k) (((PHMASK) >> (k)) & 1)
#ifndef ITMASK
#define ITMASK 15
#endif

#define LAS __attribute__((address_space(3)))
typedef unsigned short bf16_t;
typedef short bf16x8 __attribute__((ext_vector_type(8)));
typedef float f32x4 __attribute__((ext_vector_type(4)));
typedef float f32x2 __attribute__((ext_vector_type(2)));
typedef unsigned u32x4 __attribute__((ext_vector_type(4)));
typedef unsigned u32x2 __attribute__((ext_vector_type(2)));

constexpr int T = 16384, D = 1024, SEQ = 2048, NBATCH = 8, DEPTH = 4, DFF = 3584, NEXP = 8;
constexpr int HP = 6912;
constexpr int C_US5 = 0, C_CQ = 256, C_CKV = 512, C_KR = 640, C_HQ = 768, C_HF = 1024, C_HI = 1280, C_HG = 1536, C_RQ = 1792, C_RK = 2048, C_RV = 2304, C_RG = 2560, C_GATE = 2816;
constexpr float ALPHA = 1.6817928305074290f;
constexpr float EPS = 1e-5f;
constexpr float QSCALE = 0.10206207261596575f * 1.4426950408889634f;
constexpr int MOE_MAXT = 136;

constexpr size_t MiB = (size_t)1 << 20;
constexpr size_t WS_CTL = 0, CTL_BYTES = 1 * MiB;
constexpr size_t WS_WIN = 1 * MiB, WS_WB = 55 * MiB, WS_WO = 63 * MiB, WS_WPG = 71 * MiB, WS_WPP = 79 * MiB, WS_WFFU = 81 * MiB, WS_WFFD = 109 * MiB;
constexpr size_t WS_WMU = 123 * MiB, WS_WMD = 347 * MiB, WS_WUQ = 459 * MiB, WS_WUKV = 460 * MiB, WS_WGLU = 461 * MiB;
constexpr size_t WS_ROPEM = 462 * MiB, WS_ROPER = 464 * MiB, WS_S5P = 468 * MiB, WS_TOK = 469 * MiB;
constexpr size_t WS_XB = 470 * MiB, WS_PB = 502 * MiB, WS_PP = 534 * MiB, WS_PLE = 566 * MiB, WS_STAGE = 598 * MiB;
constexpr size_t WS_H = WS_STAGE, WS_Y = WS_STAGE + 216 * MiB, WS_S5PRE = WS_STAGE + 248 * MiB, WS_MIXB = WS_STAGE + 256 * MiB, WS_TMP = WS_STAGE + 288 * MiB;
constexpr size_t WS_Q = WS_STAGE + 288 * MiB, WS_K = WS_STAGE + 300 * MiB, WS_VT = WS_STAGE + 312 * MiB, WS_QR = WS_STAGE + 320 * MiB, WS_KR = WS_STAGE + 328 * MiB;
constexpr size_t WS_S5E = WS_STAGE + 336 * MiB, WS_S5C = WS_STAGE + 338 * MiB, WS_HGD = WS_STAGE + 340 * MiB, WS_HGE = WS_STAGE + 341 * MiB, WS_HGI = WS_STAGE + 357 * MiB;
constexpr size_t WS_RTE = WS_STAGE + 373 * MiB, WS_RTI = WS_STAGE + 389 * MiB;
constexpr size_t WS_HFF = WS_STAGE, WS_XG = WS_STAGE, WS_HM = WS_STAGE + 68 * MiB, WS_YM = WS_STAGE + 306 * MiB;
constexpr size_t WS_END = WS_STAGE + 405 * MiB;
constexpr size_t S5P_ABAR = 0, S5P_BM = 64 * 1024, S5P_CM = 384 * 1024, S5P_LB = 704 * 1024;
constexpr size_t TOK_E = 0, TOK_POS = 128 * 1024, TOK_W = 256 * 1024, TOK_SLOT = 384 * 1024;
constexpr int CW_BAR = 4096, CW_MOE = 32768;

constexpr int LDS_BYTES = 160 * 1024;
constexpr int LDS_STAGE = 0;
constexpr int LDS_MISC = 128 * 1024;
constexpr int LDS_CTLW = 160 * 1024 - 64;

__device__ __forceinline__ float bf2f(bf16_t b) { return __uint_as_float(((unsigned)b) << 16); }
__device__ __forceinline__ unsigned cvt_pk_bf16(float lo, float hi) { unsigned r; asm volatile("v_cvt_pk_bf16_f32 %0, %1, %2" : "=v"(r) : "v"(lo), "v"(hi)); return r; }
__device__ __forceinline__ bf16_t f2bf(float f) { return (bf16_t)(cvt_pk_bf16(f, 0.f) & 0xffffu); }
__device__ __forceinline__ float sigmoidf_(float x) { return 1.0f / (1.0f + __expf(-x)); }
__device__ __forceinline__ float siluf_(float x) { return x / (1.0f + __expf(-x)); }
__device__ __forceinline__ float gelu_tanh(float v) { const float z = 0.7978845608028654f * (v + 0.044715f * v * v * v); const float th = 1.0f - 2.0f / (__expf(2.0f * z) + 1.0f); return 0.5f * v * (1.0f + th); }
__device__ __forceinline__ f32x4 mfma16(bf16x8 a, bf16x8 b, f32x4 c) { return __builtin_amdgcn_mfma_f32_16x16x32_bf16(a, b, c, 0, 0, 0); }
union Frag { bf16x8 v; unsigned u[4]; u32x2 d[2]; u32x4 q; unsigned short h[8]; };
#define WSYNC() asm volatile("s_waitcnt lgkmcnt(0)" ::: "memory")
#define VM_WAIT() asm volatile("s_waitcnt vmcnt(0)" ::: "memory")
__device__ __forceinline__ float wave_sum(float v) {
#pragma unroll
    for (int o = 1; o < 64; o <<= 1) v += __shfl_xor(v, o);
    return v;
}

namespace pg8 {
constexpr int BM = 256, BK = 64, HALF = 128, HTB = HALF * BK * 2, STAGE_BYTES = 8 * HTB, NXCD = 8, WGM = 8;
__host__ __device__ __forceinline__ int lds_byte(int r, int c) { const int st = (r >> 4) * 2 + (c >> 5), rr = r & 15, cc = c & 31, ob = rr * 64 + cc * 2; return st * 1024 + (ob ^ (((ob >> 9) & 1) << 5)); }
__host__ __device__ __forceinline__ void stage_rc(int b, int& R, int& C) { const int st = b / 1024, sb = b % 1024, swz = sb ^ (((sb >> 9) & 1) << 5); R = (st >> 1) * 16 + swz / 64; C = (st & 1) * 32 + (swz % 64) / 2; }
__host__ __device__ __forceinline__ int perm32(int rho) { const int n = rho >> 4, i = rho & 15; return 8 * (i >> 2) + 4 * n + (i & 3); }

struct Unit { int pm, pn, ak; };
struct Gemm { const bf16_t* A; const bf16_t* Bt; int lda, ldb, K, flags; };

struct OrderStd {
    int nM, nN, nwg, G, c;
    __device__ void init(int nM_, int nN_, int G_, int c_) { nM = nM_; nN = nN_; nwg = nM * nN; G = G_; c = c_; }
    __device__ bool next(int i, Unit& u) const {
        const long L = (long)i * G + c; if (L >= nwg) return false;
        int wgid = (int)L; { const int q = nwg / NXCD, r = nwg % NXCD, xcd = wgid % NXCD, off = wgid / NXCD; wgid = (xcd < r ? xcd * (q + 1) : r * (q + 1) + (xcd - r) * q) + off; }
        const int nig = WGM * nN, gid = wgid / nig, fm = gid * WGM, gsz = (nM - fm) < WGM ? (nM - fm) : WGM;
        u.pm = fm + ((wgid % nig) % gsz); u.pn = (wgid % nig) / gsz; u.ak = 0; return true;
    }
};
struct OrderLin {
    int c, G, total, nN;
    __device__ bool next(int i, Unit& u) const { if (c < 0) return false; const int L = i * G + c; if (L >= total) return false; u.pm = L / nN; u.pn = L % nN; u.ak = 0; return true; }
};
struct OrderOne {
    int pm, pn; bool has;
    __device__ bool next(int i, Unit& u) const { if (i > 0 || !has) return false; u.pm = pm; u.pn = pn; u.ak = 0; return true; }
};
struct OrderBranch {
    int c, G;
    __device__ bool next(int i, Unit& u) const { const int t = (i >> 2) * G + c, n = i & 3; if (t >= 512) return false; u.pm = t >> 2; u.pn = n * 4 + (t & 3); u.ak = n * 256; return true; }
};
struct OrderMoe {
    int nT, ncol, G, c, t1, t2, t3, t4, t5, t6, t7;
    __device__ bool next(int i, Unit& u) const {
        const long L = (long)i * G + c; if (L >= (long)nT * ncol) return false;
        const int wg = (int)L, nig = WGM * ncol, gid = wg / nig, fm = gid * WGM, gsz = (nT - fm) < WGM ? (nT - fm) : WGM;
        const int pm = fm + ((wg % nig) % gsz), ct = (wg % nig) / gsz;
        const int e = (pm >= t1) + (pm >= t2) + (pm >= t3) + (pm >= t4) + (pm >= t5) + (pm >= t6) + (pm >= t7);
        u.pm = pm; u.pn = e * ncol + ct; u.ak = 0; return true;
    }
};

template <class Epi, class Sched, bool ALIGN_EPI = true, bool SP2 = true>
__device__ __forceinline__ void gemm_phase(LAS unsigned char* lds, const Gemm g, const Sched& S, const Epi& E) {
    int oz_; asm volatile("s_mov_b32 %0, 0" : "=s"(oz_));
    const int tid = threadIdx.x + oz_, wid = __builtin_amdgcn_readfirstlane(tid >> 6), lane = tid & 63, wr = wid >> 2, wc = wid & 3, fr = lane & 15, fq = lane >> 4;
    const int nt = (g.K + oz_) / BK;
    unsigned voffA[2], voffB[2];
#pragma unroll
    for (int i = 0; i < 2; ++i) { int R, C; stage_rc(tid * 16 + i * 8192, R, C); const int Rb = Epi::PERM ? ((R & ~31) + perm32(R & 31)) : R;
        voffA[i] = (unsigned)(R * g.lda + C) * 2u; voffB[i] = (unsigned)(Rb * g.ldb + C) * 2u; }
    const size_t kstep = (size_t)(BK * 2);
    const size_t hstepA = (size_t)HALF * g.lda * 2, hstepB = (size_t)HALF * g.ldb * 2;
    static_assert(!Epi::HALF_M || SP2, "HALF_M needs the SP2 loop");
    const size_t tstepA = Epi::HALF_M ? hstepA : 2 * hstepA, tstepB = 2 * hstepB;
    const size_t hA2 = Epi::HALF_M ? 0 : hstepA;
    const unsigned ldsw = (unsigned)wid * 1024u;
    const int aoff = lds_byte(wr * 64 + fr, fq * 8), boff = lds_byte(wc * 32 + fr, fq * 8);
#define PG8_SA(b, h) (((b) * 2 + (h)) * HTB)
#define PG8_SB(b, h) ((4 + (b) * 2 + (h)) * HTB)
#define PG8_STAGE(bufoff, gbase, voff) do { _Pragma("unroll") for (int _i = 0; _i < 2; ++_i) \
        __builtin_amdgcn_global_load_lds((const unsigned*)((const char*)(gbase) + (voff)[_i]), (LAS unsigned*)(lds + (bufoff) + ldsw + _i * 8192), 16, 0, 0); } while (0)
#define PG8_LDA(dst, b, h) do { _Pragma("unroll") for (int m = 0; m < 4; ++m) _Pragma("unroll") for (int k = 0; k < 2; ++k) dst[m][k] = *(const LAS bf16x8*)(lds + PG8_SA(b, h) + aoff + m * 2048 + k * 1024); } while (0)
#define PG8_LDB(dst, b, h) do { _Pragma("unroll") for (int n = 0; n < 2; ++n) _Pragma("unroll") for (int k = 0; k < 2; ++k) dst[n][k] = *(const LAS bf16x8*)(lds + PG8_SB(b, h) + boff + n * 2048 + k * 1024); } while (0)
#define PG8_MMA(ai, bj, At, Bt) do { __builtin_amdgcn_s_setprio(1); _Pragma("unroll") for (int m = 0; m < 4; ++m) _Pragma("unroll") for (int n = 0; n < 2; ++n) _Pragma("unroll") for (int k = 0; k < 2; ++k) \
        acc[ai][bj][m][n] = __builtin_amdgcn_mfma_f32_16x16x32_bf16(Bt[n][k], At[m][k], acc[ai][bj][m][n], 0, 0, 0); __builtin_amdgcn_s_setprio(0); } while (0)
#define PG8_WAIT_V(n) asm volatile("s_waitcnt vmcnt(" #n ")" ::: "memory")
#define PG8_WAIT_L(n) asm volatile("s_waitcnt lgkmcnt(" #n ")" ::: "memory")
#define PG8_BAR __builtin_amdgcn_s_barrier()
#define PG8_SCHED __builtin_amdgcn_sched_barrier(0)
    Unit cur, nxt; int ui = 0;
    if (!S.next(0, cur)) return;
    f32x4 acc[2][2][4][2];
#pragma unroll
    for (int a = 0; a < 2; ++a)
#pragma unroll
        for (int b = 0; b < 2; ++b)
#pragma unroll
            for (int m = 0; m < 4; ++m)
#pragma unroll
                for (int n = 0; n < 2; ++n) acc[a][b][m][n] = (f32x4){0.f, 0.f, 0.f, 0.f};
    bf16x8 At[4][2], B0[2][2], B1[2][2];
    const char* cA = (const char*)g.A + (size_t)cur.pm * tstepA + (size_t)cur.ak * 2; const char* cB = (const char*)g.Bt + (size_t)cur.pn * tstepB;
    if constexpr (SP2) {
        PG8_STAGE(PG8_SB(0, 0), cB, voffB); PG8_STAGE(PG8_SB(0, 1), cB + hstepB, voffB); PG8_STAGE(PG8_SA(0, 0), cA, voffA); PG8_STAGE(PG8_SA(0, 1), cA + hA2, voffA);
        if (wr == 1) PG8_BAR;
        PG8_WAIT_V(2); PG8_BAR;
        PG8_STAGE(PG8_SB(1, 0), cB + kstep, voffB); PG8_STAGE(PG8_SA(1, 0), cA + kstep, voffA); PG8_STAGE(PG8_SB(1, 1), cB + hstepB + kstep, voffB);
        PG8_WAIT_V(6); PG8_BAR;
    } else {
        PG8_STAGE(PG8_SB(0, 0), cB, voffB); PG8_STAGE(PG8_SA(0, 0), cA, voffA); PG8_STAGE(PG8_SB(0, 1), cB + hstepB, voffB); PG8_STAGE(PG8_SA(0, 1), cA + hstepA, voffA);
        if (wr == 1) PG8_BAR;
        PG8_WAIT_V(4); PG8_BAR;
        PG8_STAGE(PG8_SB(1, 0), cB + kstep, voffB); PG8_STAGE(PG8_SA(1, 0), cA + kstep, voffA); PG8_STAGE(PG8_SB(1, 1), cB + hstepB + kstep, voffB);
        PG8_WAIT_V(6); PG8_BAR;
    }
    for (;;) {
        const bool has_next = S.next(ui + 1, nxt);
        const char* nA = has_next ? (const char*)g.A + (size_t)nxt.pm * tstepA + (size_t)nxt.ak * 2 : cA; const char* nB = has_next ? (const char*)g.Bt + (size_t)nxt.pn * tstepB : cB;
        for (int t = 0; t < nt; t += 2) {
            const bool last = (t == nt - 2);
            const char* a1 = cA + (size_t)(t + 1) * kstep;
            const char* a2 = last ? nA : cA + (size_t)(t + 2) * kstep; const char* b2 = last ? nB : cB + (size_t)(t + 2) * kstep;
            const char* a3 = a2 + kstep; const char* b3 = b2 + kstep;
            if constexpr (SP2) {
            PG8_LDB(B0, 0, 0); PG8_LDB(B1, 0, 1); PG8_SCHED; PG8_LDA(At, 0, 0); PG8_STAGE(PG8_SA(1, 1), a1 + hA2, voffA);
            PG8_WAIT_V(8); PG8_WAIT_L(0); PG8_BAR; PG8_MMA(0, 0, At, B0); PG8_MMA(0, 1, At, B1); PG8_BAR; PG8_SCHED;
            if constexpr (!Epi::HALF_M) PG8_LDA(At, 0, 1); PG8_STAGE(PG8_SB(0, 0), b2, voffB); PG8_STAGE(PG8_SB(0, 1), b2 + hstepB, voffB); PG8_STAGE(PG8_SA(0, 0), a2, voffA);
            PG8_WAIT_V(8); PG8_WAIT_L(0); PG8_BAR; if constexpr (!Epi::HALF_M) { PG8_MMA(1, 0, At, B0); PG8_MMA(1, 1, At, B1); } PG8_BAR; PG8_SCHED;
            PG8_LDB(B0, 1, 0); PG8_LDB(B1, 1, 1); PG8_SCHED; PG8_LDA(At, 1, 0); PG8_STAGE(PG8_SA(0, 1), a2 + hA2, voffA);
            PG8_WAIT_V(8); PG8_WAIT_L(0); PG8_BAR; PG8_MMA(0, 0, At, B0); PG8_MMA(0, 1, At, B1); PG8_BAR; PG8_SCHED;
            if constexpr (!Epi::HALF_M) PG8_LDA(At, 1, 1); PG8_STAGE(PG8_SB(1, 0), b3, voffB); PG8_STAGE(PG8_SB(1, 1), b3 + hstepB, voffB); PG8_STAGE(PG8_SA(1, 0), a3, voffA);
            PG8_WAIT_V(8); PG8_WAIT_L(0); PG8_BAR; if constexpr (!Epi::HALF_M) { PG8_MMA(1, 0, At, B0); PG8_MMA(1, 1, At, B1); } PG8_BAR; PG8_SCHED;
            } else {
            PG8_LDB(B0, 0, 0); PG8_SCHED; PG8_LDA(At, 0, 0); PG8_STAGE(PG8_SA(1, 1), a1 + hstepA, voffA);
            PG8_WAIT_L(8); PG8_BAR; PG8_WAIT_L(0); PG8_MMA(0, 0, At, B0); PG8_BAR; PG8_SCHED;
            PG8_LDB(B1, 0, 1); PG8_STAGE(PG8_SB(0, 0), b2, voffB);
            PG8_BAR; PG8_WAIT_L(0); PG8_MMA(0, 1, At, B1); PG8_BAR;
            PG8_LDA(At, 0, 1); PG8_STAGE(PG8_SA(0, 0), a2, voffA);
            PG8_BAR; PG8_WAIT_L(0); PG8_MMA(1, 0, At, B0); PG8_BAR; PG8_SCHED;
            PG8_STAGE(PG8_SB(0, 1), b2 + hstepB, voffB);
            PG8_WAIT_V(6); PG8_BAR; PG8_MMA(1, 1, At, B1); PG8_BAR;
            PG8_LDB(B0, 1, 0); PG8_SCHED; PG8_LDA(At, 1, 0); PG8_STAGE(PG8_SA(0, 1), a2 + hstepA, voffA);
            PG8_WAIT_L(8); PG8_BAR; PG8_WAIT_L(0); PG8_MMA(0, 0, At, B0); PG8_BAR; PG8_SCHED;
            PG8_LDB(B1, 1, 1); PG8_STAGE(PG8_SB(1, 0), b3, voffB);
            PG8_BAR; PG8_WAIT_L(0); PG8_MMA(0, 1, At, B1); PG8_BAR;
            PG8_LDA(At, 1, 1); PG8_STAGE(PG8_SA(1, 0), a3, voffA);
            PG8_BAR; PG8_WAIT_L(0); PG8_MMA(1, 0, At, B0); PG8_BAR; PG8_SCHED;
            PG8_STAGE(PG8_SB(1, 1), b3 + hstepB, voffB);
            PG8_WAIT_V(6); PG8_BAR; PG8_MMA(1, 1, At, B1); PG8_BAR;
            }
        }
        if constexpr (ALIGN_EPI) { if (wr == 0) PG8_BAR; }
        { int vz_; asm volatile("v_mov_b32 %0, 0" : "=v"(vz_)); if (!(g.flags & 1)) E(acc, cur, wr, wc, fr + vz_, fq); }
        if (!has_next) break;
#pragma unroll
        for (int a = 0; a < (Epi::HALF_M ? 1 : 2); ++a)
#pragma unroll
            for (int b = 0; b < 2; ++b)
#pragma unroll
                for (int m = 0; m < 4; ++m)
#pragma unroll
                    for (int n = 0; n < 2; ++n) acc[a][b][m][n] = (f32x4){0.f, 0.f, 0.f, 0.f};
        cur = nxt; cA = nA; cB = nB; ++ui;
        if constexpr (ALIGN_EPI) { if (wr == 1) PG8_BAR; }
    }
    PG8_WAIT_V(0);
    if constexpr (!ALIGN_EPI) { if (wr == 0) PG8_BAR; }
    PG8_BAR;
#undef PG8_SA
#undef PG8_SB
#undef PG8_STAGE
#undef PG8_LDA
#undef PG8_LDB
#undef PG8_MMA
#undef PG8_WAIT_V
#undef PG8_WAIT_L
#undef PG8_BAR
#undef PG8_SCHED
}

typedef f32x4 Acc[2][2][4][2];
struct EpiBf16 {
    static constexpr bool PERM = true, HALF_M = false;
    bf16_t* O; int ldc; int ncol;
    __device__ __forceinline__ void operator()(const Acc& acc, const Unit& u, int wr, int wc, int fr, int fq) const {
        const int row0 = u.pm * BM + wr * 64 + fr, col0 = (u.pn % ncol) * BM + wc * 32 + 8 * fq;
#pragma unroll
        for (int ai = 0; ai < 2; ++ai)
#pragma unroll
            for (int m = 0; m < 4; ++m) { bf16_t* rowp = O + (size_t)(row0 + ai * HALF + m * 16) * ldc + col0;
#pragma unroll
                for (int bj = 0; bj < 2; ++bj) { const f32x4 v0 = acc[ai][bj][m][0], v1 = acc[ai][bj][m][1];
                    u32x4 w; w.x = cvt_pk_bf16(v0[0], v0[1]); w.y = cvt_pk_bf16(v0[2], v0[3]); w.z = cvt_pk_bf16(v1[0], v1[1]); w.w = cvt_pk_bf16(v1[2], v1[3]);
                    *(u32x4*)(rowp + bj * HALF) = w; } }
    }
};
struct EpiSwiglu {
    static constexpr bool PERM = true, HALF_M = false;
    bf16_t* O; int ldc; int ncol;
    __device__ __forceinline__ void operator()(const Acc& acc, const Unit& u, int wr, int wc, int fr, int fq) const {
        const int row0 = u.pm * BM + wr * 64 + fr, col0 = (u.pn % ncol) * HALF + wc * 32 + 8 * fq;
#pragma unroll
        for (int ai = 0; ai < 2; ++ai)
#pragma unroll
            for (int m = 0; m < 4; ++m) { bf16_t* rowp = O + (size_t)(row0 + ai * HALF + m * 16) * ldc + col0;
                float o[8];
#pragma unroll
                for (int n = 0; n < 2; ++n)
#pragma unroll
                    for (int j = 0; j < 4; ++j) o[n * 4 + j] = siluf_(acc[ai][0][m][n][j]) * acc[ai][1][m][n][j];
                u32x4 w; w.x = cvt_pk_bf16(o[0], o[1]); w.y = cvt_pk_bf16(o[2], o[3]); w.z = cvt_pk_bf16(o[4], o[5]); w.w = cvt_pk_bf16(o[6], o[7]);
                *(u32x4*)rowp = w; }
    }
};
struct EpiSigMul {
    static constexpr bool PERM = true, HALF_M = false;
    bf16_t* O; int ldc; const bf16_t* P; int ldp;
    __device__ __forceinline__ void operator()(const Acc& acc, const Unit& u, int wr, int wc, int fr, int fq) const {
        const int row0 = u.pm * BM + wr * 64 + fr, col0 = u.pn * BM + wc * 32 + 8 * fq;
#pragma unroll
        for (int ai = 0; ai < 2; ++ai)
#pragma unroll
            for (int m = 0; m < 4; ++m) { const size_t r = (size_t)(row0 + ai * HALF + m * 16);
#pragma unroll
                for (int bj = 0; bj < 2; ++bj) { const u32x4 pv = *(const u32x4*)(P + r * ldp + col0 + bj * HALF); const f32x4 v0 = acc[ai][bj][m][0], v1 = acc[ai][bj][m][1];
                    float o[8];
#pragma unroll
                    for (int j = 0; j < 4; ++j) { const unsigned pw = pv[j]; const float plo = __uint_as_float(pw << 16), phi = __uint_as_float(pw & 0xffff0000u);
                        const float a = (j < 2) ? v0[2 * j] : v1[2 * j - 4], b = (j < 2) ? v0[2 * j + 1] : v1[2 * j - 3];
                        o[2 * j] = sigmoidf_(a) * plo; o[2 * j + 1] = sigmoidf_(b) * phi; }
                    u32x4 w; w.x = cvt_pk_bf16(o[0], o[1]); w.y = cvt_pk_bf16(o[2], o[3]); w.z = cvt_pk_bf16(o[4], o[5]); w.w = cvt_pk_bf16(o[6], o[7]);
                    *(u32x4*)(O + r * ldc + col0 + bj * HALF) = w; }
                if (m == 3) asm volatile("" ::: "memory"); }
    }
};
struct EpiBranch {
    static constexpr bool PERM = true, HALF_M = false;
    const bf16_t* Hg; float* tmp; bf16_t* mixb;
    __device__ __forceinline__ void operator()(const Acc& acc, const Unit& u, int wr, int wc, int fr, int fq) const {
        const int n4 = u.pn >> 2, ct = u.pn & 3;
        const int row0 = u.pm * BM + wr * 64 + fr, col0 = ct * BM + wc * 32 + 8 * fq;
#pragma unroll
        for (int ai = 0; ai < 2; ++ai)
#pragma unroll
            for (int m = 0; m < 4; ++m) { const size_t r = (size_t)(row0 + ai * HALF + m * 16);
#pragma unroll
                for (int bj = 0; bj < 2; ++bj) { const int c = col0 + bj * HALF;
                    const u32x4 gv = *(const u32x4*)(Hg + r * HP + n4 * 1024 + c); const f32x4 v0 = acc[ai][bj][m][0], v1 = acc[ai][bj][m][1];
                    float o[8];
#pragma unroll
                    for (int j = 0; j < 4; ++j) { const unsigned gw = gv[j]; const float glo = __uint_as_float(gw << 16), ghi = __uint_as_float(gw & 0xffff0000u);
                        const float a = (j < 2) ? v0[2 * j] : v1[2 * j - 4], b = (j < 2) ? v0[2 * j + 1] : v1[2 * j - 3];
                        o[2 * j] = sigmoidf_(glo) * a; o[2 * j + 1] = sigmoidf_(ghi) * b; }
                    float* tp = tmp + r * 1024 + c;
                    if (n4 > 0) { const f32x4 p0 = *(const f32x4*)tp, p1 = *(const f32x4*)(tp + 4);
#pragma unroll
                        for (int j = 0; j < 4; ++j) { o[j] += p0[j]; o[4 + j] += p1[j]; } }
                    if (n4 < 3) { *(f32x4*)tp = (f32x4){o[0], o[1], o[2], o[3]}; *(f32x4*)(tp + 4) = (f32x4){o[4], o[5], o[6], o[7]}; }
                    else { u32x4 w; w.x = cvt_pk_bf16(o[0], o[1]); w.y = cvt_pk_bf16(o[2], o[3]); w.z = cvt_pk_bf16(o[4], o[5]); w.w = cvt_pk_bf16(o[6], o[7]); *(u32x4*)(mixb + r * 1024 + c) = w; } }
                if (m & 1) asm volatile("" ::: "memory"); }
    }
};
struct EpiBranchH {
    static constexpr bool PERM = true, HALF_M = true;
    const bf16_t* Hg; bf16_t* mixb;
    __device__ __forceinline__ void operator()(Acc& acc, const Unit& u, int wr, int wc, int fr, int fq) const {
        const int n4 = u.pn >> 2, ct = u.pn & 3;
        const int row0 = u.pm * HALF + wr * 64 + fr, col0 = ct * BM + wc * 32 + 8 * fq;
#pragma unroll
        for (int m = 0; m < 4; ++m) { const size_t r = (size_t)(row0 + m * 16);
#pragma unroll
            for (int bj = 0; bj < 2; ++bj) { const int c = col0 + bj * HALF;
                const u32x4 gv = *(const u32x4*)(Hg + r * HP + n4 * 1024 + c);
                f32x4 g0, g1;
                g0[0] = sigmoidf_(__uint_as_float(gv.x << 16)); g0[1] = sigmoidf_(__uint_as_float(gv.x & 0xffff0000u)); g0[2] = sigmoidf_(__uint_as_float(gv.y << 16)); g0[3] = sigmoidf_(__uint_as_float(gv.y & 0xffff0000u));
                g1[0] = sigmoidf_(__uint_as_float(gv.z << 16)); g1[1] = sigmoidf_(__uint_as_float(gv.z & 0xffff0000u)); g1[2] = sigmoidf_(__uint_as_float(gv.w << 16)); g1[3] = sigmoidf_(__uint_as_float(gv.w & 0xffff0000u));
                const f32x4 p0 = g0 * acc[0][bj][m][0], p1 = g1 * acc[0][bj][m][1];
                if (n4 == 0) { acc[1][bj][m][0] = p0; acc[1][bj][m][1] = p1; } else { acc[1][bj][m][0] += p0; acc[1][bj][m][1] += p1; }
                if (n4 == 3) { const f32x4 o0 = acc[1][bj][m][0], o1 = acc[1][bj][m][1]; u32x4 w; w.x = cvt_pk_bf16(o0[0], o0[1]); w.y = cvt_pk_bf16(o0[2], o0[3]); w.z = cvt_pk_bf16(o1[0], o1[1]); w.w = cvt_pk_bf16(o1[2], o1[3]);
                    *(u32x4*)(mixb + r * 1024 + c) = w; } } }
    }
};
struct EpiResid {
    static constexpr bool PERM = false, HALF_M = false;
    const float* base; float* out; const bf16_t* add;
    __device__ __forceinline__ void operator()(const Acc& acc, const Unit& u, int wr, int wc, int fr, int fq) const {
        const int row0 = u.pm * BM + wr * 64 + fr, col0 = u.pn * BM + wc * 32 + 4 * fq;
#pragma unroll
        for (int ai = 0; ai < 2; ++ai)
#pragma unroll
            for (int m = 0; m < 4; ++m) { const size_t off = (size_t)(row0 + ai * HALF + m * 16) * 1024 + col0;
#pragma unroll
                for (int bj = 0; bj < 2; ++bj)
#pragma unroll
                    for (int n = 0; n < 2; ++n) { const size_t o = off + bj * HALF + n * 16; const f32x4 bs = *(const f32x4*)(base + o); f32x4 v = bs * ALPHA + acc[ai][bj][m][n];
                        if (add) { const u32x2 av = *(const u32x2*)(add + o); v[0] += __uint_as_float(av.x << 16); v[1] += __uint_as_float(av.x & 0xffff0000u); v[2] += __uint_as_float(av.y << 16); v[3] += __uint_as_float(av.y & 0xffff0000u); }
                        *(f32x4*)(out + o) = v; }
                if (m & 1) asm volatile("" ::: "memory"); }
    }
};
struct EpiQ {
    static constexpr bool PERM = false, HALF_M = false;
    bf16_t* Qb; const float* ropeM; const LAS float* rs;
    __device__ __forceinline__ void operator()(const Acc& acc, const Unit& u, int wr, int wc, int fr, int fq) const {
#pragma unroll
        for (int bj = 0; bj < 2; ++bj) { const int gb = u.pn * BM + bj * HALF + wc * 32; if (gb >= 384) continue;
            const int hd = gb / 96, part = (gb % 96) / 32;
#pragma unroll
            for (int ai = 0; ai < 2; ++ai)
#pragma unroll
                for (int m = 0; m < 4; ++m) { const int rl = ai * HALF + wr * 64 + m * 16 + fr, t = u.pm * BM + rl, b = t >> 11, s = t & 2047; const float sc = rs[rl] * QSCALE;
                    f32x4 x1 = acc[ai][bj][m][0] * sc, x2 = acc[ai][bj][m][1] * sc;
                    if (part == 2) { const f32x4 cs = *(const f32x4*)(ropeM + (size_t)t * 32 + 4 * fq), sn = *(const f32x4*)(ropeM + (size_t)t * 32 + 16 + 4 * fq);
                        const f32x4 o1 = x1 * cs - x2 * sn, o2 = x2 * cs + x1 * sn; x1 = o1; x2 = o2; }
                    bf16_t* qp = Qb + ((size_t)((b * 4 + hd) * SEQ + s)) * 96 + part * 32 + 4 * fq;
                    u32x2 w1, w2; w1.x = cvt_pk_bf16(x1[0], x1[1]); w1.y = cvt_pk_bf16(x1[2], x1[3]); w2.x = cvt_pk_bf16(x2[0], x2[1]); w2.y = cvt_pk_bf16(x2[2], x2[3]);
                    *(u32x2*)qp = w1; *(u32x2*)(qp + 16) = w2; asm volatile("" ::: "memory"); } }
    }
};
struct EpiKV {
    static constexpr bool PERM = false, HALF_M = false;
    bf16_t* Kb; bf16_t* Vt; const LAS float* rs;
    __device__ __forceinline__ void operator()(const Acc& acc, const Unit& u, int wr, int wc, int fr, int fq) const {
#pragma unroll
        for (int bj = 0; bj < 2; ++bj) { const int gb = u.pn * BM + bj * HALF + wc * 32; const int hd = gb / 128, part = (gb % 128) / 32;
#pragma unroll
            for (int ai = 0; ai < 2; ++ai)
#pragma unroll
                for (int m = 0; m < 4; ++m) { const int rl = ai * HALF + wr * 64 + m * 16 + fr, t = u.pm * BM + rl, b = t >> 11, s = t & 2047; const float sc = rs[rl];
                    const f32x4 x1 = acc[ai][bj][m][0] * sc, x2 = acc[ai][bj][m][1] * sc;
                    if (part < 2) { bf16_t* kp = Kb + ((size_t)((b * 4 + hd) * SEQ + s)) * 96 + part * 32 + 4 * fq;
                        u32x2 w1, w2; w1.x = cvt_pk_bf16(x1[0], x1[1]); w1.y = cvt_pk_bf16(x1[2], x1[3]); w2.x = cvt_pk_bf16(x2[0], x2[1]); w2.y = cvt_pk_bf16(x2[2], x2[3]);
                        *(u32x2*)kp = w1; *(u32x2*)(kp + 16) = w2; }
                    else { bf16_t* vp = Vt + ((size_t)((b * 4 + hd) * 64 + (part - 2) * 32 + 4 * fq)) * SEQ + s;
#pragma unroll
                        for (int j = 0; j < 4; ++j) { vp[(size_t)j * SEQ] = f2bf(x1[j]); vp[(size_t)(16 + j) * SEQ] = f2bf(x2[j]); } }
                    asm volatile("" ::: "memory"); } }
    }
};
}

#define XB_TMO      128
#define XB_XCNT(j)  (256  + 64 * (j))
#define XB_XSUB(j)  (1280 + 64 * (j))
#define XB_XGEN(j)  (2304 + 64 * (j))
#define XB_TOP      3328
#define XB_TOPGEN   3392
#define XCD_BAR_WORDS 3456
#define XB_SPIN_CAP (1u << 18)
__device__ __forceinline__ unsigned xb_ld(unsigned* p)              { return __hip_atomic_load(p, __ATOMIC_RELAXED, __HIP_MEMORY_SCOPE_AGENT); }
__device__ __forceinline__ unsigned xb_add(unsigned* p, unsigned v) { return __hip_atomic_fetch_add(p, v, __ATOMIC_RELAXED, __HIP_MEMORY_SCOPE_AGENT); }
__device__ __forceinline__ unsigned xb_xcc_id() { return (unsigned)__builtin_amdgcn_s_getreg((3 << 11) | 20) & 0xFu; }
#define XB_SPIN(cond, bar) do { unsigned _sp = 0; while (cond) { __builtin_amdgcn_s_sleep(1); \
    if ((++_sp & 255u) == 0u) { if (xb_ld(&(bar)[XB_TMO])) break; if (_sp > XB_SPIN_CAP) { atomicAdd(&(bar)[XB_TMO], 1u); break; } } } } while (0)
struct XcdBarrier { unsigned* bar; unsigned x; volatile LAS unsigned* st; };
__device__ __forceinline__ XcdBarrier xcd_barrier_post(unsigned* bar, volatile LAS unsigned* st) {
    XcdBarrier b; b.bar = bar; b.x = xb_xcc_id(); b.st = st;
    if (threadIdx.x == 0) (void)xb_add(&bar[XB_XCNT(b.x)], 1u);
    return b;
}
__device__ __forceinline__ void xcd_barrier_complete(unsigned* bar, unsigned x, unsigned& nloc, unsigned& nx) {
    const unsigned G = gridDim.x * gridDim.y * gridDim.z;
    unsigned sum, cnt, mine, sp = 0u;
    for (;;) {
        sum = 0u; cnt = 0u; mine = 0u;
#pragma unroll
        for (unsigned j = 0; j < 16; ++j) { const unsigned c = xb_ld(&bar[XB_XCNT(j)]); sum += c; cnt += (c > 0u) ? 1u : 0u; mine = (j == x) ? c : mine; }
        if (sum == G) break;
        __builtin_amdgcn_s_sleep(1);
        if ((++sp & 255u) == 0u) { if (xb_ld(&bar[XB_TMO])) break; if (sp > XB_SPIN_CAP) { atomicAdd(&bar[XB_TMO], 1u); break; } }
    }
    nloc = mine > 0u ? mine : 1u; nx = cnt > 0u ? cnt : 1u;
}
__device__ __forceinline__ void xcd_barrier(const XcdBarrier& b) {
    asm volatile("s_waitcnt vmcnt(0)" ::: "memory");
    __syncthreads();
    if (threadIdx.x == 0) {
        unsigned* bar = b.bar;
        __builtin_amdgcn_s_waitcnt(0);
        unsigned nloc = b.st[0], nx = b.st[1];
        if (nloc == 0u) { xcd_barrier_complete(bar, b.x, nloc, nx); b.st[0] = nloc; b.st[1] = nx; }
        const unsigned old = xb_add(&bar[XB_XSUB(b.x)], 1u);
        const unsigned gen = old / nloc;
        if (old + 1u == (gen + 1u) * nloc) {
            __builtin_amdgcn_fence(__ATOMIC_RELEASE, "agent");
            asm volatile("s_waitcnt vmcnt(0)" ::: "memory");
            const unsigned og = xb_add(&bar[XB_TOP], 1u);
            const unsigned tg = og / nx;
            if (og + 1u == (tg + 1u) * nx) xb_add(&bar[XB_TOPGEN], 1u);
            else XB_SPIN(xb_ld(&bar[XB_TOPGEN]) == tg, bar);
            __builtin_amdgcn_fence(__ATOMIC_ACQUIRE, "agent");
            xb_add(&bar[XB_XGEN(b.x)], 1u);
            asm volatile("s_waitcnt vmcnt(0)" ::: "memory");
        } else {
            XB_SPIN(xb_ld(&bar[XB_XGEN(b.x)]) == gen, bar);
            __builtin_amdgcn_fence(__ATOMIC_ACQUIRE, "agent");
            asm volatile("s_waitcnt vmcnt(0)" ::: "memory");
        }
    }
    __syncthreads();
}

__device__ __forceinline__ int vzero() { int z; asm volatile("v_mov_b32 %0, 0" : "=v"(z)); return z; }
__device__ __forceinline__ int opaque0() { int z; asm volatile("s_mov_b32 %0, 0" : "=s"(z)); return z; }
struct Args { const void* in[36]; float* out; unsigned char* ws; int ph_lo, ph_hi, bar_region, variant; };
struct Frame {
    LAS unsigned char* lds;
    unsigned char* ws;
    const void* const* in;
    float* out;
    int tid, lane, wave, G, bid, gw, NGW;
};
__device__ __forceinline__ Frame reframe(const Frame& F) {
    Frame P = F; const int z = opaque0(), vz = vzero();
    P.ws = F.ws + z; P.out = F.out + z; P.lds = F.lds + z; P.bid = F.bid + z; P.G = F.G + z; P.wave = F.wave + z; P.gw = P.bid * 8 + P.wave; P.NGW = P.G * 8; P.tid = F.tid + vz; P.lane = F.lane + vz;
    return P;
}
#define IN_F(k) ((const float*)F.in[k])
#define WSP(T_, off) ((T_*)(F.ws + (off)))

__device__ __forceinline__ void tr_item(const float* W, int N, bf16_t* WT, int ldd, int drow0, int k0, int n0, const float* kscale, LAS float* scr, int lane) {
#pragma unroll 8
    for (int i = 0; i < 32; ++i) { const int kk = 2 * i + (lane >> 5); scr[kk * 33 + (lane & 31)] = W[(size_t)(k0 + kk) * N + n0 + (lane & 31)]; }
    WSYNC();
    const int c = lane & 7;
    float ks[8];
#pragma unroll
    for (int q = 0; q < 8; ++q) ks[q] = kscale ? kscale[k0 + 8 * c + q] : 1.0f;
#pragma unroll
    for (int j = 0; j < 4; ++j) { const int n = (lane >> 3) + 8 * j; const LAS float* s = scr + (8 * c) * 33 + n;
        u32x4 o; o.x = cvt_pk_bf16(s[0 * 33] * ks[0], s[1 * 33] * ks[1]); o.y = cvt_pk_bf16(s[2 * 33] * ks[2], s[3 * 33] * ks[3]); o.z = cvt_pk_bf16(s[4 * 33] * ks[4], s[5 * 33] * ks[5]); o.w = cvt_pk_bf16(s[6 * 33] * ks[6], s[7 * 33] * ks[7]);
        *(u32x4*)(WT + (size_t)(drow0 + n) * ldd + k0 + 8 * c) = o; }
    WSYNC();
}
__device__ __forceinline__ int win_map(int n) {
    if (n < 448) return n;
    if (n < 576) return C_CKV + (n - 448);
    if (n < 608) return C_KR + (n - 576);
    return C_HQ + (n - 608);
}
template <int MAP>
__device__ __forceinline__ bool tr_job(int& r, const float* W, int batch, int K, int N, bf16_t* dst, size_t dstride, int ldd, const float* kscale, int ksstride, LAS float* scr, int lane) {
    const int nkb = K / 64, nnb = N / 32, per = nkb * nnb, total = per * batch;
    if (r >= total) { r -= total; return false; }
    const int bi = r / per, q = r % per, kb = q / nnb, nb = q % nnb, n0 = nb * 32;
    int drow0;
    if (MAP == 0) drow0 = n0; else if (MAP == 1) drow0 = win_map(n0); else drow0 = (n0 >> 7) * 256 + (n0 & 127) + (MAP == 3 ? 128 : 0);
    tr_item(W + (size_t)bi * K * N, N, dst + (size_t)bi * dstride, ldd, drow0, kb * 64, n0, kscale ? kscale + bi * ksstride : nullptr, scr, lane);
    return true;
}
__device__ __forceinline__ void p0_prologue(const Frame& F) {
    LAS float* scr = (LAS float*)(F.lds + LDS_STAGE + F.wave * 16384);
    const int lane = F.lane;
    constexpr int NITEMS = 4 * 16 * 211 + 4 * 4 * 8 + 4 * 3 * 12 + 4 * 2 * 16 + 16 * 4 * 32 + 4 * 16 * 32 + 2 * 2 * 16 * 112 + 2 * 56 * 32 + 2 * 16 * 16 * 112 + 16 * 56 * 32 + 4 * 16 * 32 + 4 * 4 * 32;
    for (int it = F.gw; it < NITEMS; it += F.NGW) {
        int r = it;
        if (tr_job<2>(r, IN_F(29), 16, 1024, DFF, WSP(bf16_t, WS_WMU), (size_t)7168 * 1024, 1024, nullptr, 0, scr, lane)) continue;
        if (tr_job<3>(r, IN_F(30), 16, 1024, DFF, WSP(bf16_t, WS_WMU), (size_t)7168 * 1024, 1024, nullptr, 0, scr, lane)) continue;
        if (tr_job<0>(r, IN_F(31), 16, DFF, 1024, WSP(bf16_t, WS_WMD), (size_t)1024 * DFF, DFF, nullptr, 0, scr, lane)) continue;
        if (tr_job<1>(r, IN_F(3), 4, 1024, 6752, WSP(bf16_t, WS_WIN), (size_t)HP * 1024, 1024, nullptr, 0, scr, lane)) continue;
        if (tr_job<2>(r, IN_F(25), 2, 1024, DFF, WSP(bf16_t, WS_WFFU), (size_t)7168 * 1024, 1024, nullptr, 0, scr, lane)) continue;
        if (tr_job<3>(r, IN_F(26), 2, 1024, DFF, WSP(bf16_t, WS_WFFU), (size_t)7168 * 1024, 1024, nullptr, 0, scr, lane)) continue;
        if (tr_job<0>(r, IN_F(27), 2, DFF, 1024, WSP(bf16_t, WS_WFFD), (size_t)1024 * DFF, DFF, nullptr, 0, scr, lane)) continue;
        if (tr_job<0>(r, IN_F(21), 16, 256, 1024, WSP(bf16_t, WS_WB), (size_t)1024 * 256, 256, nullptr, 0, scr, lane)) continue;
        if (tr_job<0>(r, IN_F(22), 4, 1024, 1024, WSP(bf16_t, WS_WO), (size_t)1024 * 1024, 1024, nullptr, 0, scr, lane)) continue;
        if (tr_job<0>(r, IN_F(32), 4, 1024, 1024, WSP(bf16_t, WS_WPG), (size_t)1024 * 1024, 1024, nullptr, 0, scr, lane)) continue;
        if (tr_job<0>(r, IN_F(33), 4, 256, 1024, WSP(bf16_t, WS_WPP), (size_t)1024 * 256, 256, nullptr, 0, scr, lane)) continue;
        if (tr_job<0>(r, IN_F(12), 4, 256, 256, WSP(bf16_t, WS_WGLU), (size_t)256 * 256, 256, nullptr, 0, scr, lane)) continue;
        if (tr_job<0>(r, IN_F(15), 4, 192, 384, WSP(bf16_t, WS_WUQ), (size_t)512 * 256, 256, IN_F(13), 192, scr, lane)) continue;
        tr_job<0>(r, IN_F(16), 4, 128, 512, WSP(bf16_t, WS_WUKV), (size_t)512 * 256, 256, IN_F(14), 128, scr, lane);
    }
    const int gt = F.bid * 512 + F.tid, NT_ = F.G * 512;
    { bf16_t* uq = WSP(bf16_t, WS_WUQ); bf16_t* ukv = WSP(bf16_t, WS_WUKV);
      for (int i = gt; i < 4 * 512 * 256; i += NT_) { const int n = (i >> 8) & 511, k = i & 255; if (n >= 384 || k >= 192) uq[i] = 0; if (k >= 128) ukv[i] = 0; }
      bf16_t* win = WSP(bf16_t, WS_WIN);
      for (int i = gt; i < 4 * 160 * 1024; i += NT_) { const int l = i / (160 * 1024), q = i % (160 * 1024), rr = q >> 10, k = q & 1023; const int row = rr < 64 ? 448 + rr : 672 + (rr - 64); win[((size_t)l * HP + row) * 1024 + k] = 0; } }
    { const f32x4* x4 = (const f32x4*)IN_F(0); u32x2* xb = WSP(u32x2, WS_XB);
      for (int i = gt; i < T * D / 4; i += NT_) { const f32x4 v = x4[i]; u32x2 w; w.x = cvt_pk_bf16(v[0], v[1]); w.y = cvt_pk_bf16(v[2], v[3]); xb[i] = w; }
      const f32x4* p4 = (const f32x4*)IN_F(1); u32x2* pb = WSP(u32x2, WS_PB);
      for (int i = gt; i < DEPTH * T * 256 / 4; i += NT_) { const f32x4 v = p4[i]; u32x2 w; w.x = cvt_pk_bf16(v[0], v[1]); w.y = cvt_pk_bf16(v[2], v[3]); pb[i] = w; } }
    { const int* pos = (const int*)F.in[2]; float* rm = WSP(float, WS_ROPEM); float* rr = WSP(float, WS_ROPER);
      for (int i = gt; i < T * 48; i += NT_) { const int t = i / 48, j = i % 48; const bool isM = j < 16; const int jj = isM ? j : j - 16; const float half = isM ? 16.f : 32.f;
          const float inv = exp2f(-(float)jj / half * 13.287712379549449f);
          const float ang = (float)pos[t] * inv;
          const double ad = (double)ang, k2 = __builtin_rint(ad * 0.15915494309189535); const float red = (float)(ad - k2 * 6.283185307179586);
          const float c = __cosf(red), s = __sinf(red);
          if (isM) { rm[t * 32 + jj] = c; rm[t * 32 + 16 + jj] = s; } else { rr[t * 64 + jj] = c; rr[t * 64 + 32 + jj] = s; } } }
    { float* abar = (float*)(F.ws + WS_S5P + S5P_ABAR); bf16_t* Bm = (bf16_t*)(F.ws + WS_S5P + S5P_BM); bf16_t* Cm = (bf16_t*)(F.ws + WS_S5P + S5P_CM);
      for (int i = gt; i < DEPTH * 16 * 64; i += NT_) { const int lg = i >> 6, p = i & 63;
          const float dt = __expf(IN_F(6)[lg]), lr = IN_F(4)[i], li = IN_F(5)[i];
          const float mag = __expf(lr * dt); const double ad = (double)(li * dt), k2 = __builtin_rint(ad * 0.15915494309189535); const float red = (float)(ad - k2 * 6.283185307179586);
          const float are = mag * __cosf(red), aim = mag * __sinf(red);
          abar[i * 2] = are; abar[i * 2 + 1] = aim;
          const float den = lr * lr + li * li, nre = are - 1.0f, nim = aim;
          const float cre = (nre * lr + nim * li) / den, cim = (nim * lr - nre * li) / den;
          const float* br = IN_F(7) + (size_t)i * 16; const float* bi = IN_F(8) + (size_t)i * 16;
#pragma unroll
          for (int c = 0; c < 16; ++c) { Bm[((size_t)lg * 128 + p) * 16 + c] = f2bf(cre * br[c] - cim * bi[c]); Bm[((size_t)lg * 128 + 64 + p) * 16 + c] = f2bf(cre * bi[c] + cim * br[c]); }
#pragma unroll
          for (int c = 0; c < 16; ++c) { Cm[((size_t)lg * 16 + c) * 128 + p] = f2bf(IN_F(9)[((size_t)lg * 16 + c) * 64 + p]); Cm[((size_t)lg * 16 + c) * 128 + 64 + p] = f2bf(-IN_F(10)[((size_t)lg * 16 + c) * 64 + p]); } }
      float* lb = (float*)(F.ws + WS_S5P + S5P_LB);
      for (int i = gt; i < 256; i += NT_) { float r0 = IN_F(17)[i], r1 = IN_F(17)[256 + i], r2 = IN_F(17)[512 + i], r3 = IN_F(17)[768 + i]; const float mx = fmaxf(fmaxf(r0, r1), fmaxf(r2, r3));
          const float e0 = __expf(r0 - mx), e1 = __expf(r1 - mx), e2 = __expf(r2 - mx), e3 = __expf(r3 - mx), s = e0 + e1 + e2 + e3;
          lb[i] = 0.f; lb[256 + i] = e1 / s; lb[512 + i] = (e1 + e2) / s; lb[768 + i] = (e1 + e2 + e3) / s; } }
}

template <bool OUT>
__device__ __forceinline__ void s5_item(const Frame& F, int layer, int idx, LAS unsigned char* scr) {
    const int lane = F.lane + vzero(), r16 = lane & 15, g4 = lane >> 4;
    const int bg = idx >> 5, n = idx & 31, b = bg >> 4, g = bg & 15;
    LAS float* bu = (LAS float*)scr;
    LAS bf16_t* xs = (LAS bf16_t*)(scr + 8448);
    const float* abar = (const float*)(F.ws + WS_S5P + S5P_ABAR) + ((size_t)(layer * 16 + g) * 64 + lane) * 2;
    const float ar = abar[0], ai = abar[1];
    const bf16_t* Bm = (const bf16_t*)(F.ws + WS_S5P + S5P_BM) + (size_t)(layer * 16 + g) * 128 * 16;
    const bf16_t* Cm = (const bf16_t*)(F.ws + WS_S5P + S5P_CM) + (size_t)(layer * 16 + g) * 16 * 128;
    const bf16_t* H = WSP(const bf16_t, WS_H);
    Frag zf; zf.q = (u32x4){0u, 0u, 0u, 0u};
    bf16x8 bfr[8];
#pragma unroll
    for (int nb = 0; nb < 8; ++nb) bfr[nb] = (g4 < 2) ? *(const bf16x8*)(Bm + (nb * 16 + r16) * 16 + 8 * g4) : zf.v;
    bf16x8 cfr[4];
    if (OUT) {
#pragma unroll
        for (int ks = 0; ks < 4; ++ks) cfr[ks] = *(const bf16x8*)(Cm + r16 * 128 + 32 * ks + 8 * g4); }
    float xr = 0.f, xi = 0.f;
    if (OUT) { const float* ci = WSP(const float, WS_S5C) + ((size_t)(bg * 32 + n) * 64 + lane) * 2; xr = ci[0]; xi = ci[1]; }
    const float dsk = OUT ? IN_F(11)[layer * 256 + g * 16 + r16] : 0.f;
    const size_t tok0 = (size_t)b * SEQ + n * 64;
    bf16x8 afr_n = (g4 < 2) ? *(const bf16x8*)(H + (tok0 + r16) * HP + C_US5 + g * 16 + 8 * g4) : zf.v;
    bf16_t un[4] = {0, 0, 0, 0};
    if (OUT) {
#pragma unroll
        for (int r = 0; r < 4; ++r) un[r] = H[(tok0 + 4 * g4 + r) * HP + C_US5 + g * 16 + r16]; }
#pragma unroll 1
    for (int sub = 0; sub < 4; ++sub) {
        const size_t t0 = tok0 + sub * 16;
        const bf16x8 afr = afr_n; bf16_t uc[4];
#pragma unroll
        for (int r = 0; r < 4; ++r) uc[r] = un[r];
        if (sub < 3) { afr_n = (g4 < 2) ? *(const bf16x8*)(H + (t0 + 16 + r16) * HP + C_US5 + g * 16 + 8 * g4) : zf.v;
            if (OUT) {
#pragma unroll
                for (int r = 0; r < 4; ++r) un[r] = H[(t0 + 16 + 4 * g4 + r) * HP + C_US5 + g * 16 + r16]; } }
#pragma unroll
        for (int nb = 0; nb < 8; ++nb) { const f32x4 c = mfma16(afr, bfr[nb], (f32x4){0.f, 0.f, 0.f, 0.f});
#pragma unroll
            for (int r = 0; r < 4; ++r) bu[(4 * g4 + r) * 132 + nb * 16 + r16] = c[r]; }
        WSYNC();
#pragma unroll
        for (int tk = 0; tk < 16; ++tk) { const float bre = bu[tk * 132 + lane], bim = bu[tk * 132 + 64 + lane];
            const float nr = ar * xr - ai * xi + bre, ni = ar * xi + ai * xr + bim; xr = nr; xi = ni;
            if (OUT) { xs[tk * 136 + lane] = f2bf(xr); xs[tk * 136 + 64 + lane] = f2bf(xi); } }
        if (OUT) {
            WSYNC();
            f32x4 y = (f32x4){0.f, 0.f, 0.f, 0.f};
#pragma unroll
            for (int ks = 0; ks < 4; ++ks) { const bf16x8 a = *(const LAS bf16x8*)(xs + r16 * 136 + 32 * ks + 8 * g4); y = mfma16(a, cfr[ks], y); }
            bf16_t* pre = WSP(bf16_t, WS_S5PRE);
#pragma unroll
            for (int r = 0; r < 4; ++r) { const size_t t = t0 + 4 * g4 + r; pre[t * 256 + g * 16 + r16] = f2bf(gelu_tanh(y[r] + dsk * bf2f(uc[r]))); }
        }
        WSYNC();
    }
    if (!OUT) { float* e = WSP(float, WS_S5E) + ((size_t)(bg * 32 + n) * 64 + lane) * 2; e[0] = xr; e[1] = xi; }
}
__device__ __forceinline__ void s5_carry(const Frame& F, int layer) {
    const int gt = F.bid * 512 + F.tid;
    if (gt >= NBATCH * 16 * 64) return;
    const int bg = gt >> 6, p = gt & 63, g = bg & 15;
    const float* abar = (const float*)(F.ws + WS_S5P + S5P_ABAR) + ((size_t)(layer * 16 + g) * 64 + p) * 2;
    float pr = abar[0], pi = abar[1];
#pragma unroll
    for (int i = 0; i < 6; ++i) { const float nr = pr * pr - pi * pi, ni = 2.f * pr * pi; pr = nr; pi = ni; }
    const float* E = WSP(const float, WS_S5E); float* C = WSP(float, WS_S5C);
    float cr = 0.f, ci = 0.f;
#pragma unroll 1
    for (int n = 0; n < 32; ++n) { const size_t o = ((size_t)(bg * 32 + n) * 64 + p) * 2; C[o] = cr; C[o + 1] = ci;
        const float er = E[o], ei = E[o + 1]; const float nr = pr * cr - pi * ci + er, ni = pr * ci + pi * cr + ei; cr = nr; ci = ni; }
}

template <bool OUT>
__device__ __forceinline__ void hg_item(const Frame& F, int layer, int idx, LAS unsigned char* scr) {
    const int lane = F.lane + vzero(), r16 = lane & 15, g4 = lane >> 4;
    const int bh = idx >> 5, sc = idx & 31, b = bh >> 2, h = bh & 3;
    LAS bf16_t* Qt = (LAS bf16_t*)scr;
    LAS bf16_t* Kt = (LAS bf16_t*)(scr + 2304);
    LAS bf16_t* Vs = (LAS bf16_t*)(scr + 4608);
    LAS float* dec = (LAS float*)(scr + 6656);
    const bf16_t* H = WSP(const bf16_t, WS_H);
    const float lbv = ((const float*)(F.ws + WS_S5P + S5P_LB))[layer * 256 + h * 64 + lane], oml = 1.0f - lbv;
    f32x4 S[4][4];
    if (OUT) { const float* si = WSP(const float, WS_HGI) + (size_t)(bh * 32 + sc) * 4096;
#pragma unroll
        for (int mb = 0; mb < 4; ++mb)
#pragma unroll
            for (int vb = 0; vb < 4; ++vb)
#pragma unroll
                for (int r = 0; r < 4; ++r) S[mb][vb][r] = si[(16 * mb + 4 * g4 + r) * 64 + 16 * vb + r16];
    } else {
#pragma unroll
        for (int mb = 0; mb < 4; ++mb)
#pragma unroll
            for (int vb = 0; vb < 4; ++vb) S[mb][vb] = (f32x4){0.f, 0.f, 0.f, 0.f};
    }
    float ltot = 0.f;
    const size_t tbase = (size_t)b * SEQ + sc * 64;
    unsigned rf[8], ri[8], rq[8]; u32x2 rg[4];
#define HG_LOAD(t0_) do { _Pragma("unroll") for (int p = 0; p < 8; ++p) { const bf16_t* r0 = H + ((t0_) + 2 * p) * HP + h * 64 + lane; const bf16_t* r1 = r0 + HP; \
            rf[p] = (unsigned)r0[C_HF] | ((unsigned)r1[C_HF] << 16); ri[p] = (unsigned)r0[C_HI] | ((unsigned)r1[C_HI] << 16); if (OUT) rq[p] = (unsigned)r0[C_HQ] | ((unsigned)r1[C_HQ] << 16); } \
        if (OUT) { _Pragma("unroll") for (int vb = 0; vb < 4; ++vb) rg[vb] = *(const u32x2*)(H + ((t0_) + r16) * HP + C_HG + h * 64 + 16 * vb + 4 * g4); } } while (0)
    HG_LOAD(tbase);
#pragma unroll 1
    for (int ch = 0; ch < 4; ++ch) {
        const size_t t0 = tbase + ch * 16;
        float bcum = 0.f;
#pragma unroll
        for (int tk = 0; tk < 16; ++tk) { const unsigned wf = rf[tk >> 1], wi = ri[tk >> 1];
            const float fv = (tk & 1) ? __uint_as_float(wf & 0xffff0000u) : __uint_as_float(wf << 16);
            const float sg = 1.0f / (1.0f + __expf(-fv)); const float forget = lbv + oml * sg; bcum += __logf(forget);
            const float kv_ = oml * (1.0f - sg), e = __expf(fmaxf(bcum, -80.0f));
            Kt[tk * 72 + lane] = f2bf(kv_ * __builtin_amdgcn_rcpf(e));
            if (OUT) { const unsigned wq = rq[tk >> 1]; const float qv = (tk & 1) ? __uint_as_float(wq & 0xffff0000u) : __uint_as_float(wq << 16); Qt[tk * 72 + lane] = f2bf(siluf_(qv) * e); }
            Vs[tk * 64 + lane] = (bf16_t)((tk & 1) ? (wi >> 16) : (wi & 0xffffu)); }
        dec[lane] = __expf(bcum); ltot += bcum;
        u32x2 gcur[4];
        if (OUT) {
#pragma unroll
            for (int vb = 0; vb < 4; ++vb) gcur[vb] = rg[vb]; }
        if (ch < 3) HG_LOAD(t0 + 16);
        WSYNC();
        Frag vfr[4], kfr[4];
#pragma unroll
        for (int vb = 0; vb < 4; ++vb) { vfr[vb].q = (u32x4){0u, 0u, 0u, 0u};
#pragma unroll
            for (int j = 0; j < 4; ++j) vfr[vb].h[j] = Vs[(4 * g4 + j) * 64 + 16 * vb + r16]; }
#pragma unroll
        for (int mb = 0; mb < 4; ++mb) { kfr[mb].q = (u32x4){0u, 0u, 0u, 0u};
#pragma unroll
            for (int j = 0; j < 4; ++j) kfr[mb].h[j] = Kt[(4 * g4 + j) * 72 + 16 * mb + r16]; }
        if (OUT) {
            f32x4 at = (f32x4){0.f, 0.f, 0.f, 0.f};
#pragma unroll
            for (int ks = 0; ks < 2; ++ks) { const bf16x8 a = *(const LAS bf16x8*)(Kt + r16 * 72 + 32 * ks + 8 * g4), bq = *(const LAS bf16x8*)(Qt + r16 * 72 + 32 * ks + 8 * g4); at = mfma16(a, bq, at); }
#pragma unroll
            for (int r = 0; r < 4; ++r) if (4 * g4 + r > r16) at[r] = 0.f;
            Frag pfr; pfr.q = (u32x4){0u, 0u, 0u, 0u}; pfr.u[0] = cvt_pk_bf16(at[0], at[1]); pfr.u[1] = cvt_pk_bf16(at[2], at[3]);
            Frag qfr[2];
#pragma unroll
            for (int ks = 0; ks < 2; ++ks) { qfr[ks].d[0] = *(const LAS u32x2*)(Qt + r16 * 72 + 32 * ks + 4 * g4); qfr[ks].d[1] = *(const LAS u32x2*)(Qt + r16 * 72 + 32 * ks + 16 + 4 * g4); }
            f32x4 o[4]; float ss = 0.f;
#pragma unroll
            for (int vb = 0; vb < 4; ++vb) { f32x4 a = (f32x4){0.f, 0.f, 0.f, 0.f};
#pragma unroll
                for (int ks = 0; ks < 2; ++ks) { Frag sf; sf.u[0] = cvt_pk_bf16(S[2 * ks][vb][0], S[2 * ks][vb][1]); sf.u[1] = cvt_pk_bf16(S[2 * ks][vb][2], S[2 * ks][vb][3]);
                    sf.u[2] = cvt_pk_bf16(S[2 * ks + 1][vb][0], S[2 * ks + 1][vb][1]); sf.u[3] = cvt_pk_bf16(S[2 * ks + 1][vb][2], S[2 * ks + 1][vb][3]); a = mfma16(sf.v, qfr[ks].v, a); }
                a = mfma16(vfr[vb].v, pfr.v, a); o[vb] = a; ss += a[0] * a[0] + a[1] * a[1] + a[2] * a[2] + a[3] * a[3]; }
            ss += __shfl_xor(ss, 16); ss += __shfl_xor(ss, 32);
            const float rs = rsqrtf(ss * (1.0f / 64.0f) + EPS);
            const size_t t = t0 + r16; bf16_t* Y = WSP(bf16_t, WS_Y);
#pragma unroll
            for (int vb = 0; vb < 4; ++vb) { const int vi0 = h * 64 + 16 * vb + 4 * g4; const u32x2 gv = gcur[vb]; const f32x4 ng = *(const f32x4*)(IN_F(18) + layer * 256 + vi0);
                const float g0 = __uint_as_float(gv.x << 16), g1 = __uint_as_float(gv.x & 0xffff0000u), g2 = __uint_as_float(gv.y << 16), g3 = __uint_as_float(gv.y & 0xffff0000u);
                u32x2 w; w.x = cvt_pk_bf16(o[vb][0] * rs * ng[0] * siluf_(g0), o[vb][1] * rs * ng[1] * siluf_(g1)); w.y = cvt_pk_bf16(o[vb][2] * rs * ng[2] * siluf_(g2), o[vb][3] * rs * ng[3] * siluf_(g3));
                *(u32x2*)(Y + t * 1024 + 512 + vi0) = w; }
        }
#pragma unroll
        for (int mb = 0; mb < 4; ++mb) { const f32x4 dv = *(const LAS f32x4*)(dec + 16 * mb + 4 * g4);
#pragma unroll
            for (int vb = 0; vb < 4; ++vb) S[mb][vb] = mfma16(kfr[mb].v, vfr[vb].v, S[mb][vb]) * dv; }
        WSYNC();
    }
#undef HG_LOAD
    if (!OUT) { float* se = WSP(float, WS_HGE) + (size_t)(bh * 32 + sc) * 4096;
#pragma unroll
        for (int mb = 0; mb < 4; ++mb)
#pragma unroll
            for (int vb = 0; vb < 4; ++vb)
#pragma unroll
                for (int r = 0; r < 4; ++r) se[(16 * mb + 4 * g4 + r) * 64 + 16 * vb + r16] = S[mb][vb][r];
        WSP(float, WS_HGD)[(size_t)(bh * 32 + sc) * 64 + lane] = __expf(ltot); }
}
__device__ __forceinline__ void hg_carry(const Frame& F) {
    const int gt = F.bid * 512 + F.tid; if (gt >= 32 * 4096) return;
    const int bh = gt >> 12, kv = gt & 4095, k = kv >> 6;
    const float* E = WSP(const float, WS_HGE); const float* Dt = WSP(const float, WS_HGD); float* I = WSP(float, WS_HGI);
    float s = 0.f;
#pragma unroll 2
    for (int sc = 0; sc < 32; ++sc) { const size_t o = (size_t)(bh * 32 + sc) * 4096 + kv; I[o] = s; s = Dt[(size_t)(bh * 32 + sc) * 64 + k] * s + E[o]; }
}

__device__ __forceinline__ float ret_l2g(int h) { return __log2f(1.0f - exp2f(-5.0f - (float)h)); }
__device__ __forceinline__ void ret_item1(const Frame& F, int idx, LAS unsigned char* scr) {
    const int lane = F.lane + vzero(), r16 = lane & 15, g4 = lane >> 4;
    const int bh = idx >> 5, n = idx & 31, b = bh >> 2, h = bh & 3;
    LAS bf16_t* Kd = (LAS bf16_t*)scr;
    LAS bf16_t* Vs = (LAS bf16_t*)(scr + 8192);
    const bf16_t* H = WSP(const bf16_t, WS_H); const float* rope = WSP(const float, WS_ROPER);
    bf16_t* QR = WSP(bf16_t, WS_QR); bf16_t* KR = WSP(bf16_t, WS_KR);
    const float l2g = ret_l2g(h);
    const size_t t0 = (size_t)b * SEQ + n * 64;
#pragma unroll 8
    for (int tk = 0; tk < 64; ++tk) { const size_t t = t0 + tk; const bf16_t* row = H + t * HP + h * 64 + lane;
        const float kx = bf2f(row[C_RK]), qx = bf2f(row[C_RQ]); const float kp = __shfl_xor(kx, 32), qp = __shfl_xor(qx, 32);
        const float c = rope[t * 64 + (lane & 31)], s = rope[t * 64 + 32 + (lane & 31)];
        const float kh = lane < 32 ? kx * c - kp * s : kx * c + kp * s, qh = (lane < 32 ? qx * c - qp * s : qx * c + qp * s) * 0.125f;
        KR[t * 256 + h * 64 + lane] = f2bf(kh); QR[t * 256 + h * 64 + lane] = f2bf(qh);
        Kd[tk * 64 + lane] = f2bf(kh * exp2f((float)(63 - tk) * l2g)); Vs[tk * 64 + lane] = row[C_RV]; }
    WSYNC();
    Frag vfr[4][2];
#pragma unroll
    for (int vb = 0; vb < 4; ++vb)
#pragma unroll
        for (int ks = 0; ks < 2; ++ks)
#pragma unroll
            for (int j = 0; j < 8; ++j) vfr[vb][ks].h[j] = Vs[(32 * ks + 8 * g4 + j) * 64 + 16 * vb + r16];
    float* E = WSP(float, WS_RTE) + (size_t)(bh * 32 + n) * 4096;
#pragma unroll
    for (int mb = 0; mb < 4; ++mb) { Frag kf[2];
#pragma unroll
        for (int ks = 0; ks < 2; ++ks)
#pragma unroll
            for (int j = 0; j < 8; ++j) kf[ks].h[j] = Kd[(32 * ks + 8 * g4 + j) * 64 + 16 * mb + r16];
#pragma unroll
        for (int vb = 0; vb < 4; ++vb) { f32x4 a = (f32x4){0.f, 0.f, 0.f, 0.f};
#pragma unroll
            for (int ks = 0; ks < 2; ++ks) a = mfma16(kf[ks].v, vfr[vb][ks].v, a);
            *(f32x4*)(E + (16 * vb + r16) * 64 + 16 * mb + 4 * g4) = a; } }
    WSYNC();
}
__device__ __forceinline__ void ret_carry(const Frame& F) {
    const int gt = F.bid * 512 + F.tid; if (gt >= 32 * 4096) return;
    const int bh = gt >> 12, vk = gt & 4095, h = bh & 3;
    const float g64 = exp2f(64.0f * ret_l2g(h));
    const float* E = WSP(const float, WS_RTE); float* I = WSP(float, WS_RTI);
    float s = 0.f;
#pragma unroll 2
    for (int n = 0; n < 32; ++n) { const size_t o = (size_t)(bh * 32 + n) * 4096 + vk; I[o] = s; s = g64 * s + E[o]; }
}
__device__ __forceinline__ void ret_item3(const Frame& F, int layer, int idx, LAS unsigned char* scr) {
    const int lane = F.lane + vzero(), r16 = lane & 15, g4 = lane >> 4;
    const int bh = idx >> 5, n = idx & 31, b = bh >> 2, h = bh & 3;
    LAS bf16_t* Vs = (LAS bf16_t*)scr;
    const bf16_t* H = WSP(const bf16_t, WS_H); const bf16_t* QR = WSP(const bf16_t, WS_QR); const bf16_t* KR = WSP(const bf16_t, WS_KR);
    const float l2g = ret_l2g(h);
    const size_t t0 = (size_t)b * SEQ + n * 64;
#pragma unroll
    for (int tk = 0; tk < 64; ++tk) Vs[tk * 64 + lane] = H[(t0 + tk) * HP + C_RV + h * 64 + lane];
    Frag sfr[4][2];
    { const float* si = WSP(const float, WS_RTI) + (size_t)(bh * 32 + n) * 4096;
#pragma unroll
      for (int vb = 0; vb < 4; ++vb)
#pragma unroll
        for (int ks = 0; ks < 2; ++ks) { const f32x4 a = *(const f32x4*)(si + (16 * vb + r16) * 64 + 32 * ks + 8 * g4), c = *(const f32x4*)(si + (16 * vb + r16) * 64 + 32 * ks + 8 * g4 + 4);
            sfr[vb][ks].u[0] = cvt_pk_bf16(a[0], a[1]); sfr[vb][ks].u[1] = cvt_pk_bf16(a[2], a[3]); sfr[vb][ks].u[2] = cvt_pk_bf16(c[0], c[1]); sfr[vb][ks].u[3] = cvt_pk_bf16(c[2], c[3]); } }
    bf16_t* Y = WSP(bf16_t, WS_Y);
    bf16x8 kfa[4][2], qfa[4][2]; u32x2 gva[4][4];
#pragma unroll
    for (int sb = 0; sb < 4; ++sb)
#pragma unroll
        for (int ks = 0; ks < 2; ++ks) { kfa[sb][ks] = *(const bf16x8*)(KR + (t0 + 16 * sb + r16) * 256 + h * 64 + 32 * ks + 8 * g4); qfa[sb][ks] = *(const bf16x8*)(QR + (t0 + 16 * sb + r16) * 256 + h * 64 + 32 * ks + 8 * g4); }
#pragma unroll
    for (int tb = 0; tb < 4; ++tb)
#pragma unroll
        for (int vb = 0; vb < 4; ++vb) gva[tb][vb] = *(const u32x2*)(H + (t0 + 16 * tb + r16) * HP + C_RG + h * 64 + 16 * vb + 4 * g4);
    WSYNC();
    Frag vfr[4][2];
#pragma unroll
    for (int vb = 0; vb < 4; ++vb)
#pragma unroll
        for (int ks = 0; ks < 2; ++ks)
#pragma unroll
            for (int j = 0; j < 8; ++j) vfr[vb][ks].h[j] = Vs[(32 * ks + 16 * (j >> 2) + 4 * g4 + (j & 3)) * 64 + 16 * vb + r16];
#pragma unroll
    for (int tb = 0; tb < 4; ++tb) {
        const int tl = 16 * tb + r16; const size_t t = t0 + tl;
        Frag pfr[2]; pfr[0].q = (u32x4){0u, 0u, 0u, 0u}; pfr[1].q = (u32x4){0u, 0u, 0u, 0u};
#pragma unroll
        for (int sb = 0; sb < 4; ++sb) { if (sb > tb) continue;
            f32x4 sc = (f32x4){0.f, 0.f, 0.f, 0.f};
#pragma unroll
            for (int ks = 0; ks < 2; ++ks) sc = mfma16(kfa[sb][ks], qfa[tb][ks], sc);
#pragma unroll
            for (int r = 0; r < 4; ++r) { const int rel = tl - (16 * sb + 4 * g4 + r); sc[r] = rel >= 0 ? sc[r] * exp2f((float)rel * l2g) : 0.f; }
            pfr[sb >> 1].u[(sb & 1) * 2] = cvt_pk_bf16(sc[0], sc[1]); pfr[sb >> 1].u[(sb & 1) * 2 + 1] = cvt_pk_bf16(sc[2], sc[3]); }
        const float qd = exp2f((float)(tl + 1) * l2g);
        f32x4 o[4]; float s1 = 0.f;
#pragma unroll
        for (int vb = 0; vb < 4; ++vb) { f32x4 a = (f32x4){0.f, 0.f, 0.f, 0.f};
#pragma unroll
            for (int ks = 0; ks < 2; ++ks) a = mfma16(sfr[vb][ks].v, qfa[tb][ks], a);
            a = a * qd;
            a = mfma16(vfr[vb][0].v, pfr[0].v, a);
            if (tb >= 2) a = mfma16(vfr[vb][1].v, pfr[1].v, a);
            o[vb] = a; s1 += (a[0] + a[1]) + (a[2] + a[3]); }
        s1 += __shfl_xor(s1, 16); s1 += __shfl_xor(s1, 32);
        const float mean = s1 * (1.0f / 64.0f); float s2 = 0.f;
#pragma unroll
        for (int vb = 0; vb < 4; ++vb) { const f32x4 d = o[vb] - mean; s2 += d[0] * d[0] + d[1] * d[1] + d[2] * d[2] + d[3] * d[3]; }
        s2 += __shfl_xor(s2, 16); s2 += __shfl_xor(s2, 32);
        const float rstd = rsqrtf(s2 * (1.0f / 64.0f) + EPS);
#pragma unroll
        for (int vb = 0; vb < 4; ++vb) { const int vi0 = h * 64 + 16 * vb + 4 * g4; const u32x2 gv = gva[tb][vb];
            const f32x4 gg = *(const f32x4*)(IN_F(19) + layer * 256 + vi0), gb = *(const f32x4*)(IN_F(20) + layer * 256 + vi0);
            const float g0 = __uint_as_float(gv.x << 16), g1 = __uint_as_float(gv.x & 0xffff0000u), g2 = __uint_as_float(gv.y << 16), g3 = __uint_as_float(gv.y & 0xffff0000u);
            u32x2 w; w.x = cvt_pk_bf16(((o[vb][0] - mean) * rstd * gg[0] + gb[0]) * siluf_(g0), ((o[vb][1] - mean) * rstd * gg[1] + gb[1]) * siluf_(g1));
            w.y = cvt_pk_bf16(((o[vb][2] - mean) * rstd * gg[2] + gb[2]) * siluf_(g2), ((o[vb][3] - mean) * rstd * gg[3] + gb[3]) * siluf_(g3));
            *(u32x2*)(Y + t * 1024 + 768 + vi0) = w; }
    }
    WSYNC();
}

__device__ __forceinline__ void attn_unit(const Frame& F, int bh, int qt) {
    const int vz = vzero(); const int lane = F.lane + vz, r16 = lane & 15, g4 = lane >> 4, w = F.wave, tid = F.tid + vz;
    LAS bf16_t* Kt = (LAS bf16_t*)(F.lds + LDS_STAGE);
    LAS bf16_t* Vl = (LAS bf16_t*)(F.lds + LDS_STAGE + 13312);
    const bf16_t* Qb = WSP(const bf16_t, WS_Q) + (size_t)bh * SEQ * 96; const bf16_t* Kb = WSP(const bf16_t, WS_K) + (size_t)bh * SEQ * 96; const bf16_t* Vt = WSP(const bf16_t, WS_VT) + (size_t)bh * 64 * SEQ;
    const int q0 = qt * 128, qrow = q0 + 16 * w + r16;
    bf16x8 qfr[3];
#pragma unroll
    for (int ks = 0; ks < 3; ++ks) qfr[ks] = *(const bf16x8*)(Qb + (size_t)qrow * 96 + 32 * ks + 8 * g4);
    float mrun = -1e30f, lrun = 0.f;
    f32x4 O[4];
#pragma unroll
    for (int db = 0; db < 4; ++db) O[db] = (f32x4){0.f, 0.f, 0.f, 0.f};
    const int nkt = 2 * qt + 2;
    const int kkey0 = tid / 12, kpart0 = tid % 12, kkey1 = (tid + 512) / 12, kpart1 = (tid + 512) % 12; const bool k1 = tid < 256;
    const int vdv = tid >> 3, vpart = tid & 7;
    u32x4 rk0, rk1, rv;
    rk1 = (u32x4){0u, 0u, 0u, 0u};
    rk0 = *(const u32x4*)(Kb + (size_t)kkey0 * 96 + kpart0 * 8); if (k1) rk1 = *(const u32x4*)(Kb + (size_t)kkey1 * 96 + kpart1 * 8);
    rv = *(const u32x4*)(Vt + (size_t)vdv * SEQ + vpart * 8);
#pragma unroll 1
    for (int kt = 0; kt < nkt; ++kt) {
        __syncthreads();
        *(LAS u32x4*)(Kt + kkey0 * 104 + kpart0 * 8) = rk0; if (k1) *(LAS u32x4*)(Kt + kkey1 * 104 + kpart1 * 8) = rk1;
        *(LAS u32x4*)(Vl + vdv * 72 + vpart * 8) = rv;
        __syncthreads();
        if (kt + 1 < nkt) { const size_t kb = (size_t)(kt + 1) * 64;
            rk0 = *(const u32x4*)(Kb + (kb + kkey0) * 96 + kpart0 * 8); if (k1) rk1 = *(const u32x4*)(Kb + (kb + kkey1) * 96 + kpart1 * 8);
            rv = *(const u32x4*)(Vt + (size_t)vdv * SEQ + kb + vpart * 8); }
        f32x4 sc[4]; float mx = -1e30f;
#pragma unroll
        for (int kb = 0; kb < 4; ++kb) { f32x4 s = (f32x4){0.f, 0.f, 0.f, 0.f};
#pragma unroll
            for (int ks = 0; ks < 3; ++ks) { const bf16x8 a = *(const LAS bf16x8*)(Kt + (16 * kb + r16) * 104 + 32 * ks + 8 * g4); s = mfma16(a, qfr[ks], s); }
            if (kt >= 2 * qt) {
#pragma unroll
                for (int r = 0; r < 4; ++r) if (kt * 64 + 16 * kb + 4 * g4 + r > qrow) s[r] = -1e30f; }
            sc[kb] = s; mx = fmaxf(mx, fmaxf(fmaxf(s[0], s[1]), fmaxf(s[2], s[3]))); }
        mx = fmaxf(mx, __shfl_xor(mx, 16)); mx = fmaxf(mx, __shfl_xor(mx, 32));
        const float mnew = fmaxf(mrun, mx), alpha = exp2f(mrun - mnew); mrun = mnew;
        float ls = 0.f;
#pragma unroll
        for (int kb = 0; kb < 4; ++kb)
#pragma unroll
            for (int r = 0; r < 4; ++r) { const float p = exp2f(sc[kb][r] - mnew); sc[kb][r] = p; ls += p; }
        lrun = lrun * alpha + ls;
        Frag pf[2];
#pragma unroll
        for (int ks = 0; ks < 2; ++ks) { pf[ks].u[0] = cvt_pk_bf16(sc[2 * ks][0], sc[2 * ks][1]); pf[ks].u[1] = cvt_pk_bf16(sc[2 * ks][2], sc[2 * ks][3]); pf[ks].u[2] = cvt_pk_bf16(sc[2 * ks + 1][0], sc[2 * ks + 1][1]); pf[ks].u[3] = cvt_pk_bf16(sc[2 * ks + 1][2], sc[2 * ks + 1][3]); }
#pragma unroll
        for (int db = 0; db < 4; ++db) { f32x4 o = O[db] * alpha;
#pragma unroll
            for (int ks = 0; ks < 2; ++ks) { Frag vf; vf.d[0] = *(const LAS u32x2*)(Vl + (16 * db + r16) * 72 + 32 * ks + 4 * g4); vf.d[1] = *(const LAS u32x2*)(Vl + (16 * db + r16) * 72 + 32 * ks + 16 + 4 * g4); o = mfma16(vf.v, pf[ks].v, o); }
            O[db] = o; }
    }
    lrun += __shfl_xor(lrun, 16); lrun += __shfl_xor(lrun, 32);
    const float inv = 1.0f / lrun;
    const int b = bh >> 2, h = bh & 3; bf16_t* Y = WSP(bf16_t, WS_Y) + ((size_t)b * SEQ + qrow) * 1024 + 256 + h * 64;
#pragma unroll
    for (int db = 0; db < 4; ++db) { u32x2 wv; wv.x = cvt_pk_bf16(O[db][0] * inv, O[db][1] * inv); wv.y = cvt_pk_bf16(O[db][2] * inv, O[db][3] * inv); *(u32x2*)(Y + 16 * db + 4 * g4) = wv; }
}

__device__ __forceinline__ void ln_row_write(f32x4 (&v)[4], const float* g, const float* bta, float* of, bf16_t* ob, int lane) {
    float s = 0.f;
#pragma unroll
    for (int j = 0; j < 4; ++j) s += (v[j][0] + v[j][1]) + (v[j][2] + v[j][3]);
    const float mean = wave_sum(s) * (1.0f / 1024.0f); float s2 = 0.f;
#pragma unroll
    for (int j = 0; j < 4; ++j) { v[j] = v[j] - mean; s2 += (v[j][0] * v[j][0] + v[j][1] * v[j][1]) + (v[j][2] * v[j][2] + v[j][3] * v[j][3]); }
    const float rstd = rsqrtf(wave_sum(s2) * (1.0f / 1024.0f) + EPS);
#pragma unroll
    for (int j = 0; j < 4; ++j) { const f32x4 gg = *(const f32x4*)(g + 4 * lane + 256 * j), bb = *(const f32x4*)(bta + 4 * lane + 256 * j); v[j] = v[j] * rstd * gg + bb;
        *(f32x4*)(of + 4 * lane + 256 * j) = v[j]; u32x2 w; w.x = cvt_pk_bf16(v[j][0], v[j][1]); w.y = cvt_pk_bf16(v[j][2], v[j][3]); *(u32x2*)(ob + 4 * lane + 256 * j) = w; }
}
template <bool MOE>
__device__ __forceinline__ void ln1_phase(const Frame& F, int layer) {
    const int lane = F.lane; bf16_t* XB = WSP(bf16_t, WS_XB);
    LAS int* lcnt = (LAS int*)(F.lds + LDS_MISC);
    LAS int* rinfo = (LAS int*)(F.lds + LDS_MISC + 64);
    LAS float* rw = (LAS float*)(F.lds + LDS_MISC + 64 + 4096);
    if (MOE) { if (F.tid < 16) lcnt[F.tid] = 0; __syncthreads(); }
    const int rows_per_blk = T / F.G;
    const float* wr_ = MOE ? IN_F(28) + (size_t)(layer >> 1) * 1024 * 8 : nullptr;
    for (int lr = F.wave; lr < rows_per_blk; lr += 8) { const int t = F.bid * rows_per_blk + lr;
        float* xr = F.out + (size_t)t * 1024; f32x4 v[4];
#pragma unroll
        for (int j = 0; j < 4; ++j) v[j] = *(const f32x4*)(xr + 4 * lane + 256 * j);
        ln_row_write(v, IN_F(23) + layer * 1024, IN_F(24) + layer * 1024, xr, XB + (size_t)t * 1024, lane);
        if (MOE) {
            float lg[8];
#pragma unroll
            for (int e = 0; e < 8; ++e) lg[e] = 0.f;
#pragma unroll
            for (int j = 0; j < 4; ++j)
#pragma unroll
                for (int q = 0; q < 4; ++q) { const float xv = v[j][q]; const float* wrow = wr_ + (size_t)(4 * lane + 256 * j + q) * 8; const f32x4 w0 = *(const f32x4*)wrow, w1 = *(const f32x4*)(wrow + 4);
                    lg[0] += xv * w0[0]; lg[1] += xv * w0[1]; lg[2] += xv * w0[2]; lg[3] += xv * w0[3]; lg[4] += xv * w1[0]; lg[5] += xv * w1[1]; lg[6] += xv * w1[2]; lg[7] += xv * w1[3]; }
#pragma unroll
            for (int e = 0; e < 8; ++e) lg[e] = wave_sum(lg[e]);
            int e0 = 0; float v0 = lg[0];
#pragma unroll
            for (int e = 1; e < 8; ++e) if (lg[e] > v0) { v0 = lg[e]; e0 = e; }
            int e1 = -1; float v1 = -3.0e38f;
#pragma unroll
            for (int e = 0; e < 8; ++e) if (e != e0 && lg[e] > v1) { v1 = lg[e]; e1 = e; }
            if (lane == 0) { const float w0 = 1.0f / (1.0f + __expf(v1 - v0)); const int p0 = __hip_atomic_fetch_add(&lcnt[e0], 1, __ATOMIC_RELAXED, __HIP_MEMORY_SCOPE_WORKGROUP), p1 = __hip_atomic_fetch_add(&lcnt[e1], 1, __ATOMIC_RELAXED, __HIP_MEMORY_SCOPE_WORKGROUP);
                rinfo[lr * 4 + 0] = e0; rinfo[lr * 4 + 1] = e1; rinfo[lr * 4 + 2] = p0; rinfo[lr * 4 + 3] = p1; rw[lr * 2] = w0; rw[lr * 2 + 1] = 1.0f - w0; }
        }
    }
    if (MOE) {
        __syncthreads();
        unsigned* gcnt = WSP(unsigned, WS_CTL) + CW_MOE + (layer >> 1) * 64;
        if (F.tid < 8) lcnt[8 + F.tid] = (int)__hip_atomic_fetch_add(gcnt + F.tid, (unsigned)lcnt[F.tid], __ATOMIC_RELAXED, __HIP_MEMORY_SCOPE_AGENT);
        __syncthreads();
        int* te = (int*)(F.ws + WS_TOK + TOK_E); int* tp = (int*)(F.ws + WS_TOK + TOK_POS); float* tw = (float*)(F.ws + WS_TOK + TOK_W);
        for (int i = F.tid; i < rows_per_blk * 2; i += 512) { const int lr = i >> 1, k = i & 1, t = F.bid * rows_per_blk + lr; const int e = rinfo[lr * 4 + k];
            te[t * 2 + k] = e; tp[t * 2 + k] = lcnt[8 + e] + rinfo[lr * 4 + 2 + k]; tw[t * 2 + k] = rw[lr * 2 + k]; }
    }
}
struct MoeOff { int ts0, ts1, ts2, ts3, ts4, ts5, ts6, ts7, ts8; };
__device__ __forceinline__ MoeOff moe_offsets(const Frame& F, int layer, int* cnt_out  ) {
    const unsigned* gcnt = WSP(const unsigned, WS_CTL) + CW_MOE + (layer >> 1) * 64;
    MoeOff o; int c[8];
#pragma unroll
    for (int e = 0; e < 8; ++e) c[e] = (int)__hip_atomic_load(gcnt + e, __ATOMIC_RELAXED, __HIP_MEMORY_SCOPE_AGENT);
    o.ts0 = 0; o.ts1 = o.ts0 + ((c[0] + 255) >> 8); o.ts2 = o.ts1 + ((c[1] + 255) >> 8); o.ts3 = o.ts2 + ((c[2] + 255) >> 8); o.ts4 = o.ts3 + ((c[3] + 255) >> 8);
    o.ts5 = o.ts4 + ((c[4] + 255) >> 8); o.ts6 = o.ts5 + ((c[5] + 255) >> 8); o.ts7 = o.ts6 + ((c[6] + 255) >> 8); o.ts8 = o.ts7 + ((c[7] + 255) >> 8);
    if (cnt_out) {
#pragma unroll
        for (int e = 0; e < 8; ++e) cnt_out[e] = c[e]; }
    return o;
}
__device__ __forceinline__ int moe_ts(const MoeOff& o, int e) { return e == 0 ? o.ts0 : e == 1 ? o.ts1 : e == 2 ? o.ts2 : e == 3 ? o.ts3 : e == 4 ? o.ts4 : e == 5 ? o.ts5 : e == 6 ? o.ts6 : o.ts7; }
__device__ __forceinline__ void moe_gather(const Frame& F, int layer) {
    int cnt[8]; const MoeOff o = moe_offsets(F, layer, cnt);
    const int lane = F.lane; const bf16_t* XB = WSP(const bf16_t, WS_XB); bf16_t* XG = WSP(bf16_t, WS_XG);
    const int* te = (const int*)(F.ws + WS_TOK + TOK_E); const int* tp = (const int*)(F.ws + WS_TOK + TOK_POS); int* tsl = (int*)(F.ws + WS_TOK + TOK_SLOT);
    for (int i = F.gw; i < T * 2; i += F.NGW) { const int t = i >> 1; const int e = te[i], slot = moe_ts(o, e) * 256 + tp[i];
        const u32x4* src = (const u32x4*)(XB + (size_t)t * 1024); u32x4* dst = (u32x4*)(XG + (size_t)slot * 1024);
        dst[lane] = src[lane]; dst[64 + lane] = src[64 + lane];
        if (lane == 0) tsl[i] = slot; }
    int npad_pre = 0;
#pragma unroll
    for (int e = 0; e < 8; ++e) { const int start = moe_ts(o, e) * 256 + cnt[e], end = (e == 7 ? o.ts8 : moe_ts(o, e + 1)) * 256, np = end - start;
        for (int i = F.gw; i < np; i += F.NGW) { u32x4* dst = (u32x4*)(XG + (size_t)(start + i) * 1024); dst[lane] = (u32x4){0u, 0u, 0u, 0u}; dst[64 + lane] = (u32x4){0u, 0u, 0u, 0u}; }
        npad_pre += np; }
    (void)npad_pre;
}
template <bool MOE>
__device__ __forceinline__ void ln2_phase(const Frame& F, int layer) {
    const int lane = F.lane; bf16_t* XB = WSP(bf16_t, WS_XB);
    const bf16_t* YM = WSP(const bf16_t, WS_YM); const bf16_t* PLE = WSP(const bf16_t, WS_PLE);
    const int* tsl = (const int*)(F.ws + WS_TOK + TOK_SLOT); const float* tw = (const float*)(F.ws + WS_TOK + TOK_W);
    for (int t = F.gw; t < T; t += F.NGW) { float* xr = F.out + (size_t)t * 1024; f32x4 v[4];
#pragma unroll
        for (int j = 0; j < 4; ++j) v[j] = *(const f32x4*)(xr + 4 * lane + 256 * j);
        if (MOE) { const int s0 = tsl[t * 2], s1 = tsl[t * 2 + 1]; const float w0 = tw[t * 2], w1 = tw[t * 2 + 1];
#pragma unroll
            for (int j = 0; j < 4; ++j) { const u32x2 a = *(const u32x2*)(YM + (size_t)s0 * 1024 + 4 * lane + 256 * j), c = *(const u32x2*)(YM + (size_t)s1 * 1024 + 4 * lane + 256 * j), p = *(const u32x2*)(PLE + (size_t)t * 1024 + 4 * lane + 256 * j);
                f32x4 f;
                f[0] = w0 * __uint_as_float(a.x << 16) + w1 * __uint_as_float(c.x << 16) + __uint_as_float(p.x << 16);
                f[1] = w0 * __uint_as_float(a.x & 0xffff0000u) + w1 * __uint_as_float(c.x & 0xffff0000u) + __uint_as_float(p.x & 0xffff0000u);
                f[2] = w0 * __uint_as_float(a.y << 16) + w1 * __uint_as_float(c.y << 16) + __uint_as_float(p.y << 16);
                f[3] = w0 * __uint_as_float(a.y & 0xffff0000u) + w1 * __uint_as_float(c.y & 0xffff0000u) + __uint_as_float(p.y & 0xffff0000u);
                v[j] = v[j] * ALPHA + f; } }
        ln_row_write(v, IN_F(34) + layer * 1024, IN_F(35) + layer * 1024, xr, XB + (size_t)t * 1024, lane);
    }
}

constexpr int PH_PER_LAYER = 12, N_PHASES = 1 + DEPTH * PH_PER_LAYER;
__global__ void __launch_bounds__(512, 2) hybrid_fwd(Args args) {
    extern __shared__ __attribute__((aligned(16))) unsigned char lds_raw[];
    Frame F0;
    F0.lds = (LAS unsigned char*)lds_raw; F0.ws = args.ws; F0.in = args.in; F0.out = args.out;
    F0.tid = threadIdx.x; F0.lane = F0.tid & 63; F0.wave = __builtin_amdgcn_readfirstlane(F0.tid >> 6); F0.G = gridDim.x; F0.bid = blockIdx.x; F0.gw = F0.bid * 8 + F0.wave; F0.NGW = F0.G * 8;
    volatile LAS unsigned* ctlw = (volatile LAS unsigned*)(F0.lds + LDS_CTLW);
    if (F0.tid < 16) ctlw[F0.tid] = 0u;
    __syncthreads();
    const int lo = args.ph_lo, hi = args.ph_hi; const int VAR = args.variant;
    XcdBarrier bar; bar.bar = (unsigned*)(F0.ws + WS_CTL) + CW_BAR + args.bar_region * XCD_BAR_WORDS; bar.x = 0; bar.st = ctlw;
    if (hi - lo > 1) bar = xcd_barrier_post((unsigned*)(F0.ws + WS_CTL) + CW_BAR + args.bar_region * XCD_BAR_WORDS, ctlw);
#define IN_PH(k) (lo <= (k) && (k) < hi)
#define SEAM(k) do { if ((k) + 1 < hi) { XcdBarrier bb_ = bar; bb_.bar = bar.bar + opaque0(); xcd_barrier(bb_); } } while (0)

    if (PHON(12) && IN_PH(0)) { const Frame F = reframe(F0); p0_prologue(F); SEAM(0); }

    for (int layer = 0; layer < DEPTH; ++layer) {
        const int pb = 1 + layer * PH_PER_LAYER;
        const bool moe = (layer & 1) != 0;
        if (PHON(0) && IN_PH(pb + 0)) { const Frame F = reframe(F0); const int L = layer + opaque0(); LAS unsigned char* stage = F.lds + LDS_STAGE; LAS unsigned char* wscr = F.lds + LDS_STAGE + F.wave * 16384; (void)wscr; (void)stage;
            { pg8::Gemm g{WSP(const bf16_t, WS_XB), WSP(const bf16_t, WS_WIN) + (size_t)L * HP * 1024, 1024, 1024, 1024, VAR};
              pg8::OrderStd S; S.init(T / 256, HP / 256, F.G, F.bid); pg8::EpiBf16 E{WSP(bf16_t, WS_H), HP, HP / 256};
              pg8::gemm_phase(stage, g, S, E); }
            { const int L2 = L + opaque0(); pg8::Gemm g{WSP(const bf16_t, WS_PB) + (size_t)L2 * T * 256, WSP(const bf16_t, WS_WPP) + (size_t)L2 * 1024 * 256, 256, 256, 256, VAR};
              const int nshort = F.G - (1728 % F.G); pg8::OrderLin S{(F.G == 256) ? F.bid - 192 : F.bid, (F.G == 256) ? 64 : F.G, 256, 4}; (void)nshort;
              pg8::EpiBf16 E{WSP(bf16_t, WS_PP), 1024, 4};
              pg8::gemm_phase(stage, g, S, E); }
            SEAM(pb + 0);
        }
        if (PHON(1) && IN_PH(pb + 1)) { const Frame F = reframe(F0); const int L = layer + opaque0(); LAS unsigned char* stage = F.lds + LDS_STAGE; LAS unsigned char* wscr = F.lds + LDS_STAGE + F.wave * 16384; (void)wscr; (void)stage;
            const bf16_t* H = WSP(const bf16_t, WS_H);
            LAS float* rs = (LAS float*)(F.lds + LDS_MISC);
            if (!(VAR & 16)) { const int vb = F.bid;
                const int pm = vb >> 2, kind = (vb >> 1) & 1, pn = vb & 1;
                __syncthreads();
                { const int lr = F.tid >> 1, hf = F.tid & 1; const int nper = kind ? 64 : 96;
                  const u32x4* src = (const u32x4*)(H + (size_t)(pm * 256 + lr) * HP + (kind ? C_CKV : C_CQ) + hf * nper);
                  u32x4 v[12];
#pragma unroll
                  for (int q = 0; q < 12; ++q) v[q] = (q < 8 || kind == 0) ? src[q] : (u32x4){0u, 0u, 0u, 0u};
                  float ss = 0.f;
#pragma unroll
                  for (int q = 0; q < 12; ++q)
#pragma unroll
                      for (int j = 0; j < 4; ++j) { const float lo = __uint_as_float(v[q][j] << 16), hi = __uint_as_float(v[q][j] & 0xffff0000u); ss += lo * lo + hi * hi; }
                  ss += __shfl_xor(ss, 1);
                  if (hf == 0) rs[lr] = rsqrtf(ss / (kind ? 128.0f : 192.0f) + EPS); }
                __syncthreads();
                if (kind == 0) { pg8::Gemm g{H + C_CQ, WSP(const bf16_t, WS_WUQ) + (size_t)L * 512 * 256, HP, 256, 256, VAR}; pg8::OrderOne S{pm, pn, true};
                    pg8::EpiQ E{WSP(bf16_t, WS_Q), WSP(const float, WS_ROPEM), rs}; pg8::gemm_phase(stage, g, S, E); }
                else { pg8::Gemm g{H + C_CKV, WSP(const bf16_t, WS_WUKV) + (size_t)L * 512 * 256, HP, 256, 256, VAR}; pg8::OrderOne S{pm, pn, true};
                    pg8::EpiKV E{WSP(bf16_t, WS_K), WSP(bf16_t, WS_VT), rs}; pg8::gemm_phase(stage, g, S, E);
                    if (pn == 0) { const float* rope = WSP(const float, WS_ROPEM); bf16_t* Kb = WSP(bf16_t, WS_K);
#pragma unroll
                        for (int i8 = 0; i8 < 8; ++i8) { const int i = F.tid + i8 * 512; const int lr = i >> 4, j = i & 15, t = pm * 256 + lr, b = t >> 11, s = t & 2047;
                            const float x1 = bf2f(H[(size_t)t * HP + C_KR + j]), x2 = bf2f(H[(size_t)t * HP + C_KR + 16 + j]), c = rope[t * 32 + j], sn = rope[t * 32 + 16 + j];
                            const bf16_t o1 = f2bf(x1 * c - x2 * sn), o2 = f2bf(x2 * c + x1 * sn);
#pragma unroll
                            for (int hd = 0; hd < 4; ++hd) { bf16_t* kp = Kb + ((size_t)((b * 4 + hd) * SEQ + s)) * 96; kp[64 + j] = o1; kp[80 + j] = o2; } } } }
            }
            __syncthreads();
            for (int it = F.gw; it < 1024 + 1024 + 4096; it += F.NGW) {
                if (it < 1024) { if (!(VAR & 2)) hg_item<false>(F, L, it, wscr); }
                else if (it < 2048) { if (!(VAR & 4)) ret_item1(F, it - 1024, wscr); }
                else { if (!(VAR & 8)) s5_item<false>(F, L, it - 2048, wscr); }
            }
            SEAM(pb + 1);
        }
        if (PHON(2) && IN_PH(pb + 2)) { const Frame F = reframe(F0); const int L = layer + opaque0(); LAS unsigned char* stage = F.lds + LDS_STAGE; LAS unsigned char* wscr = F.lds + LDS_STAGE + F.wave * 16384; (void)wscr; (void)stage; s5_carry(F, L); hg_carry(F); ret_carry(F); SEAM(pb + 2); }
        if (PHON(3) && IN_PH(pb + 3)) { const Frame F = reframe(F0); const int L = layer + opaque0(); LAS unsigned char* stage = F.lds + LDS_STAGE; LAS unsigned char* wscr = F.lds + LDS_STAGE + F.wave * 16384; (void)wscr; (void)stage;
            if (!(VAR & 16)) { const int vb = F.bid; const int bh = vb >> 3, j = vb & 7; attn_unit(F, bh, 15 - j); attn_unit(F, bh, j); }
            __syncthreads();
            for (int it = F.gw; it < 1024 + 1024 + 4096; it += F.NGW) {
                if (it < 1024) { if (!(VAR & 2)) hg_item<true>(F, L, it, wscr); }
                else if (it < 2048) { if (!(VAR & 4)) ret_item3(F, L, it - 1024, wscr); }
                else { if (!(VAR & 8)) s5_item<true>(F, L, it - 2048, wscr); }
            }
            SEAM(pb + 3);
        }
        if (PHON(4) && IN_PH(pb + 4)) { const Frame F = reframe(F0); const int L = layer + opaque0(); LAS unsigned char* stage = F.lds + LDS_STAGE; LAS unsigned char* wscr = F.lds + LDS_STAGE + F.wave * 16384; (void)wscr; (void)stage;
            pg8::Gemm g{WSP(const bf16_t, WS_S5PRE), WSP(const bf16_t, WS_WGLU) + (size_t)L * 256 * 256, 256, 256, 256, VAR};
            pg8::OrderLin S{F.bid, F.G, 64, 1}; pg8::EpiSigMul E{WSP(bf16_t, WS_Y), 1024, WSP(const bf16_t, WS_S5PRE), 256};
            pg8::gemm_phase(stage, g, S, E);
            SEAM(pb + 4);
        }
        if (PHON(5) && IN_PH(pb + 5)) { const Frame F = reframe(F0); const int L = layer + opaque0(); LAS unsigned char* stage = F.lds + LDS_STAGE; LAS unsigned char* wscr = F.lds + LDS_STAGE + F.wave * 16384; (void)wscr; (void)stage;
            pg8::Gemm g{WSP(const bf16_t, WS_Y), WSP(const bf16_t, WS_WB) + (size_t)L * 4 * 1024 * 256, 1024, 256, 256, VAR};
            pg8::OrderBranch S{F.bid, F.G}; pg8::EpiBranchH E{WSP(const bf16_t, WS_H) + C_GATE, WSP(bf16_t, WS_MIXB)};
            pg8::gemm_phase(stage, g, S, E);
            SEAM(pb + 5);
        }
        if (PHON(6) && IN_PH(pb + 6)) { const Frame F = reframe(F0); const int L = layer + opaque0(); LAS unsigned char* stage = F.lds + LDS_STAGE; LAS unsigned char* wscr = F.lds + LDS_STAGE + F.wave * 16384; (void)wscr; (void)stage;
            pg8::Gemm g{WSP(const bf16_t, WS_MIXB), WSP(const bf16_t, WS_WO) + (size_t)L * 1024 * 1024, 1024, 1024, 1024, VAR};
            pg8::OrderStd S; S.init(T / 256, 4, F.G, F.bid); pg8::EpiResid E{L == 0 ? IN_F(0) : (const float*)F.out, F.out, nullptr};
            pg8::gemm_phase(stage, g, S, E);
            SEAM(pb + 6);
        }
        if (PHON(7) && IN_PH(pb + 7)) { const Frame F = reframe(F0); const int L = layer + opaque0(); LAS unsigned char* stage = F.lds + LDS_STAGE; LAS unsigned char* wscr = F.lds + LDS_STAGE + F.wave * 16384; (void)wscr; (void)stage; if (moe) ln1_phase<true>(F, L); else ln1_phase<false>(F, L); SEAM(pb + 7); }
        if (!moe) {
            if (PHON(8) && IN_PH(pb + 8)) { const Frame F = reframe(F0); const int L = layer + opaque0(); LAS unsigned char* stage = F.lds + LDS_STAGE; LAS unsigned char* wscr = F.lds + LDS_STAGE + F.wave * 16384; (void)wscr; (void)stage;
                { pg8::Gemm g{WSP(const bf16_t, WS_XB), WSP(const bf16_t, WS_WFFU) + (size_t)(L >> 1) * 7168 * 1024, 1024, 1024, 1024, VAR};
                  pg8::OrderStd S; S.init(T / 256, 28, F.G, F.bid); pg8::EpiSwiglu E{WSP(bf16_t, WS_HFF), DFF, 28};
                  pg8::gemm_phase(stage, g, S, E); }
                { const int L2 = L + opaque0(); pg8::Gemm g{WSP(const bf16_t, WS_XB), WSP(const bf16_t, WS_WPG) + (size_t)L2 * 1024 * 1024, 1024, 1024, 1024, VAR};
                  pg8::OrderStd S; S.init(T / 256, 4, F.G, F.bid); pg8::EpiSigMul E{WSP(bf16_t, WS_PLE), 1024, WSP(const bf16_t, WS_PP), 1024};
                  pg8::gemm_phase(stage, g, S, E); }
                SEAM(pb + 8);
            }
            if (PHON(9) && IN_PH(pb + 9)) { const Frame F = reframe(F0); const int L = layer + opaque0(); LAS unsigned char* stage = F.lds + LDS_STAGE; LAS unsigned char* wscr = F.lds + LDS_STAGE + F.wave * 16384; (void)wscr; (void)stage;
                pg8::Gemm g{WSP(const bf16_t, WS_HFF), WSP(const bf16_t, WS_WFFD) + (size_t)(L >> 1) * 1024 * DFF, DFF, DFF, DFF, VAR};
                pg8::OrderStd S; S.init(T / 256, 4, F.G, F.bid); pg8::EpiResid E{(const float*)F.out, F.out, WSP(const bf16_t, WS_PLE)};
                pg8::gemm_phase(stage, g, S, E);
                SEAM(pb + 9);
            }
            if (PHON(10) && IN_PH(pb + 10)) { const Frame F = reframe(F0); const int L = layer + opaque0(); LAS unsigned char* stage = F.lds + LDS_STAGE; LAS unsigned char* wscr = F.lds + LDS_STAGE + F.wave * 16384; (void)wscr; (void)stage; ln2_phase<false>(F, L); if (hi > pb + 12) { XcdBarrier bb_ = bar; bb_.bar = bar.bar + opaque0(); xcd_barrier(bb_); } }
        } else {
            if (PHON(8) && IN_PH(pb + 8)) { const Frame F = reframe(F0); const int L = layer + opaque0(); LAS unsigned char* stage = F.lds + LDS_STAGE; LAS unsigned char* wscr = F.lds + LDS_STAGE + F.wave * 16384; (void)wscr; (void)stage;
                moe_gather(F, L);
                { const int L2 = L + opaque0(); pg8::Gemm g{WSP(const bf16_t, WS_XB), WSP(const bf16_t, WS_WPG) + (size_t)L2 * 1024 * 1024, 1024, 1024, 1024, VAR};
                  pg8::OrderStd S; S.init(T / 256, 4, F.G, F.bid); pg8::EpiSigMul E{WSP(bf16_t, WS_PLE), 1024, WSP(const bf16_t, WS_PP), 1024};
                  pg8::gemm_phase(stage, g, S, E); }
                SEAM(pb + 8);
            }
            if (PHON(9) && IN_PH(pb + 9)) { const Frame F = reframe(F0); const int L = layer + opaque0(); LAS unsigned char* stage = F.lds + LDS_STAGE; LAS unsigned char* wscr = F.lds + LDS_STAGE + F.wave * 16384; (void)wscr; (void)stage;
                const MoeOff o = moe_offsets(F, L, nullptr);
                pg8::Gemm g{WSP(const bf16_t, WS_XG), WSP(const bf16_t, WS_WMU) + (size_t)(L >> 1) * 8 * 7168 * 1024, 1024, 1024, 1024, VAR};
                pg8::OrderMoe S{o.ts8, 28, F.G, F.bid, o.ts1, o.ts2, o.ts3, o.ts4, o.ts5, o.ts6, o.ts7}; pg8::EpiSwiglu E{WSP(bf16_t, WS_HM), DFF, 28};
                pg8::gemm_phase(stage, g, S, E);
                SEAM(pb + 9);
            }
            if (PHON(10) && IN_PH(pb + 10)) { const Frame F = reframe(F0); const int L = layer + opaque0(); LAS unsigned char* stage = F.lds + LDS_STAGE; LAS unsigned char* wscr = F.lds + LDS_STAGE + F.wave * 16384; (void)wscr; (void)stage;
                const MoeOff o = moe_offsets(F, L, nullptr);
                pg8::Gemm g{WSP(const bf16_t, WS_HM), WSP(const bf16_t, WS_WMD) + (size_t)(L >> 1) * 8 * 1024 * DFF, DFF, DFF, DFF, VAR};
                pg8::OrderMoe S{o.ts8, 4, F.G, F.bid, o.ts1, o.ts2, o.ts3, o.ts4, o.ts5, o.ts6, o.ts7}; pg8::EpiBf16 E{WSP(bf16_t, WS_YM), 1024, 4};
                pg8::gemm_phase(stage, g, S, E);
                SEAM(pb + 10);
            }
            if (PHON(11) && IN_PH(pb + 11)) { const Frame F = reframe(F0); const int L = layer + opaque0(); LAS unsigned char* stage = F.lds + LDS_STAGE; LAS unsigned char* wscr = F.lds + LDS_STAGE + F.wave * 16384; (void)wscr; (void)stage; ln2_phase<true>(F, L); SEAM(pb + 11); }
        }
    }
#undef IN_PH
#undef SEAM
}

extern "C" void kernel_launch(void* const* d_in, const int* in_sizes, int n_in, void* d_out, int out_size, void* d_ws, size_t ws_size, hipStream_t stream) {
    static int grid = 0;
    if (grid == 0) {
        if (n_in != 36 || out_size != T * D || ws_size < WS_END) { fprintf(stderr, "kernel_launch: unexpected problem (n_in %d, out %d, ws %zu < %zu)\n", n_in, out_size, ws_size, (size_t)WS_END); grid = -1; return; }
        int dev = 0, cus = 0, per_cu = 0;
        if (hipGetDevice(&dev) != hipSuccess || hipDeviceGetAttribute(&cus, hipDeviceAttributeMultiprocessorCount, dev) != hipSuccess) { grid = -1; return; }
        if (hipFuncSetAttribute((const void*)hybrid_fwd, hipFuncAttributeMaxDynamicSharedMemorySize, LDS_BYTES) != hipSuccess) { fprintf(stderr, "kernel_launch: hipFuncSetAttribute failed\n"); grid = -1; return; }
        if (hipOccupancyMaxActiveBlocksPerMultiprocessor(&per_cu, (const void*)hybrid_fwd, 512, LDS_BYTES) != hipSuccess || per_cu < 1) fprintf(stderr, "kernel_launch: occupancy query says %d\n", per_cu);
        (void)hipGetLastError();
        if (cus != 256) { fprintf(stderr, "kernel_launch: built for 256 CUs, device has %d\n", cus); }
        grid = 256;
    }
    if (grid < 0) return;
    (void)hipMemsetAsync((char*)d_ws + WS_CTL, 0, CTL_BYTES, stream);
    Args a{};
    for (int i = 0; i < 36; ++i) a.in[i] = d_in[i];
    a.out = (float*)d_out; a.ws = (unsigned char*)d_ws;
    if (DUP_PHASE >= 0) {
        a.ph_lo = 0; a.ph_hi = DUP_PHASE + 1; a.bar_region = 0; hipLaunchKernelGGL(hybrid_fwd, dim3(grid), dim3(512), LDS_BYTES, stream, a);
        for (int n = 0; n < DUP_N; ++n) { a.ph_lo = DUP_PHASE; a.ph_hi = DUP_PHASE + 1; a.bar_region = 1; a.variant = DUP_VARIANT; hipLaunchKernelGGL(hybrid_fwd, dim3(grid), dim3(512), LDS_BYTES, stream, a); }
        a.variant = 0;
        if (DUP_PHASE + 1 < N_PHASES) { a.ph_lo = DUP_PHASE + 1; a.ph_hi = N_PHASES; a.bar_region = 2; hipLaunchKernelGGL(hybrid_fwd, dim3(grid), dim3(512), LDS_BYTES, stream, a); }
    } else if (MK_N_LAUNCHES == 1) {
        a.ph_lo = 0; a.ph_hi = N_PHASES;
        hipLaunchKernelGGL(hybrid_fwd, dim3(grid), dim3(512), LDS_BYTES, stream, a);
    } else {
        for (int p = 0; p < N_PHASES; ++p) { a.ph_lo = p; a.ph_hi = p + 1; hipLaunchKernelGGL(hybrid_fwd, dim3(grid), dim3(512), LDS_BYTES, stream, a); }
    }
    const hipError_t le = hipPeekAtLastError();
    if (le != hipSuccess) fprintf(stderr, "kernel_launch: launch failed: %s\n", hipGetErrorName(le));
}
```

```cpp
#include <hip/hip_runtime.h>
#include <cstdio>
#include <cstdint>

#ifndef MK_N_LAUNCHES
#define MK_N_LAUNCHES 1
#endif
#ifndef DUP_PHASE
#define DUP_PHASE -1
#endif
#define DUP_N 4
#ifndef DUP_VARIANT
#define DUP_VARIANT 0
#endif
#ifndef PHMASK
#define PHMASK 0xFFFF
#endif
#define PHON(k) (((PHMASK) >> (k)) & 1)
#ifndef ITMASK
#define ITMASK 15
#endif

#define LAS __attribute__((address_space(3)))
typedef unsigned short bf16_t;
typedef short bf16x8 __attribute__((ext_vector_type(8)));
typedef float f32x4 __attribute__((ext_vector_type(4)));
typedef float f32x2 __attribute__((ext_vector_type(2)));
typedef unsigned u32x4 __attribute__((ext_vector_type(4)));
typedef unsigned u32x2 __attribute__((ext_vector_type(2)));

constexpr int T = 16384, D = 1024, SEQ = 2048, NBATCH = 8, DEPTH = 4, DFF = 3584, NEXP = 8;
constexpr int HP = 6912;
constexpr int C_US5 = 0, C_CQ = 256, C_CKV = 512, C_KR = 640, C_HQ = 768, C_HF = 1024, C_HI = 1280, C_HG = 1536, C_RQ = 1792, C_RK = 2048, C_RV = 2304, C_RG = 2560, C_GATE = 2816;
constexpr float ALPHA = 1.6817928305074290f;
constexpr float EPS = 1e-5f;
constexpr float QSCALE = 0.10206207261596575f * 1.4426950408889634f;
constexpr int MOE_MAXT = 136;

constexpr size_t MiB = (size_t)1 << 20;
constexpr size_t WS_CTL = 0, CTL_BYTES = 1 * MiB;
constexpr size_t WS_WIN = 1 * MiB, WS_WB = 55 * MiB, WS_WO = 63 * MiB, WS_WPG = 71 * MiB, WS_WPP = 79 * MiB, WS_WFFU = 81 * MiB, WS_WFFD = 109 * MiB;
constexpr size_t WS_WMU = 123 * MiB, WS_WMD = 347 * MiB, WS_WUQ = 459 * MiB, WS_WUKV = 460 * MiB, WS_WGLU = 461 * MiB;
constexpr size_t WS_ROPEM = 462 * MiB, WS_ROPER = 464 * MiB, WS_S5P = 468 * MiB, WS_TOK = 469 * MiB;
constexpr size_t WS_XB = 470 * MiB, WS_PB = 502 * MiB, WS_PP = 534 * MiB, WS_PLE = 566 * MiB, WS_STAGE = 598 * MiB;
constexpr size_t WS_H = WS_STAGE, WS_Y = WS_STAGE + 216 * MiB, WS_S5PRE = WS_STAGE + 248 * MiB, WS_MIXB = WS_STAGE + 256 * MiB, WS_TMP = WS_STAGE + 288 * MiB;
constexpr size_t WS_Q = WS_STAGE + 288 * MiB, WS_K = WS_STAGE + 300 * MiB, WS_VT = WS_STAGE + 312 * MiB, WS_QR = WS_STAGE + 320 * MiB, WS_KR = WS_STAGE + 328 * MiB;
constexpr size_t WS_S5E = WS_STAGE + 336 * MiB, WS_S5C = WS_STAGE + 338 * MiB, WS_HGD = WS_STAGE + 340 * MiB, WS_HGE = WS_STAGE + 341 * MiB, WS_HGI = WS_STAGE + 357 * MiB;
constexpr size_t WS_RTE = WS_STAGE + 373 * MiB, WS_RTI = WS_STAGE + 389 * MiB;
constexpr size_t WS_HFF = WS_STAGE, WS_XG = WS_STAGE, WS_HM = WS_STAGE + 68 * MiB, WS_YM = WS_STAGE + 306 * MiB;
constexpr size_t WS_END = WS_STAGE + 405 * MiB;
constexpr size_t S5P_ABAR = 0, S5P_BM = 64 * 1024, S5P_CM = 384 * 1024, S5P_LB = 704 * 1024;
constexpr size_t TOK_E = 0, TOK_POS = 128 * 1024, TOK_W = 256 * 1024, TOK_SLOT = 384 * 1024;
constexpr int CW_BAR = 4096, CW_MOE = 32768;

constexpr int LDS_BYTES = 160 * 1024;
constexpr int LDS_STAGE = 0;
constexpr int LDS_MISC = 128 * 1024;
constexpr int LDS_CTLW = 160 * 1024 - 64;

__device__ __forceinline__ float bf2f(bf16_t b) { return __uint_as_float(((unsigned)b) << 16); }
__device__ __forceinline__ unsigned cvt_pk_bf16(float lo, float hi) { unsigned r; asm volatile("v_cvt_pk_bf16_f32 %0, %1, %2" : "=v"(r) : "v"(lo), "v"(hi)); return r; }
__device__ __forceinline__ bf16_t f2bf(float f) { return (bf16_t)(cvt_pk_bf16(f, 0.f) & 0xffffu); }
__device__ __forceinline__ float sigmoidf_(float x) { return 1.0f / (1.0f + __expf(-x)); }
__device__ __forceinline__ float siluf_(float x) { return x / (1.0f + __expf(-x)); }
__device__ __forceinline__ float gelu_tanh(float v) { const float z = 0.7978845608028654f * (v + 0.044715f * v * v * v); const float th = 1.0f - 2.0f / (__expf(2.0f * z) + 1.0f); return 0.5f * v * (1.0f + th); }
__device__ __forceinline__ f32x4 mfma16(bf16x8 a, bf16x8 b, f32x4 c) { return __builtin_amdgcn_mfma_f32_16x16x32_bf16(a, b, c, 0, 0, 0); }
union Frag { bf16x8 v; unsigned u[4]; u32x2 d[2]; u32x4 q; unsigned short h[8]; };
#define WSYNC() asm volatile("s_waitcnt lgkmcnt(0)" ::: "memory")
#define VM_WAIT() asm volatile("s_waitcnt vmcnt(0)" ::: "memory")
__device__ __forceinline__ float wave_sum(float v) {
#pragma unroll
    for (int o = 1; o < 64; o <<= 1) v += __shfl_xor(v, o);
    return v;
}

namespace pg8 {
constexpr int BM = 256, BK = 64, HALF = 128, HTB = HALF * BK * 2, STAGE_BYTES = 8 * HTB, NXCD = 8, WGM = 8;
__host__ __device__ __forceinline__ int lds_byte(int r, int c) { const int st = (r >> 4) * 2 + (c >> 5), rr = r & 15, cc = c & 31, ob = rr * 64 + cc * 2; return st * 1024 + (ob ^ (((ob >> 9) & 1) << 5)); }
__host__ __device__ __forceinline__ void stage_rc(int b, int& R, int& C) { const int st = b / 1024, sb = b % 1024, swz = sb ^ (((sb >> 9) & 1) << 5); R = (st >> 1) * 16 + swz / 64; C = (st & 1) * 32 + (swz % 64) / 2; }
__host__ __device__ __forceinline__ int perm32(int rho) { const int n = rho >> 4, i = rho & 15; return 8 * (i >> 2) + 4 * n + (i & 3); }

struct Unit { int pm, pn, ak; };
struct Gemm { const bf16_t* A; const bf16_t* Bt; int lda, ldb, K, flags; };

struct OrderStd {
    int nM, nN, nwg, G, c;
    __device__ void init(int nM_, int nN_, int G_, int c_) { nM = nM_; nN = nN_; nwg = nM * nN; G = G_; c = c_; }
    __device__ bool next(int i, Unit& u) const {
        const long L = (long)i * G + c; if (L >= nwg) return false;
        int wgid = (int)L; { const int q = nwg / NXCD, r = nwg % NXCD, xcd = wgid % NXCD, off = wgid / NXCD; wgid = (xcd < r ? xcd * (q + 1) : r * (q + 1) + (xcd - r) * q) + off; }
        const int nig = WGM * nN, gid = wgid / nig, fm = gid * WGM, gsz = (nM - fm) < WGM ? (nM - fm) : WGM;
        u.pm = fm + ((wgid % nig) % gsz); u.pn = (wgid % nig) / gsz; u.ak = 0; return true;
    }
};
struct OrderLin {
    int c, G, total, nN;
    __device__ bool next(int i, Unit& u) const { if (c < 0) return false; const int L = i * G + c; if (L >= total) return false; u.pm = L / nN; u.pn = L % nN; u.ak = 0; return true; }
};
struct OrderOne {
    int pm, pn; bool has;
    __device__ bool next(int i, Unit& u) const { if (i > 0 || !has) return false; u.pm = pm; u.pn = pn; u.ak = 0; return true; }
};
struct OrderBranch {
    int c, G;
    __device__ bool next(int i, Unit& u) const { const int t = (i >> 2) * G + c, n = i & 3; if (t >= 512) return false; u.pm = t >> 2; u.pn = n * 4 + (t & 3); u.ak = n * 256; return true; }
};
struct OrderMoe {
    int nT, ncol, G, c, t1, t2, t3, t4, t5, t6, t7;
    __device__ bool next(int i, Unit& u) const {
        const long L = (long)i * G + c; if (L >= (long)nT * ncol) return false;
        const int wg = (int)L, nig = WGM * ncol, gid = wg / nig, fm = gid * WGM, gsz = (nT - fm) < WGM ? (nT - fm) : WGM;
        const int pm = fm + ((wg % nig) % gsz), ct = (wg % nig) / gsz;
        const int e = (pm >= t1) + (pm >= t2) + (pm >= t3) + (pm >= t4) + (pm >= t5) + (pm >= t6) + (pm >= t7);
        u.pm = pm; u.pn = e * ncol + ct; u.ak = 0; return true;
    }
};

template <class Epi, class Sched, bool ALIGN_EPI = true, bool SP2 = true>
__device__ __forceinline__ void gemm_phase(LAS unsigned char* lds, const Gemm g, const Sched& S, const Epi& E) {
    int oz_; asm volatile("s_mov_b32 %0, 0" : "=s"(oz_));
    const int tid = threadIdx.x + oz_, wid = __builtin_amdgcn_readfirstlane(tid >> 6), lane = tid & 63, wr = wid >> 2, wc = wid & 3, fr = lane & 15, fq = lane >> 4;
    const int nt = (g.K + oz_) / BK;
    unsigned voffA[2], voffB[2];
#pragma unroll
    for (int i = 0; i < 2; ++i) { int R, C; stage_rc(tid * 16 + i * 8192, R, C); const int Rb = Epi::PERM ? ((R & ~31) + perm32(R & 31)) : R;
        voffA[i] = (unsigned)(R * g.lda + C) * 2u; voffB[i] = (unsigned)(Rb * g.ldb + C) * 2u; }
    const size_t kstep = (size_t)(BK * 2);
    const size_t hstepA = (size_t)HALF * g.lda * 2, hstepB = (size_t)HALF * g.ldb * 2;
    static_assert(!Epi::HALF_M || SP2, "HALF_M needs the SP2 loop");
    const size_t tstepA = Epi::HALF_M ? hstepA : 2 * hstepA, tstepB = 2 * hstepB;
    const size_t hA2 = Epi::HALF_M ? 0 : hstepA;
    const unsigned ldsw = (unsigned)wid * 1024u;
    const int aoff = lds_byte(wr * 64 + fr, fq * 8), boff = lds_byte(wc * 32 + fr, fq * 8);
#define PG8_SA(b, h) (((b) * 2 + (h)) * HTB)
#define PG8_SB(b, h) ((4 + (b) * 2 + (h)) * HTB)
#define PG8_STAGE(bufoff, gbase, voff) do { _Pragma("unroll") for (int _i = 0; _i < 2; ++_i) \
        __builtin_amdgcn_global_load_lds((const unsigned*)((const char*)(gbase) + (voff)[_i]), (LAS unsigned*)(lds + (bufoff) + ldsw + _i * 8192), 16, 0, 0); } while (0)
#define PG8_LDA(dst, b, h) do { _Pragma("unroll") for (int m = 0; m < 4; ++m) _Pragma("unroll") for (int k = 0; k < 2; ++k) dst[m][k] = *(const LAS bf16x8*)(lds + PG8_SA(b, h) + aoff + m * 2048 + k * 1024); } while (0)
#define PG8_LDB(dst, b, h) do { _Pragma("unroll") for (int n = 0; n < 2; ++n) _Pragma("unroll") for (int k = 0; k < 2; ++k) dst[n][k] = *(const LAS bf16x8*)(lds + PG8_SB(b, h) + boff + n * 2048 + k * 1024); } while (0)
#define PG8_MMA(ai, bj, At, Bt) do { __builtin_amdgcn_s_setprio(1); _Pragma("unroll") for (int m = 0; m < 4; ++m) _Pragma("unroll") for (int n = 0; n < 2; ++n) _Pragma("unroll") for (int k = 0; k < 2; ++k) \
        acc[ai][bj][m][n] = __builtin_amdgcn_mfma_f32_16x16x32_bf16(Bt[n][k], At[m][k], acc[ai][bj][m][n], 0, 0, 0); __builtin_amdgcn_s_setprio(0); } while (0)
#define PG8_WAIT_V(n) asm volatile("s_waitcnt vmcnt(" #n ")" ::: "memory")
#define PG8_WAIT_L(n) asm volatile("s_waitcnt lgkmcnt(" #n ")" ::: "memory")
#define PG8_BAR __builtin_amdgcn_s_barrier()
#define PG8_SCHED __builtin_amdgcn_sched_barrier(0)
    Unit cur, nxt; int ui = 0;
    if (!S.next(0, cur)) return;
    f32x4 acc[2][2][4][2];
#pragma unroll
    for (int a = 0; a < 2; ++a)
#pragma unroll
        for (int b = 0; b < 2; ++b)
#pragma unroll
            for (int m = 0; m < 4; ++m)
#pragma unroll
                for (int n = 0; n < 2; ++n) acc[a][b][m][n] = (f32x4){0.f, 0.f, 0.f, 0.f};
    bf16x8 At[4][2], B0[2][2], B1[2][2];
    const char* cA = (const char*)g.A + (size_t)cur.pm * tstepA + (size_t)cur.ak * 2; const char* cB = (const char*)g.Bt + (size_t)cur.pn * tstepB;
    if constexpr (SP2) {
        PG8_STAGE(PG8_SB(0, 0), cB, voffB); PG8_STAGE(PG8_SB(0, 1), cB + hstepB, voffB); PG8_STAGE(PG8_SA(0, 0), cA, voffA); PG8_STAGE(PG8_SA(0, 1), cA + hA2, voffA);
        if (wr == 1) PG8_BAR;
        PG8_WAIT_V(2); PG8_BAR;
        PG8_STAGE(PG8_SB(1, 0), cB + kstep, voffB); PG8_STAGE(PG8_SA(1, 0), cA + kstep, voffA); PG8_STAGE(PG8_SB(1, 1), cB + hstepB + kstep, voffB);
        PG8_WAIT_V(6); PG8_BAR;
    } else {
        PG8_STAGE(PG8_SB(0, 0), cB, voffB); PG8_STAGE(PG8_SA(0, 0), cA, voffA); PG8_STAGE(PG8_SB(0, 1), cB + hstepB, voffB); PG8_STAGE(PG8_SA(0, 1), cA + hstepA, voffA);
        if (wr == 1) PG8_BAR;
        PG8_WAIT_V(4); PG8_BAR;
        PG8_STAGE(PG8_SB(1, 0), cB + kstep, voffB); PG8_STAGE(PG8_SA(1, 0), cA + kstep, voffA); PG8_STAGE(PG8_SB(1, 1), cB + hstepB + kstep, voffB);
        PG8_WAIT_V(6); PG8_BAR;
    }
    for (;;) {
        const bool has_next = S.next(ui + 1, nxt);
        const char* nA = has_next ? (const char*)g.A + (size_t)nxt.pm * tstepA + (size_t)nxt.ak * 2 : cA; const char* nB = has_next ? (const char*)g.Bt + (size_t)nxt.pn * tstepB : cB;
        for (int t = 0; t < nt; t += 2) {
            const bool last = (t == nt - 2);
            const char* a1 = cA + (size_t)(t + 1) * kstep;
            const char* a2 = last ? nA : cA + (size_t)(t + 2) * kstep; const char* b2 = last ? nB : cB + (size_t)(t + 2) * kstep;
            const char* a3 = a2 + kstep; const char* b3 = b2 + kstep;
            if constexpr (SP2) {
            PG8_LDB(B0, 0, 0); PG8_LDB(B1, 0, 1); PG8_SCHED; PG8_LDA(At, 0, 0); PG8_STAGE(PG8_SA(1, 1), a1 + hA2, voffA);
            PG8_WAIT_V(8); PG8_WAIT_L(0); PG8_BAR; PG8_MMA(0, 0, At, B0); PG8_MMA(0, 1, At, B1); PG8_BAR; PG8_SCHED;
            if constexpr (!Epi::HALF_M) PG8_LDA(At, 0, 1); PG8_STAGE(PG8_SB(0, 0), b2, voffB); PG8_STAGE(PG8_SB(0, 1), b2 + hstepB, voffB); PG8_STAGE(PG8_SA(0, 0), a2, voffA);
            PG8_WAIT_V(8); PG8_WAIT_L(0); PG8_BAR; if constexpr (!Epi::HALF_M) { PG8_MMA(1, 0, At, B0); PG8_MMA(1, 1, At, B1); } PG8_BAR; PG8_SCHED;
            PG8_LDB(B0, 1, 0); PG8_LDB(B1, 1, 1); PG8_SCHED; PG8_LDA(At, 1, 0); PG8_STAGE(PG8_SA(0, 1), a2 + hA2, voffA);
            PG8_WAIT_V(8); PG8_WAIT_L(0); PG8_BAR; PG8_MMA(0, 0, At, B0); PG8_MMA(0, 1, At, B1); PG8_BAR; PG8_SCHED;
            if constexpr (!Epi::HALF_M) PG8_LDA(At, 1, 1); PG8_STAGE(PG8_SB(1, 0), b3, voffB); PG8_STAGE(PG8_SB(1, 1), b3 + hstepB, voffB); PG8_STAGE(PG8_SA(1, 0), a3, voffA);
            PG8_WAIT_V(8); PG8_WAIT_L(0); PG8_BAR; if constexpr (!Epi::HALF_M) { PG8_MMA(1, 0, At, B0); PG8_MMA(1, 1, At, B1); } PG8_BAR; PG8_SCHED;
            } else {
            PG8_LDB(B0, 0, 0); PG8_SCHED; PG8_LDA(At, 0, 0); PG8_STAGE(PG8_SA(1, 1), a1 + hstepA, voffA);
            PG8_WAIT_L(8); PG8_BAR; PG8_WAIT_L(0); PG8_MMA(0, 0, At, B0); PG8_BAR; PG8_SCHED;
            PG8_LDB(B1, 0, 1); PG8_STAGE(PG8_SB(0, 0), b2, voffB);
            PG8_BAR; PG8_WAIT_L(0); PG8_MMA(0, 1, At, B1); PG8_BAR;
            PG8_LDA(At, 0, 1); PG8_STAGE(PG8_SA(0, 0), a2, voffA);
            PG8_BAR; PG8_WAIT_L(0); PG8_MMA(1, 0, At, B0); PG8_BAR; PG8_SCHED;
            PG8_STAGE(PG8_SB(0, 1), b2 + hstepB, voffB);
            PG8_WAIT_V(6); PG8_BAR; PG8_MMA(1, 1, At, B1); PG8_BAR;
            PG8_LDB(B0, 1, 0); PG8_SCHED; PG8_LDA(At, 1, 0); PG8_STAGE(PG8_SA(0, 1), a2 + hstepA, voffA);
            PG8_WAIT_L(8); PG8_BAR; PG8_WAIT_L(0); PG8_MMA(0, 0, At, B0); PG8_BAR; PG8_SCHED;
            PG8_LDB(B1, 1, 1); PG8_STAGE(PG8_SB(1, 0), b3, voffB);
            PG8_BAR; PG8_WAIT_L(0); PG8_MMA(0, 1, At, B1); PG8_BAR;
            PG8_LDA(At, 1, 1); PG8_STAGE(PG8_SA(1, 0), a3, voffA);
            PG8_BAR; PG8_WAIT_L(0); PG8_MMA(1, 0, At, B0); PG8_BAR; PG8_SCHED;
            PG8_STAGE(PG8_SB(1, 1), b3 + hstepB, voffB);
            PG8_WAIT_V(6); PG8_BAR; PG8_MMA(1, 1, At, B1); PG8_BAR;
            }
        }
        if constexpr (ALIGN_EPI) { if (wr == 0) PG8_BAR; }
        { int vz_; asm volatile("v_mov_b32 %0, 0" : "=v"(vz_)); if (!(g.flags & 1)) E(acc, cur, wr, wc, fr + vz_, fq); }
        if (!has_next) break;
#pragma unroll
        for (int a = 0; a < (Epi::HALF_M ? 1 : 2); ++a)
#pragma unroll
            for (int b = 0; b < 2; ++b)
#pragma unroll
                for (int m = 0; m < 4; ++m)
#pragma unroll
                    for (int n = 0; n < 2; ++n) acc[a][b][m][n] = (f32x4){0.f, 0.f, 0.f, 0.f};
        cur = nxt; cA = nA; cB = nB; ++ui;
        if constexpr (ALIGN_EPI) { if (wr == 1) PG8_BAR; }
    }
    PG8_WAIT_V(0);
    if constexpr (!ALIGN_EPI) { if (wr == 0) PG8_BAR; }
    PG8_BAR;
#undef PG8_SA
#undef PG8_SB
#undef PG8_STAGE
#undef PG8_LDA
#undef PG8_LDB
#undef PG8_MMA
#undef PG8_WAIT_V
#undef PG8_WAIT_L
#undef PG8_BAR
#undef PG8_SCHED
}

typedef f32x4 Acc[2][2][4][2];
struct EpiBf16 {
    static constexpr bool PERM = true, HALF_M = false;
    bf16_t* O; int ldc; int ncol;
    __device__ __forceinline__ void operator()(const Acc& acc, const Unit& u, int wr, int wc, int fr, int fq) const {
        const int row0 = u.pm * BM + wr * 64 + fr, col0 = (u.pn % ncol) * BM + wc * 32 + 8 * fq;
#pragma unroll
        for (int ai = 0; ai < 2; ++ai)
#pragma unroll
            for (int m = 0; m < 4; ++m) { bf16_t* rowp = O + (size_t)(row0 + ai * HALF + m * 16) * ldc + col0;
#pragma unroll
                for (int bj = 0; bj < 2; ++bj) { const f32x4 v0 = acc[ai][bj][m][0], v1 = acc[ai][bj][m][1];
                    u32x4 w; w.x = cvt_pk_bf16(v0[0], v0[1]); w.y = cvt_pk_bf16(v0[2], v0[3]); w.z = cvt_pk_bf16(v1[0], v1[1]); w.w = cvt_pk_bf16(v1[2], v1[3]);
                    *(u32x4*)(rowp + bj * HALF) = w; } }
    }
};
struct EpiSwiglu {
    static constexpr bool PERM = true, HALF_M = false;
    bf16_t* O; int ldc; int ncol;
    __device__ __forceinline__ void operator()(const Acc& acc, const Unit& u, int wr, int wc, int fr, int fq) const {
        const int row0 = u.pm * BM + wr * 64 + fr, col0 = (u.pn % ncol) * HALF + wc * 32 + 8 * fq;
#pragma unroll
        for (int ai = 0; ai < 2; ++ai)
#pragma unroll
            for (int m = 0; m < 4; ++m) { bf16_t* rowp = O + (size_t)(row0 + ai * HALF + m * 16) * ldc + col0;
                float o[8];
#pragma unroll
                for (int n = 0; n < 2; ++n)
#pragma unroll
                    for (int j = 0; j < 4; ++j) o[n * 4 + j] = siluf_(acc[ai][0][m][n][j]) * acc[ai][1][m][n][j];
                u32x4 w; w.x = cvt_pk_bf16(o[0], o[1]); w.y = cvt_pk_bf16(o[2], o[3]); w.z = cvt_pk_bf16(o[4], o[5]); w.w = cvt_pk_bf16(o[6], o[7]);
                *(u32x4*)rowp = w; }
    }
};
struct EpiSigMul {
    static constexpr bool PERM = true, HALF_M = false;
    bf16_t* O; int ldc; const bf16_t* P; int ldp;
    __device__ __forceinline__ void operator()(const Acc& acc, const Unit& u, int wr, int wc, int fr, int fq) const {
        const int row0 = u.pm * BM + wr * 64 + fr, col0 = u.pn * BM + wc * 32 + 8 * fq;
#pragma unroll
        for (int ai = 0; ai < 2; ++ai)
#pragma unroll
            for (int m = 0; m < 4; ++m) { const size_t r = (size_t)(row0 + ai * HALF + m * 16);
#pragma unroll
                for (int bj = 0; bj < 2; ++bj) { const u32x4 pv = *(const u32x4*)(P + r * ldp + col0 + bj * HALF); const f32x4 v0 = acc[ai][bj][m][0], v1 = acc[ai][bj][m][1];
                    float o[8];
#pragma unroll
                    for (int j = 0; j < 4; ++j) { const unsigned pw = pv[j]; const float plo = __uint_as_float(pw << 16), phi = __uint_as_float(pw & 0xffff0000u);
                        const float a = (j < 2) ? v0[2 * j] : v1[2 * j - 4], b = (j < 2) ? v0[2 * j + 1] : v1[2 * j - 3];
                        o[2 * j] = sigmoidf_(a) * plo; o[2 * j + 1] = sigmoidf_(b) * phi; }
                    u32x4 w; w.x = cvt_pk_bf16(o[0], o[1]); w.y = cvt_pk_bf16(o[2], o[3]); w.z = cvt_pk_bf16(o[4], o[5]); w.w = cvt_pk_bf16(o[6], o[7]);
                    *(u32x4*)(O + r * ldc + col0 + bj * HALF) = w; }
                if (m == 3) asm volatile("" ::: "memory"); }
    }
};
struct EpiBranch {
    static constexpr bool PERM = true, HALF_M = false;
    const bf16_t* Hg; float* tmp; bf16_t* mixb;
    __device__ __forceinline__ void operator()(const Acc& acc, const Unit& u, int wr, int wc, int fr, int fq) const {
        const int n4 = u.pn >> 2, ct = u.pn & 3;
        const int row0 = u.pm * BM + wr * 64 + fr, col0 = ct * BM + wc * 32 + 8 * fq;
#pragma unroll
        for (int ai = 0; ai < 2; ++ai)
#pragma unroll
            for (int m = 0; m < 4; ++m) { const size_t r = (size_t)(row0 + ai * HALF + m * 16);
#pragma unroll
                for (int bj = 0; bj < 2; ++bj) { const int c = col0 + bj * HALF;
                    const u32x4 gv = *(const u32x4*)(Hg + r * HP + n4 * 1024 + c); const f32x4 v0 = acc[ai][bj][m][0], v1 = acc[ai][bj][m][1];
                    float o[8];
#pragma unroll
                    for (int j = 0; j < 4; ++j) { const unsigned gw = gv[j]; const float glo = __uint_as_float(gw << 16), ghi = __uint_as_float(gw & 0xffff0000u);
                        const float a = (j < 2) ? v0[2 * j] : v1[2 * j - 4], b = (j < 2) ? v0[2 * j + 1] : v1[2 * j - 3];
                        o[2 * j] = sigmoidf_(glo) * a; o[2 * j + 1] = sigmoidf_(ghi) * b; }
                    float* tp = tmp + r * 1024 + c;
                    if (n4 > 0) { const f32x4 p0 = *(const f32x4*)tp, p1 = *(const f32x4*)(tp + 4);
#pragma unroll
                        for (int j = 0; j < 4; ++j) { o[j] += p0[j]; o[4 + j] += p1[j]; } }
                    if (n4 < 3) { *(f32x4*)tp = (f32x4){o[0], o[1], o[2], o[3]}; *(f32x4*)(tp + 4) = (f32x4){o[4], o[5], o[6], o[7]}; }
                    else { u32x4 w; w.x = cvt_pk_bf16(o[0], o[1]); w.y = cvt_pk_bf16(o[2], o[3]); w.z = cvt_pk_bf16(o[4], o[5]); w.w = cvt_pk_bf16(o[6], o[7]); *(u32x4*)(mixb + r * 1024 + c) = w; } }
                if (m & 1) asm volatile("" ::: "memory"); }
    }
};
struct EpiBranchH {
    static constexpr bool PERM = true, HALF_M = true;
    const bf16_t* Hg; bf16_t* mixb;
    __device__ __forceinline__ void operator()(Acc& acc, const Unit& u, int wr, int wc, int fr, int fq) const {
        const int n4 = u.pn >> 2, ct = u.pn & 3;
        const int row0 = u.pm * HALF + wr * 64 + fr, col0 = ct * BM + wc * 32 + 8 * fq;
#pragma unroll
        for (int m = 0; m < 4; ++m) { const size_t r = (size_t)(row0 + m * 16);
#pragma unroll
            for (int bj = 0; bj < 2; ++bj) { const int c = col0 + bj * HALF;
                const u32x4 gv = *(const u32x4*)(Hg + r * HP + n4 * 1024 + c);
                f32x4 g0, g1;
                g0[0] = sigmoidf_(__uint_as_float(gv.x << 16)); g0[1] = sigmoidf_(__uint_as_float(gv.x & 0xffff0000u)); g0[2] = sigmoidf_(__uint_as_float(gv.y << 16)); g0[3] = sigmoidf_(__uint_as_float(gv.y & 0xffff0000u));
                g1[0] = sigmoidf_(__uint_as_float(gv.z << 16)); g1[1] = sigmoidf_(__uint_as_float(gv.z & 0xffff0000u)); g1[2] = sigmoidf_(__uint_as_float(gv.w << 16)); g1[3] = sigmoidf_(__uint_as_float(gv.w & 0xffff0000u));
                const f32x4 p0 = g0 * acc[0][bj][m][0], p1 = g1 * acc[0][bj][m][1];
                if (n4 == 0) { acc[1][bj][m][0] = p0; acc[1][bj][m][1] = p1; } else { acc[1][bj][m][0] += p0; acc[1][bj][m][1] += p1; }
                if (n4 == 3) { const f32x4 o0 = acc[1][bj][m][0], o1 = acc[1][bj][m][1]; u32x4 w; w.x = cvt_pk_bf16(o0[0], o0[1]); w.y = cvt_pk_bf16(o0[2], o0[3]); w.z = cvt_pk_bf16(o1[0], o1[1]); w.w = cvt_pk_bf16(o1[2], o1[3]);
                    *(u32x4*)(mixb + r * 1024 + c) = w; } } }
    }
};
struct EpiResid {
    static constexpr bool PERM = false, HALF_M = false;
    const float* base; float* out; const bf16_t* add;
    __device__ __forceinline__ void operator()(const Acc& acc, const Unit& u, int wr, int wc, int fr, int fq) const {
        const int row0 = u.pm * BM + wr * 64 + fr, col0 = u.pn * BM + wc * 32 + 4 * fq;
#pragma unroll
        for (int ai = 0; ai < 2; ++ai)
#pragma unroll
            for (int m = 0; m < 4; ++m) { const size_t off = (size_t)(row0 + ai * HALF + m * 16) * 1024 + col0;
#pragma unroll
                for (int bj = 0; bj < 2; ++bj)
#pragma unroll
                    for (int n = 0; n < 2; ++n) { const size_t o = off + bj * HALF + n * 16; const f32x4 bs = *(const f32x4*)(base + o); f32x4 v = bs * ALPHA + acc[ai][bj][m][n];
                        if (add) { const u32x2 av = *(const u32x2*)(add + o); v[0] += __uint_as_float(av.x << 16); v[1] += __uint_as_float(av.x & 0xffff0000u); v[2] += __uint_as_float(av.y << 16); v[3] += __uint_as_float(av.y & 0xffff0000u); }
                        *(f32x4*)(out + o) = v; }
                if (m & 1) asm volatile("" ::: "memory"); }
    }
};
struct EpiQ {
    static constexpr bool PERM = false, HALF_M = false;
    bf16_t* Qb; const float* ropeM; const LAS float* rs;
    __device__ __forceinline__ void operator()(const Acc& acc, const Unit& u, int wr, int wc, int fr, int fq) const {
#pragma unroll
        for (int bj = 0; bj < 2; ++bj) { const int gb = u.pn * BM + bj * HALF + wc * 32; if (gb >= 384) continue;
            const int hd = gb / 96, part = (gb % 96) / 32;
#pragma unroll
            for (int ai = 0; ai < 2; ++ai)
#pragma unroll
                for (int m = 0; m < 4; ++m) { const int rl = ai * HALF + wr * 64 + m * 16 + fr, t = u.pm * BM + rl, b = t >> 11, s = t & 2047; const float sc = rs[rl] * QSCALE;
                    f32x4 x1 = acc[ai][bj][m][0] * sc, x2 = acc[ai][bj][m][1] * sc;
                    if (part == 2) { const f32x4 cs = *(const f32x4*)(ropeM + (size_t)t * 32 + 4 * fq), sn = *(const f32x4*)(ropeM + (size_t)t * 32 + 16 + 4 * fq);
                        const f32x4 o1 = x1 * cs - x2 * sn, o2 = x2 * cs + x1 * sn; x1 = o1; x2 = o2; }
                    bf16_t* qp = Qb + ((size_t)((b * 4 + hd) * SEQ + s)) * 96 + part * 32 + 4 * fq;
                    u32x2 w1, w2; w1.x = cvt_pk_bf16(x1[0], x1[1]); w1.y = cvt_pk_bf16(x1[2], x1[3]); w2.x = cvt_pk_bf16(x2[0], x2[1]); w2.y = cvt_pk_bf16(x2[2], x2[3]);
                    *(u32x2*)qp = w1; *(u32x2*)(qp + 16) = w2; asm volatile("" ::: "memory"); } }
    }
};
struct EpiKV {
    static constexpr bool PERM = false, HALF_M = false;
    bf16_t* Kb; bf16_t* Vt; const LAS float* rs;
    __device__ __forceinline__ void operator()(const Acc& acc, const Unit& u, int wr, int wc, int fr, int fq) const {
#pragma unroll
        for (int bj = 0; bj < 2; ++bj) { const int gb = u.pn * BM + bj * HALF + wc * 32; const int hd = gb / 128, part = (gb % 128) / 32;
#pragma unroll
            for (int ai = 0; ai < 2; ++ai)
#pragma unroll
                for (int m = 0; m < 4; ++m) { const int rl = ai * HALF + wr * 64 + m * 16 + fr, t = u.pm * BM + rl, b = t >> 11, s = t & 2047; const float sc = rs[rl];
                    const f32x4 x1 = acc[ai][bj][m][0] * sc, x2 = acc[ai][bj][m][1] * sc;
                    if (part < 2) { bf16_t* kp = Kb + ((size_t)((b * 4 + hd) * SEQ + s)) * 96 + part * 32 + 4 * fq;
                        u32x2 w1, w2; w1.x = cvt_pk_bf16(x1[0], x1[1]); w1.y = cvt_pk_bf16(x1[2], x1[3]); w2.x = cvt_pk_bf16(x2[0], x2[1]); w2.y = cvt_pk_bf16(x2[2], x2[3]);
                        *(u32x2*)kp = w1; *(u32x2*)(kp + 16) = w2; }
                    else { bf16_t* vp = Vt + ((size_t)((b * 4 + hd) * 64 + (part - 2) * 32 + 4 * fq)) * SEQ + s;
#pragma unroll
                        for (int j = 0; j < 4; ++j) { vp[(size_t)j * SEQ] = f2bf(x1[j]); vp[(size_t)(16 + j) * SEQ] = f2bf(x2[j]); } }
                    asm volatile("" ::: "memory"); } }
    }
};
}

#define XB_TMO      128
#define XB_XCNT(j)  (256  + 64 * (j))
#define XB_XSUB(j)  (1280 + 64 * (j))
#define XB_XGEN(j)  (2304 + 64 * (j))
#define XB_TOP      3328
#define XB_TOPGEN   3392
#define XCD_BAR_WORDS 3456
#define XB_SPIN_CAP (1u << 18)
__device__ __forceinline__ unsigned xb_ld(unsigned* p)              { return __hip_atomic_load(p, __ATOMIC_RELAXED, __HIP_MEMORY_SCOPE_AGENT); }
__device__ __forceinline__ unsigned xb_add(unsigned* p, unsigned v) { return __hip_atomic_fetch_add(p, v, __ATOMIC_RELAXED, __HIP_MEMORY_SCOPE_AGENT); }
__device__ __forceinline__ unsigned xb_xcc_id() { return (unsigned)__builtin_amdgcn_s_getreg((3 << 11) | 20) & 0xFu; }
#define XB_SPIN(cond, bar) do { unsigned _sp = 0; while (cond) { __builtin_amdgcn_s_sleep(1); \
    if ((++_sp & 255u) == 0u) { if (xb_ld(&(bar)[XB_TMO])) break; if (_sp > XB_SPIN_CAP) { atomicAdd(&(bar)[XB_TMO], 1u); break; } } } } while (0)
struct XcdBarrier { unsigned* bar; unsigned x; volatile LAS unsigned* st; };
__device__ __forceinline__ XcdBarrier xcd_barrier_post(unsigned* bar, volatile LAS unsigned* st) {
    XcdBarrier b; b.bar = bar; b.x = xb_xcc_id(); b.st = st;
    if (threadIdx.x == 0) (void)xb_add(&bar[XB_XCNT(b.x)], 1u);
    return b;
}
__device__ __forceinline__ void xcd_barrier_complete(unsigned* bar, unsigned x, unsigned& nloc, unsigned& nx) {
    const unsigned G = gridDim.x * gridDim.y * gridDim.z;
    unsigned sum, cnt, mine, sp = 0u;
    for (;;) {
        sum = 0u; cnt = 0u; mine = 0u;
#pragma unroll
        for (unsigned j = 0; j < 16; ++j) { const unsigned c = xb_ld(&bar[XB_XCNT(j)]); sum += c; cnt += (c > 0u) ? 1u : 0u; mine = (j == x) ? c : mine; }
        if (sum == G) break;
        __builtin_amdgcn_s_sleep(1);
        if ((++sp & 255u) == 0u) { if (xb_ld(&bar[XB_TMO])) break; if (sp > XB_SPIN_CAP) { atomicAdd(&bar[XB_TMO], 1u); break; } }
    }
    nloc = mine > 0u ? mine : 1u; nx = cnt > 0u ? cnt : 1u;
}
__device__ __forceinline__ void xcd_barrier(const XcdBarrier& b) {
    asm volatile("s_waitcnt vmcnt(0)" ::: "memory");
    __syncthreads();
    if (threadIdx.x == 0) {
        unsigned* bar = b.bar;
        __builtin_amdgcn_s_waitcnt(0);
        unsigned nloc = b.st[0], nx = b.st[1];
        if (nloc == 0u) { xcd_barrier_complete(bar, b.x, nloc, nx); b.st[0] = nloc; b.st[1] = nx; }
        const unsigned old = xb_add(&bar[XB_XSUB(b.x)], 1u);
        const unsigned gen = old / nloc;
        if (old + 1u == (gen + 1u) * nloc) {
            __builtin_amdgcn_fence(__ATOMIC_RELEASE, "agent");
            asm volatile("s_waitcnt vmcnt(0)" ::: "memory");
            const unsigned og = xb_add(&bar[XB_TOP], 1u);
            const unsigned tg = og / nx;
            if (og + 1u == (tg + 1u) * nx) xb_add(&bar[XB_TOPGEN], 1u);
            else XB_SPIN(xb_ld(&bar[XB_TOPGEN]) == tg, bar);
            __builtin_amdgcn_fence(__ATOMIC_ACQUIRE, "agent");
            xb_add(&bar[XB_XGEN(b.x)], 1u);
            asm volatile("s_waitcnt vmcnt(0)" ::: "memory");
        } else {
            XB_SPIN(xb_ld(&bar[XB_XGEN(b.x)]) == gen, bar);
            __builtin_amdgcn_fence(__ATOMIC_ACQUIRE, "agent");
            asm volatile("s_waitcnt vmcnt(0)" ::: "memory");
        }
    }
    __syncthreads();
}

__device__ __forceinline__ int vzero() { int z; asm volatile("v_mov_b32 %0, 0" : "=v"(z)); return z; }
__device__ __forceinline__ int opaque0() { int z; asm volatile("s_mov_b32 %0, 0" : "=s"(z)); return z; }
struct Args { const void* in[36]; float* out; unsigned char* ws; int ph_lo, ph_hi, bar_region, variant; };
struct Frame {
    LAS unsigned char* lds;
    unsigned char* ws;
    const void* const* in;
    float* out;
    int tid, lane, wave, G, bid, gw, NGW;
};
__device__ __forceinline__ Frame reframe(const Frame& F) {
    Frame P = F; const int z = opaque0(), vz = vzero();
    P.ws = F.ws + z; P.out = F.out + z; P.lds = F.lds + z; P.bid = F.bid + z; P.G = F.G + z; P.wave = F.wave + z; P.gw = P.bid * 8 + P.wave; P.NGW = P.G * 8; P.tid = F.tid + vz; P.lane = F.lane + vz;
    return P;
}
#define IN_F(k) ((const float*)F.in[k])
#define WSP(T_, off) ((T_*)(F.ws + (off)))

__device__ __forceinline__ void tr_item(const float* W, int N, bf16_t* WT, int ldd, int drow0, int k0, int n0, const float* kscale, LAS float* scr, int lane) {
#pragma unroll 8
    for (int i = 0; i < 32; ++i) { const int kk = 2 * i + (lane >> 5); scr[kk * 33 + (lane & 31)] = W[(size_t)(k0 + kk) * N + n0 + (lane & 31)]; }
    WSYNC();
    const int c = lane & 7;
    float ks[8];
#pragma unroll
    for (int q = 0; q < 8; ++q) ks[q] = kscale ? kscale[k0 + 8 * c + q] : 1.0f;
#pragma unroll
    for (int j = 0; j < 4; ++j) { const int n = (lane >> 3) + 8 * j; const LAS float* s = scr + (8 * c) * 33 + n;
        u32x4 o; o.x = cvt_pk_bf16(s[0 * 33] * ks[0], s[1 * 33] * ks[1]); o.y = cvt_pk_bf16(s[2 * 33] * ks[2], s[3 * 33] * ks[3]); o.z = cvt_pk_bf16(s[4 * 33] * ks[4], s[5 * 33] * ks[5]); o.w = cvt_pk_bf16(s[6 * 33] * ks[6], s[7 * 33] * ks[7]);
        *(u32x4*)(WT + (size_t)(drow0 + n) * ldd + k0 + 8 * c) = o; }
    WSYNC();
}
__device__ __forceinline__ int win_map(int n) {
    if (n < 448) return n;
    if (n < 576) return C_CKV + (n - 448);
    if (n < 608) return C_KR + (n - 576);
    return C_HQ + (n - 608);
}
template <int MAP>
__device__ __forceinline__ bool tr_job(int& r, const float* W, int batch, int K, int N, bf16_t* dst, size_t dstride, int ldd, const float* kscale, int ksstride, LAS float* scr, int lane) {
    const int nkb = K / 64, nnb = N / 32, per = nkb * nnb, total = per * batch;
    if (r >= total) { r -= total; return false; }
    const int bi = r / per, q = r % per, kb = q / nnb, nb = q % nnb, n0 = nb * 32;
    int drow0;
    if (MAP == 0) drow0 = n0; else if (MAP == 1) drow0 = win_map(n0); else drow0 = (n0 >> 7) * 256 + (n0 & 127) + (MAP == 3 ? 128 : 0);
    tr_item(W + (size_t)bi * K * N, N, dst + (size_t)bi * dstride, ldd, drow0, kb * 64, n0, kscale ? kscale + bi * ksstride : nullptr, scr, lane);
    return true;
}
__device__ __forceinline__ void p0_prologue(const Frame& F) {
    LAS float* scr = (LAS float*)(F.lds + LDS_STAGE + F.wave * 16384);
    const int lane = F.lane;
    constexpr int NITEMS = 4 * 16 * 211 + 4 * 4 * 8 + 4 * 3 * 12 + 4 * 2 * 16 + 16 * 4 * 32 + 4 * 16 * 32 + 2 * 2 * 16 * 112 + 2 * 56 * 32 + 2 * 16 * 16 * 112 + 16 * 56 * 32 + 4 * 16 * 32 + 4 * 4 * 32;
    for (int it = F.gw; it < NITEMS; it += F.NGW) {
        int r = it;
        if (tr_job<2>(r, IN_F(29), 16, 1024, DFF, WSP(bf16_t, WS_WMU), (size_t)7168 * 1024, 1024, nullptr, 0, scr, lane)) continue;
        if (tr_job<3>(r, IN_F(30), 16, 1024, DFF, WSP(bf16_t, WS_WMU), (size_t)7168 * 1024, 1024, nullptr, 0, scr, lane)) continue;
        if (tr_job<0>(r, IN_F(31), 16, DFF, 1024, WSP(bf16_t, WS_WMD), (size_t)1024 * DFF, DFF, nullptr, 0, scr, lane)) continue;
        if (tr_job<1>(r, IN_F(3), 4, 1024, 6752, WSP(bf16_t, WS_WIN), (size_t)HP * 1024, 1024, nullptr, 0, scr, lane)) continue;
        if (tr_job<2>(r, IN_F(25), 2, 1024, DFF, WSP(bf16_t, WS_WFFU), (size_t)7168 * 1024, 1024, nullptr, 0, scr, lane)) continue;
        if (tr_job<3>(r, IN_F(26), 2, 1024, DFF, WSP(bf16_t, WS_WFFU), (size_t)7168 * 1024, 1024, nullptr, 0, scr, lane)) continue;
        if (tr_job<0>(r, IN_F(27), 2, DFF, 1024, WSP(bf16_t, WS_WFFD), (size_t)1024 * DFF, DFF, nullptr, 0, scr, lane)) continue;
        if (tr_job<0>(r, IN_F(21), 16, 256, 1024, WSP(bf16_t, WS_WB), (size_t)1024 * 256, 256, nullptr, 0, scr, lane)) continue;
        if (tr_job<0>(r, IN_F(22), 4, 1024, 1024, WSP(bf16_t, WS_WO), (size_t)1024 * 1024, 1024, nullptr, 0, scr, lane)) continue;
        if (tr_job<0>(r, IN_F(32), 4, 1024, 1024, WSP(bf16_t, WS_WPG), (size_t)1024 * 1024, 1024, nullptr, 0, scr, lane)) continue;
        if (tr_job<0>(r, IN_F(33), 4, 256, 1024, WSP(bf16_t, WS_WPP), (size_t)1024 * 256, 256, nullptr, 0, scr, lane)) continue;
        if (tr_job<0>(r, IN_F(12), 4, 256, 256, WSP(bf16_t, WS_WGLU), (size_t)256 * 256, 256, nullptr, 0, scr, lane)) continue;
        if (tr_job<0>(r, IN_F(15), 4, 192, 384, WSP(bf16_t, WS_WUQ), (size_t)512 * 256, 256, IN_F(13), 192, scr, lane)) continue;
        tr_job<0>(r, IN_F(16), 4, 128, 512, WSP(bf16_t, WS_WUKV), (size_t)512 * 256, 256, IN_F(14), 128, scr, lane);
    }
    const int gt = F.bid * 512 + F.tid, NT_ = F.G * 512;
    { bf16_t* uq = WSP(bf16_t, WS_WUQ); bf16_t* ukv = WSP(bf16_t, WS_WUKV);
      for (int i = gt; i < 4 * 512 * 256; i += NT_) { const int n = (i >> 8) & 511, k = i & 255; if (n >= 384 || k >= 192) uq[i] = 0; if (k >= 128) ukv[i] = 0; }
      bf16_t* win = WSP(bf16_t, WS_WIN);
      for (int i = gt; i < 4 * 160 * 1024; i += NT_) { const int l = i / (160 * 1024), q = i % (160 * 1024), rr = q >> 10, k = q & 1023; const int row = rr < 64 ? 448 + rr : 672 + (rr - 64); win[((size_t)l * HP + row) * 1024 + k] = 0; } }
    { const f32x4* x4 = (const f32x4*)IN_F(0); u32x2* xb = WSP(u32x2, WS_XB);
      for (int i = gt; i < T * D / 4; i += NT_) { const f32x4 v = x4[i]; u32x2 w; w.x = cvt_pk_bf16(v[0], v[1]); w.y = cvt_pk_bf16(v[2], v[3]); xb[i] = w; }
      const f32x4* p4 = (const f32x4*)IN_F(1); u32x2* pb = WSP(u32x2, WS_PB);
      for (int i = gt; i < DEPTH * T * 256 / 4; i += NT_) { const f32x4 v = p4[i]; u32x2 w; w.x = cvt_pk_bf16(v[0], v[1]); w.y = cvt_pk_bf16(v[2], v[3]); pb[i] = w; } }
    { const int* pos = (const int*)F.in[2]; float* rm = WSP(float, WS_ROPEM); float* rr = WSP(float, WS_ROPER);
      for (int i = gt; i < T * 48; i += NT_) { const int t = i / 48, j = i % 48; const bool isM = j < 16; const int jj = isM ? j : j - 16; const float half = isM ? 16.f : 32.f;
          const float inv = exp2f(-(float)jj / half * 13.287712379549449f);
          const float ang = (float)pos[t] * inv;
          const double ad = (double)ang, k2 = __builtin_rint(ad * 0.15915494309189535); const float red = (float)(ad - k2 * 6.283185307179586);
          const float c = __cosf(red), s = __sinf(red);
          if (isM) { rm[t * 32 + jj] = c; rm[t * 32 + 16 + jj] = s; } else { rr[t * 64 + jj] = c; rr[t * 64 + 32 + jj] = s; } } }
    { float* abar = (float*)(F.ws + WS_S5P + S5P_ABAR); bf16_t* Bm = (bf16_t*)(F.ws + WS_S5P + S5P_BM); bf16_t* Cm = (bf16_t*)(F.ws + WS_S5P + S5P_CM);
      for (int i = gt; i < DEPTH * 16 * 64; i += NT_) { const int lg = i >> 6, p = i & 63;
          const float dt = __expf(IN_F(6)[lg]), lr = IN_F(4)[i], li = IN_F(5)[i];
          const float mag = __expf(lr * dt); const double ad = (double)(li * dt), k2 = __builtin_rint(ad * 0.15915494309189535); const float red = (float)(ad - k2 * 6.283185307179586);
          const float are = mag * __cosf(red), aim = mag * __sinf(red);
          abar[i * 2] = are; abar[i * 2 + 1] = aim;
          const float den = lr * lr + li * li, nre = are - 1.0f, nim = aim;
          const float cre = (nre * lr + nim * li) / den, cim = (nim * lr - nre * li) / den;
          const float* br = IN_F(7) + (size_t)i * 16; const float* bi = IN_F(8) + (size_t)i * 16;
#pragma unroll
          for (int c = 0; c < 16; ++c) { Bm[((size_t)lg * 128 + p) * 16 + c] = f2bf(cre * br[c] - cim * bi[c]); Bm[((size_t)lg * 128 + 64 + p) * 16 + c] = f2bf(cre * bi[c] + cim * br[c]); }
#pragma unroll
          for (int c = 0; c < 16; ++c) { Cm[((size_t)lg * 16 + c) * 128 + p] = f2bf(IN_F(9)[((size_t)lg * 16 + c) * 64 + p]); Cm[((size_t)lg * 16 + c) * 128 + 64 + p] = f2bf(-IN_F(10)[((size_t)lg * 16 + c) * 64 + p]); } }
      float* lb = (float*)(F.ws + WS_S5P + S5P_LB);
      for (int i = gt; i < 256; i += NT_) { float r0 = IN_F(17)[i], r1 = IN_F(17)[256 + i], r2 = IN_F(17)[512 + i], r3 = IN_F(17)[768 + i]; const float mx = fmaxf(fmaxf(r0, r1), fmaxf(r2, r3));
          const float e0 = __expf(r0 - mx), e1 = __expf(r1 - mx), e2 = __expf(r2 - mx), e3 = __expf(r3 - mx), s = e0 + e1 + e2 + e3;
          lb[i] = 0.f; lb[256 + i] = e1 / s; lb[512 + i] = (e1 + e2) / s; lb[768 + i] = (e1 + e2 + e3) / s; } }
}

template <bool OUT>
__device__ __forceinline__ void s5_item(const Frame& F, int layer, int idx, LAS unsigned char* scr) {
    const int lane = F.lane + vzero(), r16 = lane & 15, g4 = lane >> 4;
    const int bg = idx >> 5, n = idx & 31, b = bg >> 4, g = bg & 15;
    LAS float* bu = (LAS float*)scr;
    LAS bf16_t* xs = (LAS bf16_t*)(scr + 8448);
    const float* abar = (const float*)(F.ws + WS_S5P + S5P_ABAR) + ((size_t)(layer * 16 + g) * 64 + lane) * 2;
    const float ar = abar[0], ai = abar[1];
    const bf16_t* Bm = (const bf16_t*)(F.ws + WS_S5P + S5P_BM) + (size_t)(layer * 16 + g) * 128 * 16;
    const bf16_t* Cm = (const bf16_t*)(F.ws + WS_S5P + S5P_CM) + (size_t)(layer * 16 + g) * 16 * 128;
    const bf16_t* H = WSP(const bf16_t, WS_H);
    Frag zf; zf.q = (u32x4){0u, 0u, 0u, 0u};
    bf16x8 bfr[8];
#pragma unroll
    for (int nb = 0; nb < 8; ++nb) bfr[nb] = (g4 < 2) ? *(const bf16x8*)(Bm + (nb * 16 + r16) * 16 + 8 * g4) : zf.v;
    bf16x8 cfr[4];
    if (OUT) {
#pragma unroll
        for (int ks = 0; ks < 4; ++ks) cfr[ks] = *(const bf16x8*)(Cm + r16 * 128 + 32 * ks + 8 * g4); }
    float xr = 0.f, xi = 0.f;
    if (OUT) { const float* ci = WSP(const float, WS_S5C) + ((size_t)(bg * 32 + n) * 64 + lane) * 2; xr = ci[0]; xi = ci[1]; }
    const float dsk = OUT ? IN_F(11)[layer * 256 + g * 16 + r16] : 0.f;
    const size_t tok0 = (size_t)b * SEQ + n * 64;
    bf16x8 afr_n = (g4 < 2) ? *(const bf16x8*)(H + (tok0 + r16) * HP + C_US5 + g * 16 + 8 * g4) : zf.v;
    bf16_t un[4] = {0, 0, 0, 0};
    if (OUT) {
#pragma unroll
        for (int r = 0; r < 4; ++r) un[r] = H[(tok0 + 4 * g4 + r) * HP + C_US5 + g * 16 + r16]; }
#pragma unroll 1
    for (int sub = 0; sub < 4; ++sub) {
        const size_t t0 = tok0 + sub * 16;
        const bf16x8 afr = afr_n; bf16_t uc[4];
#pragma unroll
        for (int r = 0; r < 4; ++r) uc[r] = un[r];
        if (sub < 3) { afr_n = (g4 < 2) ? *(const bf16x8*)(H + (t0 + 16 + r16) * HP + C_US5 + g * 16 + 8 * g4) : zf.v;
            if (OUT) {
#pragma unroll
                for (int r = 0; r < 4; ++r) un[r] = H[(t0 + 16 + 4 * g4 + r) * HP + C_US5 + g * 16 + r16]; } }
#pragma unroll
        for (int nb = 0; nb < 8; ++nb) { const f32x4 c = mfma16(afr, bfr[nb], (f32x4){0.f, 0.f, 0.f, 0.f});
#pragma unroll
            for (int r = 0; r < 4; ++r) bu[(4 * g4 + r) * 132 + nb * 16 + r16] = c[r]; }
        WSYNC();
#pragma unroll
        for (int tk = 0; tk < 16; ++tk) { const float bre = bu[tk * 132 + lane], bim = bu[tk * 132 + 64 + lane];
            const float nr = ar * xr - ai * xi + bre, ni = ar * xi + ai * xr + bim; xr = nr; xi = ni;
            if (OUT) { xs[tk * 136 + lane] = f2bf(xr); xs[tk * 136 + 64 + lane] = f2bf(xi); } }
        if (OUT) {
            WSYNC();
            f32x4 y = (f32x4){0.f, 0.f, 0.f, 0.f};
#pragma unroll
            for (int ks = 0; ks < 4; ++ks) { const bf16x8 a = *(const LAS bf16x8*)(xs + r16 * 136 + 32 * ks + 8 * g4); y = mfma16(a, cfr[ks], y); }
            bf16_t* pre = WSP(bf16_t, WS_S5PRE);
#pragma unroll
            for (int r = 0; r < 4; ++r) { const size_t t = t0 + 4 * g4 + r; pre[t * 256 + g * 16 + r16] = f2bf(gelu_tanh(y[r] + dsk * bf2f(uc[r]))); }
        }
        WSYNC();
    }
    if (!OUT) { float* e = WSP(float, WS_S5E) + ((size_t)(bg * 32 + n) * 64 + lane) * 2; e[0] = xr; e[1] = xi; }
}
__device__ __forceinline__ void s5_carry(const Frame& F, int layer) {
    const int gt = F.bid * 512 + F.tid;
    if (gt >= NBATCH * 16 * 64) return;
    const int bg = gt >> 6, p = gt & 63, g = bg & 15;
    const float* abar = (const float*)(F.ws + WS_S5P + S5P_ABAR) + ((size_t)(layer * 16 + g) * 64 + p) * 2;
    float pr = abar[0], pi = abar[1];
#pragma unroll
    for (int i = 0; i < 6; ++i) { const float nr = pr * pr - pi * pi, ni = 2.f * pr * pi; pr = nr; pi = ni; }
    const float* E = WSP(const float, WS_S5E); float* C = WSP(float, WS_S5C);
    float er[32], ei[32];
#pragma unroll
    for (int n = 0; n < 32; ++n) { const size_t o = ((size_t)(bg * 32 + n) * 64 + p) * 2; er[n] = E[o]; ei[n] = E[o + 1]; }
    float cr = 0.f, ci = 0.f;
#pragma unroll
    for (int n = 0; n < 32; ++n) { const float nr = pr * cr - pi * ci + er[n], ni = pr * ci + pi * cr + ei[n]; er[n] = cr; ei[n] = ci; cr = nr; ci = ni; }
#pragma unroll
    for (int n = 0; n < 32; ++n) { const size_t o = ((size_t)(bg * 32 + n) * 64 + p) * 2; C[o] = er[n]; C[o + 1] = ei[n]; }
}

template <bool OUT>
__device__ __forceinline__ void hg_item(const Frame& F, int layer, int idx, LAS unsigned char* scr) {
    const int lane = F.lane + vzero(), r16 = lane & 15, g4 = lane >> 4;
    const int bh = idx >> 5, sc = idx & 31, b = bh >> 2, h = bh & 3;
    LAS bf16_t* Qt = (LAS bf16_t*)scr;
    LAS bf16_t* Kt = (LAS bf16_t*)(scr + 2304);
    LAS bf16_t* Vs = (LAS bf16_t*)(scr + 4608);
    LAS float* dec = (LAS float*)(scr + 6656);
    const bf16_t* H = WSP(const bf16_t, WS_H);
    const float lbv = ((const float*)(F.ws + WS_S5P + S5P_LB))[layer * 256 + h * 64 + lane], oml = 1.0f - lbv;
    f32x4 S[4][4];
    if (OUT) { const float* si = WSP(const float, WS_HGI) + (size_t)(bh * 32 + sc) * 4096;
#pragma unroll
        for (int mb = 0; mb < 4; ++mb)
#pragma unroll
            for (int vb = 0; vb < 4; ++vb)
#pragma unroll
                for (int r = 0; r < 4; ++r) S[mb][vb][r] = si[(16 * mb + 4 * g4 + r) * 64 + 16 * vb + r16];
    } else {
#pragma unroll
        for (int mb = 0; mb < 4; ++mb)
#pragma unroll
            for (int vb = 0; vb < 4; ++vb) S[mb][vb] = (f32x4){0.f, 0.f, 0.f, 0.f};
    }
    float ltot = 0.f;
    const size_t tbase = (size_t)b * SEQ + sc * 64;
    unsigned rf[8], ri[8], rq[8]; u32x2 rg[4];
#define HG_LOAD(t0_) do { _Pragma("unroll") for (int p = 0; p < 8; ++p) { const bf16_t* r0 = H + ((t0_) + 2 * p) * HP + h * 64 + lane; const bf16_t* r1 = r0 + HP; \
            rf[p] = (unsigned)r0[C_HF] | ((unsigned)r1[C_HF] << 16); ri[p] = (unsigned)r0[C_HI] | ((unsigned)r1[C_HI] << 16); if (OUT) rq[p] = (unsigned)r0[C_HQ] | ((unsigned)r1[C_HQ] << 16); } \
        if (OUT) { _Pragma("unroll") for (int vb = 0; vb < 4; ++vb) rg[vb] = *(const u32x2*)(H + ((t0_) + r16) * HP + C_HG + h * 64 + 16 * vb + 4 * g4); } } while (0)
    HG_LOAD(tbase);
#pragma unroll 1
    for (int ch = 0; ch < 4; ++ch) {
        const size_t t0 = tbase + ch * 16;
        float bcum = 0.f;
#pragma unroll
        for (int tk = 0; tk < 16; ++tk) { const unsigned wf = rf[tk >> 1], wi = ri[tk >> 1];
            const float fv = (tk & 1) ? __uint_as_float(wf & 0xffff0000u) : __uint_as_float(wf << 16);
            const float sg = 1.0f / (1.0f + __expf(-fv)); const float forget = lbv + oml * sg; bcum += __logf(forget);
            const float kv_ = oml * (1.0f - sg), e = __expf(fmaxf(bcum, -80.0f));
            Kt[tk * 72 + lane] = f2bf(kv_ * __builtin_amdgcn_rcpf(e));
            if (OUT) { const unsigned wq = rq[tk >> 1]; const float qv = (tk & 1) ? __uint_as_float(wq & 0xffff0000u) : __uint_as_float(wq << 16); Qt[tk * 72 + lane] = f2bf(siluf_(qv) * e); }
            Vs[tk * 64 + lane] = (bf16_t)((tk & 1) ? (wi >> 16) : (wi & 0xffffu)); }
        dec[lane] = __expf(bcum); ltot += bcum;
        u32x2 gcur[4];
        if (OUT) {
#pragma unroll
            for (int vb = 0; vb < 4; ++vb) gcur[vb] = rg[vb]; }
        if (ch < 3) HG_LOAD(t0 + 16);
        WSYNC();
        Frag vfr[4], kfr[4];
#pragma unroll
        for (int vb = 0; vb < 4; ++vb) { vfr[vb].q = (u32x4){0u, 0u, 0u, 0u};
#pragma unroll
            for (int j = 0; j < 4; ++j) vfr[vb].h[j] = Vs[(4 * g4 + j) * 64 + 16 * vb + r16]; }
#pragma unroll
        for (int mb = 0; mb < 4; ++mb) { kfr[mb].q = (u32x4){0u, 0u, 0u, 0u};
#pragma unroll
            for (int j = 0; j < 4; ++j) kfr[mb].h[j] = Kt[(4 * g4 + j) * 72 + 16 * mb + r16]; }
        if (OUT) {
            f32x4 at = (f32x4){0.f, 0.f, 0.f, 0.f};
#pragma unroll
            for (int ks = 0; ks < 2; ++ks) { const bf16x8 a = *(const LAS bf16x8*)(Kt + r16 * 72 + 32 * ks + 8 * g4), bq = *(const LAS bf16x8*)(Qt + r16 * 72 + 32 * ks + 8 * g4); at = mfma16(a, bq, at); }
#pragma unroll
            for (int r = 0; r < 4; ++r) if (4 * g4 + r > r16) at[r] = 0.f;
            Frag pfr; pfr.q = (u32x4){0u, 0u, 0u, 0u}; pfr.u[0] = cvt_pk_bf16(at[0], at[1]); pfr.u[1] = cvt_pk_bf16(at[2], at[3]);
            Frag qfr[2];
#pragma unroll
            for (int ks = 0; ks < 2; ++ks) { qfr[ks].d[0] = *(const LAS u32x2*)(Qt + r16 * 72 + 32 * ks + 4 * g4); qfr[ks].d[1] = *(const LAS u32x2*)(Qt + r16 * 72 + 32 * ks + 16 + 4 * g4); }
            f32x4 o[4]; float ss = 0.f;
#pragma unroll
            for (int vb = 0; vb < 4; ++vb) { f32x4 a = (f32x4){0.f, 0.f, 0.f, 0.f};
#pragma unroll
                for (int ks = 0; ks < 2; ++ks) { Frag sf; sf.u[0] = cvt_pk_bf16(S[2 * ks][vb][0], S[2 * ks][vb][1]); sf.u[1] = cvt_pk_bf16(S[2 * ks][vb][2], S[2 * ks][vb][3]);
                    sf.u[2] = cvt_pk_bf16(S[2 * ks + 1][vb][0], S[2 * ks + 1][vb][1]); sf.u[3] = cvt_pk_bf16(S[2 * ks + 1][vb][2], S[2 * ks + 1][vb][3]); a = mfma16(sf.v, qfr[ks].v, a); }
                a = mfma16(vfr[vb].v, pfr.v, a); o[vb] = a; ss += a[0] * a[0] + a[1] * a[1] + a[2] * a[2] + a[3] * a[3]; }
            ss += __shfl_xor(ss, 16); ss += __shfl_xor(ss, 32);
            const float rs = rsqrtf(ss * (1.0f / 64.0f) + EPS);
            const size_t t = t0 + r16; bf16_t* Y = WSP(bf16_t, WS_Y);
#pragma unroll
            for (int vb = 0; vb < 4; ++vb) { const int vi0 = h * 64 + 16 * vb + 4 * g4; const u32x2 gv = gcur[vb]; const f32x4 ng = *(const f32x4*)(IN_F(18) + layer * 256 + vi0);
                const float g0 = __uint_as_float(gv.x << 16), g1 = __uint_as_float(gv.x & 0xffff0000u), g2 = __uint_as_float(gv.y << 16), g3 = __uint_as_float(gv.y & 0xffff0000u);
                u32x2 w; w.x = cvt_pk_bf16(o[vb][0] * rs * ng[0] * siluf_(g0), o[vb][1] * rs * ng[1] * siluf_(g1)); w.y = cvt_pk_bf16(o[vb][2] * rs * ng[2] * siluf_(g2), o[vb][3] * rs * ng[3] * siluf_(g3));
                *(u32x2*)(Y + t * 1024 + 512 + vi0) = w; }
        }
#pragma unroll
        for (int mb = 0; mb < 4; ++mb) { const f32x4 dv = *(const LAS f32x4*)(dec + 16 * mb + 4 * g4);
#pragma unroll
            for (int vb = 0; vb < 4; ++vb) S[mb][vb] = mfma16(kfr[mb].v, vfr[vb].v, S[mb][vb]) * dv; }
        WSYNC();
    }
#undef HG_LOAD
    if (!OUT) { float* se = WSP(float, WS_HGE) + (size_t)(bh * 32 + sc) * 4096;
#pragma unroll
        for (int mb = 0; mb < 4; ++mb)
#pragma unroll
            for (int vb = 0; vb < 4; ++vb)
#pragma unroll
                for (int r = 0; r < 4; ++r) se[(16 * mb + 4 * g4 + r) * 64 + 16 * vb + r16] = S[mb][vb][r];
        WSP(float, WS_HGD)[(size_t)(bh * 32 + sc) * 64 + lane] = __expf(ltot); }
}
__device__ __forceinline__ void hg_carry(const Frame& F) {
    const int gt = F.bid * 512 + F.tid; if (gt >= 32 * 4096) return;
    const int bh = gt >> 12, kv = gt & 4095, k = kv >> 6;
    const float* E = WSP(const float, WS_HGE); const float* Dt = WSP(const float, WS_HGD); float* I = WSP(float, WS_HGI);
    float e[32], d[32];
#pragma unroll
    for (int sc = 0; sc < 32; ++sc) { e[sc] = E[(size_t)(bh * 32 + sc) * 4096 + kv]; d[sc] = Dt[(size_t)(bh * 32 + sc) * 64 + k]; }
    float s = 0.f;
#pragma unroll
    for (int sc = 0; sc < 32; ++sc) { const float nx = d[sc] * s + e[sc]; e[sc] = s; s = nx; }
#pragma unroll
    for (int sc = 0; sc < 32; ++sc) I[(size_t)(bh * 32 + sc) * 4096 + kv] = e[sc];
}

__device__ __forceinline__ float ret_l2g(int h) { return __log2f(1.0f - exp2f(-5.0f - (float)h)); }
__device__ __forceinline__ void ret_item1(const Frame& F, int idx, LAS unsigned char* scr) {
    const int lane = F.lane + vzero(), r16 = lane & 15, g4 = lane >> 4;
    const int bh = idx >> 5, n = idx & 31, b = bh >> 2, h = bh & 3;
    LAS bf16_t* Kd = (LAS bf16_t*)scr;
    LAS bf16_t* Vs = (LAS bf16_t*)(scr + 8192);
    const bf16_t* H = WSP(const bf16_t, WS_H); const float* rope = WSP(const float, WS_ROPER);
    bf16_t* QR = WSP(bf16_t, WS_QR); bf16_t* KR = WSP(bf16_t, WS_KR);
    const float l2g = ret_l2g(h);
    const size_t t0 = (size_t)b * SEQ + n * 64;
#pragma unroll 1
    for (int tb = 0; tb < 4; ++tb) {
        bf16_t kx[16], qx[16], vx[16]; float cs[16], sn[16];
#pragma unroll
        for (int j = 0; j < 16; ++j) { const size_t t = t0 + tb * 16 + j; const bf16_t* row = H + t * HP + h * 64 + lane; kx[j] = row[C_RK]; qx[j] = row[C_RQ]; vx[j] = row[C_RV]; cs[j] = rope[t * 64 + (lane & 31)]; sn[j] = rope[t * 64 + 32 + (lane & 31)]; }
#pragma unroll
        for (int j = 0; j < 16; ++j) { const int tk = tb * 16 + j; const size_t t = t0 + tk;
            const float kf_ = bf2f(kx[j]), qf_ = bf2f(qx[j]); const float kp = __shfl_xor(kf_, 32), qp = __shfl_xor(qf_, 32);
            const float kh = lane < 32 ? kf_ * cs[j] - kp * sn[j] : kf_ * cs[j] + kp * sn[j], qh = (lane < 32 ? qf_ * cs[j] - qp * sn[j] : qf_ * cs[j] + qp * sn[j]) * 0.125f;
            KR[t * 256 + h * 64 + lane] = f2bf(kh); QR[t * 256 + h * 64 + lane] = f2bf(qh);
            Kd[tk * 64 + lane] = f2bf(kh * exp2f((float)(63 - tk) * l2g)); Vs[tk * 64 + lane] = vx[j]; }
    }
    WSYNC();
    Frag vfr[4][2];
#pragma unroll
    for (int vb = 0; vb < 4; ++vb)
#pragma unroll
        for (int ks = 0; ks < 2; ++ks)
#pragma unroll
            for (int j = 0; j < 8; ++j) vfr[vb][ks].h[j] = Vs[(32 * ks + 8 * g4 + j) * 64 + 16 * vb + r16];
    float* E = WSP(float, WS_RTE) + (size_t)(bh * 32 + n) * 4096;
#pragma unroll
    for (int mb = 0; mb < 4; ++mb) { Frag kf[2];
#pragma unroll
        for (int ks = 0; ks < 2; ++ks)
#pragma unroll
            for (int j = 0; j < 8; ++j) kf[ks].h[j] = Kd[(32 * ks + 8 * g4 + j) * 64 + 16 * mb + r16];
#pragma unroll
        for (int vb = 0; vb < 4; ++vb) { f32x4 a = (f32x4){0.f, 0.f, 0.f, 0.f};
#pragma unroll
            for (int ks = 0; ks < 2; ++ks) a = mfma16(kf[ks].v, vfr[vb][ks].v, a);
            *(f32x4*)(E + (16 * vb + r16) * 64 + 16 * mb + 4 * g4) = a; } }
    WSYNC();
}
__device__ __forceinline__ void ret_carry(const Frame& F) {
    const int gt = F.bid * 512 + F.tid; if (gt >= 32 * 4096) return;
    const int bh = gt >> 12, vk = gt & 4095, h = bh & 3;
    const float g64 = exp2f(64.0f * ret_l2g(h));
    const float* E = WSP(const float, WS_RTE); float* I = WSP(float, WS_RTI);
    float e[32];
#pragma unroll
    for (int n = 0; n < 32; ++n) e[n] = E[(size_t)(bh * 32 + n) * 4096 + vk];
    float s = 0.f;
#pragma unroll
    for (int n = 0; n < 32; ++n) { const float nx = g64 * s + e[n]; e[n] = s; s = nx; }
#pragma unroll
    for (int n = 0; n < 32; ++n) I[(size_t)(bh * 32 + n) * 4096 + vk] = e[n];
}
__device__ __forceinline__ void ret_item3(const Frame& F, int layer, int idx, LAS unsigned char* scr) {
    const int lane = F.lane + vzero(), r16 = lane & 15, g4 = lane >> 4;
    const int bh = idx >> 5, n = idx & 31, b = bh >> 2, h = bh & 3;
    LAS bf16_t* Vs = (LAS bf16_t*)scr;
    const bf16_t* H = WSP(const bf16_t, WS_H); const bf16_t* QR = WSP(const bf16_t, WS_QR); const bf16_t* KR = WSP(const bf16_t, WS_KR);
    const float l2g = ret_l2g(h);
    const size_t t0 = (size_t)b * SEQ + n * 64;
#pragma unroll
    for (int tk = 0; tk < 64; ++tk) Vs[tk * 64 + lane] = H[(t0 + tk) * HP + C_RV + h * 64 + lane];
    Frag sfr[4][2];
    { const float* si = WSP(const float, WS_RTI) + (size_t)(bh * 32 + n) * 4096;
#pragma unroll
      for (int vb = 0; vb < 4; ++vb)
#pragma unroll
        for (int ks = 0; ks < 2; ++ks) { const f32x4 a = *(const f32x4*)(si + (16 * vb + r16) * 64 + 32 * ks + 8 * g4), c = *(const f32x4*)(si + (16 * vb + r16) * 64 + 32 * ks + 8 * g4 + 4);
            sfr[vb][ks].u[0] = cvt_pk_bf16(a[0], a[1]); sfr[vb][ks].u[1] = cvt_pk_bf16(a[2], a[3]); sfr[vb][ks].u[2] = cvt_pk_bf16(c[0], c[1]); sfr[vb][ks].u[3] = cvt_pk_bf16(c[2], c[3]); } }
    bf16_t* Y = WSP(bf16_t, WS_Y);
    bf16x8 kfa[4][2], qfa[4][2]; u32x2 gva[4][4];
#pragma unroll
    for (int sb = 0; sb < 4; ++sb)
#pragma unroll
        for (int ks = 0; ks < 2; ++ks) { kfa[sb][ks] = *(const bf16x8*)(KR + (t0 + 16 * sb + r16) * 256 + h * 64 + 32 * ks + 8 * g4); qfa[sb][ks] = *(const bf16x8*)(QR + (t0 + 16 * sb + r16) * 256 + h * 64 + 32 * ks + 8 * g4); }
#pragma unroll
    for (int tb = 0; tb < 4; ++tb)
#pragma unroll
        for (int vb = 0; vb < 4; ++vb) gva[tb][vb] = *(const u32x2*)(H + (t0 + 16 * tb + r16) * HP + C_RG + h * 64 + 16 * vb + 4 * g4);
    WSYNC();
    Frag vfr[4][2];
#pragma unroll
    for (int vb = 0; vb < 4; ++vb)
#pragma unroll
        for (int ks = 0; ks < 2; ++ks)
#pragma unroll
            for (int j = 0; j < 8; ++j) vfr[vb][ks].h[j] = Vs[(32 * ks + 16 * (j >> 2) + 4 * g4 + (j & 3)) * 64 + 16 * vb + r16];
#pragma unroll
    for (int tb = 0; tb < 4; ++tb) {
        const int tl = 16 * tb + r16; const size_t t = t0 + tl;
        Frag pfr[2]; pfr[0].q = (u32x4){0u, 0u, 0u, 0u}; pfr[1].q = (u32x4){0u, 0u, 0u, 0u};
#pragma unroll
        for (int sb = 0; sb < 4; ++sb) { if (sb > tb) continue;
            f32x4 sc = (f32x4){0.f, 0.f, 0.f, 0.f};
#pragma unroll
            for (int ks = 0; ks < 2; ++ks) sc = mfma16(kfa[sb][ks], qfa[tb][ks], sc);
#pragma unroll
            for (int r = 0; r < 4; ++r) { const int rel = tl - (16 * sb + 4 * g4 + r); sc[r] = rel >= 0 ? sc[r] * exp2f((float)rel * l2g) : 0.f; }
            pfr[sb >> 1].u[(sb & 1) * 2] = cvt_pk_bf16(sc[0], sc[1]); pfr[sb >> 1].u[(sb & 1) * 2 + 1] = cvt_pk_bf16(sc[2], sc[3]); }
        const float qd = exp2f((float)(tl + 1) * l2g);
        f32x4 o[4]; float s1 = 0.f;
#pragma unroll
        for (int vb = 0; vb < 4; ++vb) { f32x4 a = (f32x4){0.f, 0.f, 0.f, 0.f};
#pragma unroll
            for (int ks = 0; ks < 2; ++ks) a = mfma16(sfr[vb][ks].v, qfa[tb][ks], a);
            a = a * qd;
            a = mfma16(vfr[vb][0].v, pfr[0].v, a);
            if (tb >= 2) a = mfma16(vfr[vb][1].v, pfr[1].v, a);
            o[vb] = a; s1 += (a[0] + a[1]) + (a[2] + a[3]); }
        s1 += __shfl_xor(s1, 16); s1 += __shfl_xor(s1, 32);
        const float mean = s1 * (1.0f / 64.0f); float s2 = 0.f;
#pragma unroll
        for (int vb = 0; vb < 4; ++vb) { const f32x4 d = o[vb] - mean; s2 += d[0] * d[0] + d[1] * d[1] + d[2] * d[2] + d[3] * d[3]; }
        s2 += __shfl_xor(s2, 16); s2 += __shfl_xor(s2, 32);
        const float rstd = rsqrtf(s2 * (1.0f / 64.0f) + EPS);
#pragma unroll
        for (int vb = 0; vb < 4; ++vb) { const int vi0 = h * 64 + 16 * vb + 4 * g4; const u32x2 gv = gva[tb][vb];
            const f32x4 gg = *(const f32x4*)(IN_F(19) + layer * 256 + vi0), gb = *(const f32x4*)(IN_F(20) + layer * 256 + vi0);
            const float g0 = __uint_as_float(gv.x << 16), g1 = __uint_as_float(gv.x & 0xffff0000u), g2 = __uint_as_float(gv.y << 16), g3 = __uint_as_float(gv.y & 0xffff0000u);
            u32x2 w; w.x = cvt_pk_bf16(((o[vb][0] - mean) * rstd * gg[0] + gb[0]) * siluf_(g0), ((o[vb][1] - mean) * rstd * gg[1] + gb[1]) * siluf_(g1));
            w.y = cvt_pk_bf16(((o[vb][2] - mean) * rstd * gg[2] + gb[2]) * siluf_(g2), ((o[vb][3] - mean) * rstd * gg[3] + gb[3]) * siluf_(g3));
            *(u32x2*)(Y + t * 1024 + 768 + vi0) = w; }
    }
    WSYNC();
}

__device__ __forceinline__ void attn_unit(const Frame& F, int bh, int qt) {
    const int vz = vzero(); const int lane = F.lane + vz, r16 = lane & 15, g4 = lane >> 4, w = F.wave, tid = F.tid + vz;
    LAS bf16_t* Kt = (LAS bf16_t*)(F.lds + LDS_STAGE);
    LAS bf16_t* Vl = (LAS bf16_t*)(F.lds + LDS_STAGE + 13312);
    const bf16_t* Qb = WSP(const bf16_t, WS_Q) + (size_t)bh * SEQ * 96; const bf16_t* Kb = WSP(const bf16_t, WS_K) + (size_t)bh * SEQ * 96; const bf16_t* Vt = WSP(const bf16_t, WS_VT) + (size_t)bh * 64 * SEQ;
    const int q0 = qt * 128, qrow = q0 + 16 * w + r16;
    bf16x8 qfr[3];
#pragma unroll
    for (int ks = 0; ks < 3; ++ks) qfr[ks] = *(const bf16x8*)(Qb + (size_t)qrow * 96 + 32 * ks + 8 * g4);
    float mrun = -1e30f, lrun = 0.f;
    f32x4 O[4];
#pragma unroll
    for (int db = 0; db < 4; ++db) O[db] = (f32x4){0.f, 0.f, 0.f, 0.f};
    const int nkt = 2 * qt + 2;
    const int kkey0 = tid / 12, kpart0 = tid % 12, kkey1 = (tid + 512) / 12, kpart1 = (tid + 512) % 12; const bool k1 = tid < 256;
    const int vdv = tid >> 3, vpart = tid & 7;
    u32x4 rk0, rk1, rv;
    rk1 = (u32x4){0u, 0u, 0u, 0u};
    rk0 = *(const u32x4*)(Kb + (size_t)kkey0 * 96 + kpart0 * 8); if (k1) rk1 = *(const u32x4*)(Kb + (size_t)kkey1 * 96 + kpart1 * 8);
    rv = *(const u32x4*)(Vt + (size_t)vdv * SEQ + vpart * 8);
#pragma unroll 1
    for (int kt = 0; kt < nkt; ++kt) {
        __syncthreads();
        *(LAS u32x4*)(Kt + kkey0 * 104 + kpart0 * 8) = rk0; if (k1) *(LAS u32x4*)(Kt + kkey1 * 104 + kpart1 * 8) = rk1;
        *(LAS u32x4*)(Vl + vdv * 72 + vpart * 8) = rv;
        __syncthreads();
        if (kt + 1 < nkt) { const size_t kb = (size_t)(kt + 1) * 64;
            rk0 = *(const u32x4*)(Kb + (kb + kkey0) * 96 + kpart0 * 8); if (k1) rk1 = *(const u32x4*)(Kb + (kb + kkey1) * 96 + kpart1 * 8);
            rv = *(const u32x4*)(Vt + (size_t)vdv * SEQ + kb + vpart * 8); }
        f32x4 sc[4]; float mx = -1e30f;
#pragma unroll
        for (int kb = 0; kb < 4; ++kb) { f32x4 s = (f32x4){0.f, 0.f, 0.f, 0.f};
#pragma unroll
            for (int ks = 0; ks < 3; ++ks) { const bf16x8 a = *(const LAS bf16x8*)(Kt + (16 * kb + r16) * 104 + 32 * ks + 8 * g4); s = mfma16(a, qfr[ks], s); }
            if (kt >= 2 * qt) {
#pragma unroll
                for (int r = 0; r < 4; ++r) if (kt * 64 + 16 * kb + 4 * g4 + r > qrow) s[r] = -1e30f; }
            sc[kb] = s; mx = fmaxf(mx, fmaxf(fmaxf(s[0], s[1]), fmaxf(s[2], s[3]))); }
        mx = fmaxf(mx, __shfl_xor(mx, 16)); mx = fmaxf(mx, __shfl_xor(mx, 32));
        const float mnew = fmaxf(mrun, mx), alpha = exp2f(mrun - mnew); mrun = mnew;
        float ls = 0.f;
#pragma unroll
        for (int kb = 0; kb < 4; ++kb)
#pragma unroll
            for (int r = 0; r < 4; ++r) { const float p = exp2f(sc[kb][r] - mnew); sc[kb][r] = p; ls += p; }
        lrun = lrun * alpha + ls;
        Frag pf[2];
#pragma unroll
        for (int ks = 0; ks < 2; ++ks) { pf[ks].u[0] = cvt_pk_bf16(sc[2 * ks][0], sc[2 * ks][1]); pf[ks].u[1] = cvt_pk_bf16(sc[2 * ks][2], sc[2 * ks][3]); pf[ks].u[2] = cvt_pk_bf16(sc[2 * ks + 1][0], sc[2 * ks + 1][1]); pf[ks].u[3] = cvt_pk_bf16(sc[2 * ks + 1][2], sc[2 * ks + 1][3]); }
#pragma unroll
        for (int db = 0; db < 4; ++db) { f32x4 o = O[db] * alpha;
#pragma unroll
            for (int ks = 0; ks < 2; ++ks) { Frag vf; vf.d[0] = *(const LAS u32x2*)(Vl + (16 * db + r16) * 72 + 32 * ks + 4 * g4); vf.d[1] = *(const LAS u32x2*)(Vl + (16 * db + r16) * 72 + 32 * ks + 16 + 4 * g4); o = mfma16(vf.v, pf[ks].v, o); }
            O[db] = o; }
    }
    lrun += __shfl_xor(lrun, 16); lrun += __shfl_xor(lrun, 32);
    const float inv = 1.0f / lrun;
    const int b = bh >> 2, h = bh & 3; bf16_t* Y = WSP(bf16_t, WS_Y) + ((size_t)b * SEQ + qrow) * 1024 + 256 + h * 64;
#pragma unroll
    for (int db = 0; db < 4; ++db) { u32x2 wv; wv.x = cvt_pk_bf16(O[db][0] * inv, O[db][1] * inv); wv.y = cvt_pk_bf16(O[db][2] * inv, O[db][3] * inv); *(u32x2*)(Y + 16 * db + 4 * g4) = wv; }
}

__device__ __forceinline__ void ln_row_write(f32x4 (&v)[4], const float* g, const float* bta, float* of, bf16_t* ob, int lane) {
    float s = 0.f;
#pragma unroll
    for (int j = 0; j < 4; ++j) s += (v[j][0] + v[j][1]) + (v[j][2] + v[j][3]);
    const float mean = wave_sum(s) * (1.0f / 1024.0f); float s2 = 0.f;
#pragma unroll
    for (int j = 0; j < 4; ++j) { v[j] = v[j] - mean; s2 += (v[j][0] * v[j][0] + v[j][1] * v[j][1]) + (v[j][2] * v[j][2] + v[j][3] * v[j][3]); }
    const float rstd = rsqrtf(wave_sum(s2) * (1.0f / 1024.0f) + EPS);
#pragma unroll
    for (int j = 0; j < 4; ++j) { const f32x4 gg = *(const f32x4*)(g + 4 * lane + 256 * j), bb = *(const f32x4*)(bta + 4 * lane + 256 * j); v[j] = v[j] * rstd * gg + bb;
        *(f32x4*)(of + 4 * lane + 256 * j) = v[j]; u32x2 w; w.x = cvt_pk_bf16(v[j][0], v[j][1]); w.y = cvt_pk_bf16(v[j][2], v[j][3]); *(u32x2*)(ob + 4 * lane + 256 * j) = w; }
}
template <bool MOE>
__device__ __forceinline__ void ln1_phase(const Frame& F, int layer) {
    const int lane = F.lane; bf16_t* XB = WSP(bf16_t, WS_XB);
    LAS int* lcnt = (LAS int*)(F.lds + LDS_MISC);
    LAS int* rinfo = (LAS int*)(F.lds + LDS_MISC + 64);
    LAS float* rw = (LAS float*)(F.lds + LDS_MISC + 64 + 4096);
    if (MOE) { if (F.tid < 16) lcnt[F.tid] = 0; __syncthreads(); }
    const int rows_per_blk = T / F.G;
    const float* wr_ = MOE ? IN_F(28) + (size_t)(layer >> 1) * 1024 * 8 : nullptr;
    f32x4 nv[4];
    if (F.wave < rows_per_blk) { const float* x0 = F.out + (size_t)(F.bid * rows_per_blk + F.wave) * 1024;
#pragma unroll
        for (int j = 0; j < 4; ++j) nv[j] = *(const f32x4*)(x0 + 4 * lane + 256 * j); }
    for (int lr = F.wave; lr < rows_per_blk; lr += 8) { const int t = F.bid * rows_per_blk + lr;
        float* xr = F.out + (size_t)t * 1024; f32x4 v[4];
#pragma unroll
        for (int j = 0; j < 4; ++j) v[j] = nv[j];
        if (lr + 8 < rows_per_blk) {
#pragma unroll
            for (int j = 0; j < 4; ++j) nv[j] = *(const f32x4*)(xr + 8 * 1024 + 4 * lane + 256 * j); }
        ln_row_write(v, IN_F(23) + layer * 1024, IN_F(24) + layer * 1024, xr, XB + (size_t)t * 1024, lane);
        if (MOE) {
            float lg[8];
#pragma unroll
            for (int e = 0; e < 8; ++e) lg[e] = 0.f;
#pragma unroll
            for (int j = 0; j < 4; ++j)
#pragma unroll
                for (int q = 0; q < 4; ++q) { const float xv = v[j][q]; const float* wrow = wr_ + (size_t)(4 * lane + 256 * j + q) * 8; const f32x4 w0 = *(const f32x4*)wrow, w1 = *(const f32x4*)(wrow + 4);
                    lg[0] += xv * w0[0]; lg[1] += xv * w0[1]; lg[2] += xv * w0[2]; lg[3] += xv * w0[3]; lg[4] += xv * w1[0]; lg[5] += xv * w1[1]; lg[6] += xv * w1[2]; lg[7] += xv * w1[3]; }
#pragma unroll
            for (int e = 0; e < 8; ++e) lg[e] = wave_sum(lg[e]);
            int e0 = 0; float v0 = lg[0];
#pragma unroll
            for (int e = 1; e < 8; ++e) if (lg[e] > v0) { v0 = lg[e]; e0 = e; }
            int e1 = -1; float v1 = -3.0e38f;
#pragma unroll
            for (int e = 0; e < 8; ++e) if (e != e0 && lg[e] > v1) { v1 = lg[e]; e1 = e; }
            if (lane == 0) { const float w0 = 1.0f / (1.0f + __expf(v1 - v0)); const int p0 = __hip_atomic_fetch_add(&lcnt[e0], 1, __ATOMIC_RELAXED, __HIP_MEMORY_SCOPE_WORKGROUP), p1 = __hip_atomic_fetch_add(&lcnt[e1], 1, __ATOMIC_RELAXED, __HIP_MEMORY_SCOPE_WORKGROUP);
                rinfo[lr * 4 + 0] = e0; rinfo[lr * 4 + 1] = e1; rinfo[lr * 4 + 2] = p0; rinfo[lr * 4 + 3] = p1; rw[lr * 2] = w0; rw[lr * 2 + 1] = 1.0f - w0; }
        }
    }
    if (MOE) {
        __syncthreads();
        unsigned* gcnt = WSP(unsigned, WS_CTL) + CW_MOE + (layer >> 1) * 64;
        if (F.tid < 8) lcnt[8 + F.tid] = (int)__hip_atomic_fetch_add(gcnt + F.tid, (unsigned)lcnt[F.tid], __ATOMIC_RELAXED, __HIP_MEMORY_SCOPE_AGENT);
        __syncthreads();
        int* te = (int*)(F.ws + WS_TOK + TOK_E); int* tp = (int*)(F.ws + WS_TOK + TOK_POS); float* tw = (float*)(F.ws + WS_TOK + TOK_W);
        for (int i = F.tid; i < rows_per_blk * 2; i += 512) { const int lr = i >> 1, k = i & 1, t = F.bid * rows_per_blk + lr; const int e = rinfo[lr * 4 + k];
            te[t * 2 + k] = e; tp[t * 2 + k] = lcnt[8 + e] + rinfo[lr * 4 + 2 + k]; tw[t * 2 + k] = rw[lr * 2 + k]; }
    }
}
struct MoeOff { int ts0, ts1, ts2, ts3, ts4, ts5, ts6, ts7, ts8; };
__device__ __forceinline__ MoeOff moe_offsets(const Frame& F, int layer, int* cnt_out  ) {
    const unsigned* gcnt = WSP(const unsigned, WS_CTL) + CW_MOE + (layer >> 1) * 64;
    MoeOff o; int c[8];
#pragma unroll
    for (int e = 0; e < 8; ++e) c[e] = (int)__hip_atomic_load(gcnt + e, __ATOMIC_RELAXED, __HIP_MEMORY_SCOPE_AGENT);
    o.ts0 = 0; o.ts1 = o.ts0 + ((c[0] + 255) >> 8); o.ts2 = o.ts1 + ((c[1] + 255) >> 8); o.ts3 = o.ts2 + ((c[2] + 255) >> 8); o.ts4 = o.ts3 + ((c[3] + 255) >> 8);
    o.ts5 = o.ts4 + ((c[4] + 255) >> 8); o.ts6 = o.ts5 + ((c[5] + 255) >> 8); o.ts7 = o.ts6 + ((c[6] + 255) >> 8); o.ts8 = o.ts7 + ((c[7] + 255) >> 8);
    if (cnt_out) {
#pragma unroll
        for (int e = 0; e < 8; ++e) cnt_out[e] = c[e]; }
    return o;
}
__device__ __forceinline__ int moe_ts(const MoeOff& o, int e) { return e == 0 ? o.ts0 : e == 1 ? o.ts1 : e == 2 ? o.ts2 : e == 3 ? o.ts3 : e == 4 ? o.ts4 : e == 5 ? o.ts5 : e == 6 ? o.ts6 : o.ts7; }
__device__ __forceinline__ void moe_gather(const Frame& F, int layer) {
    int cnt[8]; const MoeOff o = moe_offsets(F, layer, cnt);
    const int lane = F.lane; const bf16_t* XB = WSP(const bf16_t, WS_XB); bf16_t* XG = WSP(bf16_t, WS_XG);
    const int* te = (const int*)(F.ws + WS_TOK + TOK_E); const int* tp = (const int*)(F.ws + WS_TOK + TOK_POS); int* tsl = (int*)(F.ws + WS_TOK + TOK_SLOT);
    for (int i0 = F.gw * 4; i0 < T * 2; i0 += F.NGW * 4) {
        int ee[4], pp[4]; u32x4 a[4], c[4];
#pragma unroll
        for (int q = 0; q < 4; ++q) { ee[q] = te[i0 + q]; pp[q] = tp[i0 + q]; const u32x4* src = (const u32x4*)(XB + (size_t)((i0 + q) >> 1) * 1024); a[q] = src[lane]; c[q] = src[64 + lane]; }
#pragma unroll
        for (int q = 0; q < 4; ++q) { const int slot = moe_ts(o, ee[q]) * 256 + pp[q]; u32x4* dst = (u32x4*)(XG + (size_t)slot * 1024); dst[lane] = a[q]; dst[64 + lane] = c[q]; if (lane == 0) tsl[i0 + q] = slot; }
    }
    int npad_pre = 0;
#pragma unroll
    for (int e = 0; e < 8; ++e) { const int start = moe_ts(o, e) * 256 + cnt[e], end = (e == 7 ? o.ts8 : moe_ts(o, e + 1)) * 256, np = end - start;
        for (int i = F.gw; i < np; i += F.NGW) { u32x4* dst = (u32x4*)(XG + (size_t)(start + i) * 1024); dst[lane] = (u32x4){0u, 0u, 0u, 0u}; dst[64 + lane] = (u32x4){0u, 0u, 0u, 0u}; }
        npad_pre += np; }
    (void)npad_pre;
}
template <bool MOE>
__device__ __forceinline__ void ln2_phase(const Frame& F, int layer) {
    const int lane = F.lane; bf16_t* XB = WSP(bf16_t, WS_XB);
    const bf16_t* YM = WSP(const bf16_t, WS_YM); const bf16_t* PLE = WSP(const bf16_t, WS_PLE);
    const int* tsl = (const int*)(F.ws + WS_TOK + TOK_SLOT); const float* tw = (const float*)(F.ws + WS_TOK + TOK_W);
    f32x4 nx[4]; u32x2 na[4], nc[4], np_[4]; float nw0 = 0.f, nw1 = 0.f;
#define LN2_LOAD(t_) do { const int tt_ = (t_); const float* xr_ = F.out + (size_t)tt_ * 1024; \
        _Pragma("unroll") for (int j = 0; j < 4; ++j) nx[j] = *(const f32x4*)(xr_ + 4 * lane + 256 * j); \
        if (MOE) { const int s0_ = tsl[tt_ * 2], s1_ = tsl[tt_ * 2 + 1]; nw0 = tw[tt_ * 2]; nw1 = tw[tt_ * 2 + 1]; \
            _Pragma("unroll") for (int j = 0; j < 4; ++j) { na[j] = *(const u32x2*)(YM + (size_t)s0_ * 1024 + 4 * lane + 256 * j); nc[j] = *(const u32x2*)(YM + (size_t)s1_ * 1024 + 4 * lane + 256 * j); np_[j] = *(const u32x2*)(PLE + (size_t)tt_ * 1024 + 4 * lane + 256 * j); } } } while (0)
    if (F.gw < T) LN2_LOAD(F.gw);
    for (int t = F.gw; t < T; t += F.NGW) { float* xr = F.out + (size_t)t * 1024; f32x4 v[4];
#pragma unroll
        for (int j = 0; j < 4; ++j) v[j] = nx[j];
        if (MOE) { const float w0 = nw0, w1 = nw1;
#pragma unroll
            for (int j = 0; j < 4; ++j) { const u32x2 a = na[j], c = nc[j], p = np_[j];
                f32x4 f;
                f[0] = w0 * __uint_as_float(a.x << 16) + w1 * __uint_as_float(c.x << 16) + __uint_as_float(p.x << 16);
                f[1] = w0 * __uint_as_float(a.x & 0xffff0000u) + w1 * __uint_as_float(c.x & 0xffff0000u) + __uint_as_float(p.x & 0xffff0000u);
                f[2] = w0 * __uint_as_float(a.y << 16) + w1 * __uint_as_float(c.y << 16) + __uint_as_float(p.y << 16);
                f[3] = w0 * __uint_as_float(a.y & 0xffff0000u) + w1 * __uint_as_float(c.y & 0xffff0000u) + __uint_as_float(p.y & 0xffff0000u);
                v[j] = v[j] * ALPHA + f; } }
        if (t + F.NGW < T) LN2_LOAD(t + F.NGW);
        ln_row_write(v, IN_F(34) + layer * 1024, IN_F(35) + layer * 1024, xr, XB + (size_t)t * 1024, lane);
    }
#undef LN2_LOAD
}

constexpr int PH_PER_LAYER = 12, N_PHASES = 1 + DEPTH * PH_PER_LAYER;
__global__ void __launch_bounds__(512, 2) hybrid_fwd(Args args) {
    extern __shared__ __attribute__((aligned(16))) unsigned char lds_raw[];
    Frame F0;
    F0.lds = (LAS unsigned char*)lds_raw; F0.ws = args.ws; F0.in = args.in; F0.out = args.out;
    F0.tid = threadIdx.x; F0.lane = F0.tid & 63; F0.wave = __builtin_amdgcn_readfirstlane(F0.tid >> 6); F0.G = gridDim.x; F0.bid = blockIdx.x; F0.gw = F0.bid * 8 + F0.wave; F0.NGW = F0.G * 8;
    volatile LAS unsigned* ctlw = (volatile LAS unsigned*)(F0.lds + LDS_CTLW);
    if (F0.tid < 16) ctlw[F0.tid] = 0u;
    __syncthreads();
    const int lo = args.ph_lo, hi = args.ph_hi; const int VAR = args.variant;
    XcdBarrier bar; bar.bar = (unsigned*)(F0.ws + WS_CTL) + CW_BAR + args.bar_region * XCD_BAR_WORDS; bar.x = 0; bar.st = ctlw;
    if (hi - lo > 1) bar = xcd_barrier_post((unsigned*)(F0.ws + WS_CTL) + CW_BAR + args.bar_region * XCD_BAR_WORDS, ctlw);
#define IN_PH(k) (lo <= (k) && (k) < hi)
#define SEAM(k) do { if ((k) + 1 < hi) { XcdBarrier bb_ = bar; bb_.bar = bar.bar + opaque0(); xcd_barrier(bb_); } } while (0)

    if (PHON(12) && IN_PH(0)) { const Frame F = reframe(F0); p0_prologue(F); SEAM(0); }

    for (int layer = 0; layer < DEPTH; ++layer) {
        const int pb = 1 + layer * PH_PER_LAYER;
        const bool moe = (layer & 1) != 0;
        if (PHON(0) && IN_PH(pb + 0)) { const Frame F = reframe(F0); const int L = layer + opaque0(); LAS unsigned char* stage = F.lds + LDS_STAGE; LAS unsigned char* wscr = F.lds + LDS_STAGE + F.wave * 16384; (void)wscr; (void)stage;
            { pg8::Gemm g{WSP(const bf16_t, WS_XB), WSP(const bf16_t, WS_WIN) + (size_t)L * HP * 1024, 1024, 1024, 1024, VAR};
              pg8::OrderStd S; S.init(T / 256, HP / 256, F.G, F.bid); pg8::EpiBf16 E{WSP(bf16_t, WS_H), HP, HP / 256};
              pg8::gemm_phase(stage, g, S, E); }
            { const int L2 = L + opaque0(); pg8::Gemm g{WSP(const bf16_t, WS_PB) + (size_t)L2 * T * 256, WSP(const bf16_t, WS_WPP) + (size_t)L2 * 1024 * 256, 256, 256, 256, VAR};
              const int nshort = F.G - (1728 % F.G); pg8::OrderLin S{(F.G == 256) ? F.bid - 192 : F.bid, (F.G == 256) ? 64 : F.G, 256, 4}; (void)nshort;
              pg8::EpiBf16 E{WSP(bf16_t, WS_PP), 1024, 4};
              pg8::gemm_phase(stage, g, S, E); }
            SEAM(pb + 0);
        }
        if (PHON(1) && IN_PH(pb + 1)) { const Frame F = reframe(F0); const int L = layer + opaque0(); LAS unsigned char* stage = F.lds + LDS_STAGE; LAS unsigned char* wscr = F.lds + LDS_STAGE + F.wave * 16384; (void)wscr; (void)stage;
            const bf16_t* H = WSP(const bf16_t, WS_H);
            LAS float* rs = (LAS float*)(F.lds + LDS_MISC);
            if (!(VAR & 16)) { const int vb = F.bid;
                const int pm = vb >> 2, kind = (vb >> 1) & 1, pn = vb & 1;
                __syncthreads();
                { const int lr = F.tid >> 1, hf = F.tid & 1; const int nper = kind ? 64 : 96;
                  const u32x4* src = (const u32x4*)(H + (size_t)(pm * 256 + lr) * HP + (kind ? C_CKV : C_CQ) + hf * nper);
                  u32x4 v[12];
#pragma unroll
                  for (int q = 0; q < 12; ++q) v[q] = (q < 8 || kind == 0) ? src[q] : (u32x4){0u, 0u, 0u, 0u};
                  float ss = 0.f;
#pragma unroll
                  for (int q = 0; q < 12; ++q)
#pragma unroll
                      for (int j = 0; j < 4; ++j) { const float lo = __uint_as_float(v[q][j] << 16), hi = __uint_as_float(v[q][j] & 0xffff0000u); ss += lo * lo + hi * hi; }
                  ss += __shfl_xor(ss, 1);
                  if (hf == 0) rs[lr] = rsqrtf(ss / (kind ? 128.0f : 192.0f) + EPS); }
                __syncthreads();
                if (kind == 0) { pg8::Gemm g{H + C_CQ, WSP(const bf16_t, WS_WUQ) + (size_t)L * 512 * 256, HP, 256, 256, VAR}; pg8::OrderOne S{pm, pn, true};
                    pg8::EpiQ E{WSP(bf16_t, WS_Q), WSP(const float, WS_ROPEM), rs}; pg8::gemm_phase(stage, g, S, E); }
                else { pg8::Gemm g{H + C_CKV, WSP(const bf16_t, WS_WUKV) + (size_t)L * 512 * 256, HP, 256, 256, VAR}; pg8::OrderOne S{pm, pn, true};
                    pg8::EpiKV E{WSP(bf16_t, WS_K), WSP(bf16_t, WS_VT), rs}; pg8::gemm_phase(stage, g, S, E);
                    if (pn == 0) { const float* rope = WSP(const float, WS_ROPEM); bf16_t* Kb = WSP(bf16_t, WS_K);
#pragma unroll
                        for (int i8 = 0; i8 < 8; ++i8) { const int i = F.tid + i8 * 512; const int lr = i >> 4, j = i & 15, t = pm * 256 + lr, b = t >> 11, s = t & 2047;
                            const float x1 = bf2f(H[(size_t)t * HP + C_KR + j]), x2 = bf2f(H[(size_t)t * HP + C_KR + 16 + j]), c = rope[t * 32 + j], sn = rope[t * 32 + 16 + j];
                            const bf16_t o1 = f2bf(x1 * c - x2 * sn), o2 = f2bf(x2 * c + x1 * sn);
#pragma unroll
                            for (int hd = 0; hd < 4; ++hd) { bf16_t* kp = Kb + ((size_t)((b * 4 + hd) * SEQ + s)) * 96; kp[64 + j] = o1; kp[80 + j] = o2; } } } }
            }
            __syncthreads();
            for (int it = F.gw; it < 1024 + 1024 + 4096; it += F.NGW) {
                if (it < 1024) { if (!(VAR & 2)) hg_item<false>(F, L, it, wscr); }
                else if (it < 2048) { if (!(VAR & 4)) ret_item1(F, it - 1024, wscr); }
                else { if (!(VAR & 8)) s5_item<false>(F, L, it - 2048, wscr); }
            }
            SEAM(pb + 1);
        }
        if (PHON(2) && IN_PH(pb + 2)) { const Frame F = reframe(F0); const int L = layer + opaque0(); LAS unsigned char* stage = F.lds + LDS_STAGE; LAS unsigned char* wscr = F.lds + LDS_STAGE + F.wave * 16384; (void)wscr; (void)stage; s5_carry(F, L); hg_carry(F); ret_carry(F); SEAM(pb + 2); }
        if (PHON(3) && IN_PH(pb + 3)) { const Frame F = reframe(F0); const int L = layer + opaque0(); LAS unsigned char* stage = F.lds + LDS_STAGE; LAS unsigned char* wscr = F.lds + LDS_STAGE + F.wave * 16384; (void)wscr; (void)stage;
            if (!(VAR & 16)) { const int vb = F.bid; const int bh = vb >> 3, j = vb & 7; attn_unit(F, bh, 15 - j); attn_unit(F, bh, j); }
            __syncthreads();
            for (int it = F.gw; it < 1024 + 1024 + 4096; it += F.NGW) {
                if (it < 1024) { if (!(VAR & 2)) hg_item<true>(F, L, it, wscr); }
                else if (it < 2048) { if (!(VAR & 4)) ret_item3(F, L, it - 1024, wscr); }
                else { if (!(VAR & 8)) s5_item<true>(F, L, it - 2048, wscr); }
            }
            SEAM(pb + 3);
        }
        if (PHON(4) && IN_PH(pb + 4)) { const Frame F = reframe(F0); const int L = layer + opaque0(); LAS unsigned char* stage = F.lds + LDS_STAGE; LAS unsigned char* wscr = F.lds + LDS_STAGE + F.wave * 16384; (void)wscr; (void)stage;
            pg8::Gemm g{WSP(const bf16_t, WS_S5PRE), WSP(const bf16_t, WS_WGLU) + (size_t)L * 256 * 256, 256, 256, 256, VAR};
            pg8::OrderLin S{F.bid, F.G, 64, 1}; pg8::EpiSigMul E{WSP(bf16_t, WS_Y), 1024, WSP(const bf16_t, WS_S5PRE), 256};
            pg8::gemm_phase(stage, g, S, E);
            SEAM(pb + 4);
        }
        if (PHON(5) && IN_PH(pb + 5)) { const Frame F = reframe(F0); const int L = layer + opaque0(); LAS unsigned char* stage = F.lds + LDS_STAGE; LAS unsigned char* wscr = F.lds + LDS_STAGE + F.wave * 16384; (void)wscr; (void)stage;
            pg8::Gemm g{WSP(const bf16_t, WS_Y), WSP(const bf16_t, WS_WB) + (size_t)L * 4 * 1024 * 256, 1024, 256, 256, VAR};
            pg8::OrderBranch S{F.bid, F.G}; pg8::EpiBranchH E{WSP(const bf16_t, WS_H) + C_GATE, WSP(bf16_t, WS_MIXB)};
            pg8::gemm_phase(stage, g, S, E);
            SEAM(pb + 5);
        }
        if (PHON(6) && IN_PH(pb + 6)) { const Frame F = reframe(F0); const int L = layer + opaque0(); LAS unsigned char* stage = F.lds + LDS_STAGE; LAS unsigned char* wscr = F.lds + LDS_STAGE + F.wave * 16384; (void)wscr; (void)stage;
            pg8::Gemm g{WSP(const bf16_t, WS_MIXB), WSP(const bf16_t, WS_WO) + (size_t)L * 1024 * 1024, 1024, 1024, 1024, VAR};
            pg8::OrderStd S; S.init(T / 256, 4, F.G, F.bid); pg8::EpiResid E{L == 0 ? IN_F(0) : (const float*)F.out, F.out, nullptr};
            pg8::gemm_phase(stage, g, S, E);
            SEAM(pb + 6);
        }
        if (PHON(7) && IN_PH(pb + 7)) { const Frame F = reframe(F0); const int L = layer + opaque0(); LAS unsigned char* stage = F.lds + LDS_STAGE; LAS unsigned char* wscr = F.lds + LDS_STAGE + F.wave * 16384; (void)wscr; (void)stage; if (moe) ln1_phase<true>(F, L); else ln1_phase<false>(F, L); SEAM(pb + 7); }
        if (!moe) {
            if (PHON(8) && IN_PH(pb + 8)) { const Frame F = reframe(F0); const int L = layer + opaque0(); LAS unsigned char* stage = F.lds + LDS_STAGE; LAS unsigned char* wscr = F.lds + LDS_STAGE + F.wave * 16384; (void)wscr; (void)stage;
                { pg8::Gemm g{WSP(const bf16_t, WS_XB), WSP(const bf16_t, WS_WFFU) + (size_t)(L >> 1) * 7168 * 1024, 1024, 1024, 1024, VAR};
                  pg8::OrderStd S; S.init(T / 256, 28, F.G, F.bid); pg8::EpiSwiglu E{WSP(bf16_t, WS_HFF), DFF, 28};
                  pg8::gemm_phase(stage, g, S, E); }
                { const int L2 = L + opaque0(); pg8::Gemm g{WSP(const bf16_t, WS_XB), WSP(const bf16_t, WS_WPG) + (size_t)L2 * 1024 * 1024, 1024, 1024, 1024, VAR};
                  pg8::OrderStd S; S.init(T / 256, 4, F.G, F.bid); pg8::EpiSigMul E{WSP(bf16_t, WS_PLE), 1024, WSP(const bf16_t, WS_PP), 1024};
                  pg8::gemm_phase(stage, g, S, E); }
                SEAM(pb + 8);
            }
            if (PHON(9) && IN_PH(pb + 9)) { const Frame F = reframe(F0); const int L = layer + opaque0(); LAS unsigned char* stage = F.lds + LDS_STAGE; LAS unsigned char* wscr = F.lds + LDS_STAGE + F.wave * 16384; (void)wscr; (void)stage;
                pg8::Gemm g{WSP(const bf16_t, WS_HFF), WSP(const bf16_t, WS_WFFD) + (size_t)(L >> 1) * 1024 * DFF, DFF, DFF, DFF, VAR};
                pg8::OrderStd S; S.init(T / 256, 4, F.G, F.bid); pg8::EpiResid E{(const float*)F.out, F.out, WSP(const bf16_t, WS_PLE)};
                pg8::gemm_phase(stage, g, S, E);
                SEAM(pb + 9);
            }
            if (PHON(10) && IN_PH(pb + 10)) { const Frame F = reframe(F0); const int L = layer + opaque0(); LAS unsigned char* stage = F.lds + LDS_STAGE; LAS unsigned char* wscr = F.lds + LDS_STAGE + F.wave * 16384; (void)wscr; (void)stage; ln2_phase<false>(F, L); if (hi > pb + 12) { XcdBarrier bb_ = bar; bb_.bar = bar.bar + opaque0(); xcd_barrier(bb_); } }
        } else {
            if (PHON(8) && IN_PH(pb + 8)) { const Frame F = reframe(F0); const int L = layer + opaque0(); LAS unsigned char* stage = F.lds + LDS_STAGE; LAS unsigned char* wscr = F.lds + LDS_STAGE + F.wave * 16384; (void)wscr; (void)stage;
                moe_gather(F, L);
                { const int L2 = L + opaque0(); pg8::Gemm g{WSP(const bf16_t, WS_XB), WSP(const bf16_t, WS_WPG) + (size_t)L2 * 1024 * 1024, 1024, 1024, 1024, VAR};
                  pg8::OrderStd S; S.init(T / 256, 4, F.G, F.bid); pg8::EpiSigMul E{WSP(bf16_t, WS_PLE), 1024, WSP(const bf16_t, WS_PP), 1024};
                  pg8::gemm_phase(stage, g, S, E); }
                SEAM(pb + 8);
            }
            if (PHON(9) && IN_PH(pb + 9)) { const Frame F = reframe(F0); const int L = layer + opaque0(); LAS unsigned char* stage = F.lds + LDS_STAGE; LAS unsigned char* wscr = F.lds + LDS_STAGE + F.wave * 16384; (void)wscr; (void)stage;
                const MoeOff o = moe_offsets(F, L, nullptr);
                pg8::Gemm g{WSP(const bf16_t, WS_XG), WSP(const bf16_t, WS_WMU) + (size_t)(L >> 1) * 8 * 7168 * 1024, 1024, 1024, 1024, VAR};
                pg8::OrderMoe S{o.ts8, 28, F.G, F.bid, o.ts1, o.ts2, o.ts3, o.ts4, o.ts5, o.ts6, o.ts7}; pg8::EpiSwiglu E{WSP(bf16_t, WS_HM), DFF, 28};
                pg8::gemm_phase(stage, g, S, E);
                SEAM(pb + 9);
            }
            if (PHON(10) && IN_PH(pb + 10)) { const Frame F = reframe(F0); const int L = layer + opaque0(); LAS unsigned char* stage = F.lds + LDS_STAGE; LAS unsigned char* wscr = F.lds + LDS_STAGE + F.wave * 16384; (void)wscr; (void)stage;
                const MoeOff o = moe_offsets(F, L, nullptr);
                pg8::Gemm g{WSP(const bf16_t, WS_HM), WSP(const bf16_t, WS_WMD) + (size_t)(L >> 1) * 8 * 1024 * DFF, DFF, DFF, DFF, VAR};
                pg8::OrderMoe S{o.ts8, 4, F.G, F.bid, o.ts1, o.ts2, o.ts3, o.ts4, o.ts5, o.ts6, o.ts7}; pg8::EpiBf16 E{WSP(bf16_t, WS_YM), 1024, 4};
                pg8::gemm_phase(stage, g, S, E);
                SEAM(pb + 10);
            }
            if (PHON(11) && IN_PH(pb + 11)) { const Frame F = reframe(F0); const int L = layer + opaque0(); LAS unsigned char* stage = F.lds + LDS_STAGE; LAS unsigned char* wscr = F.lds + LDS_STAGE + F.wave * 16384; (void)wscr; (void)stage; ln2_phase<true>(F, L); SEAM(pb + 11); }
        }
    }
#undef IN_PH
#undef SEAM
}

extern "C" void kernel_launch(void* const* d_in, const int* in_sizes, int n_in, void* d_out, int out_size, void* d_ws, size_t ws_size, hipStream_t stream) {
    static int grid = 0;
    if (grid == 0) {
        if (n_in != 36 || out_size != T * D || ws_size < WS_END) { fprintf(stderr, "kernel_launch: unexpected problem (n_in %d, out %d, ws %zu < %zu)\n", n_in, out_size, ws_size, (size_t)WS_END); grid = -1; return; }
        int dev = 0, cus = 0, per_cu = 0;
        if (hipGetDevice(&dev) != hipSuccess || hipDeviceGetAttribute(&cus, hipDeviceAttributeMultiprocessorCount, dev) != hipSuccess) { grid = -1; return; }
        if (hipFuncSetAttribute((const void*)hybrid_fwd, hipFuncAttributeMaxDynamicSharedMemorySize, LDS_BYTES) != hipSuccess) { fprintf(stderr, "kernel_launch: hipFuncSetAttribute failed\n"); grid = -1; return; }
        if (hipOccupancyMaxActiveBlocksPerMultiprocessor(&per_cu, (const void*)hybrid_fwd, 512, LDS_BYTES) != hipSuccess || per_cu < 1) fprintf(stderr, "kernel_launch: occupancy query says %d\n", per_cu);
        (void)hipGetLastError();
        if (cus != 256) { fprintf(stderr, "kernel_launch: built for 256 CUs, device has %d\n", cus); }
        grid = 256;
    }
    if (grid < 0) return;
    (void)hipMemsetAsync((char*)d_ws + WS_CTL, 0, CTL_BYTES, stream);
    Args a{};
    for (int i = 0; i < 36; ++i) a.in[i] = d_in[i];
    a.out = (float*)d_out; a.ws = (unsigned char*)d_ws;
    if (DUP_PHASE >= 0) {
        a.ph_lo = 0; a.ph_hi = DUP_PHASE + 1; a.bar_region = 0; hipLaunchKernelGGL(hybrid_fwd, dim3(grid), dim3(512), LDS_BYTES, stream, a);
        for (int n = 0; n < DUP_N; ++n) { a.ph_lo = DUP_PHASE; a.ph_hi = DUP_PHASE + 1; a.bar_region = 1; a.variant = DUP_VARIANT; hipLaunchKernelGGL(hybrid_fwd, dim3(grid), dim3(512), LDS_BYTES, stream, a); }
        a.variant = 0;
        if (DUP_PHASE + 1 < N_PHASES) { a.ph_lo = DUP_PHASE + 1; a.ph_hi = N_PHASES; a.bar_region = 2; hipLaunchKernelGGL(hybrid_fwd, dim3(grid), dim3(512), LDS_BYTES, stream, a); }
    } else if (MK_N_LAUNCHES == 1) {
        a.ph_lo = 0; a.ph_hi = N_PHASES;
        hipLaunchKernelGGL(hybrid_fwd, dim3(grid), dim3(512), LDS_BYTES, stream, a);
    } else {
        for (int p = 0; p < N_PHASES; ++p) { a.ph_lo = p; a.ph_hi = p + 1; hipLaunchKernelGGL(hybrid_fwd, dim3(grid), dim3(512), LDS_BYTES, stream, a); }
    }
    const hipError_t le = hipPeekAtLastError();
    if (le != hipSuccess) fprintf(stderr, "kernel_launch: launch failed: %s\n", hipGetErrorName(le));
}
```

```cpp
#include <hip/hip_runtime.h>
#include <cstdio>
#include <cstdint>

#ifndef MK_N_LAUNCHES
#define MK_N_LAUNCHES 1
#endif
#ifndef DUP_PHASE
#define DUP_PHASE -1
#endif
#define DUP_N 4
#ifndef DUP_VARIANT
#define DUP_VARIANT 0
#endif
#ifndef PHMASK
#define PHMASK 0xFFFF
#endif
#define PHON(k) (((PHMASK) >> (k)) & 1)
#ifndef ITMASK
#define ITMASK 15
#endif

#define LAS __attribute__((address_space(3)))
typedef unsigned short bf16_t;
typedef short bf16x8 __attribute__((ext_vector_type(8)));
typedef float f32x4 __attribute__((ext_vector_type(4)));
typedef float f32x2 __attribute__((ext_vector_type(2)));
typedef unsigned u32x4 __attribute__((ext_vector_type(4)));
typedef unsigned u32x2 __attribute__((ext_vector_type(2)));

constexpr int T = 16384, D = 1024, SEQ = 2048, NBATCH = 8, DEPTH = 4, DFF = 3584, NEXP = 8;
constexpr int HP = 6912;
constexpr int C_US5 = 0, C_CQ = 256, C_CKV = 512, C_KR = 640, C_HQ = 768, C_HF = 1024, C_HI = 1280, C_HG = 1536, C_RQ = 1792, C_RK = 2048, C_RV = 2304, C_RG = 2560, C_GATE = 2816;
constexpr float ALPHA = 1.6817928305074290f;
constexpr float EPS = 1e-5f;
constexpr float QSCALE = 0.10206207261596575f * 1.4426950408889634f;
constexpr int MOE_MAXT = 136;

constexpr size_t MiB = (size_t)1 << 20;
constexpr size_t WS_CTL = 0, CTL_BYTES = 1 * MiB;
constexpr size_t WS_WIN = 1 * MiB, WS_WB = 55 * MiB, WS_WO = 63 * MiB, WS_WPG = 71 * MiB, WS_WPP = 79 * MiB, WS_WFFU = 81 * MiB, WS_WFFD = 109 * MiB;
constexpr size_t WS_WMU = 123 * MiB, WS_WMD = 347 * MiB, WS_WUQ = 459 * MiB, WS_WUKV = 460 * MiB, WS_WGLU = 461 * MiB;
constexpr size_t WS_ROPEM = 462 * MiB, WS_ROPER = 464 * MiB, WS_S5P = 468 * MiB, WS_TOK = 469 * MiB;
constexpr size_t WS_XB = 470 * MiB, WS_PB = 502 * MiB, WS_PP = 534 * MiB, WS_PLE = 566 * MiB, WS_STAGE = 598 * MiB;
constexpr size_t WS_H = WS_STAGE, WS_Y = WS_STAGE + 216 * MiB, WS_S5PRE = WS_STAGE + 248 * MiB, WS_MIXB = WS_STAGE + 256 * MiB, WS_TMP = WS_STAGE + 288 * MiB;
constexpr size_t WS_Q = WS_STAGE + 288 * MiB, WS_K = WS_STAGE + 300 * MiB, WS_VT = WS_STAGE + 312 * MiB, WS_QR = WS_STAGE + 320 * MiB, WS_KR = WS_STAGE + 328 * MiB;
constexpr size_t WS_S5E = WS_STAGE + 336 * MiB, WS_S5C = WS_STAGE + 338 * MiB, WS_HGD = WS_STAGE + 340 * MiB, WS_HGE = WS_STAGE + 341 * MiB, WS_HGI = WS_STAGE + 357 * MiB;
constexpr size_t WS_RTE = WS_STAGE + 373 * MiB, WS_RTI = WS_STAGE + 389 * MiB;
constexpr size_t WS_HFF = WS_STAGE, WS_XG = WS_STAGE, WS_HM = WS_STAGE + 68 * MiB, WS_YM = WS_STAGE + 306 * MiB;
constexpr size_t WS_END = WS_STAGE + 405 * MiB;
constexpr size_t WS_X8 = 236 * MiB;
constexpr size_t S5P_ABAR = 0, S5P_BM = 64 * 1024, S5P_CM = 384 * 1024, S5P_LB = 704 * 1024;
constexpr size_t TOK_E = 0, TOK_POS = 128 * 1024, TOK_W = 256 * 1024, TOK_SLOT = 384 * 1024;
constexpr int CW_BAR = 4096, CW_MOE = 32768;

constexpr int LDS_BYTES = 160 * 1024;
constexpr int LDS_STAGE = 0;
constexpr int LDS_MISC = 128 * 1024;
constexpr int LDS_CTLW = 160 * 1024 - 64;

__device__ __forceinline__ float bf2f(bf16_t b) { return __uint_as_float(((unsigned)b) << 16); }
__device__ __forceinline__ unsigned cvt_pk_bf16(float lo, float hi) { unsigned r; asm volatile("v_cvt_pk_bf16_f32 %0, %1, %2" : "=v"(r) : "v"(lo), "v"(hi)); return r; }
__device__ __forceinline__ bf16_t f2bf(float f) { return (bf16_t)(cvt_pk_bf16(f, 0.f) & 0xffffu); }
__device__ __forceinline__ unsigned cvt4_fp8(float a, float b, float c, float d) { int w = 0; w = __builtin_amdgcn_cvt_pk_fp8_f32(a, b, w, false); w = __builtin_amdgcn_cvt_pk_fp8_f32(c, d, w, true); return (unsigned)w; }
__device__ __forceinline__ float sigmoidf_(float x) { return 1.0f / (1.0f + __expf(-x)); }
__device__ __forceinline__ float siluf_(float x) { return x / (1.0f + __expf(-x)); }
__device__ __forceinline__ float gelu_tanh(float v) { const float z = 0.7978845608028654f * (v + 0.044715f * v * v * v); const float th = 1.0f - 2.0f / (__expf(2.0f * z) + 1.0f); return 0.5f * v * (1.0f + th); }
__device__ __forceinline__ f32x4 mfma16(bf16x8 a, bf16x8 b, f32x4 c) { return __builtin_amdgcn_mfma_f32_16x16x32_bf16(a, b, c, 0, 0, 0); }
typedef int i32x8 __attribute__((ext_vector_type(8)));
typedef int i32x4 __attribute__((ext_vector_type(4)));
union Frag { bf16x8 v; unsigned u[4]; u32x2 d[2]; u32x4 q; unsigned short h[8]; };
#define WSYNC() asm volatile("s_waitcnt lgkmcnt(0)" ::: "memory")
#define VM_WAIT() asm volatile("s_waitcnt vmcnt(0)" ::: "memory")
__device__ __forceinline__ float wave_sum(float v) {
#pragma unroll
    for (int o = 1; o < 64; o <<= 1) v += __shfl_xor(v, o);
    return v;
}

namespace pg8 {
constexpr int BM = 256, BK = 64, HALF = 128, HTB = HALF * BK * 2, STAGE_BYTES = 8 * HTB, NXCD = 8, WGM = 8;
__host__ __device__ __forceinline__ int lds_byte(int r, int c) { const int st = (r >> 4) * 2 + (c >> 5), rr = r & 15, cc = c & 31, ob = rr * 64 + cc * 2; return st * 1024 + (ob ^ (((ob >> 9) & 1) << 5)); }
__host__ __device__ __forceinline__ void stage_rc(int b, int& R, int& C) { const int st = b / 1024, sb = b % 1024, swz = sb ^ (((sb >> 9) & 1) << 5); R = (st >> 1) * 16 + swz / 64; C = (st & 1) * 32 + (swz % 64) / 2; }
__host__ __device__ __forceinline__ int perm32(int rho) { const int n = rho >> 4, i = rho & 15; return 8 * (i >> 2) + 4 * n + (i & 3); }

struct Unit { int pm, pn, ak; };
struct Gemm { const void* A; const void* Bt; int lda, ldb, K, flags; };

struct OrderStd {
    int nM, nN, nwg, G, c;
    __device__ void init(int nM_, int nN_, int G_, int c_) { nM = nM_; nN = nN_; nwg = nM * nN; G = G_; c = c_; }
    __device__ bool next(int i, Unit& u) const {
        const long L = (long)i * G + c; if (L >= nwg) return false;
        int wgid = (int)L; { const int q = nwg / NXCD, r = nwg % NXCD, xcd = wgid % NXCD, off = wgid / NXCD; wgid = (xcd < r ? xcd * (q + 1) : r * (q + 1) + (xcd - r) * q) + off; }
        const int nig = WGM * nN, gid = wgid / nig, fm = gid * WGM, gsz = (nM - fm) < WGM ? (nM - fm) : WGM;
        u.pm = fm + ((wgid % nig) % gsz); u.pn = (wgid % nig) / gsz; u.ak = 0; return true;
    }
};
struct OrderLin {
    int c, G, total, nN;
    __device__ bool next(int i, Unit& u) const { if (c < 0) return false; const int L = i * G + c; if (L >= total) return false; u.pm = L / nN; u.pn = L % nN; u.ak = 0; return true; }
};
struct OrderOne {
    int pm, pn; bool has;
    __device__ bool next(int i, Unit& u) const { if (i > 0 || !has) return false; u.pm = pm; u.pn = pn; u.ak = 0; return true; }
};
struct OrderBranch {
    int c, G;
    __device__ bool next(int i, Unit& u) const { const int t = (i >> 2) * G + c, n = i & 3; if (t >= 512) return false; u.pm = t >> 2; u.pn = n * 4 + (t & 3); u.ak = n * 256; return true; }
};
struct OrderMoe {
    int nT, ncol, G, c, t1, t2, t3, t4, t5, t6, t7;
    __device__ bool next(int i, Unit& u) const {
        const long L = (long)i * G + c; if (L >= (long)nT * ncol) return false;
        const int wg = (int)L, nig = WGM * ncol, gid = wg / nig, fm = gid * WGM, gsz = (nT - fm) < WGM ? (nT - fm) : WGM;
        const int pm = fm + ((wg % nig) % gsz), ct = (wg % nig) / gsz;
        const int e = (pm >= t1) + (pm >= t2) + (pm >= t3) + (pm >= t4) + (pm >= t5) + (pm >= t6) + (pm >= t7);
        u.pm = pm; u.pn = e * ncol + ct; u.ak = 0; return true;
    }
};

template <class Epi, class Sched, bool ALIGN_EPI = true, bool SP2 = true>
__device__ __forceinline__ void gemm_phase(LAS unsigned char* lds, const Gemm g, const Sched& S, const Epi& E) {
    int oz_; asm volatile("s_mov_b32 %0, 0" : "=s"(oz_));
    const int tid = threadIdx.x + oz_, wid = __builtin_amdgcn_readfirstlane(tid >> 6), lane = tid & 63, wr = wid >> 2, wc = wid & 3, fr = lane & 15, fq = lane >> 4;
    constexpr int ESZ = Epi::FP8 ? 1 : 2;
    const int nt = (g.K * ESZ + oz_) / (BK * 2);
    unsigned voffA[2], voffB[2]; const unsigned hoffA = Epi::HALF_M ? 0u : (unsigned)(HALF * g.lda * ESZ), hoffB = (unsigned)(HALF * g.ldb * ESZ);
#pragma unroll
    for (int i = 0; i < 2; ++i) { int R, C; stage_rc(tid * 16 + i * 8192, R, C); const int Rb = Epi::PERM ? ((R & ~31) + perm32(R & 31)) : R;
        voffA[i] = (unsigned)(R * g.lda * ESZ + C * 2); voffB[i] = (unsigned)(Rb * g.ldb * ESZ + C * 2); }
    const size_t kstep = (size_t)(BK * 2);
    const size_t hstepA = (size_t)HALF * g.lda * ESZ, hstepB = (size_t)HALF * g.ldb * ESZ;
    static_assert(!Epi::HALF_M || SP2, "HALF_M needs the SP2 loop");
    const size_t tstepA = Epi::HALF_M ? hstepA : 2 * hstepA, tstepB = 2 * hstepB;
    const size_t hA2 = Epi::HALF_M ? 0 : hstepA;
    const unsigned ldsw = (unsigned)wid * 1024u;
    const int aoff = lds_byte(wr * 64 + fr, Epi::FP8 ? fq * 16 : fq * 8), boff = lds_byte(wc * 32 + fr, Epi::FP8 ? fq * 16 : fq * 8);
#define PG8_SA(b, h) (((b) * 2 + (h)) * HTB)
#define PG8_SB(b, h) ((4 + (b) * 2 + (h)) * HTB)
#define voffAh voffA, hoffA
#define voffBh voffB, hoffB
#define PG8_STAGE(...) PG8_STAGE_(__VA_ARGS__, 0u)
#define PG8_STAGE_(bufoff, gbase, voff, hoff, ...) do { _Pragma("unroll") for (int _i = 0; _i < 2; ++_i) { unsigned vo_ = (voff)[_i] + (hoff); asm volatile("" : "+v"(vo_)); \
        __builtin_amdgcn_global_load_lds((const unsigned*)((const char*)(gbase) + vo_), (LAS unsigned*)(lds + (bufoff) + ldsw + _i * 8192), 16, 0, 0); } } while (0)
#define PG8_LDA(dst, b, h) do { if constexpr (Epi::FP8) { _Pragma("unroll") for (int m = 0; m < 4; ++m) { const i32x4 lo_ = *(const LAS i32x4*)(lds + PG8_SA(b, h) + aoff + m * 2048), hi_ = *(const LAS i32x4*)(lds + PG8_SA(b, h) + aoff + m * 2048 + 16); dst##8[m] = __builtin_shufflevector(lo_, hi_, 0, 1, 2, 3, 4, 5, 6, 7); } } \
        else { _Pragma("unroll") for (int m = 0; m < 4; ++m) _Pragma("unroll") for (int k = 0; k < 2; ++k) dst[m][k] = *(const LAS bf16x8*)(lds + PG8_SA(b, h) + aoff + m * 2048 + k * 1024); } } while (0)
#define PG8_LDB(dst, b, h) do { if constexpr (Epi::FP8) { _Pragma("unroll") for (int n = 0; n < 2; ++n) { const i32x4 lo_ = *(const LAS i32x4*)(lds + PG8_SB(b, h) + boff + n * 2048), hi_ = *(const LAS i32x4*)(lds + PG8_SB(b, h) + boff + n * 2048 + 16); dst##8[n] = __builtin_shufflevector(lo_, hi_, 0, 1, 2, 3, 4, 5, 6, 7); } } \
        else { _Pragma("unroll") for (int n = 0; n < 2; ++n) _Pragma("unroll") for (int k = 0; k < 2; ++k) dst[n][k] = *(const LAS bf16x8*)(lds + PG8_SB(b, h) + boff + n * 2048 + k * 1024); } } while (0)
#define PG8_MMA(ai, bj, At, Bt) do { __builtin_amdgcn_s_setprio(1); if constexpr (Epi::FP8) { _Pragma("unroll") for (int m = 0; m < 4; ++m) _Pragma("unroll") for (int n = 0; n < 2; ++n) \
            asm volatile("v_mfma_scale_f32_16x16x128_f8f6f4 %0, %1, %2, %0, %3, %3 op_sel_hi:[0,0,0]" : "+v"(acc[ai][bj][m][n]) : "v"(Bt##8[n]), "v"(At##8[m]), "v"(scl8)); } \
        else { _Pragma("unroll") for (int m = 0; m < 4; ++m) _Pragma("unroll") for (int n = 0; n < 2; ++n) _Pragma("unroll") for (int k = 0; k < 2; ++k) \
            acc[ai][bj][m][n] = __builtin_amdgcn_mfma_f32_16x16x32_bf16(Bt[n][k], At[m][k], acc[ai][bj][m][n], 0, 0, 0); } __builtin_amdgcn_s_setprio(0); } while (0)
#define PG8_WAIT_V(n) asm volatile("s_waitcnt vmcnt(" #n ")" ::: "memory")
#define PG8_WAIT_L(n) asm volatile("s_waitcnt lgkmcnt(" #n ")" ::: "memory")
#define PG8_BAR __builtin_amdgcn_s_barrier()
#define PG8_SCHED __builtin_amdgcn_sched_barrier(0)
    Unit cur, nxt; int ui = 0;
    if (!S.next(0, cur)) return;
    f32x4 acc[2][2][4][2];
#pragma unroll
    for (int a = 0; a < 2; ++a)
#pragma unroll
        for (int b = 0; b < 2; ++b)
#pragma unroll
            for (int m = 0; m < 4; ++m)
#pragma unroll
                for (int n = 0; n < 2; ++n) acc[a][b][m][n] = (f32x4){0.f, 0.f, 0.f, 0.f};
    bf16x8 At[4][2], B0[2][2], B1[2][2]; i32x8 At8[4], B08[2], B18[2]; const int scl8 = 0x7f7f7f7f;
    const char* cA = (const char*)g.A + (size_t)cur.pm * tstepA + (size_t)cur.ak * ESZ; const char* cB = (const char*)g.Bt + (size_t)cur.pn * tstepB;
    if constexpr (SP2) {
        PG8_STAGE(PG8_SB(0, 0), cB, voffB); PG8_STAGE(PG8_SB(0, 1), cB, voffBh); PG8_STAGE(PG8_SA(0, 0), cA, voffA); PG8_STAGE(PG8_SA(0, 1), cA, voffAh);
        if (wr == 1) PG8_BAR;
        PG8_WAIT_V(2); PG8_BAR;
        PG8_STAGE(PG8_SB(1, 0), cB + kstep, voffB); PG8_STAGE(PG8_SA(1, 0), cA + kstep, voffA); PG8_STAGE(PG8_SB(1, 1), cB + kstep, voffBh);
        PG8_WAIT_V(6); PG8_BAR;
    } else {
        PG8_STAGE(PG8_SB(0, 0), cB, voffB); PG8_STAGE(PG8_SA(0, 0), cA, voffA); PG8_STAGE(PG8_SB(0, 1), cB, voffBh); PG8_STAGE(PG8_SA(0, 1), cA, voffAh);
        if (wr == 1) PG8_BAR;
        PG8_WAIT_V(4); PG8_BAR;
        PG8_STAGE(PG8_SB(1, 0), cB + kstep, voffB); PG8_STAGE(PG8_SA(1, 0), cA + kstep, voffA); PG8_STAGE(PG8_SB(1, 1), cB + kstep, voffBh);
        PG8_WAIT_V(6); PG8_BAR;
    }
    for (;;) {
        const bool has_next = S.next(ui + 1, nxt);
        const char* nA = has_next ? (const char*)g.A + (size_t)nxt.pm * tstepA + (size_t)nxt.ak * ESZ : cA; const char* nB = has_next ? (const char*)g.Bt + (size_t)nxt.pn * tstepB : cB;
        for (int t = 0; t < nt; t += 2) {
            const bool last = (t == nt - 2);
            const char* a1 = cA + (size_t)(t + 1) * kstep;
            const char* a2 = last ? nA : cA + (size_t)(t + 2) * kstep; const char* b2 = last ? nB : cB + (size_t)(t + 2) * kstep;
            const char* a3 = a2 + kstep; const char* b3 = b2 + kstep;
            if constexpr (SP2) {
            PG8_LDB(B0, 0, 0); PG8_LDB(B1, 0, 1); PG8_SCHED; PG8_LDA(At, 0, 0); PG8_STAGE(PG8_SA(1, 1), a1, voffAh);
            PG8_WAIT_V(8); PG8_WAIT_L(0); PG8_BAR; PG8_MMA(0, 0, At, B0); PG8_MMA(0, 1, At, B1); PG8_BAR; PG8_SCHED;
            if constexpr (!Epi::HALF_M) PG8_LDA(At, 0, 1); PG8_STAGE(PG8_SB(0, 0), b2, voffB); PG8_STAGE(PG8_SB(0, 1), b2, voffBh); PG8_STAGE(PG8_SA(0, 0), a2, voffA);
            PG8_WAIT_V(8); PG8_WAIT_L(0); PG8_BAR; if constexpr (!Epi::HALF_M) { PG8_MMA(1, 0, At, B0); PG8_MMA(1, 1, At, B1); } PG8_BAR; PG8_SCHED;
            PG8_LDB(B0, 1, 0); PG8_LDB(B1, 1, 1); PG8_SCHED; PG8_LDA(At, 1, 0); PG8_STAGE(PG8_SA(0, 1), a2, voffAh);
            PG8_WAIT_V(8); PG8_WAIT_L(0); PG8_BAR; PG8_MMA(0, 0, At, B0); PG8_MMA(0, 1, At, B1); PG8_BAR; PG8_SCHED;
            if constexpr (!Epi::HALF_M) PG8_LDA(At, 1, 1); PG8_STAGE(PG8_SB(1, 0), b3, voffB); PG8_STAGE(PG8_SB(1, 1), b3, voffBh); PG8_STAGE(PG8_SA(1, 0), a3, voffA);
            PG8_WAIT_V(8); PG8_WAIT_L(0); PG8_BAR; if constexpr (!Epi::HALF_M) { PG8_MMA(1, 0, At, B0); PG8_MMA(1, 1, At, B1); } PG8_BAR; PG8_SCHED;
            } else {
            PG8_LDB(B0, 0, 0); PG8_SCHED; PG8_LDA(At, 0, 0); PG8_STAGE(PG8_SA(1, 1), a1, voffAh);
            PG8_WAIT_L(8); PG8_BAR; PG8_WAIT_L(0); PG8_MMA(0, 0, At, B0); PG8_BAR; PG8_SCHED;
            PG8_LDB(B1, 0, 1); PG8_STAGE(PG8_SB(0, 0), b2, voffB);
            PG8_BAR; PG8_WAIT_L(0); PG8_MMA(0, 1, At, B1); PG8_BAR;
            PG8_LDA(At, 0, 1); PG8_STAGE(PG8_SA(0, 0), a2, voffA);
            PG8_BAR; PG8_WAIT_L(0); PG8_MMA(1, 0, At, B0); PG8_BAR; PG8_SCHED;
            PG8_STAGE(PG8_SB(0, 1), b2, voffBh);
            PG8_WAIT_V(6); PG8_BAR; PG8_MMA(1, 1, At, B1); PG8_BAR;
            PG8_LDB(B0, 1, 0); PG8_SCHED; PG8_LDA(At, 1, 0); PG8_STAGE(PG8_SA(0, 1), a2, voffAh);
            PG8_WAIT_L(8); PG8_BAR; PG8_WAIT_L(0); PG8_MMA(0, 0, At, B0); PG8_BAR; PG8_SCHED;
            PG8_LDB(B1, 1, 1); PG8_STAGE(PG8_SB(1, 0), b3, voffB);
            PG8_BAR; PG8_WAIT_L(0); PG8_MMA(0, 1, At, B1); PG8_BAR;
            PG8_LDA(At, 1, 1); PG8_STAGE(PG8_SA(1, 0), a3, voffA);
            PG8_BAR; PG8_WAIT_L(0); PG8_MMA(1, 0, At, B0); PG8_BAR; PG8_SCHED;
            PG8_STAGE(PG8_SB(1, 1), b3, voffBh);
            PG8_WAIT_V(6); PG8_BAR; PG8_MMA(1, 1, At, B1); PG8_BAR;
            }
        }
        if constexpr (ALIGN_EPI) { if (wr == 0) PG8_BAR; }
        if constexpr (Epi::FP8) { asm volatile("s_nop 15\n\ts_nop 15\n\ts_nop 15" ::: "memory"); }
        { int vz_; asm volatile("v_mov_b32 %0, 0" : "=v"(vz_)); if (!(g.flags & 1)) E(acc, cur, wr, wc, fr + vz_, fq); }
        if (!has_next) break;
#pragma unroll
        for (int a = 0; a < (Epi::HALF_M ? 1 : 2); ++a)
#pragma unroll
            for (int b = 0; b < 2; ++b)
#pragma unroll
                for (int m = 0; m < 4; ++m)
#pragma unroll
                    for (int n = 0; n < 2; ++n) acc[a][b][m][n] = (f32x4){0.f, 0.f, 0.f, 0.f};
        cur = nxt; cA = nA; cB = nB; ++ui;
        if constexpr (ALIGN_EPI) { if (wr == 1) PG8_BAR; }
    }
    PG8_WAIT_V(0);
    if constexpr (!ALIGN_EPI) { if (wr == 0) PG8_BAR; }
    PG8_BAR;
#undef PG8_SA
#undef PG8_SB
#undef PG8_STAGE
#undef PG8_STAGE_
#undef voffAh
#undef voffBh
#undef PG8_LDA
#undef PG8_LDB
#undef PG8_MMA
#undef PG8_WAIT_V
#undef PG8_WAIT_L
#undef PG8_BAR
#undef PG8_SCHED
}

typedef f32x4 Acc[2][2][4][2];
template <bool F8>
struct EpiBf16T {
    static constexpr bool PERM = true, HALF_M = false, FP8 = F8;
    bf16_t* O; int ldc; int ncol; float sc;
    __device__ __forceinline__ void operator()(const Acc& acc, const Unit& u, int wr, int wc, int fr, int fq) const {
        const int row0 = u.pm * BM + wr * 64 + fr, col0 = (u.pn % ncol) * BM + wc * 32 + 8 * fq;
#pragma unroll
        for (int ai = 0; ai < 2; ++ai)
#pragma unroll
            for (int m = 0; m < 4; ++m) { bf16_t* rowp = O + (size_t)(row0 + ai * HALF + m * 16) * ldc + col0;
#pragma unroll
                for (int bj = 0; bj < 2; ++bj) { const f32x4 v0 = acc[ai][bj][m][0] * sc, v1 = acc[ai][bj][m][1] * sc;
                    u32x4 w; w.x = cvt_pk_bf16(v0[0], v0[1]); w.y = cvt_pk_bf16(v0[2], v0[3]); w.z = cvt_pk_bf16(v1[0], v1[1]); w.w = cvt_pk_bf16(v1[2], v1[3]);
                    *(u32x4*)(rowp + bj * HALF) = w; } }
    }
};
typedef EpiBf16T<false> EpiBf16;
struct EpiSwiglu8 {
    static constexpr bool PERM = true, HALF_M = false, FP8 = true;
    unsigned char* O; int ldc; int ncol;
    __device__ __forceinline__ void operator()(const Acc& acc, const Unit& u, int wr, int wc, int fr, int fq) const {
        const int row0 = u.pm * BM + wr * 64 + fr, col0 = (u.pn % ncol) * HALF + wc * 32 + 8 * fq;
#pragma unroll
        for (int ai = 0; ai < 2; ++ai)
#pragma unroll
            for (int m = 0; m < 4; ++m) { unsigned char* rowp = O + (size_t)(row0 + ai * HALF + m * 16) * ldc + col0;
                float o[8];
#pragma unroll
                for (int n = 0; n < 2; ++n)
#pragma unroll
                    for (int j = 0; j < 4; ++j) o[n * 4 + j] = siluf_(acc[ai][0][m][n][j] * 0.015625f) * (acc[ai][1][m][n][j] * 0.25f);
                u32x2 w; w.x = cvt4_fp8(o[0], o[1], o[2], o[3]); w.y = cvt4_fp8(o[4], o[5], o[6], o[7]);
                *(u32x2*)rowp = w; }
    }
};
struct EpiSigMul {
    static constexpr bool PERM = true, HALF_M = false, FP8 = false;
    bf16_t* O; int ldc; const bf16_t* P; int ldp;
    __device__ __forceinline__ void operator()(const Acc& acc, const Unit& u, int wr, int wc, int fr, int fq) const {
        const int row0 = u.pm * BM + wr * 64 + fr, col0 = u.pn * BM + wc * 32 + 8 * fq;
#pragma unroll
        for (int ai = 0; ai < 2; ++ai)
#pragma unroll
            for (int m = 0; m < 4; ++m) { const size_t r = (size_t)(row0 + ai * HALF + m * 16);
#pragma unroll
                for (int bj = 0; bj < 2; ++bj) { const u32x4 pv = *(const u32x4*)(P + r * ldp + col0 + bj * HALF); const f32x4 v0 = acc[ai][bj][m][0], v1 = acc[ai][bj][m][1];
                    float o[8];
#pragma unroll
                    for (int j = 0; j < 4; ++j) { const unsigned pw = pv[j]; const float plo = __uint_as_float(pw << 16), phi = __uint_as_float(pw & 0xffff0000u);
                        const float a = (j < 2) ? v0[2 * j] : v1[2 * j - 4], b = (j < 2) ? v0[2 * j + 1] : v1[2 * j - 3];
                        o[2 * j] = sigmoidf_(a) * plo; o[2 * j + 1] = sigmoidf_(b) * phi; }
                    u32x4 w; w.x = cvt_pk_bf16(o[0], o[1]); w.y = cvt_pk_bf16(o[2], o[3]); w.z = cvt_pk_bf16(o[4], o[5]); w.w = cvt_pk_bf16(o[6], o[7]);
                    *(u32x4*)(O + r * ldc + col0 + bj * HALF) = w; }
                if (m == 3) asm volatile("" ::: "memory"); }
    }
};
struct EpiBranch {
    static constexpr bool PERM = true, HALF_M = false, FP8 = false;
    const bf16_t* Hg; float* tmp; bf16_t* mixb;
    __device__ __forceinline__ void operator()(const Acc& acc, const Unit& u, int wr, int wc, int fr, int fq) const {
        const int n4 = u.pn >> 2, ct = u.pn & 3;
        const int row0 = u.pm * BM + wr * 64 + fr, col0 = ct * BM + wc * 32 + 8 * fq;
#pragma unroll
        for (int ai = 0; ai < 2; ++ai)
#pragma unroll
            for (int m = 0; m < 4; ++m) { const size_t r = (size_t)(row0 + ai * HALF + m * 16);
#pragma unroll
                for (int bj = 0; bj < 2; ++bj) { const int c = col0 + bj * HALF;
                    const u32x4 gv = *(const u32x4*)(Hg + r * HP + n4 * 1024 + c); const f32x4 v0 = acc[ai][bj][m][0], v1 = acc[ai][bj][m][1];
                    float o[8];
#pragma unroll
                    for (int j = 0; j < 4; ++j) { const unsigned gw = gv[j]; const float glo = __uint_as_float(gw << 16), ghi = __uint_as_float(gw & 0xffff0000u);
                        const float a = (j < 2) ? v0[2 * j] : v1[2 * j - 4], b = (j < 2) ? v0[2 * j + 1] : v1[2 * j - 3];
                        o[2 * j] = sigmoidf_(glo) * a; o[2 * j + 1] = sigmoidf_(ghi) * b; }
                    float* tp = tmp + r * 1024 + c;
                    if (n4 > 0) { const f32x4 p0 = *(const f32x4*)tp, p1 = *(const f32x4*)(tp + 4);
#pragma unroll
                        for (int j = 0; j < 4; ++j) { o[j] += p0[j]; o[4 + j] += p1[j]; } }
                    if (n4 < 3) { *(f32x4*)tp = (f32x4){o[0], o[1], o[2], o[3]}; *(f32x4*)(tp + 4) = (f32x4){o[4], o[5], o[6], o[7]}; }
                    else { u32x4 w; w.x = cvt_pk_bf16(o[0], o[1]); w.y = cvt_pk_bf16(o[2], o[3]); w.z = cvt_pk_bf16(o[4], o[5]); w.w = cvt_pk_bf16(o[6], o[7]); *(u32x4*)(mixb + r * 1024 + c) = w; } }
                if (m & 1) asm volatile("" ::: "memory"); }
    }
};
struct EpiBranchH {
    static constexpr bool PERM = true, HALF_M = true, FP8 = false;
    const bf16_t* Hg; bf16_t* mixb;
    __device__ __forceinline__ void operator()(Acc& acc, const Unit& u, int wr, int wc, int fr, int fq) const {
        const int n4 = u.pn >> 2, ct = u.pn & 3;
        const int row0 = u.pm * HALF + wr * 64 + fr, col0 = ct * BM + wc * 32 + 8 * fq;
#pragma unroll
        for (int m = 0; m < 4; ++m) { const size_t r = (size_t)(row0 + m * 16);
#pragma unroll
            for (int bj = 0; bj < 2; ++bj) { const int c = col0 + bj * HALF;
                const u32x4 gv = *(const u32x4*)(Hg + r * HP + n4 * 1024 + c);
                f32x4 g0, g1;
                g0[0] = sigmoidf_(__uint_as_float(gv.x << 16)); g0[1] = sigmoidf_(__uint_as_float(gv.x & 0xffff0000u)); g0[2] = sigmoidf_(__uint_as_float(gv.y << 16)); g0[3] = sigmoidf_(__uint_as_float(gv.y & 0xffff0000u));
                g1[0] = sigmoidf_(__uint_as_float(gv.z << 16)); g1[1] = sigmoidf_(__uint_as_float(gv.z & 0xffff0000u)); g1[2] = sigmoidf_(__uint_as_float(gv.w << 16)); g1[3] = sigmoidf_(__uint_as_float(gv.w & 0xffff0000u));
                const f32x4 p0 = g0 * acc[0][bj][m][0], p1 = g1 * acc[0][bj][m][1];
                if (n4 == 0) { acc[1][bj][m][0] = p0; acc[1][bj][m][1] = p1; } else { acc[1][bj][m][0] += p0; acc[1][bj][m][1] += p1; }
                if (n4 == 3) { const f32x4 o0 = acc[1][bj][m][0], o1 = acc[1][bj][m][1]; u32x4 w; w.x = cvt_pk_bf16(o0[0], o0[1]); w.y = cvt_pk_bf16(o0[2], o0[3]); w.z = cvt_pk_bf16(o1[0], o1[1]); w.w = cvt_pk_bf16(o1[2], o1[3]);
                    *(u32x4*)(mixb + r * 1024 + c) = w; } } }
    }
};
template <bool F8>
struct EpiResidT {
    static constexpr bool PERM = false, HALF_M = false, FP8 = F8;
    const float* base; float* out; const bf16_t* add; float sc;
    __device__ __forceinline__ void operator()(const Acc& acc, const Unit& u, int wr, int wc, int fr, int fq) const {
        const int row0 = u.pm * BM + wr * 64 + fr, col0 = u.pn * BM + wc * 32 + 4 * fq;
#pragma unroll
        for (int ai = 0; ai < 2; ++ai)
#pragma unroll
            for (int m = 0; m < 4; ++m) { const size_t off = (size_t)(row0 + ai * HALF + m * 16) * 1024 + col0;
#pragma unroll
                for (int bj = 0; bj < 2; ++bj)
#pragma unroll
                    for (int n = 0; n < 2; ++n) { const size_t o = off + bj * HALF + n * 16; const f32x4 bs = *(const f32x4*)(base + o); f32x4 v = bs * ALPHA + acc[ai][bj][m][n] * sc;
                        if (add) { const u32x2 av = *(const u32x2*)(add + o); v[0] += __uint_as_float(av.x << 16); v[1] += __uint_as_float(av.x & 0xffff0000u); v[2] += __uint_as_float(av.y << 16); v[3] += __uint_as_float(av.y & 0xffff0000u); }
                        *(f32x4*)(out + o) = v; }
                if (m & 1) asm volatile("" ::: "memory"); }
    }
};
typedef EpiResidT<false> EpiResid;
struct EpiQ {
    static constexpr bool PERM = false, HALF_M = false, FP8 = false;
    bf16_t* Qb; const float* ropeM; const LAS float* rs;
    __device__ __forceinline__ void operator()(const Acc& acc, const Unit& u, int wr, int wc, int fr, int fq) const {
#pragma unroll
        for (int bj = 0; bj < 2; ++bj) { const int gb = u.pn * BM + bj * HALF + wc * 32; if (gb >= 384) continue;
            const int hd = gb / 96, part = (gb % 96) / 32;
#pragma unroll
            for (int ai = 0; ai < 2; ++ai)
#pragma unroll
                for (int m = 0; m < 4; ++m) { const int rl = ai * HALF + wr * 64 + m * 16 + fr, t = u.pm * BM + rl, b = t >> 11, s = t & 2047; const float sc = rs[rl] * QSCALE;
                    f32x4 x1 = acc[ai][bj][m][0] * sc, x2 = acc[ai][bj][m][1] * sc;
                    if (part == 2) { const f32x4 cs = *(const f32x4*)(ropeM + (size_t)t * 32 + 4 * fq), sn = *(const f32x4*)(ropeM + (size_t)t * 32 + 16 + 4 * fq);
                        const f32x4 o1 = x1 * cs - x2 * sn, o2 = x2 * cs + x1 * sn; x1 = o1; x2 = o2; }
                    bf16_t* qp = Qb + ((size_t)((b * 4 + hd) * SEQ + s)) * 96 + part * 32 + 4 * fq;
                    u32x2 w1, w2; w1.x = cvt_pk_bf16(x1[0], x1[1]); w1.y = cvt_pk_bf16(x1[2], x1[3]); w2.x = cvt_pk_bf16(x2[0], x2[1]); w2.y = cvt_pk_bf16(x2[2], x2[3]);
                    *(u32x2*)qp = w1; *(u32x2*)(qp + 16) = w2; asm volatile("" ::: "memory"); } }
    }
};
struct EpiKV {
    static constexpr bool PERM = false, HALF_M = false, FP8 = false;
    bf16_t* Kb; bf16_t* Vt; const LAS float* rs;
    __device__ __forceinline__ void operator()(const Acc& acc, const Unit& u, int wr, int wc, int fr, int fq) const {
#pragma unroll
        for (int bj = 0; bj < 2; ++bj) { const int gb = u.pn * BM + bj * HALF + wc * 32; const int hd = gb / 128, part = (gb % 128) / 32;
#pragma unroll
            for (int ai = 0; ai < 2; ++ai)
#pragma unroll
                for (int m = 0; m < 4; ++m) { const int rl = ai * HALF + wr * 64 + m * 16 + fr, t = u.pm * BM + rl, b = t >> 11, s = t & 2047; const float sc = rs[rl];
                    const f32x4 x1 = acc[ai][bj][m][0] * sc, x2 = acc[ai][bj][m][1] * sc;
                    if (part < 2) { bf16_t* kp = Kb + ((size_t)((b * 4 + hd) * SEQ + s)) * 96 + part * 32 + 4 * fq;
                        u32x2 w1, w2; w1.x = cvt_pk_bf16(x1[0], x1[1]); w1.y = cvt_pk_bf16(x1[2], x1[3]); w2.x = cvt_pk_bf16(x2[0], x2[1]); w2.y = cvt_pk_bf16(x2[2], x2[3]);
                        *(u32x2*)kp = w1; *(u32x2*)(kp + 16) = w2; }
                    else { bf16_t* vp = Vt + ((size_t)((b * 4 + hd) * 64 + (part - 2) * 32 + 4 * fq)) * SEQ + s;
#pragma unroll
                        for (int j = 0; j < 4; ++j) { vp[(size_t)j * SEQ] = f2bf(x1[j]); vp[(size_t)(16 + j) * SEQ] = f2bf(x2[j]); } }
                    asm volatile("" ::: "memory"); } }
    }
};
}

#define XB_TMO      128
#define XB_XCNT(j)  (256  + 64 * (j))
#define XB_XSUB(j)  (1280 + 64 * (j))
#define XB_XGEN(j)  (2304 + 64 * (j))
#define XB_TOP      3328
#define XB_TOPGEN   3392
#define XCD_BAR_WORDS 3456
#define XB_SPIN_CAP (1u << 18)
__device__ __forceinline__ unsigned xb_ld(unsigned* p)              { return __hip_atomic_load(p, __ATOMIC_RELAXED, __HIP_MEMORY_SCOPE_AGENT); }
__device__ __forceinline__ unsigned xb_add(unsigned* p, unsigned v) { return __hip_atomic_fetch_add(p, v, __ATOMIC_RELAXED, __HIP_MEMORY_SCOPE_AGENT); }
__device__ __forceinline__ unsigned xb_xcc_id() { return (unsigned)__builtin_amdgcn_s_getreg((3 << 11) | 20) & 0xFu; }
#define XB_SPIN(cond, bar) do { unsigned _sp = 0; while (cond) { __builtin_amdgcn_s_sleep(1); \
    if ((++_sp & 255u) == 0u) { if (xb_ld(&(bar)[XB_TMO])) break; if (_sp > XB_SPIN_CAP) { atomicAdd(&(bar)[XB_TMO], 1u); break; } } } } while (0)
struct XcdBarrier { unsigned* bar; unsigned x; volatile LAS unsigned* st; };
__device__ __forceinline__ XcdBarrier xcd_barrier_post(unsigned* bar, volatile LAS unsigned* st) {
    XcdBarrier b; b.bar = bar; b.x = xb_xcc_id(); b.st = st;
    if (threadIdx.x == 0) (void)xb_add(&bar[XB_XCNT(b.x)], 1u);
    return b;
}
__device__ __forceinline__ void xcd_barrier_complete(unsigned* bar, unsigned x, unsigned& nloc, unsigned& nx) {
    const unsigned G = gridDim.x * gridDim.y * gridDim.z;
    unsigned sum, cnt, mine, sp = 0u;
    for (;;) {
        sum = 0u; cnt = 0u; mine = 0u;
#pragma unroll
        for (unsigned j = 0; j < 16; ++j) { const unsigned c = xb_ld(&bar[XB_XCNT(j)]); sum += c; cnt += (c > 0u) ? 1u : 0u; mine = (j == x) ? c : mine; }
        if (sum == G) break;
        __builtin_amdgcn_s_sleep(1);
        if ((++sp & 255u) == 0u) { if (xb_ld(&bar[XB_TMO])) break; if (sp > XB_SPIN_CAP) { atomicAdd(&bar[XB_TMO], 1u); break; } }
    }
    nloc = mine > 0u ? mine : 1u; nx = cnt > 0u ? cnt : 1u;
}
__device__ __forceinline__ void xcd_barrier(const XcdBarrier& b) {
    asm volatile("s_waitcnt vmcnt(0)" ::: "memory");
    __syncthreads();
    if (threadIdx.x == 0) {
        unsigned* bar = b.bar;
        __builtin_amdgcn_s_waitcnt(0);
        unsigned nloc = b.st[0], nx = b.st[1];
        if (nloc == 0u) { xcd_barrier_complete(bar, b.x, nloc, nx); b.st[0] = nloc; b.st[1] = nx; }
        const unsigned old = xb_add(&bar[XB_XSUB(b.x)], 1u);
        const unsigned gen = old / nloc;
        if (old + 1u == (gen + 1u) * nloc) {
            __builtin_amdgcn_fence(__ATOMIC_RELEASE, "agent");
            asm volatile("s_waitcnt vmcnt(0)" ::: "memory");
            const unsigned og = xb_add(&bar[XB_TOP], 1u);
            const unsigned tg = og / nx;
            if (og + 1u == (tg + 1u) * nx) xb_add(&bar[XB_TOPGEN], 1u);
            else XB_SPIN(xb_ld(&bar[XB_TOPGEN]) == tg, bar);
            __builtin_amdgcn_fence(__ATOMIC_ACQUIRE, "agent");
            xb_add(&bar[XB_XGEN(b.x)], 1u);
            asm volatile("s_waitcnt vmcnt(0)" ::: "memory");
        } else {
            XB_SPIN(xb_ld(&bar[XB_XGEN(b.x)]) == gen, bar);
            __builtin_amdgcn_fence(__ATOMIC_ACQUIRE, "agent");
            asm volatile("s_waitcnt vmcnt(0)" ::: "memory");
        }
    }
    __syncthreads();
}

__device__ __forceinline__ int vzero() { int z; asm volatile("v_mov_b32 %0, 0" : "=v"(z)); return z; }
__device__ __forceinline__ int opaque0() { int z; asm volatile("s_mov_b32 %0, 0" : "=s"(z)); return z; }
struct Args { const void* in[36]; float* out; unsigned char* ws; int ph_lo, ph_hi, bar_region, variant; };
struct Frame {
    LAS unsigned char* lds;
    unsigned char* ws;
    const void* const* in;
    float* out;
    int tid, lane, wave, G, bid, gw, NGW;
};
__device__ __forceinline__ Frame reframe(const Frame& F) {
    Frame P = F; const int z = opaque0(), vz = vzero();
    P.ws = F.ws + z; P.out = F.out + z; P.lds = F.lds + z; P.bid = F.bid + z; P.G = F.G + z; P.wave = F.wave + z; P.gw = P.bid * 8 + P.wave; P.NGW = P.G * 8; P.tid = F.tid + vz; P.lane = F.lane + vz;
    return P;
}
#define IN_F(k) ((const float*)F.in[k])
#define WSP(T_, off) ((T_*)(F.ws + (off)))

__device__ __forceinline__ void tr_item(const float* W, int N, bf16_t* WT, int ldd, int drow0, int k0, int n0, const float* kscale, LAS float* scr, int lane) {
#pragma unroll 8
    for (int i = 0; i < 32; ++i) { const int kk = 2 * i + (lane >> 5); scr[kk * 33 + (lane & 31)] = W[(size_t)(k0 + kk) * N + n0 + (lane & 31)]; }
    WSYNC();
    const int c = lane & 7;
    float ks[8];
#pragma unroll
    for (int q = 0; q < 8; ++q) ks[q] = kscale ? kscale[k0 + 8 * c + q] : 1.0f;
#pragma unroll
    for (int j = 0; j < 4; ++j) { const int n = (lane >> 3) + 8 * j; const LAS float* s = scr + (8 * c) * 33 + n;
        u32x4 o; o.x = cvt_pk_bf16(s[0 * 33] * ks[0], s[1 * 33] * ks[1]); o.y = cvt_pk_bf16(s[2 * 33] * ks[2], s[3 * 33] * ks[3]); o.z = cvt_pk_bf16(s[4 * 33] * ks[4], s[5 * 33] * ks[5]); o.w = cvt_pk_bf16(s[6 * 33] * ks[6], s[7 * 33] * ks[7]);
        *(u32x4*)(WT + (size_t)(drow0 + n) * ldd + k0 + 8 * c) = o; }
    WSYNC();
}
__device__ __forceinline__ void tr_item8(const float* W, int N, unsigned char* WT, int ldd, int drow0, int k0, int n0, float scale, LAS float* scr, int lane) {
#pragma unroll 8
    for (int i = 0; i < 32; ++i) { const int kk = 2 * i + (lane >> 5); scr[kk * 33 + (lane & 31)] = W[(size_t)(k0 + kk) * N + n0 + (lane & 31)]; }
    WSYNC();
    const int c = lane & 3;
#pragma unroll
    for (int j = 0; j < 2; ++j) { const int n = (lane >> 2) + 16 * j; const LAS float* s = scr + (16 * c) * 33 + n;
        u32x4 o;
        o.x = cvt4_fp8(s[0 * 33] * scale, s[1 * 33] * scale, s[2 * 33] * scale, s[3 * 33] * scale); o.y = cvt4_fp8(s[4 * 33] * scale, s[5 * 33] * scale, s[6 * 33] * scale, s[7 * 33] * scale);
        o.z = cvt4_fp8(s[8 * 33] * scale, s[9 * 33] * scale, s[10 * 33] * scale, s[11 * 33] * scale); o.w = cvt4_fp8(s[12 * 33] * scale, s[13 * 33] * scale, s[14 * 33] * scale, s[15 * 33] * scale);
        *(u32x4*)(WT + (size_t)(drow0 + n) * ldd + k0 + 16 * c) = o; }
    WSYNC();
}
template <int MAP>
__device__ __forceinline__ bool tr_job8(int& r, const float* W, int batch, int K, int N, unsigned char* dst, size_t dstride, int ldd, float scale, LAS float* scr, int lane) {
    const int nkb = K / 64, nnb = N / 32, per = nkb * nnb, total = per * batch;
    if (r >= total) { r -= total; return false; }
    const int bi = r / per, q = r % per, kb = q / nnb, nb = q % nnb, n0 = nb * 32;
    int drow0;
    if (MAP == 0) drow0 = n0; else drow0 = (n0 >> 7) * 256 + (n0 & 127) + (MAP == 3 ? 128 : 0);
    tr_item8(W + (size_t)bi * K * N, N, dst + (size_t)bi * dstride, ldd, drow0, kb * 64, n0, scale, scr, lane);
    return true;
}
__device__ __forceinline__ int win_map(int n) {
    if (n < 448) return n;
    if (n < 576) return C_CKV + (n - 448);
    if (n < 608) return C_KR + (n - 576);
    return C_HQ + (n - 608);
}
template <int MAP>
__device__ __forceinline__ bool tr_job(int& r, const float* W, int batch, int K, int N, bf16_t* dst, size_t dstride, int ldd, const float* kscale, int ksstride, LAS float* scr, int lane) {
    const int nkb = K / 64, nnb = N / 32, per = nkb * nnb, total = per * batch;
    if (r >= total) { r -= total; return false; }
    const int bi = r / per, q = r % per, kb = q / nnb, nb = q % nnb, n0 = nb * 32;
    int drow0;
    if (MAP == 0) drow0 = n0; else if (MAP == 1) drow0 = win_map(n0); else drow0 = (n0 >> 7) * 256 + (n0 & 127) + (MAP == 3 ? 128 : 0);
    tr_item(W + (size_t)bi * K * N, N, dst + (size_t)bi * dstride, ldd, drow0, kb * 64, n0, kscale ? kscale + bi * ksstride : nullptr, scr, lane);
    return true;
}
__device__ __forceinline__ void p0_prologue(const Frame& F) {
    LAS float* scr = (LAS float*)(F.lds + LDS_STAGE + F.wave * 16384);
    const int lane = F.lane;
    constexpr int NITEMS = 4 * 16 * 211 + 4 * 4 * 8 + 4 * 3 * 12 + 4 * 2 * 16 + 16 * 4 * 32 + 4 * 16 * 32 + 2 * 2 * 16 * 112 + 2 * 56 * 32 + 2 * 16 * 16 * 112 + 16 * 56 * 32 + 4 * 16 * 32 + 4 * 4 * 32;
    for (int it = F.gw; it < NITEMS; it += F.NGW) {
        int r = it;
        if (tr_job8<2>(r, IN_F(29), 16, 1024, DFF, WSP(unsigned char, WS_WMU), (size_t)7168 * 1024, 1024, 64.0f, scr, lane)) continue;
        if (tr_job8<3>(r, IN_F(30), 16, 1024, DFF, WSP(unsigned char, WS_WMU), (size_t)7168 * 1024, 1024, 64.0f, scr, lane)) continue;
        if (tr_job8<0>(r, IN_F(31), 16, DFF, 1024, WSP(unsigned char, WS_WMD), (size_t)1024 * DFF, DFF, 128.0f, scr, lane)) continue;
        if (tr_job<1>(r, IN_F(3), 4, 1024, 6752, WSP(bf16_t, WS_WIN), (size_t)HP * 1024, 1024, nullptr, 0, scr, lane)) continue;
        if (tr_job8<2>(r, IN_F(25), 2, 1024, DFF, WSP(unsigned char, WS_WFFU), (size_t)7168 * 1024, 1024, 64.0f, scr, lane)) continue;
        if (tr_job8<3>(r, IN_F(26), 2, 1024, DFF, WSP(unsigned char, WS_WFFU), (size_t)7168 * 1024, 1024, 64.0f, scr, lane)) continue;
        if (tr_job8<0>(r, IN_F(27), 2, DFF, 1024, WSP(unsigned char, WS_WFFD), (size_t)1024 * DFF, DFF, 128.0f, scr, lane)) continue;
        if (tr_job<0>(r, IN_F(21), 16, 256, 1024, WSP(bf16_t, WS_WB), (size_t)1024 * 256, 256, nullptr, 0, scr, lane)) continue;
        if (tr_job<0>(r, IN_F(22), 4, 1024, 1024, WSP(bf16_t, WS_WO), (size_t)1024 * 1024, 1024, nullptr, 0, scr, lane)) continue;
        if (tr_job<0>(r, IN_F(32), 4, 1024, 1024, WSP(bf16_t, WS_WPG), (size_t)1024 * 1024, 1024, nullptr, 0, scr, lane)) continue;
        if (tr_job<0>(r, IN_F(33), 4, 256, 1024, WSP(bf16_t, WS_WPP), (size_t)1024 * 256, 256, nullptr, 0, scr, lane)) continue;
        if (tr_job<0>(r, IN_F(12), 4, 256, 256, WSP(bf16_t, WS_WGLU), (size_t)256 * 256, 256, nullptr, 0, scr, lane)) continue;
        if (tr_job<0>(r, IN_F(15), 4, 192, 384, WSP(bf16_t, WS_WUQ), (size_t)512 * 256, 256, IN_F(13), 192, scr, lane)) continue;
        tr_job<0>(r, IN_F(16), 4, 128, 512, WSP(bf16_t, WS_WUKV), (size_t)512 * 256, 256, IN_F(14), 128, scr, lane);
    }
    const int gt = F.bid * 512 + F.tid, NT_ = F.G * 512;
    { bf16_t* uq = WSP(bf16_t, WS_WUQ); bf16_t* ukv = WSP(bf16_t, WS_WUKV);
      for (int i = gt; i < 4 * 512 * 256; i += NT_) { const int n = (i >> 8) & 511, k = i & 255; if (n >= 384 || k >= 192) uq[i] = 0; if (k >= 128) ukv[i] = 0; }
      bf16_t* win = WSP(bf16_t, WS_WIN);
      for (int i = gt; i < 4 * 160 * 1024; i += NT_) { const int l = i / (160 * 1024), q = i % (160 * 1024), rr = q >> 10, k = q & 1023; const int row = rr < 64 ? 448 + rr : 672 + (rr - 64); win[((size_t)l * HP + row) * 1024 + k] = 0; } }
    { const f32x4* x4 = (const f32x4*)IN_F(0); u32x2* xb = WSP(u32x2, WS_XB);
      for (int i = gt; i < T * D / 4; i += NT_) { const f32x4 v = x4[i]; u32x2 w; w.x = cvt_pk_bf16(v[0], v[1]); w.y = cvt_pk_bf16(v[2], v[3]); xb[i] = w; }
      const f32x4* p4 = (const f32x4*)IN_F(1); u32x2* pb = WSP(u32x2, WS_PB);
      for (int i = gt; i < DEPTH * T * 256 / 4; i += NT_) { const f32x4 v = p4[i]; u32x2 w; w.x = cvt_pk_bf16(v[0], v[1]); w.y = cvt_pk_bf16(v[2], v[3]); pb[i] = w; } }
    { const int* pos = (const int*)F.in[2]; float* rm = WSP(float, WS_ROPEM); float* rr = WSP(float, WS_ROPER);
      for (int i = gt; i < T * 48; i += NT_) { const int t = i / 48, j = i % 48; const bool isM = j < 16; const int jj = isM ? j : j - 16; const float half = isM ? 16.f : 32.f;
          const float inv = exp2f(-(float)jj / half * 13.287712379549449f);
          const float ang = (float)pos[t] * inv;
          const double ad = (double)ang, k2 = __builtin_rint(ad * 0.15915494309189535); const float red = (float)(ad - k2 * 6.283185307179586);
          const float c = __cosf(red), s = __sinf(red);
          if (isM) { rm[t * 32 + jj] = c; rm[t * 32 + 16 + jj] = s; } else { rr[t * 64 + jj] = c; rr[t * 64 + 32 + jj] = s; } } }
    { float* abar = (float*)(F.ws + WS_S5P + S5P_ABAR); bf16_t* Bm = (bf16_t*)(F.ws + WS_S5P + S5P_BM); bf16_t* Cm = (bf16_t*)(F.ws + WS_S5P + S5P_CM);
      for (int i = gt; i < DEPTH * 16 * 64; i += NT_) { const int lg = i >> 6, p = i & 63;
          const float dt = __expf(IN_F(6)[lg]), lr = IN_F(4)[i], li = IN_F(5)[i];
          const float mag = __expf(lr * dt); const double ad = (double)(li * dt), k2 = __builtin_rint(ad * 0.15915494309189535); const float red = (float)(ad - k2 * 6.283185307179586);
          const float are = mag * __cosf(red), aim = mag * __sinf(red);
          abar[i * 2] = are; abar[i * 2 + 1] = aim;
          const float den = lr * lr + li * li, nre = are - 1.0f, nim = aim;
          const float cre = (nre * lr + nim * li) / den, cim = (nim * lr - nre * li) / den;
          const float* br = IN_F(7) + (size_t)i * 16; const float* bi = IN_F(8) + (size_t)i * 16;
#pragma unroll
          for (int c = 0; c < 16; ++c) { Bm[((size_t)lg * 128 + p) * 16 + c] = f2bf(cre * br[c] - cim * bi[c]); Bm[((size_t)lg * 128 + 64 + p) * 16 + c] = f2bf(cre * bi[c] + cim * br[c]); }
#pragma unroll
          for (int c = 0; c < 16; ++c) { Cm[((size_t)lg * 16 + c) * 128 + p] = f2bf(IN_F(9)[((size_t)lg * 16 + c) * 64 + p]); Cm[((size_t)lg * 16 + c) * 128 + 64 + p] = f2bf(-IN_F(10)[((size_t)lg * 16 + c) * 64 + p]); } }
      float* lb = (float*)(F.ws + WS_S5P + S5P_LB);
      for (int i = gt; i < 256; i += NT_) { float r0 = IN_F(17)[i], r1 = IN_F(17)[256 + i], r2 = IN_F(17)[512 + i], r3 = IN_F(17)[768 + i]; const float mx = fmaxf(fmaxf(r0, r1), fmaxf(r2, r3));
          const float e0 = __expf(r0 - mx), e1 = __expf(r1 - mx), e2 = __expf(r2 - mx), e3 = __expf(r3 - mx), s = e0 + e1 + e2 + e3;
          lb[i] = 0.f; lb[256 + i] = e1 / s; lb[512 + i] = (e1 + e2) / s; lb[768 + i] = (e1 + e2 + e3) / s; } }
}

template <bool OUT>
__device__ __forceinline__ void s5_item(const Frame& F, int layer, int idx, LAS unsigned char* scr) {
    const int lane = F.lane + vzero(), r16 = lane & 15, g4 = lane >> 4;
    const int bg = idx >> 5, n = idx & 31, b = bg >> 4, g = bg & 15;
    LAS float* bu = (LAS float*)scr;
    LAS bf16_t* xs = (LAS bf16_t*)(scr + 8448);
    const float* abar = (const float*)(F.ws + WS_S5P + S5P_ABAR) + ((size_t)(layer * 16 + g) * 64 + lane) * 2;
    const float ar = abar[0], ai = abar[1];
    const bf16_t* Bm = (const bf16_t*)(F.ws + WS_S5P + S5P_BM) + (size_t)(layer * 16 + g) * 128 * 16;
    const bf16_t* Cm = (const bf16_t*)(F.ws + WS_S5P + S5P_CM) + (size_t)(layer * 16 + g) * 16 * 128;
    const bf16_t* H = WSP(const bf16_t, WS_H);
    Frag zf; zf.q = (u32x4){0u, 0u, 0u, 0u};
    bf16x8 bfr[8];
#pragma unroll
    for (int nb = 0; nb < 8; ++nb) bfr[nb] = (g4 < 2) ? *(const bf16x8*)(Bm + (nb * 16 + r16) * 16 + 8 * g4) : zf.v;
    bf16x8 cfr[4];
    if (OUT) {
#pragma unroll
        for (int ks = 0; ks < 4; ++ks) cfr[ks] = *(const bf16x8*)(Cm + r16 * 128 + 32 * ks + 8 * g4); }
    float xr = 0.f, xi = 0.f;
    if (OUT) { const float* ci = WSP(const float, WS_S5C) + ((size_t)(bg * 32 + n) * 64 + lane) * 2; xr = ci[0]; xi = ci[1]; }
    const float dsk = OUT ? IN_F(11)[layer * 256 + g * 16 + r16] : 0.f;
    const size_t tok0 = (size_t)b * SEQ + n * 64;
    bf16x8 afr_n = (g4 < 2) ? *(const bf16x8*)(H + (tok0 + r16) * HP + C_US5 + g * 16 + 8 * g4) : zf.v;
    bf16_t un[4] = {0, 0, 0, 0};
    if (OUT) {
#pragma unroll
        for (int r = 0; r < 4; ++r) un[r] = H[(tok0 + 4 * g4 + r) * HP + C_US5 + g * 16 + r16]; }
#pragma unroll 1
    for (int sub = 0; sub < 4; ++sub) {
        const size_t t0 = tok0 + sub * 16;
        const bf16x8 afr = afr_n; bf16_t uc[4];
#pragma unroll
        for (int r = 0; r < 4; ++r) uc[r] = un[r];
        if (sub < 3) { afr_n = (g4 < 2) ? *(const bf16x8*)(H + (t0 + 16 + r16) * HP + C_US5 + g * 16 + 8 * g4) : zf.v;
            if (OUT) {
#pragma unroll
                for (int r = 0; r < 4; ++r) un[r] = H[(t0 + 16 + 4 * g4 + r) * HP + C_US5 + g * 16 + r16]; } }
#pragma unroll
        for (int nb = 0; nb < 8; ++nb) { const f32x4 c = mfma16(afr, bfr[nb], (f32x4){0.f, 0.f, 0.f, 0.f});
#pragma unroll
            for (int r = 0; r < 4; ++r) bu[(4 * g4 + r) * 132 + nb * 16 + r16] = c[r]; }
        WSYNC();
#pragma unroll
        for (int tk = 0; tk < 16; ++tk) { const float bre = bu[tk * 132 + lane], bim = bu[tk * 132 + 64 + lane];
            const float nr = ar * xr - ai * xi + bre, ni = ar * xi + ai * xr + bim; xr = nr; xi = ni;
            if (OUT) { xs[tk * 136 + lane] = f2bf(xr); xs[tk * 136 + 64 + lane] = f2bf(xi); } }
        if (OUT) {
            WSYNC();
            f32x4 y = (f32x4){0.f, 0.f, 0.f, 0.f};
#pragma unroll
            for (int ks = 0; ks < 4; ++ks) { const bf16x8 a = *(const LAS bf16x8*)(xs + r16 * 136 + 32 * ks + 8 * g4); y = mfma16(a, cfr[ks], y); }
            bf16_t* pre = WSP(bf16_t, WS_S5PRE);
#pragma unroll
            for (int r = 0; r < 4; ++r) { const size_t t = t0 + 4 * g4 + r; pre[t * 256 + g * 16 + r16] = f2bf(gelu_tanh(y[r] + dsk * bf2f(uc[r]))); }
        }
        WSYNC();
    }
    if (!OUT) { float* e = WSP(float, WS_S5E) + ((size_t)(bg * 32 + n) * 64 + lane) * 2; e[0] = xr; e[1] = xi; }
}
__device__ __forceinline__ void s5_carry(const Frame& F, int layer) {
    const int gt = F.bid * 512 + F.tid;
    if (gt >= NBATCH * 16 * 64) return;
    const int bg = gt >> 6, p = gt & 63, g = bg & 15;
    const float* abar = (const float*)(F.ws + WS_S5P + S5P_ABAR) + ((size_t)(layer * 16 + g) * 64 + p) * 2;
    float pr = abar[0], pi = abar[1];
#pragma unroll
    for (int i = 0; i < 6; ++i) { const float nr = pr * pr - pi * pi, ni = 2.f * pr * pi; pr = nr; pi = ni; }
    const float* E = WSP(const float, WS_S5E); float* C = WSP(float, WS_S5C);
    float er[32], ei[32];
#pragma unroll
    for (int n = 0; n < 32; ++n) { const size_t o = ((size_t)(bg * 32 + n) * 64 + p) * 2; er[n] = E[o]; ei[n] = E[o + 1]; }
    float cr = 0.f, ci = 0.f;
#pragma unroll
    for (int n = 0; n < 32; ++n) { const float nr = pr * cr - pi * ci + er[n], ni = pr * ci + pi * cr + ei[n]; er[n] = cr; ei[n] = ci; cr = nr; ci = ni; }
#pragma unroll
    for (int n = 0; n < 32; ++n) { const size_t o = ((size_t)(bg * 32 + n) * 64 + p) * 2; C[o] = er[n]; C[o + 1] = ei[n]; }
}

template <bool OUT>
__device__ __forceinline__ void hg_item(const Frame& F, int layer, int idx, LAS unsigned char* scr) {
    const int lane = F.lane + vzero(), r16 = lane & 15, g4 = lane >> 4;
    const int bh = idx >> 5, sc = idx & 31, b = bh >> 2, h = bh & 3;
    LAS bf16_t* Qt = (LAS bf16_t*)scr;
    LAS bf16_t* Kt = (LAS bf16_t*)(scr + 2304);
    LAS bf16_t* Vs = (LAS bf16_t*)(scr + 4608);
    LAS float* dec = (LAS float*)(scr + 6656);
    const bf16_t* H = WSP(const bf16_t, WS_H);
    const float lbv = ((const float*)(F.ws + WS_S5P + S5P_LB))[layer * 256 + h * 64 + lane], oml = 1.0f - lbv;
    f32x4 S[4][4];
    if (OUT) { const float* si = WSP(const float, WS_HGI) + (size_t)(bh * 32 + sc) * 4096;
#pragma unroll
        for (int mb = 0; mb < 4; ++mb)
#pragma unroll
            for (int vb = 0; vb < 4; ++vb)
#pragma unroll
                for (int r = 0; r < 4; ++r) S[mb][vb][r] = si[(16 * mb + 4 * g4 + r) * 64 + 16 * vb + r16];
    } else {
#pragma unroll
        for (int mb = 0; mb < 4; ++mb)
#pragma unroll
            for (int vb = 0; vb < 4; ++vb) S[mb][vb] = (f32x4){0.f, 0.f, 0.f, 0.f};
    }
    float ltot = 0.f;
    const size_t tbase = (size_t)b * SEQ + sc * 64;
    unsigned rf[8], ri[8], rq[8]; u32x2 rg[4];
#define HG_LOAD(t0_) do { _Pragma("unroll") for (int p = 0; p < 8; ++p) { const bf16_t* r0 = H + ((t0_) + 2 * p) * HP + h * 64 + lane; const bf16_t* r1 = r0 + HP; \
            rf[p] = (unsigned)r0[C_HF] | ((unsigned)r1[C_HF] << 16); ri[p] = (unsigned)r0[C_HI] | ((unsigned)r1[C_HI] << 16); if (OUT) rq[p] = (unsigned)r0[C_HQ] | ((unsigned)r1[C_HQ] << 16); } \
        if (OUT) { _Pragma("unroll") for (int vb = 0; vb < 4; ++vb) rg[vb] = *(const u32x2*)(H + ((t0_) + r16) * HP + C_HG + h * 64 + 16 * vb + 4 * g4); } } while (0)
    HG_LOAD(tbase);
#pragma unroll 1
    for (int ch = 0; ch < 4; ++ch) {
        const size_t t0 = tbase + ch * 16;
        float bcum = 0.f;
#pragma unroll
        for (int tk = 0; tk < 16; ++tk) { const unsigned wf = rf[tk >> 1], wi = ri[tk >> 1];
            const float fv = (tk & 1) ? __uint_as_float(wf & 0xffff0000u) : __uint_as_float(wf << 16);
            const float sg = 1.0f / (1.0f + __expf(-fv)); const float forget = lbv + oml * sg; bcum += __logf(forget);
            const float kv_ = oml * (1.0f - sg), e = __expf(fmaxf(bcum, -80.0f));
            Kt[tk * 72 + lane] = f2bf(kv_ * __builtin_amdgcn_rcpf(e));
            if (OUT) { const unsigned wq = rq[tk >> 1]; const float qv = (tk & 1) ? __uint_as_float(wq & 0xffff0000u) : __uint_as_float(wq << 16); Qt[tk * 72 + lane] = f2bf(siluf_(qv) * e); }
            Vs[tk * 64 + lane] = (bf16_t)((tk & 1) ? (wi >> 16) : (wi & 0xffffu)); }
        dec[lane] = __expf(bcum); ltot += bcum;
        u32x2 gcur[4];
        if (OUT) {
#pragma unroll
            for (int vb = 0; vb < 4; ++vb) gcur[vb] = rg[vb]; }
        if (ch < 3) HG_LOAD(t0 + 16);
        WSYNC();
        Frag vfr[4], kfr[4];
#pragma unroll
        for (int vb = 0; vb < 4; ++vb) { vfr[vb].q = (u32x4){0u, 0u, 0u, 0u};
#pragma unroll
            for (int j = 0; j < 4; ++j) vfr[vb].h[j] = Vs[(4 * g4 + j) * 64 + 16 * vb + r16]; }
#pragma unroll
        for (int mb = 0; mb < 4; ++mb) { kfr[mb].q = (u32x4){0u, 0u, 0u, 0u};
#pragma unroll
            for (int j = 0; j < 4; ++j) kfr[mb].h[j] = Kt[(4 * g4 + j) * 72 + 16 * mb + r16]; }
        if (OUT) {
            f32x4 at = (f32x4){0.f, 0.f, 0.f, 0.f};
#pragma unroll
            for (int ks = 0; ks < 2; ++ks) { const bf16x8 a = *(const LAS bf16x8*)(Kt + r16 * 72 + 32 * ks + 8 * g4), bq = *(const LAS bf16x8*)(Qt + r16 * 72 + 32 * ks + 8 * g4); at = mfma16(a, bq, at); }
#pragma unroll
            for (int r = 0; r < 4; ++r) if (4 * g4 + r > r16) at[r] = 0.f;
            Frag pfr; pfr.q = (u32x4){0u, 0u, 0u, 0u}; pfr.u[0] = cvt_pk_bf16(at[0], at[1]); pfr.u[1] = cvt_pk_bf16(at[2], at[3]);
            Frag qfr[2];
#pragma unroll
            for (int ks = 0; ks < 2; ++ks) { qfr[ks].d[0] = *(const LAS u32x2*)(Qt + r16 * 72 + 32 * ks + 4 * g4); qfr[ks].d[1] = *(const LAS u32x2*)(Qt + r16 * 72 + 32 * ks + 16 + 4 * g4); }
            f32x4 o[4]; float ss = 0.f;
#pragma unroll
            for (int vb = 0; vb < 4; ++vb) { f32x4 a = (f32x4){0.f, 0.f, 0.f, 0.f};
#pragma unroll
                for (int ks = 0; ks < 2; ++ks) { Frag sf; sf.u[0] = cvt_pk_bf16(S[2 * ks][vb][0], S[2 * ks][vb][1]); sf.u[1] = cvt_pk_bf16(S[2 * ks][vb][2], S[2 * ks][vb][3]);
                    sf.u[2] = cvt_pk_bf16(S[2 * ks + 1][vb][0], S[2 * ks + 1][vb][1]); sf.u[3] = cvt_pk_bf16(S[2 * ks + 1][vb][2], S[2 * ks + 1][vb][3]); a = mfma16(sf.v, qfr[ks].v, a); }
                a = mfma16(vfr[vb].v, pfr.v, a); o[vb] = a; ss += a[0] * a[0] + a[1] * a[1] + a[2] * a[2] + a[3] * a[3]; }
            ss += __shfl_xor(ss, 16); ss += __shfl_xor(ss, 32);
            const float rs = rsqrtf(ss * (1.0f / 64.0f) + EPS);
            const size_t t = t0 + r16; bf16_t* Y = WSP(bf16_t, WS_Y);
#pragma unroll
            for (int vb = 0; vb < 4; ++vb) { const int vi0 = h * 64 + 16 * vb + 4 * g4; const u32x2 gv = gcur[vb]; const f32x4 ng = *(const f32x4*)(IN_F(18) + layer * 256 + vi0);
                const float g0 = __uint_as_float(gv.x << 16), g1 = __uint_as_float(gv.x & 0xffff0000u), g2 = __uint_as_float(gv.y << 16), g3 = __uint_as_float(gv.y & 0xffff0000u);
                u32x2 w; w.x = cvt_pk_bf16(o[vb][0] * rs * ng[0] * siluf_(g0), o[vb][1] * rs * ng[1] * siluf_(g1)); w.y = cvt_pk_bf16(o[vb][2] * rs * ng[2] * siluf_(g2), o[vb][3] * rs * ng[3] * siluf_(g3));
                *(u32x2*)(Y + t * 1024 + 512 + vi0) = w; }
        }
#pragma unroll
        for (int mb = 0; mb < 4; ++mb) { const f32x4 dv = *(const LAS f32x4*)(dec + 16 * mb + 4 * g4);
#pragma unroll
            for (int vb = 0; vb < 4; ++vb) S[mb][vb] = mfma16(kfr[mb].v, vfr[vb].v, S[mb][vb]) * dv; }
        WSYNC();
    }
#undef HG_LOAD
    if (!OUT) { float* se = WSP(float, WS_HGE) + (size_t)(bh * 32 + sc) * 4096;
#pragma unroll
        for (int mb = 0; mb < 4; ++mb)
#pragma unroll
            for (int vb = 0; vb < 4; ++vb)
#pragma unroll
                for (int r = 0; r < 4; ++r) se[(16 * mb + 4 * g4 + r) * 64 + 16 * vb + r16] = S[mb][vb][r];
        WSP(float, WS_HGD)[(size_t)(bh * 32 + sc) * 64 + lane] = __expf(ltot); }
}
__device__ __forceinline__ void hg_carry(const Frame& F) {
    const int gt = F.bid * 512 + F.tid; if (gt >= 32 * 4096) return;
    const int bh = gt >> 12, kv = gt & 4095, k = kv >> 6;
    const float* E = WSP(const float, WS_HGE); const float* Dt = WSP(const float, WS_HGD); float* I = WSP(float, WS_HGI);
    float e[32], d[32];
#pragma unroll
    for (int sc = 0; sc < 32; ++sc) { e[sc] = E[(size_t)(bh * 32 + sc) * 4096 + kv]; d[sc] = Dt[(size_t)(bh * 32 + sc) * 64 + k]; }
    float s = 0.f;
#pragma unroll
    for (int sc = 0; sc < 32; ++sc) { const float nx = d[sc] * s + e[sc]; e[sc] = s; s = nx; }
#pragma unroll
    for (int sc = 0; sc < 32; ++sc) I[(size_t)(bh * 32 + sc) * 4096 + kv] = e[sc];
}

__device__ __forceinline__ float ret_l2g(int h) { return __log2f(1.0f - exp2f(-5.0f - (float)h)); }
__device__ __forceinline__ void ret_item1(const Frame& F, int idx, LAS unsigned char* scr) {
    const int lane = F.lane + vzero(), r16 = lane & 15, g4 = lane >> 4;
    const int bh = idx >> 5, n = idx & 31, b = bh >> 2, h = bh & 3;
    LAS bf16_t* Kd = (LAS bf16_t*)scr;
    LAS bf16_t* Vs = (LAS bf16_t*)(scr + 8192);
    const bf16_t* H = WSP(const bf16_t, WS_H); const float* rope = WSP(const float, WS_ROPER);
    bf16_t* QR = WSP(bf16_t, WS_QR); bf16_t* KR = WSP(bf16_t, WS_KR);
    const float l2g = ret_l2g(h);
    const size_t t0 = (size_t)b * SEQ + n * 64;
#pragma unroll 1
    for (int tb = 0; tb < 4; ++tb) {
        bf16_t kx[16], qx[16], vx[16]; float cs[16], sn[16];
#pragma unroll
        for (int j = 0; j < 16; ++j) { const size_t t = t0 + tb * 16 + j; const bf16_t* row = H + t * HP + h * 64 + lane; kx[j] = row[C_RK]; qx[j] = row[C_RQ]; vx[j] = row[C_RV]; cs[j] = rope[t * 64 + (lane & 31)]; sn[j] = rope[t * 64 + 32 + (lane & 31)]; }
#pragma unroll
        for (int j = 0; j < 16; ++j) { const int tk = tb * 16 + j; const size_t t = t0 + tk;
            const float kf_ = bf2f(kx[j]), qf_ = bf2f(qx[j]); const float kp = __shfl_xor(kf_, 32), qp = __shfl_xor(qf_, 32);
            const float kh = lane < 32 ? kf_ * cs[j] - kp * sn[j] : kf_ * cs[j] + kp * sn[j], qh = (lane < 32 ? qf_ * cs[j] - qp * sn[j] : qf_ * cs[j] + qp * sn[j]) * 0.125f;
            KR[t * 256 + h * 64 + lane] = f2bf(kh); QR[t * 256 + h * 64 + lane] = f2bf(qh);
            Kd[tk * 64 + lane] = f2bf(kh * exp2f((float)(63 - tk) * l2g)); Vs[tk * 64 + lane] = vx[j]; }
    }
    WSYNC();
    Frag vfr[4][2];
#pragma unroll
    for (int vb = 0; vb < 4; ++vb)
#pragma unroll
        for (int ks = 0; ks < 2; ++ks)
#pragma unroll
            for (int j = 0; j < 8; ++j) vfr[vb][ks].h[j] = Vs[(32 * ks + 8 * g4 + j) * 64 + 16 * vb + r16];
    float* E = WSP(float, WS_RTE) + (size_t)(bh * 32 + n) * 4096;
#pragma unroll
    for (int mb = 0; mb < 4; ++mb) { Frag kf[2];
#pragma unroll
        for (int ks = 0; ks < 2; ++ks)
#pragma unroll
            for (int j = 0; j < 8; ++j) kf[ks].h[j] = Kd[(32 * ks + 8 * g4 + j) * 64 + 16 * mb + r16];
#pragma unroll
        for (int vb = 0; vb < 4; ++vb) { f32x4 a = (f32x4){0.f, 0.f, 0.f, 0.f};
#pragma unroll
            for (int ks = 0; ks < 2; ++ks) a = mfma16(kf[ks].v, vfr[vb][ks].v, a);
            *(f32x4*)(E + (16 * vb + r16) * 64 + 16 * mb + 4 * g4) = a; } }
    WSYNC();
}
__device__ __forceinline__ void ret_carry(const Frame& F) {
    const int gt = F.bid * 512 + F.tid; if (gt >= 32 * 4096) return;
    const int bh = gt >> 12, vk = gt & 4095, h = bh & 3;
    const float g64 = exp2f(64.0f * ret_l2g(h));
    const float* E = WSP(const float, WS_RTE); float* I = WSP(float, WS_RTI);
    float e[32];
#pragma unroll
    for (int n = 0; n < 32; ++n) e[n] = E[(size_t)(bh * 32 + n) * 4096 + vk];
    float s = 0.f;
#pragma unroll
    for (int n = 0; n < 32; ++n) { const float nx = g64 * s + e[n]; e[n] = s; s = nx; }
#pragma unroll
    for (int n = 0; n < 32; ++n) I[(size_t)(bh * 32 + n) * 4096 + vk] = e[n];
}
__device__ __forceinline__ void ret_item3(const Frame& F, int layer, int idx, LAS unsigned char* scr) {
    const int lane = F.lane + vzero(), r16 = lane & 15, g4 = lane >> 4;
    const int bh = idx >> 5, n = idx & 31, b = bh >> 2, h = bh & 3;
    LAS bf16_t* Vs = (LAS bf16_t*)scr;
    const bf16_t* H = WSP(const bf16_t, WS_H); const bf16_t* QR = WSP(const bf16_t, WS_QR); const bf16_t* KR = WSP(const bf16_t, WS_KR);
    const float l2g = ret_l2g(h);
    const size_t t0 = (size_t)b * SEQ + n * 64;
#pragma unroll
    for (int tk = 0; tk < 64; ++tk) Vs[tk * 64 + lane] = H[(t0 + tk) * HP + C_RV + h * 64 + lane];
    Frag sfr[4][2];
    { const float* si = WSP(const float, WS_RTI) + (size_t)(bh * 32 + n) * 4096;
#pragma unroll
      for (int vb = 0; vb < 4; ++vb)
#pragma unroll
        for (int ks = 0; ks < 2; ++ks) { const f32x4 a = *(const f32x4*)(si + (16 * vb + r16) * 64 + 32 * ks + 8 * g4), c = *(const f32x4*)(si + (16 * vb + r16) * 64 + 32 * ks + 8 * g4 + 4);
            sfr[vb][ks].u[0] = cvt_pk_bf16(a[0], a[1]); sfr[vb][ks].u[1] = cvt_pk_bf16(a[2], a[3]); sfr[vb][ks].u[2] = cvt_pk_bf16(c[0], c[1]); sfr[vb][ks].u[3] = cvt_pk_bf16(c[2], c[3]); } }
    bf16_t* Y = WSP(bf16_t, WS_Y);
    bf16x8 kfa[4][2], qfa[4][2]; u32x2 gva[4][4];
#pragma unroll
    for (int sb = 0; sb < 4; ++sb)
#pragma unroll
        for (int ks = 0; ks < 2; ++ks) { kfa[sb][ks] = *(const bf16x8*)(KR + (t0 + 16 * sb + r16) * 256 + h * 64 + 32 * ks + 8 * g4); qfa[sb][ks] = *(const bf16x8*)(QR + (t0 + 16 * sb + r16) * 256 + h * 64 + 32 * ks + 8 * g4); }
#pragma unroll
    for (int tb = 0; tb < 4; ++tb)
#pragma unroll
        for (int vb = 0; vb < 4; ++vb) gva[tb][vb] = *(const u32x2*)(H + (t0 + 16 * tb + r16) * HP + C_RG + h * 64 + 16 * vb + 4 * g4);
    WSYNC();
    Frag vfr[4][2];
#pragma unroll
    for (int vb = 0; vb < 4; ++vb)
#pragma unroll
        for (int ks = 0; ks < 2; ++ks)
#pragma unroll
            for (int j = 0; j < 8; ++j) vfr[vb][ks].h[j] = Vs[(32 * ks + 16 * (j >> 2) + 4 * g4 + (j & 3)) * 64 + 16 * vb + r16];
#pragma unroll
    for (int tb = 0; tb < 4; ++tb) {
        const int tl = 16 * tb + r16; const size_t t = t0 + tl;
        Frag pfr[2]; pfr[0].q = (u32x4){0u, 0u, 0u, 0u}; pfr[1].q = (u32x4){0u, 0u, 0u, 0u};
#pragma unroll
        for (int sb = 0; sb < 4; ++sb) { if (sb > tb) continue;
            f32x4 sc = (f32x4){0.f, 0.f, 0.f, 0.f};
#pragma unroll
            for (int ks = 0; ks < 2; ++ks) sc = mfma16(kfa[sb][ks], qfa[tb][ks], sc);
#pragma unroll
            for (int r = 0; r < 4; ++r) { const int rel = tl - (16 * sb + 4 * g4 + r); sc[r] = rel >= 0 ? sc[r] * exp2f((float)rel * l2g) : 0.f; }
            pfr[sb >> 1].u[(sb & 1) * 2] = cvt_pk_bf16(sc[0], sc[1]); pfr[sb >> 1].u[(sb & 1) * 2 + 1] = cvt_pk_bf16(sc[2], sc[3]); }
        const float qd = exp2f((float)(tl + 1) * l2g);
        f32x4 o[4]; float s1 = 0.f;
#pragma unroll
        for (int vb = 0; vb < 4; ++vb) { f32x4 a = (f32x4){0.f, 0.f, 0.f, 0.f};
#pragma unroll
            for (int ks = 0; ks < 2; ++ks) a = mfma16(sfr[vb][ks].v, qfa[tb][ks], a);
            a = a * qd;
            a = mfma16(vfr[vb][0].v, pfr[0].v, a);
            if (tb >= 2) a = mfma16(vfr[vb][1].v, pfr[1].v, a);
            o[vb] = a; s1 += (a[0] + a[1]) + (a[2] + a[3]); }
        s1 += __shfl_xor(s1, 16); s1 += __shfl_xor(s1, 32);
        const float mean = s1 * (1.0f / 64.0f); float s2 = 0.f;
#pragma unroll
        for (int vb = 0; vb < 4; ++vb) { const f32x4 d = o[vb] - mean; s2 += d[0] * d[0] + d[1] * d[1] + d[2] * d[2] + d[3] * d[3]; }
        s2 += __shfl_xor(s2, 16); s2 += __shfl_xor(s2, 32);
        const float rstd = rsqrtf(s2 * (1.0f / 64.0f) + EPS);
#pragma unroll
        for (int vb = 0; vb < 4; ++vb) { const int vi0 = h * 64 + 16 * vb + 4 * g4; const u32x2 gv = gva[tb][vb];
            const f32x4 gg = *(const f32x4*)(IN_F(19) + layer * 256 + vi0), gb = *(const f32x4*)(IN_F(20) + layer * 256 + vi0);
            const float g0 = __uint_as_float(gv.x << 16), g1 = __uint_as_float(gv.x & 0xffff0000u), g2 = __uint_as_float(gv.y << 16), g3 = __uint_as_float(gv.y & 0xffff0000u);
            u32x2 w; w.x = cvt_pk_bf16(((o[vb][0] - mean) * rstd * gg[0] + gb[0]) * siluf_(g0), ((o[vb][1] - mean) * rstd * gg[1] + gb[1]) * siluf_(g1));
            w.y = cvt_pk_bf16(((o[vb][2] - mean) * rstd * gg[2] + gb[2]) * siluf_(g2), ((o[vb][3] - mean) * rstd * gg[3] + gb[3]) * siluf_(g3));
            *(u32x2*)(Y + t * 1024 + 768 + vi0) = w; }
    }
    WSYNC();
}

__device__ __forceinline__ void attn_unit(const Frame& F, int bh, int qt) {
    const int vz = vzero(); const int lane = F.lane + vz, r16 = lane & 15, g4 = lane >> 4, w = F.wave, tid = F.tid + vz;
    LAS bf16_t* Kt = (LAS bf16_t*)(F.lds + LDS_STAGE);
    LAS bf16_t* Vl = (LAS bf16_t*)(F.lds + LDS_STAGE + 13312);
    const bf16_t* Qb = WSP(const bf16_t, WS_Q) + (size_t)bh * SEQ * 96; const bf16_t* Kb = WSP(const bf16_t, WS_K) + (size_t)bh * SEQ * 96; const bf16_t* Vt = WSP(const bf16_t, WS_VT) + (size_t)bh * 64 * SEQ;
    const int q0 = qt * 128, qrow = q0 + 16 * w + r16;
    bf16x8 qfr[3];
#pragma unroll
    for (int ks = 0; ks < 3; ++ks) qfr[ks] = *(const bf16x8*)(Qb + (size_t)qrow * 96 + 32 * ks + 8 * g4);
    float mrun = -1e30f, lrun = 0.f;
    f32x4 O[4];
#pragma unroll
    for (int db = 0; db < 4; ++db) O[db] = (f32x4){0.f, 0.f, 0.f, 0.f};
    const int nkt = 2 * qt + 2;
    const int kkey0 = tid / 12, kpart0 = tid % 12, kkey1 = (tid + 512) / 12, kpart1 = (tid + 512) % 12; const bool k1 = tid < 256;
    const int vdv = tid >> 3, vpart = tid & 7;
    u32x4 rk0, rk1, rv;
    rk1 = (u32x4){0u, 0u, 0u, 0u};
    rk0 = *(const u32x4*)(Kb + (size_t)kkey0 * 96 + kpart0 * 8); if (k1) rk1 = *(const u32x4*)(Kb + (size_t)kkey1 * 96 + kpart1 * 8);
    rv = *(const u32x4*)(Vt + (size_t)vdv * SEQ + vpart * 8);
#pragma unroll 1
    for (int kt = 0; kt < nkt; ++kt) {
        __syncthreads();
        *(LAS u32x4*)(Kt + kkey0 * 104 + kpart0 * 8) = rk0; if (k1) *(LAS u32x4*)(Kt + kkey1 * 104 + kpart1 * 8) = rk1;
        *(LAS u32x4*)(Vl + vdv * 72 + vpart * 8) = rv;
        __syncthreads();
        if (kt + 1 < nkt) { const size_t kb = (size_t)(kt + 1) * 64;
            rk0 = *(const u32x4*)(Kb + (kb + kkey0) * 96 + kpart0 * 8); if (k1) rk1 = *(const u32x4*)(Kb + (kb + kkey1) * 96 + kpart1 * 8);
            rv = *(const u32x4*)(Vt + (size_t)vdv * SEQ + kb + vpart * 8); }
        f32x4 sc[4]; float mx = -1e30f;
#pragma unroll
        for (int kb = 0; kb < 4; ++kb) { f32x4 s = (f32x4){0.f, 0.f, 0.f, 0.f};
#pragma unroll
            for (int ks = 0; ks < 3; ++ks) { const bf16x8 a = *(const LAS bf16x8*)(Kt + (16 * kb + r16) * 104 + 32 * ks + 8 * g4); s = mfma16(a, qfr[ks], s); }
            if (kt >= 2 * qt) {
#pragma unroll
                for (int r = 0; r < 4; ++r) if (kt * 64 + 16 * kb + 4 * g4 + r > qrow) s[r] = -1e30f; }
            sc[kb] = s; mx = fmaxf(mx, fmaxf(fmaxf(s[0], s[1]), fmaxf(s[2], s[3]))); }
        mx = fmaxf(mx, __shfl_xor(mx, 16)); mx = fmaxf(mx, __shfl_xor(mx, 32));
        const float mnew = fmaxf(mrun, mx), alpha = exp2f(mrun - mnew); mrun = mnew;
        float ls = 0.f;
#pragma unroll
        for (int kb = 0; kb < 4; ++kb)
#pragma unroll
            for (int r = 0; r < 4; ++r) { const float p = exp2f(sc[kb][r] - mnew); sc[kb][r] = p; ls += p; }
        lrun = lrun * alpha + ls;
        Frag pf[2];
#pragma unroll
        for (int ks = 0; ks < 2; ++ks) { pf[ks].u[0] = cvt_pk_bf16(sc[2 * ks][0], sc[2 * ks][1]); pf[ks].u[1] = cvt_pk_bf16(sc[2 * ks][2], sc[2 * ks][3]); pf[ks].u[2] = cvt_pk_bf16(sc[2 * ks + 1][0], sc[2 * ks + 1][1]); pf[ks].u[3] = cvt_pk_bf16(sc[2 * ks + 1][2], sc[2 * ks + 1][3]); }
#pragma unroll
        for (int db = 0; db < 4; ++db) { f32x4 o = O[db] * alpha;
#pragma unroll
            for (int ks = 0; ks < 2; ++ks) { Frag vf; vf.d[0] = *(const LAS u32x2*)(Vl + (16 * db + r16) * 72 + 32 * ks + 4 * g4); vf.d[1] = *(const LAS u32x2*)(Vl + (16 * db + r16) * 72 + 32 * ks + 16 + 4 * g4); o = mfma16(vf.v, pf[ks].v, o); }
            O[db] = o; }
    }
    lrun += __shfl_xor(lrun, 16); lrun += __shfl_xor(lrun, 32);
    const float inv = 1.0f / lrun;
    const int b = bh >> 2, h = bh & 3; bf16_t* Y = WSP(bf16_t, WS_Y) + ((size_t)b * SEQ + qrow) * 1024 + 256 + h * 64;
#pragma unroll
    for (int db = 0; db < 4; ++db) { u32x2 wv; wv.x = cvt_pk_bf16(O[db][0] * inv, O[db][1] * inv); wv.y = cvt_pk_bf16(O[db][2] * inv, O[db][3] * inv); *(u32x2*)(Y + 16 * db + 4 * g4) = wv; }
}

__device__ __forceinline__ void ln_row_write(f32x4 (&v)[4], const float* g, const float* bta, float* of, bf16_t* ob, int lane, unsigned char* o8 = nullptr) {
    float s = 0.f;
#pragma unroll
    for (int j = 0; j < 4; ++j) s += (v[j][0] + v[j][1]) + (v[j][2] + v[j][3]);
    const float mean = wave_sum(s) * (1.0f / 1024.0f); float s2 = 0.f;
#pragma unroll
    for (int j = 0; j < 4; ++j) { v[j] = v[j] - mean; s2 += (v[j][0] * v[j][0] + v[j][1] * v[j][1]) + (v[j][2] * v[j][2] + v[j][3] * v[j][3]); }
    const float rstd = rsqrtf(wave_sum(s2) * (1.0f / 1024.0f) + EPS);
#pragma unroll
    for (int j = 0; j < 4; ++j) { const f32x4 gg = *(const f32x4*)(g + 4 * lane + 256 * j), bb = *(const f32x4*)(bta + 4 * lane + 256 * j); v[j] = v[j] * rstd * gg + bb;
        *(f32x4*)(of + 4 * lane + 256 * j) = v[j]; u32x2 w; w.x = cvt_pk_bf16(v[j][0], v[j][1]); w.y = cvt_pk_bf16(v[j][2], v[j][3]); *(u32x2*)(ob + 4 * lane + 256 * j) = w;
        if (o8) *(unsigned*)(o8 + 4 * lane + 256 * j) = cvt4_fp8(v[j][0], v[j][1], v[j][2], v[j][3]); }
}
template <bool MOE>
__device__ __forceinline__ void ln1_phase(const Frame& F, int layer) {
    const int lane = F.lane; bf16_t* XB = WSP(bf16_t, WS_XB);
    LAS int* lcnt = (LAS int*)(F.lds + LDS_MISC);
    LAS int* rinfo = (LAS int*)(F.lds + LDS_MISC + 64);
    LAS float* rw = (LAS float*)(F.lds + LDS_MISC + 64 + 4096);
    if (MOE) { if (F.tid < 16) lcnt[F.tid] = 0; __syncthreads(); }
    const int rows_per_blk = T / F.G;
    const float* wr_ = MOE ? IN_F(28) + (size_t)(layer >> 1) * 1024 * 8 : nullptr;
    f32x4 nv[4];
    if (F.wave < rows_per_blk) { const float* x0 = F.out + (size_t)(F.bid * rows_per_blk + F.wave) * 1024;
#pragma unroll
        for (int j = 0; j < 4; ++j) nv[j] = *(const f32x4*)(x0 + 4 * lane + 256 * j); }
    for (int lr = F.wave; lr < rows_per_blk; lr += 8) { const int t = F.bid * rows_per_blk + lr;
        float* xr = F.out + (size_t)t * 1024; f32x4 v[4];
#pragma unroll
        for (int j = 0; j < 4; ++j) v[j] = nv[j];
        if (lr + 8 < rows_per_blk) {
#pragma unroll
            for (int j = 0; j < 4; ++j) nv[j] = *(const f32x4*)(xr + 8 * 1024 + 4 * lane + 256 * j); }
        ln_row_write(v, IN_F(23) + layer * 1024, IN_F(24) + layer * 1024, xr, XB + (size_t)t * 1024, lane, WSP(unsigned char, WS_X8) + (size_t)t * 1024);
        if (MOE) {
            float lg[8];
#pragma unroll
            for (int e = 0; e < 8; ++e) lg[e] = 0.f;
#pragma unroll
            for (int j = 0; j < 4; ++j)
#pragma unroll
                for (int q = 0; q < 4; ++q) { const float xv = v[j][q]; const float* wrow = wr_ + (size_t)(4 * lane + 256 * j + q) * 8; const f32x4 w0 = *(const f32x4*)wrow, w1 = *(const f32x4*)(wrow + 4);
                    lg[0] += xv * w0[0]; lg[1] += xv * w0[1]; lg[2] += xv * w0[2]; lg[3] += xv * w0[3]; lg[4] += xv * w1[0]; lg[5] += xv * w1[1]; lg[6] += xv * w1[2]; lg[7] += xv * w1[3]; }
#pragma unroll
            for (int e = 0; e < 8; ++e) lg[e] = wave_sum(lg[e]);
            int e0 = 0; float v0 = lg[0];
#pragma unroll
            for (int e = 1; e < 8; ++e) if (lg[e] > v0) { v0 = lg[e]; e0 = e; }
            int e1 = -1; float v1 = -3.0e38f;
#pragma unroll
            for (int e = 0; e < 8; ++e) if (e != e0 && lg[e] > v1) { v1 = lg[e]; e1 = e; }
            if (lane == 0) { const float w0 = 1.0f / (1.0f + __expf(v1 - v0)); const int p0 = __hip_atomic_fetch_add(&lcnt[e0], 1, __ATOMIC_RELAXED, __HIP_MEMORY_SCOPE_WORKGROUP), p1 = __hip_atomic_fetch_add(&lcnt[e1], 1, __ATOMIC_RELAXED, __HIP_MEMORY_SCOPE_WORKGROUP);
                rinfo[lr * 4 + 0] = e0; rinfo[lr * 4 + 1] = e1; rinfo[lr * 4 + 2] = p0; rinfo[lr * 4 + 3] = p1; rw[lr * 2] = w0; rw[lr * 2 + 1] = 1.0f - w0; }
        }
    }
    if (MOE) {
        __syncthreads();
        unsigned* gcnt = WSP(unsigned, WS_CTL) + CW_MOE + (layer >> 1) * 64;
        if (F.tid < 8) lcnt[8 + F.tid] = (int)__hip_atomic_fetch_add(gcnt + F.tid, (unsigned)lcnt[F.tid], __ATOMIC_RELAXED, __HIP_MEMORY_SCOPE_AGENT);
        __syncthreads();
        int* te = (int*)(F.ws + WS_TOK + TOK_E); int* tp = (int*)(F.ws + WS_TOK + TOK_POS); float* tw = (float*)(F.ws + WS_TOK + TOK_W);
        for (int i = F.tid; i < rows_per_blk * 2; i += 512) { const int lr = i >> 1, k = i & 1, t = F.bid * rows_per_blk + lr; const int e = rinfo[lr * 4 + k];
            te[t * 2 + k] = e; tp[t * 2 + k] = lcnt[8 + e] + rinfo[lr * 4 + 2 + k]; tw[t * 2 + k] = rw[lr * 2 + k]; }
    }
}
struct MoeOff { int ts0, ts1, ts2, ts3, ts4, ts5, ts6, ts7, ts8; };
__device__ __forceinline__ MoeOff moe_offsets(const Frame& F, int layer, int* cnt_out  ) {
    const unsigned* gcnt = WSP(const unsigned, WS_CTL) + CW_MOE + (layer >> 1) * 64;
    MoeOff o; int c[8];
#pragma unroll
    for (int e = 0; e < 8; ++e) c[e] = (int)__hip_atomic_load(gcnt + e, __ATOMIC_RELAXED, __HIP_MEMORY_SCOPE_AGENT);
    o.ts0 = 0; o.ts1 = o.ts0 + ((c[0] + 255) >> 8); o.ts2 = o.ts1 + ((c[1] + 255) >> 8); o.ts3 = o.ts2 + ((c[2] + 255) >> 8); o.ts4 = o.ts3 + ((c[3] + 255) >> 8);
    o.ts5 = o.ts4 + ((c[4] + 255) >> 8); o.ts6 = o.ts5 + ((c[5] + 255) >> 8); o.ts7 = o.ts6 + ((c[6] + 255) >> 8); o.ts8 = o.ts7 + ((c[7] + 255) >> 8);
    if (cnt_out) {
#pragma unroll
        for (int e = 0; e < 8; ++e) cnt_out[e] = c[e]; }
    return o;
}
__device__ __forceinline__ int moe_ts(const MoeOff& o, int e) { return e == 0 ? o.ts0 : e == 1 ? o.ts1 : e == 2 ? o.ts2 : e == 3 ? o.ts3 : e == 4 ? o.ts4 : e == 5 ? o.ts5 : e == 6 ? o.ts6 : o.ts7; }
__device__ __forceinline__ void moe_gather(const Frame& F, int layer) {
    int cnt[8]; const MoeOff o = moe_offsets(F, layer, cnt);
    const int lane = F.lane; const unsigned char* X8 = WSP(const unsigned char, WS_X8); unsigned char* XG = WSP(unsigned char, WS_XG);
    const int* te = (const int*)(F.ws + WS_TOK + TOK_E); const int* tp = (const int*)(F.ws + WS_TOK + TOK_POS); int* tsl = (int*)(F.ws + WS_TOK + TOK_SLOT);
    for (int i0 = F.gw * 4; i0 < T * 2; i0 += F.NGW * 4) {
        int ee[4], pp[4]; u32x4 a[4];
#pragma unroll
        for (int q = 0; q < 4; ++q) { ee[q] = te[i0 + q]; pp[q] = tp[i0 + q]; a[q] = ((const u32x4*)(X8 + (size_t)((i0 + q) >> 1) * 1024))[lane]; }
#pragma unroll
        for (int q = 0; q < 4; ++q) { const int slot = moe_ts(o, ee[q]) * 256 + pp[q]; ((u32x4*)(XG + (size_t)slot * 1024))[lane] = a[q]; if (lane == 0) tsl[i0 + q] = slot; }
    }
    int npad_pre = 0;
#pragma unroll
    for (int e = 0; e < 8; ++e) { const int start = moe_ts(o, e) * 256 + cnt[e], end = (e == 7 ? o.ts8 : moe_ts(o, e + 1)) * 256, np = end - start;
        for (int i = F.gw; i < np; i += F.NGW) ((u32x4*)(XG + (size_t)(start + i) * 1024))[lane] = (u32x4){0u, 0u, 0u, 0u};
        npad_pre += np; }
    (void)npad_pre;
}
template <bool MOE>
__device__ __forceinline__ void ln2_phase(const Frame& F, int layer) {
    const int lane = F.lane; bf16_t* XB = WSP(bf16_t, WS_XB);
    const bf16_t* YM = WSP(const bf16_t, WS_YM); const bf16_t* PLE = WSP(const bf16_t, WS_PLE);
    const int* tsl = (const int*)(F.ws + WS_TOK + TOK_SLOT); const float* tw = (const float*)(F.ws + WS_TOK + TOK_W);
    f32x4 nx[4]; u32x2 na[4], nc[4], np_[4]; float nw0 = 0.f, nw1 = 0.f;
#define LN2_LOAD(t_) do { const int tt_ = (t_); const float* xr_ = F.out + (size_t)tt_ * 1024; \
        _Pragma("unroll") for (int j = 0; j < 4; ++j) nx[j] = *(const f32x4*)(xr_ + 4 * lane + 256 * j); \
        if (MOE) { const int s0_ = tsl[tt_ * 2], s1_ = tsl[tt_ * 2 + 1]; nw0 = tw[tt_ * 2]; nw1 = tw[tt_ * 2 + 1]; \
            _Pragma("unroll") for (int j = 0; j < 4; ++j) { na[j] = *(const u32x2*)(YM + (size_t)s0_ * 1024 + 4 * lane + 256 * j); nc[j] = *(const u32x2*)(YM + (size_t)s1_ * 1024 + 4 * lane + 256 * j); np_[j] = *(const u32x2*)(PLE + (size_t)tt_ * 1024 + 4 * lane + 256 * j); } } } while (0)
    if (F.gw < T) LN2_LOAD(F.gw);
    for (int t = F.gw; t < T; t += F.NGW) { float* xr = F.out + (size_t)t * 1024; f32x4 v[4];
#pragma unroll
        for (int j = 0; j < 4; ++j) v[j] = nx[j];
        if (MOE) { const float w0 = nw0, w1 = nw1;
#pragma unroll
            for (int j = 0; j < 4; ++j) { const u32x2 a = na[j], c = nc[j], p = np_[j];
                f32x4 f;
                f[0] = w0 * __uint_as_float(a.x << 16) + w1 * __uint_as_float(c.x << 16) + __uint_as_float(p.x << 16);
                f[1] = w0 * __uint_as_float(a.x & 0xffff0000u) + w1 * __uint_as_float(c.x & 0xffff0000u) + __uint_as_float(p.x & 0xffff0000u);
                f[2] = w0 * __uint_as_float(a.y << 16) + w1 * __uint_as_float(c.y << 16) + __uint_as_float(p.y << 16);
                f[3] = w0 * __uint_as_float(a.y & 0xffff0000u) + w1 * __uint_as_float(c.y & 0xffff0000u) + __uint_as_float(p.y & 0xffff0000u);
                v[j] = v[j] * ALPHA + f; } }
        if (t + F.NGW < T) LN2_LOAD(t + F.NGW);
        ln_row_write(v, IN_F(34) + layer * 1024, IN_F(35) + layer * 1024, xr, XB + (size_t)t * 1024, lane);
    }
#undef LN2_LOAD
}

constexpr int PH_PER_LAYER = 12, N_PHASES = 1 + DEPTH * PH_PER_LAYER;
__global__ void __launch_bounds__(512, 2) hybrid_fwd(Args args) {
    extern __shared__ __attribute__((aligned(16))) unsigned char lds_raw[];
    Frame F0;
    F0.lds = (LAS unsigned char*)lds_raw; F0.ws = args.ws; F0.in = args.in; F0.out = args.out;
    F0.tid = threadIdx.x; F0.lane = F0.tid & 63; F0.wave = __builtin_amdgcn_readfirstlane(F0.tid >> 6); F0.G = gridDim.x; F0.bid = blockIdx.x; F0.gw = F0.bid * 8 + F0.wave; F0.NGW = F0.G * 8;
    volatile LAS unsigned* ctlw = (volatile LAS unsigned*)(F0.lds + LDS_CTLW);
    if (F0.tid < 16) ctlw[F0.tid] = 0u;
    __syncthreads();
    const int lo = args.ph_lo, hi = args.ph_hi; const int VAR = args.variant;
    XcdBarrier bar; bar.bar = (unsigned*)(F0.ws + WS_CTL) + CW_BAR + args.bar_region * XCD_BAR_WORDS; bar.x = 0; bar.st = ctlw;
    if (hi - lo > 1) bar = xcd_barrier_post((unsigned*)(F0.ws + WS_CTL) + CW_BAR + args.bar_region * XCD_BAR_WORDS, ctlw);
#define IN_PH(k) (lo <= (k) && (k) < hi)
#define SEAM(k) do { if ((k) + 1 < hi) { XcdBarrier bb_ = bar; bb_.bar = bar.bar + opaque0(); xcd_barrier(bb_); } } while (0)

    if (PHON(12) && IN_PH(0)) { const Frame F = reframe(F0); p0_prologue(F); SEAM(0); }

    for (int layer = 0; layer < DEPTH; ++layer) {
        const int pb = 1 + layer * PH_PER_LAYER;
        const bool moe = (layer & 1) != 0;
        if (PHON(0) && IN_PH(pb + 0)) { const Frame F = reframe(F0); const int L = layer + opaque0(); LAS unsigned char* stage = F.lds + LDS_STAGE; LAS unsigned char* wscr = F.lds + LDS_STAGE + F.wave * 16384; (void)wscr; (void)stage;
            { pg8::Gemm g{WSP(const bf16_t, WS_XB), WSP(const bf16_t, WS_WIN) + (size_t)L * HP * 1024, 1024, 1024, 1024, VAR};
              pg8::OrderStd S; S.init(T / 256, HP / 256, F.G, F.bid); pg8::EpiBf16 E{WSP(bf16_t, WS_H), HP, HP / 256, 1.0f};
              pg8::gemm_phase(stage, g, S, E); }
            { const int L2 = L + opaque0(); pg8::Gemm g{WSP(const bf16_t, WS_PB) + (size_t)L2 * T * 256, WSP(const bf16_t, WS_WPP) + (size_t)L2 * 1024 * 256, 256, 256, 256, VAR};
              const int nshort = F.G - (1728 % F.G); pg8::OrderLin S{(F.G == 256) ? F.bid - 192 : F.bid, (F.G == 256) ? 64 : F.G, 256, 4}; (void)nshort;
              pg8::EpiBf16 E{WSP(bf16_t, WS_PP), 1024, 4, 1.0f};
              pg8::gemm_phase(stage, g, S, E); }
            SEAM(pb + 0);
        }
        if (PHON(1) && IN_PH(pb + 1)) { const Frame F = reframe(F0); const int L = layer + opaque0(); LAS unsigned char* stage = F.lds + LDS_STAGE; LAS unsigned char* wscr = F.lds + LDS_STAGE + F.wave * 16384; (void)wscr; (void)stage;
            const bf16_t* H = WSP(const bf16_t, WS_H);
            LAS float* rs = (LAS float*)(F.lds + LDS_MISC);
            if (!(VAR & 16)) { const int vb = F.bid;
                const int pm = vb >> 2, kind = (vb >> 1) & 1, pn = vb & 1;
                __syncthreads();
                { const int lr = F.tid >> 1, hf = F.tid & 1; const int nper = kind ? 64 : 96;
                  const u32x4* src = (const u32x4*)(H + (size_t)(pm * 256 + lr) * HP + (kind ? C_CKV : C_CQ) + hf * nper);
                  u32x4 v[12];
#pragma unroll
                  for (int q = 0; q < 12; ++q) v[q] = (q < 8 || kind == 0) ? src[q] : (u32x4){0u, 0u, 0u, 0u};
                  float ss = 0.f;
#pragma unroll
                  for (int q = 0; q < 12; ++q)
#pragma unroll
                      for (int j = 0; j < 4; ++j) { const float lo = __uint_as_float(v[q][j] << 16), hi = __uint_as_float(v[q][j] & 0xffff0000u); ss += lo * lo + hi * hi; }
                  ss += __shfl_xor(ss, 1);
                  if (hf == 0) rs[lr] = rsqrtf(ss / (kind ? 128.0f : 192.0f) + EPS); }
                __syncthreads();
                if (kind == 0) { pg8::Gemm g{H + C_CQ, WSP(const bf16_t, WS_WUQ) + (size_t)L * 512 * 256, HP, 256, 256, VAR}; pg8::OrderOne S{pm, pn, true};
                    pg8::EpiQ E{WSP(bf16_t, WS_Q), WSP(const float, WS_ROPEM), rs}; pg8::gemm_phase(stage, g, S, E); }
                else { pg8::Gemm g{H + C_CKV, WSP(const bf16_t, WS_WUKV) + (size_t)L * 512 * 256, HP, 256, 256, VAR}; pg8::OrderOne S{pm, pn, true};
                    pg8::EpiKV E{WSP(bf16_t, WS_K), WSP(bf16_t, WS_VT), rs}; pg8::gemm_phase(stage, g, S, E);
                    if (pn == 0) { const float* rope = WSP(const float, WS_ROPEM); bf16_t* Kb = WSP(bf16_t, WS_K);
#pragma unroll
                        for (int i8 = 0; i8 < 8; ++i8) { const int i = F.tid + i8 * 512; const int lr = i >> 4, j = i & 15, t = pm * 256 + lr, b = t >> 11, s = t & 2047;
                            const float x1 = bf2f(H[(size_t)t * HP + C_KR + j]), x2 = bf2f(H[(size_t)t * HP + C_KR + 16 + j]), c = rope[t * 32 + j], sn = rope[t * 32 + 16 + j];
                            const bf16_t o1 = f2bf(x1 * c - x2 * sn), o2 = f2bf(x2 * c + x1 * sn);
#pragma unroll
                            for (int hd = 0; hd < 4; ++hd) { bf16_t* kp = Kb + ((size_t)((b * 4 + hd) * SEQ + s)) * 96; kp[64 + j] = o1; kp[80 + j] = o2; } } } }
            }
            __syncthreads();
            for (int it = F.gw; it < 1024 + 1024 + 4096; it += F.NGW) {
                if (it < 1024) { if (!(VAR & 2)) hg_item<false>(F, L, it, wscr); }
                else if (it < 2048) { if (!(VAR & 4)) ret_item1(F, it - 1024, wscr); }
                else { if (!(VAR & 8)) s5_item<false>(F, L, it - 2048, wscr); }
            }
            SEAM(pb + 1);
        }
        if (PHON(2) && IN_PH(pb + 2)) { const Frame F = reframe(F0); const int L = layer + opaque0(); LAS unsigned char* stage = F.lds + LDS_STAGE; LAS unsigned char* wscr = F.lds + LDS_STAGE + F.wave * 16384; (void)wscr; (void)stage; s5_carry(F, L); hg_carry(F); ret_carry(F); SEAM(pb + 2); }
        if (PHON(3) && IN_PH(pb + 3)) { const Frame F = reframe(F0); const int L = layer + opaque0(); LAS unsigned char* stage = F.lds + LDS_STAGE; LAS unsigned char* wscr = F.lds + LDS_STAGE + F.wave * 16384; (void)wscr; (void)stage;
            if (!(VAR & 16)) { const int vb = F.bid; const int bh = vb >> 3, j = vb & 7; attn_unit(F, bh, 15 - j); attn_unit(F, bh, j); }
            __syncthreads();
            for (int it = F.gw; it < 1024 + 1024 + 4096; it += F.NGW) {
                if (it < 1024) { if (!(VAR & 2)) hg_item<true>(F, L, it, wscr); }
                else if (it < 2048) { if (!(VAR & 4)) ret_item3(F, L, it - 1024, wscr); }
                else { if (!(VAR & 8)) s5_item<true>(F, L, it - 2048, wscr); }
            }
            SEAM(pb + 3);
        }
        if (PHON(4) && IN_PH(pb + 4)) { const Frame F = reframe(F0); const int L = layer + opaque0(); LAS unsigned char* stage = F.lds + LDS_STAGE; LAS unsigned char* wscr = F.lds + LDS_STAGE + F.wave * 16384; (void)wscr; (void)stage;
            pg8::Gemm g{WSP(const bf16_t, WS_S5PRE), WSP(const bf16_t, WS_WGLU) + (size_t)L * 256 * 256, 256, 256, 256, VAR};
            pg8::OrderLin S{F.bid, F.G, 64, 1}; pg8::EpiSigMul E{WSP(bf16_t, WS_Y), 1024, WSP(const bf16_t, WS_S5PRE), 256};
            pg8::gemm_phase(stage, g, S, E);
            SEAM(pb + 4);
        }
        if (PHON(5) && IN_PH(pb + 5)) { const Frame F = reframe(F0); const int L = layer + opaque0(); LAS unsigned char* stage = F.lds + LDS_STAGE; LAS unsigned char* wscr = F.lds + LDS_STAGE + F.wave * 16384; (void)wscr; (void)stage;
            pg8::Gemm g{WSP(const bf16_t, WS_Y), WSP(const bf16_t, WS_WB) + (size_t)L * 4 * 1024 * 256, 1024, 256, 256, VAR};
            pg8::OrderBranch S{F.bid, F.G}; pg8::EpiBranchH E{WSP(const bf16_t, WS_H) + C_GATE, WSP(bf16_t, WS_MIXB)};
            pg8::gemm_phase(stage, g, S, E);
            SEAM(pb + 5);
        }
        if (PHON(6) && IN_PH(pb + 6)) { const Frame F = reframe(F0); const int L = layer + opaque0(); LAS unsigned char* stage = F.lds + LDS_STAGE; LAS unsigned char* wscr = F.lds + LDS_STAGE + F.wave * 16384; (void)wscr; (void)stage;
            pg8::Gemm g{WSP(const bf16_t, WS_MIXB), WSP(const bf16_t, WS_WO) + (size_t)L * 1024 * 1024, 1024, 1024, 1024, VAR};
            pg8::OrderStd S; S.init(T / 256, 4, F.G, F.bid); pg8::EpiResid E{L == 0 ? IN_F(0) : (const float*)F.out, F.out, nullptr, 1.0f};
            pg8::gemm_phase(stage, g, S, E);
            SEAM(pb + 6);
        }
        if (PHON(7) && IN_PH(pb + 7)) { const Frame F = reframe(F0); const int L = layer + opaque0(); LAS unsigned char* stage = F.lds + LDS_STAGE; LAS unsigned char* wscr = F.lds + LDS_STAGE + F.wave * 16384; (void)wscr; (void)stage; if (moe) ln1_phase<true>(F, L); else ln1_phase<false>(F, L); SEAM(pb + 7); }
        if (!moe) {
            if (PHON(8) && IN_PH(pb + 8)) { const Frame F = reframe(F0); const int L = layer + opaque0(); LAS unsigned char* stage = F.lds + LDS_STAGE; LAS unsigned char* wscr = F.lds + LDS_STAGE + F.wave * 16384; (void)wscr; (void)stage;
                { pg8::Gemm g{WSP(const unsigned char, WS_X8), WSP(const unsigned char, WS_WFFU) + (size_t)(L >> 1) * 7168 * 1024, 1024, 1024, 1024, VAR};
                  pg8::OrderStd S; S.init(T / 256, 28, F.G, F.bid); pg8::EpiSwiglu8 E{WSP(unsigned char, WS_HFF), DFF, 28};
                  pg8::gemm_phase(stage, g, S, E); }
                { const int L2 = L + opaque0(); pg8::Gemm g{WSP(const bf16_t, WS_XB), WSP(const bf16_t, WS_WPG) + (size_t)L2 * 1024 * 1024, 1024, 1024, 1024, VAR};
                  pg8::OrderStd S; S.init(T / 256, 4, F.G, F.bid); pg8::EpiSigMul E{WSP(bf16_t, WS_PLE), 1024, WSP(const bf16_t, WS_PP), 1024};
                  pg8::gemm_phase(stage, g, S, E); }
                SEAM(pb + 8);
            }
            if (PHON(9) && IN_PH(pb + 9)) { const Frame F = reframe(F0); const int L = layer + opaque0(); LAS unsigned char* stage = F.lds + LDS_STAGE; LAS unsigned char* wscr = F.lds + LDS_STAGE + F.wave * 16384; (void)wscr; (void)stage;
                pg8::Gemm g{WSP(const unsigned char, WS_HFF), WSP(const unsigned char, WS_WFFD) + (size_t)(L >> 1) * 1024 * DFF, DFF, DFF, DFF, VAR};
                pg8::OrderStd S; S.init(T / 256, 4, F.G, F.bid); pg8::EpiResidT<true> E{(const float*)F.out, F.out, WSP(const bf16_t, WS_PLE), 0.00048828125f};
                pg8::gemm_phase(stage, g, S, E);
                SEAM(pb + 9);
            }
            if (PHON(10) && IN_PH(pb + 10)) { const Frame F = reframe(F0); const int L = layer + opaque0(); LAS unsigned char* stage = F.lds + LDS_STAGE; LAS unsigned char* wscr = F.lds + LDS_STAGE + F.wave * 16384; (void)wscr; (void)stage; ln2_phase<false>(F, L); if (hi > pb + 12) { XcdBarrier bb_ = bar; bb_.bar = bar.bar + opaque0(); xcd_barrier(bb_); } }
        } else {
            if (PHON(8) && IN_PH(pb + 8)) { const Frame F = reframe(F0); const int L = layer + opaque0(); LAS unsigned char* stage = F.lds + LDS_STAGE; LAS unsigned char* wscr = F.lds + LDS_STAGE + F.wave * 16384; (void)wscr; (void)stage;
                moe_gather(F, L);
                { const int L2 = L + opaque0(); pg8::Gemm g{WSP(const bf16_t, WS_XB), WSP(const bf16_t, WS_WPG) + (size_t)L2 * 1024 * 1024, 1024, 1024, 1024, VAR};
                  pg8::OrderStd S; S.init(T / 256, 4, F.G, F.bid); pg8::EpiSigMul E{WSP(bf16_t, WS_PLE), 1024, WSP(const bf16_t, WS_PP), 1024};
                  pg8::gemm_phase(stage, g, S, E); }
                SEAM(pb + 8);
            }
            if (PHON(9) && IN_PH(pb + 9)) { const Frame F = reframe(F0); const int L = layer + opaque0(); LAS unsigned char* stage = F.lds + LDS_STAGE; LAS unsigned char* wscr = F.lds + LDS_STAGE + F.wave * 16384; (void)wscr; (void)stage;
                const MoeOff o = moe_offsets(F, L, nullptr);
                pg8::Gemm g{WSP(const unsigned char, WS_XG), WSP(const unsigned char, WS_WMU) + (size_t)(L >> 1) * 8 * 7168 * 1024, 1024, 1024, 1024, VAR};
                pg8::OrderMoe S{o.ts8, 28, F.G, F.bid, o.ts1, o.ts2, o.ts3, o.ts4, o.ts5, o.ts6, o.ts7}; pg8::EpiSwiglu8 E{WSP(unsigned char, WS_HM), DFF, 28};
                pg8::gemm_phase(stage, g, S, E);
                SEAM(pb + 9);
            }
            if (PHON(10) && IN_PH(pb + 10)) { const Frame F = reframe(F0); const int L = layer + opaque0(); LAS unsigned char* stage = F.lds + LDS_STAGE; LAS unsigned char* wscr = F.lds + LDS_STAGE + F.wave * 16384; (void)wscr; (void)stage;
                const MoeOff o = moe_offsets(F, L, nullptr);
                pg8::Gemm g{WSP(const unsigned char, WS_HM), WSP(const unsigned char, WS_WMD) + (size_t)(L >> 1) * 8 * 1024 * DFF, DFF, DFF, DFF, VAR};
                pg8::OrderMoe S{o.ts8, 4, F.G, F.bid, o.ts1, o.ts2, o.ts3, o.ts4, o.ts5, o.ts6, o.ts7}; pg8::EpiBf16T<true> E{WSP(bf16_t, WS_YM), 1024, 4, 0.00048828125f};
                pg8::gemm_phase(stage, g, S, E);
                SEAM(pb + 10);
            }
            if (PHON(11) && IN_PH(pb + 11)) { const Frame F = reframe(F0); const int L = layer + opaque0(); LAS unsigned char* stage = F.lds + LDS_STAGE; LAS unsigned char* wscr = F.lds + LDS_STAGE + F.wave * 16384; (void)wscr; (void)stage; ln2_phase<true>(F, L); SEAM(pb + 11); }
        }
    }
#undef IN_PH
#undef SEAM
}

extern "C" void kernel_launch(void* const* d_in, const int* in_sizes, int n_in, void* d_out, int out_size, void* d_ws, size_t ws_size, hipStream_t stream) {
    static int grid = 0;
    if (grid == 0) {
        if (n_in != 36 || out_size != T * D || ws_size < WS_END) { fprintf(stderr, "kernel_launch: unexpected problem (n_in %d, out %d, ws %zu < %zu)\n", n_in, out_size, ws_size, (size_t)WS_END); grid = -1; return; }
        int dev = 0, cus = 0, per_cu = 0;
        if (hipGetDevice(&dev) != hipSuccess || hipDeviceGetAttribute(&cus, hipDeviceAttributeMultiprocessorCount, dev) != hipSuccess) { grid = -1; return; }
        if (hipFuncSetAttribute((const void*)hybrid_fwd, hipFuncAttributeMaxDynamicSharedMemorySize, LDS_BYTES) != hipSuccess) { fprintf(stderr, "kernel_launch: hipFuncSetAttribute failed\n"); grid = -1; return; }
        if (hipOccupancyMaxActiveBlocksPerMultiprocessor(&per_cu, (const void*)hybrid_fwd, 512, LDS_BYTES) != hipSuccess || per_cu < 1) fprintf(stderr, "kernel_launch: occupancy query says %d\n", per_cu);
        (void)hipGetLastError();
        if (cus != 256) { fprintf(stderr, "kernel_launch: built for 256 CUs, device has %d\n", cus); }
        grid = 256;
    }
    if (grid < 0) return;
    (void)hipMemsetAsync((char*)d_ws + WS_CTL, 0, CTL_BYTES, stream);
    Args a{};
    for (int i = 0; i < 36; ++i) a.in[i] = d_in[i];
    a.out = (float*)d_out; a.ws = (unsigned char*)d_ws;
    if (DUP_PHASE >= 0) {
        a.ph_lo = 0; a.ph_hi = DUP_PHASE + 1; a.bar_region = 0; hipLaunchKernelGGL(hybrid_fwd, dim3(grid), dim3(512), LDS_BYTES, stream, a);
        for (int n = 0; n < DUP_N; ++n) { a.ph_lo = DUP_PHASE; a.ph_hi = DUP_PHASE + 1; a.bar_region = 1; a.variant = DUP_VARIANT; hipLaunchKernelGGL(hybrid_fwd, dim3(grid), dim3(512), LDS_BYTES, stream, a); }
        a.variant = 0;
        if (DUP_PHASE + 1 < N_PHASES) { a.ph_lo = DUP_PHASE + 1; a.ph_hi = N_PHASES; a.bar_region = 2; hipLaunchKernelGGL(hybrid_fwd, dim3(grid), dim3(512), LDS_BYTES, stream, a); }
    } else if (MK_N_LAUNCHES == 1) {
        a.ph_lo = 0; a.ph_hi = N_PHASES;
        hipLaunchKernelGGL(hybrid_fwd, dim3(grid), dim3(512), LDS_BYTES, stream, a);
    } else {
        for (int p = 0; p < N_PHASES; ++p) { a.ph_lo = p; a.ph_hi = p + 1; hipLaunchKernelGGL(hybrid_fwd, dim3(grid), dim3(512), LDS_BYTES, stream, a); }
    }
    const hipError_t le = hipPeekAtLastError();
    if (le != hipSuccess) fprintf(stderr, "kernel_launch: launch failed: %s\n", hipGetErrorName(le));
}
```

```cpp
#include <hip/hip_runtime.h>
#include <cstdio>
#include <cstdint>

#ifndef MK_N_LAUNCHES
#define MK_N_LAUNCHES 1
#endif
#ifndef DUP_PHASE
#define DUP_PHASE -1
#endif
#define DUP_N 4
#ifndef DUP_VARIANT
#define DUP_VARIANT 0
#endif
#ifndef PHMASK
#define PHMASK 0xFFFF
#endif
#define PHON(k) (((PHMASK) >> (k)) & 1)
#ifndef ITMASK
#define ITMASK 15
#endif

#define LAS __attribute__((address_space(3)))
typedef unsigned short bf16_t;
typedef short bf16x8 __attribute__((ext_vector_type(8)));
typedef float f32x4 __attribute__((ext_vector_type(4)));
typedef float f32x2 __attribute__((ext_vector_type(2)));
typedef unsigned u32x4 __attribute__((ext_vector_type(4)));
typedef unsigned u32x2 __attribute__((ext_vector_type(2)));

constexpr int T = 16384, D = 1024, SEQ = 2048, NBATCH = 8, DEPTH = 4, DFF = 3584, NEXP = 8;
constexpr int HP = 6912;
constexpr int C_US5 = 0, C_CQ = 256, C_CKV = 512, C_KR = 640, C_HQ = 768, C_HF = 1024, C_HI = 1280, C_HG = 1536, C_RQ = 1792, C_RK = 2048, C_RV = 2304, C_RG = 2560, C_GATE = 2816;
constexpr float ALPHA = 1.6817928305074290f;
constexpr float EPS = 1e-5f;
constexpr float QSCALE = 0.10206207261596575f * 1.4426950408889634f;
constexpr int MOE_MAXT = 136;

constexpr size_t MiB = (size_t)1 << 20;
constexpr size_t WS_CTL = 0, CTL_BYTES = 1 * MiB;
constexpr size_t WS_WIN = 1 * MiB, WS_WB = 55 * MiB, WS_WO = 63 * MiB, WS_WPG = 71 * MiB, WS_WPP = 79 * MiB, WS_WFFU = 81 * MiB, WS_WFFD = 109 * MiB;
constexpr size_t WS_WMU = 123 * MiB, WS_WMD = 347 * MiB, WS_WUQ = 459 * MiB, WS_WUKV = 460 * MiB, WS_WGLU = 461 * MiB;
constexpr size_t WS_ROPEM = 462 * MiB, WS_ROPER = 464 * MiB, WS_S5P = 468 * MiB, WS_TOK = 469 * MiB;
constexpr size_t WS_XB = 470 * MiB, WS_PB = 502 * MiB, WS_PP = 534 * MiB, WS_PLE = 566 * MiB, WS_STAGE = 598 * MiB;
constexpr size_t WS_H = WS_STAGE, WS_Y = WS_STAGE + 216 * MiB, WS_S5PRE = WS_STAGE + 248 * MiB, WS_MIXB = WS_STAGE + 256 * MiB, WS_TMP = WS_STAGE + 288 * MiB;
constexpr size_t WS_Q = WS_STAGE + 288 * MiB, WS_K = WS_STAGE + 300 * MiB, WS_VT = WS_STAGE + 312 * MiB, WS_QR = WS_STAGE + 320 * MiB, WS_KR = WS_STAGE + 328 * MiB;
constexpr size_t WS_S5E = WS_STAGE + 336 * MiB, WS_S5C = WS_STAGE + 338 * MiB, WS_HGD = WS_STAGE + 340 * MiB, WS_HGE = WS_STAGE + 341 * MiB, WS_HGI = WS_STAGE + 357 * MiB;
constexpr size_t WS_RTE = WS_STAGE + 373 * MiB, WS_RTI = WS_STAGE + 389 * MiB;
constexpr size_t WS_HFF = WS_STAGE, WS_XG = WS_STAGE, WS_HM = WS_STAGE + 68 * MiB, WS_YM = WS_STAGE + 306 * MiB;
constexpr size_t WS_END = WS_STAGE + 405 * MiB;
constexpr size_t WS_X8 = 236 * MiB;
constexpr size_t S5P_ABAR = 0, S5P_BM = 64 * 1024, S5P_CM = 384 * 1024, S5P_LB = 704 * 1024;
constexpr size_t TOK_E = 0, TOK_POS = 128 * 1024, TOK_W = 256 * 1024, TOK_SLOT = 384 * 1024;
constexpr int CW_BAR = 4096, CW_MOE = 32768;

constexpr int LDS_BYTES = 160 * 1024;
constexpr int LDS_STAGE = 0;
constexpr int LDS_MISC = 128 * 1024;
constexpr int LDS_CTLW = 160 * 1024 - 64;

__device__ __forceinline__ float bf2f(bf16_t b) { return __uint_as_float(((unsigned)b) << 16); }
__device__ __forceinline__ unsigned cvt_pk_bf16(float lo, float hi) { unsigned r; asm volatile("v_cvt_pk_bf16_f32 %0, %1, %2" : "=v"(r) : "v"(lo), "v"(hi)); return r; }
__device__ __forceinline__ bf16_t f2bf(float f) { return (bf16_t)(cvt_pk_bf16(f, 0.f) & 0xffffu); }
__device__ __forceinline__ unsigned cvt4_fp8(float a, float b, float c, float d) { int w = 0; w = __builtin_amdgcn_cvt_pk_fp8_f32(a, b, w, false); w = __builtin_amdgcn_cvt_pk_fp8_f32(c, d, w, true); return (unsigned)w; }
__device__ __forceinline__ float sigmoidf_(float x) { return 1.0f / (1.0f + __expf(-x)); }
__device__ __forceinline__ float siluf_(float x) { return x / (1.0f + __expf(-x)); }
__device__ __forceinline__ float gelu_tanh(float v) { const float z = 0.7978845608028654f * (v + 0.044715f * v * v * v); const float th = 1.0f - 2.0f / (__expf(2.0f * z) + 1.0f); return 0.5f * v * (1.0f + th); }
__device__ __forceinline__ f32x4 mfma16(bf16x8 a, bf16x8 b, f32x4 c) { return __builtin_amdgcn_mfma_f32_16x16x32_bf16(a, b, c, 0, 0, 0); }
typedef int i32x8 __attribute__((ext_vector_type(8)));
typedef int i32x4 __attribute__((ext_vector_type(4)));
union Frag { bf16x8 v; unsigned u[4]; u32x2 d[2]; u32x4 q; unsigned short h[8]; };
#define WSYNC() asm volatile("s_waitcnt lgkmcnt(0)" ::: "memory")
#define VM_WAIT() asm volatile("s_waitcnt vmcnt(0)" ::: "memory")
__device__ __forceinline__ float wave_sum(float v) {
#pragma unroll
    for (int o = 1; o < 64; o <<= 1) v += __shfl_xor(v, o);
    return v;
}

namespace pg8 {
constexpr int BM = 256, BK = 64, HALF = 128, HTB = HALF * BK * 2, STAGE_BYTES = 8 * HTB, NXCD = 8, WGM = 8;
__host__ __device__ __forceinline__ int lds_byte(int r, int c) { const int st = (r >> 4) * 2 + (c >> 5), rr = r & 15, cc = c & 31, ob = rr * 64 + cc * 2; return st * 1024 + (ob ^ (((ob >> 9) & 1) << 5)); }
__host__ __device__ __forceinline__ void stage_rc(int b, int& R, int& C) { const int st = b / 1024, sb = b % 1024, swz = sb ^ (((sb >> 9) & 1) << 5); R = (st >> 1) * 16 + swz / 64; C = (st & 1) * 32 + (swz % 64) / 2; }
__host__ __device__ __forceinline__ int perm32(int rho) { const int n = rho >> 4, i = rho & 15; return 8 * (i >> 2) + 4 * n + (i & 3); }

struct Unit { int pm, pn, ak; };
struct Gemm { const void* A; const void* Bt; int lda, ldb, K, flags; };

struct OrderStd {
    int nM, nN, nwg, G, c;
    __device__ void init(int nM_, int nN_, int G_, int c_) { nM = nM_; nN = nN_; nwg = nM * nN; G = G_; c = c_; }
    __device__ bool next(int i, Unit& u) const {
        const long L = (long)i * G + c; if (L >= nwg) return false;
        int wgid = (int)L; { const int q = nwg / NXCD, r = nwg % NXCD, xcd = wgid % NXCD, off = wgid / NXCD; wgid = (xcd < r ? xcd * (q + 1) : r * (q + 1) + (xcd - r) * q) + off; }
        const int nig = WGM * nN, gid = wgid / nig, fm = gid * WGM, gsz = (nM - fm) < WGM ? (nM - fm) : WGM;
        u.pm = fm + ((wgid % nig) % gsz); u.pn = (wgid % nig) / gsz; u.ak = 0; return true;
    }
};
struct OrderLin {
    int c, G, total, nN;
    __device__ bool next(int i, Unit& u) const { if (c < 0) return false; const int L = i * G + c; if (L >= total) return false; u.pm = L / nN; u.pn = L % nN; u.ak = 0; return true; }
};
struct OrderOne {
    int pm, pn; bool has;
    __device__ bool next(int i, Unit& u) const { if (i > 0 || !has) return false; u.pm = pm; u.pn = pn; u.ak = 0; return true; }
};
struct OrderBranch {
    int c, G;
    __device__ bool next(int i, Unit& u) const { const int t = (i >> 2) * G + c, n = i & 3; if (t >= 512) return false; u.pm = t >> 2; u.pn = n * 4 + (t & 3); u.ak = n * 256; return true; }
};
struct OrderMoe {
    int nT, ncol, G, c, t1, t2, t3, t4, t5, t6, t7;
    __device__ bool next(int i, Unit& u) const {
        const long L = (long)i * G + c; if (L >= (long)nT * ncol) return false;
        const int wg = (int)L, nig = WGM * ncol, gid = wg / nig, fm = gid * WGM, gsz = (nT - fm) < WGM ? (nT - fm) : WGM;
        const int pm = fm + ((wg % nig) % gsz), ct = (wg % nig) / gsz;
        const int e = (pm >= t1) + (pm >= t2) + (pm >= t3) + (pm >= t4) + (pm >= t5) + (pm >= t6) + (pm >= t7);
        u.pm = pm; u.pn = e * ncol + ct; u.ak = 0; return true;
    }
};

template <class Epi, class Sched, bool ALIGN_EPI = true, bool SP2 = true>
__device__ __forceinline__ void gemm_phase(LAS unsigned char* lds, const Gemm g, const Sched& S, const Epi& E) {
    int oz_; asm volatile("s_mov_b32 %0, 0" : "=s"(oz_));
    const int tid = threadIdx.x + oz_, wid = __builtin_amdgcn_readfirstlane(tid >> 6), lane = tid & 63, wr = wid >> 2, wc = wid & 3, fr = lane & 15, fq = lane >> 4;
    constexpr int ESZ = Epi::FP8 ? 1 : 2;
    const int nt = (g.K * ESZ + oz_) / (BK * 2);
    unsigned voffA[2], voffB[2]; const unsigned hoffA = Epi::HALF_M ? 0u : (unsigned)(HALF * g.lda * ESZ), hoffB = (unsigned)(HALF * g.ldb * ESZ);
#pragma unroll
    for (int i = 0; i < 2; ++i) { int R, C; stage_rc(tid * 16 + i * 8192, R, C); const int Rb = Epi::PERM ? ((R & ~31) + perm32(R & 31)) : R;
        voffA[i] = (unsigned)(R * g.lda * ESZ + C * 2); voffB[i] = (unsigned)(Rb * g.ldb * ESZ + C * 2); }
    const size_t kstep = (size_t)(BK * 2);
    const size_t hstepA = (size_t)HALF * g.lda * ESZ, hstepB = (size_t)HALF * g.ldb * ESZ;
    static_assert(!Epi::HALF_M || SP2, "HALF_M needs the SP2 loop");
    const size_t tstepA = Epi::HALF_M ? hstepA : 2 * hstepA, tstepB = 2 * hstepB;
    const size_t hA2 = Epi::HALF_M ? 0 : hstepA;
    const unsigned ldsw = (unsigned)wid * 1024u;
    const int aoff = lds_byte(wr * 64 + fr, fq * 8), boff = lds_byte(wc * 32 + fr, fq * 8);
#define PG8_SA(b, h) (((b) * 2 + (h)) * HTB)
#define PG8_SB(b, h) ((4 + (b) * 2 + (h)) * HTB)
#define voffAh voffA, hoffA
#define voffBh voffB, hoffB
#define PG8_STAGE(...) PG8_STAGE_(__VA_ARGS__, 0u)
#define PG8_STAGE_(bufoff, gbase, voff, hoff, ...) do { _Pragma("unroll") for (int _i = 0; _i < 2; ++_i) { unsigned vo_ = (voff)[_i] + (hoff); asm volatile("" : "+v"(vo_)); \
        __builtin_amdgcn_global_load_lds((const unsigned*)((const char*)(gbase) + vo_), (LAS unsigned*)(lds + (bufoff) + ldsw + _i * 8192), 16, 0, 0); } } while (0)
#define PG8_LDA(dst, b, h) do { if constexpr (Epi::FP8) { _Pragma("unroll") for (int m = 0; m < 4; ++m) { const i32x4 lo_ = *(const LAS i32x4*)(lds + PG8_SA(b, h) + aoff + m * 2048), hi_ = *(const LAS i32x4*)(lds + PG8_SA(b, h) + aoff + m * 2048 + 1024); dst##8[m] = __builtin_shufflevector(lo_, hi_, 0, 1, 2, 3, 4, 5, 6, 7); } } \
        else { _Pragma("unroll") for (int m = 0; m < 4; ++m) _Pragma("unroll") for (int k = 0; k < 2; ++k) dst[m][k] = *(const LAS bf16x8*)(lds + PG8_SA(b, h) + aoff + m * 2048 + k * 1024); } } while (0)
#define PG8_LDB(dst, b, h) do { if constexpr (Epi::FP8) { _Pragma("unroll") for (int n = 0; n < 2; ++n) { const i32x4 lo_ = *(const LAS i32x4*)(lds + PG8_SB(b, h) + boff + n * 2048), hi_ = *(const LAS i32x4*)(lds + PG8_SB(b, h) + boff + n * 2048 + 1024); dst##8[n] = __builtin_shufflevector(lo_, hi_, 0, 1, 2, 3, 4, 5, 6, 7); } } \
        else { _Pragma("unroll") for (int n = 0; n < 2; ++n) _Pragma("unroll") for (int k = 0; k < 2; ++k) dst[n][k] = *(const LAS bf16x8*)(lds + PG8_SB(b, h) + boff + n * 2048 + k * 1024); } } while (0)
#define PG8_MMA(ai, bj, At, Bt) do { __builtin_amdgcn_s_setprio(1); if constexpr (Epi::FP8) { _Pragma("unroll") for (int m = 0; m < 4; ++m) _Pragma("unroll") for (int n = 0; n < 2; ++n) \
            asm volatile("v_mfma_scale_f32_16x16x128_f8f6f4 %0, %1, %2, %0, %3, %3 op_sel_hi:[0,0,0]" : "+v"(acc[ai][bj][m][n]) : "v"(Bt##8[n]), "v"(At##8[m]), "v"(scl8)); } \
        else { _Pragma("unroll") for (int m = 0; m < 4; ++m) _Pragma("unroll") for (int n = 0; n < 2; ++n) _Pragma("unroll") for (int k = 0; k < 2; ++k) \
            acc[ai][bj][m][n] = __builtin_amdgcn_mfma_f32_16x16x32_bf16(Bt[n][k], At[m][k], acc[ai][bj][m][n], 0, 0, 0); } __builtin_amdgcn_s_setprio(0); } while (0)
#define PG8_WAIT_V(n) asm volatile("s_waitcnt vmcnt(" #n ")" ::: "memory")
#define PG8_WAIT_L(n) asm volatile("s_waitcnt lgkmcnt(" #n ")" ::: "memory")
#define PG8_BAR __builtin_amdgcn_s_barrier()
#define PG8_SCHED __builtin_amdgcn_sched_barrier(0)
    Unit cur, nxt; int ui = 0;
    if (!S.next(0, cur)) return;
    f32x4 acc[2][2][4][2];
#pragma unroll
    for (int a = 0; a < 2; ++a)
#pragma unroll
        for (int b = 0; b < 2; ++b)
#pragma unroll
            for (int m = 0; m < 4; ++m)
#pragma unroll
                for (int n = 0; n < 2; ++n) acc[a][b][m][n] = (f32x4){0.f, 0.f, 0.f, 0.f};
    bf16x8 At[4][2], B0[2][2], B1[2][2]; i32x8 At8[4], B08[2], B18[2]; const int scl8 = 0x7f7f7f7f;
    const char* cA = (const char*)g.A + (size_t)cur.pm * tstepA + (size_t)cur.ak * ESZ; const char* cB = (const char*)g.Bt + (size_t)cur.pn * tstepB;
    if constexpr (SP2) {
        PG8_STAGE(PG8_SB(0, 0), cB, voffB); PG8_STAGE(PG8_SB(0, 1), cB, voffBh); PG8_STAGE(PG8_SA(0, 0), cA, voffA); PG8_STAGE(PG8_SA(0, 1), cA, voffAh);
        if (wr == 1) PG8_BAR;
        PG8_WAIT_V(2); PG8_BAR;
        PG8_STAGE(PG8_SB(1, 0), cB + kstep, voffB); PG8_STAGE(PG8_SA(1, 0), cA + kstep, voffA); PG8_STAGE(PG8_SB(1, 1), cB + kstep, voffBh);
        PG8_WAIT_V(6); PG8_BAR;
    } else {
        PG8_STAGE(PG8_SB(0, 0), cB, voffB); PG8_STAGE(PG8_SA(0, 0), cA, voffA); PG8_STAGE(PG8_SB(0, 1), cB, voffBh); PG8_STAGE(PG8_SA(0, 1), cA, voffAh);
        if (wr == 1) PG8_BAR;
        PG8_WAIT_V(4); PG8_BAR;
        PG8_STAGE(PG8_SB(1, 0), cB + kstep, voffB); PG8_STAGE(PG8_SA(1, 0), cA + kstep, voffA); PG8_STAGE(PG8_SB(1, 1), cB + kstep, voffBh);
        PG8_WAIT_V(6); PG8_BAR;
    }
    for (;;) {
        const bool has_next = S.next(ui + 1, nxt);
        const char* nA = has_next ? (const char*)g.A + (size_t)nxt.pm * tstepA + (size_t)nxt.ak * ESZ : cA; const char* nB = has_next ? (const char*)g.Bt + (size_t)nxt.pn * tstepB : cB;
        for (int t = 0; t < nt; t += 2) {
            const bool last = (t == nt - 2);
            const char* a1 = cA + (size_t)(t + 1) * kstep;
            const char* a2 = last ? nA : cA + (size_t)(t + 2) * kstep; const char* b2 = last ? nB : cB + (size_t)(t + 2) * kstep;
            const char* a3 = a2 + kstep; const char* b3 = b2 + kstep;
            if constexpr (SP2) {
            PG8_LDB(B0, 0, 0); PG8_LDB(B1, 0, 1); PG8_SCHED; PG8_LDA(At, 0, 0); PG8_STAGE(PG8_SA(1, 1), a1, voffAh);
            PG8_WAIT_V(8); PG8_WAIT_L(0); PG8_BAR; PG8_MMA(0, 0, At, B0); PG8_MMA(0, 1, At, B1); PG8_BAR; PG8_SCHED;
            if constexpr (!Epi::HALF_M) PG8_LDA(At, 0, 1); PG8_STAGE(PG8_SB(0, 0), b2, voffB); PG8_STAGE(PG8_SB(0, 1), b2, voffBh); PG8_STAGE(PG8_SA(0, 0), a2, voffA);
            PG8_WAIT_V(8); PG8_WAIT_L(0); PG8_BAR; if constexpr (!Epi::HALF_M) { PG8_MMA(1, 0, At, B0); PG8_MMA(1, 1, At, B1); } PG8_BAR; PG8_SCHED;
            PG8_LDB(B0, 1, 0); PG8_LDB(B1, 1, 1); PG8_SCHED; PG8_LDA(At, 1, 0); PG8_STAGE(PG8_SA(0, 1), a2, voffAh);
            PG8_WAIT_V(8); PG8_WAIT_L(0); PG8_BAR; PG8_MMA(0, 0, At, B0); PG8_MMA(0, 1, At, B1); PG8_BAR; PG8_SCHED;
            if constexpr (!Epi::HALF_M) PG8_LDA(At, 1, 1); PG8_STAGE(PG8_SB(1, 0), b3, voffB); PG8_STAGE(PG8_SB(1, 1), b3, voffBh); PG8_STAGE(PG8_SA(1, 0), a3, voffA);
            PG8_WAIT_V(8); PG8_WAIT_L(0); PG8_BAR; if constexpr (!Epi::HALF_M) { PG8_MMA(1, 0, At, B0); PG8_MMA(1, 1, At, B1); } PG8_BAR; PG8_SCHED;
            } else {
            PG8_LDB(B0, 0, 0); PG8_SCHED; PG8_LDA(At, 0, 0); PG8_STAGE(PG8_SA(1, 1), a1, voffAh);
            PG8_WAIT_L(8); PG8_BAR; PG8_WAIT_L(0); PG8_MMA(0, 0, At, B0); PG8_BAR; PG8_SCHED;
            PG8_LDB(B1, 0, 1); PG8_STAGE(PG8_SB(0, 0), b2, voffB);
            PG8_BAR; PG8_WAIT_L(0); PG8_MMA(0, 1, At, B1); PG8_BAR;
            PG8_LDA(At, 0, 1); PG8_STAGE(PG8_SA(0, 0), a2, voffA);
            PG8_BAR; PG8_WAIT_L(0); PG8_MMA(1, 0, At, B0); PG8_BAR; PG8_SCHED;
            PG8_STAGE(PG8_SB(0, 1), b2, voffBh);
            PG8_WAIT_V(6); PG8_BAR; PG8_MMA(1, 1, At, B1); PG8_BAR;
            PG8_LDB(B0, 1, 0); PG8_SCHED; PG8_LDA(At, 1, 0); PG8_STAGE(PG8_SA(0, 1), a2, voffAh);
            PG8_WAIT_L(8); PG8_BAR; PG8_WAIT_L(0); PG8_MMA(0, 0, At, B0); PG8_BAR; PG8_SCHED;
            PG8_LDB(B1, 1, 1); PG8_STAGE(PG8_SB(1, 0), b3, voffB);
            PG8_BAR; PG8_WAIT_L(0); PG8_MMA(0, 1, At, B1); PG8_BAR;
            PG8_LDA(At, 1, 1); PG8_STAGE(PG8_SA(1, 0), a3, voffA);
            PG8_BAR; PG8_WAIT_L(0); PG8_MMA(1, 0, At, B0); PG8_BAR; PG8_SCHED;
            PG8_STAGE(PG8_SB(1, 1), b3, voffBh);
            PG8_WAIT_V(6); PG8_BAR; PG8_MMA(1, 1, At, B1); PG8_BAR;
            }
        }
        if constexpr (ALIGN_EPI) { if (wr == 0) PG8_BAR; }
        if constexpr (Epi::FP8) { asm volatile("s_nop 15\n\ts_nop 15\n\ts_nop 15" ::: "memory"); }
        { int vz_; asm volatile("v_mov_b32 %0, 0" : "=v"(vz_)); if (!(g.flags & 1)) E(acc, cur, wr, wc, fr + vz_, fq); }
        if (!has_next) break;
#pragma unroll
        for (int a = 0; a < (Epi::HALF_M ? 1 : 2); ++a)
#pragma unroll
            for (int b = 0; b < 2; ++b)
#pragma unroll
                for (int m = 0; m < 4; ++m)
#pragma unroll
                    for (int n = 0; n < 2; ++n) acc[a][b][m][n] = (f32x4){0.f, 0.f, 0.f, 0.f};
        cur = nxt; cA = nA; cB = nB; ++ui;
        if constexpr (ALIGN_EPI) { if (wr == 1) PG8_BAR; }
    }
    PG8_WAIT_V(0);
    if constexpr (!ALIGN_EPI) { if (wr == 0) PG8_BAR; }
    PG8_BAR;
#undef PG8_SA
#undef PG8_SB
#undef PG8_STAGE
#undef PG8_STAGE_
#undef voffAh
#undef voffBh
#undef PG8_LDA
#undef PG8_LDB
#undef PG8_MMA
#undef PG8_WAIT_V
#undef PG8_WAIT_L
#undef PG8_BAR
#undef PG8_SCHED
}

typedef f32x4 Acc[2][2][4][2];
template <bool F8>
struct EpiBf16T {
    static constexpr bool PERM = true, HALF_M = false, FP8 = F8;
    bf16_t* O; int ldc; int ncol; float sc;
    __device__ __forceinline__ void operator()(const Acc& acc, const Unit& u, int wr, int wc, int fr, int fq) const {
        const int row0 = u.pm * BM + wr * 64 + fr, col0 = (u.pn % ncol) * BM + wc * 32 + 8 * fq;
#pragma unroll
        for (int ai = 0; ai < 2; ++ai)
#pragma unroll
            for (int m = 0; m < 4; ++m) { bf16_t* rowp = O + (size_t)(row0 + ai * HALF + m * 16) * ldc + col0;
#pragma unroll
                for (int bj = 0; bj < 2; ++bj) { const f32x4 v0 = acc[ai][bj][m][0] * sc, v1 = acc[ai][bj][m][1] * sc;
                    u32x4 w; w.x = cvt_pk_bf16(v0[0], v0[1]); w.y = cvt_pk_bf16(v0[2], v0[3]); w.z = cvt_pk_bf16(v1[0], v1[1]); w.w = cvt_pk_bf16(v1[2], v1[3]);
                    *(u32x4*)(rowp + bj * HALF) = w; } }
    }
};
typedef EpiBf16T<false> EpiBf16;
struct EpiSwiglu8 {
    static constexpr bool PERM = true, HALF_M = false, FP8 = true;
    unsigned char* O; int ldc; int ncol;
    __device__ __forceinline__ void operator()(const Acc& acc, const Unit& u, int wr, int wc, int fr, int fq) const {
        const int row0 = u.pm * BM + wr * 64 + fr, col0 = (u.pn % ncol) * HALF + wc * 32 + 8 * fq;
#pragma unroll
        for (int ai = 0; ai < 2; ++ai)
#pragma unroll
            for (int m = 0; m < 4; ++m) { unsigned char* rowp = O + (size_t)(row0 + ai * HALF + m * 16) * ldc + col0;
                float o[8];
#pragma unroll
                for (int n = 0; n < 2; ++n)
#pragma unroll
                    for (int j = 0; j < 4; ++j) o[n * 4 + j] = siluf_(acc[ai][0][m][n][j] * 0.015625f) * (acc[ai][1][m][n][j] * 0.25f);
                u32x2 w; w.x = cvt4_fp8(o[0], o[1], o[2], o[3]); w.y = cvt4_fp8(o[4], o[5], o[6], o[7]);
                *(u32x2*)rowp = w; }
    }
};
struct EpiSigMul {
    static constexpr bool PERM = true, HALF_M = false, FP8 = false;
    bf16_t* O; int ldc; const bf16_t* P; int ldp;
    __device__ __forceinline__ void operator()(const Acc& acc, const Unit& u, int wr, int wc, int fr, int fq) const {
        const int row0 = u.pm * BM + wr * 64 + fr, col0 = u.pn * BM + wc * 32 + 8 * fq;
#pragma unroll
        for (int ai = 0; ai < 2; ++ai)
#pragma unroll
            for (int m = 0; m < 4; ++m) { const size_t r = (size_t)(row0 + ai * HALF + m * 16);
#pragma unroll
                for (int bj = 0; bj < 2; ++bj) { const u32x4 pv = *(const u32x4*)(P + r * ldp + col0 + bj * HALF); const f32x4 v0 = acc[ai][bj][m][0], v1 = acc[ai][bj][m][1];
                    float o[8];
#pragma unroll
                    for (int j = 0; j < 4; ++j) { const unsigned pw = pv[j]; const float plo = __uint_as_float(pw << 16), phi = __uint_as_float(pw & 0xffff0000u);
                        const float a = (j < 2) ? v0[2 * j] : v1[2 * j - 4], b = (j < 2) ? v0[2 * j + 1] : v1[2 * j - 3];
                        o[2 * j] = sigmoidf_(a) * plo; o[2 * j + 1] = sigmoidf_(b) * phi; }
                    u32x4 w; w.x = cvt_pk_bf16(o[0], o[1]); w.y = cvt_pk_bf16(o[2], o[3]); w.z = cvt_pk_bf16(o[4], o[5]); w.w = cvt_pk_bf16(o[6], o[7]);
                    *(u32x4*)(O + r * ldc + col0 + bj * HALF) = w; }
                if (m == 3) asm volatile("" ::: "memory"); }
    }
};
struct EpiBranch {
    static constexpr bool PERM = true, HALF_M = false, FP8 = false;
    const bf16_t* Hg; float* tmp; bf16_t* mixb;
    __device__ __forceinline__ void operator()(const Acc& acc, const Unit& u, int wr, int wc, int fr, int fq) const {
        const int n4 = u.pn >> 2, ct = u.pn & 3;
        const int row0 = u.pm * BM + wr * 64 + fr, col0 = ct * BM + wc * 32 + 8 * fq;
#pragma unroll
        for (int ai = 0; ai < 2; ++ai)
#pragma unroll
            for (int m = 0; m < 4; ++m) { const size_t r = (size_t)(row0 + ai * HALF + m * 16);
#pragma unroll
                for (int bj = 0; bj < 2; ++bj) { const int c = col0 + bj * HALF;
                    const u32x4 gv = *(const u32x4*)(Hg + r * HP + n4 * 1024 + c); const f32x4 v0 = acc[ai][bj][m][0], v1 = acc[ai][bj][m][1];
                    float o[8];
#pragma unroll
                    for (int j = 0; j < 4; ++j) { const unsigned gw = gv[j]; const float glo = __uint_as_float(gw << 16), ghi = __uint_as_float(gw & 0xffff0000u);
                        const float a = (j < 2) ? v0[2 * j] : v1[2 * j - 4], b = (j < 2) ? v0[2 * j + 1] : v1[2 * j - 3];
                        o[2 * j] = sigmoidf_(glo) * a; o[2 * j + 1] = sigmoidf_(ghi) * b; }
                    float* tp = tmp + r * 1024 + c;
                    if (n4 > 0) { const f32x4 p0 = *(const f32x4*)tp, p1 = *(const f32x4*)(tp + 4);
#pragma unroll
                        for (int j = 0; j < 4; ++j) { o[j] += p0[j]; o[4 + j] += p1[j]; } }
                    if (n4 < 3) { *(f32x4*)tp = (f32x4){o[0], o[1], o[2], o[3]}; *(f32x4*)(tp + 4) = (f32x4){o[4], o[5], o[6], o[7]}; }
                    else { u32x4 w; w.x = cvt_pk_bf16(o[0], o[1]); w.y = cvt_pk_bf16(o[2], o[3]); w.z = cvt_pk_bf16(o[4], o[5]); w.w = cvt_pk_bf16(o[6], o[7]); *(u32x4*)(mixb + r * 1024 + c) = w; } }
                if (m & 1) asm volatile("" ::: "memory"); }
    }
};
struct EpiBranchH {
    static constexpr bool PERM = true, HALF_M = true, FP8 = false;
    const bf16_t* Hg; bf16_t* mixb;
    __device__ __forceinline__ void operator()(Acc& acc, const Unit& u, int wr, int wc, int fr, int fq) const {
        const int n4 = u.pn >> 2, ct = u.pn & 3;
        const int row0 = u.pm * HALF + wr * 64 + fr, col0 = ct * BM + wc * 32 + 8 * fq;
#pragma unroll
        for (int m = 0; m < 4; ++m) { const size_t r = (size_t)(row0 + m * 16);
#pragma unroll
            for (int bj = 0; bj < 2; ++bj) { const int c = col0 + bj * HALF;
                const u32x4 gv = *(const u32x4*)(Hg + r * HP + n4 * 1024 + c);
                f32x4 g0, g1;
                g0[0] = sigmoidf_(__uint_as_float(gv.x << 16)); g0[1] = sigmoidf_(__uint_as_float(gv.x & 0xffff0000u)); g0[2] = sigmoidf_(__uint_as_float(gv.y << 16)); g0[3] = sigmoidf_(__uint_as_float(gv.y & 0xffff0000u));
                g1[0] = sigmoidf_(__uint_as_float(gv.z << 16)); g1[1] = sigmoidf_(__uint_as_float(gv.z & 0xffff0000u)); g1[2] = sigmoidf_(__uint_as_float(gv.w << 16)); g1[3] = sigmoidf_(__uint_as_float(gv.w & 0xffff0000u));
                const f32x4 p0 = g0 * acc[0][bj][m][0], p1 = g1 * acc[0][bj][m][1];
                if (n4 == 0) { acc[1][bj][m][0] = p0; acc[1][bj][m][1] = p1; } else { acc[1][bj][m][0] += p0; acc[1][bj][m][1] += p1; }
                if (n4 == 3) { const f32x4 o0 = acc[1][bj][m][0], o1 = acc[1][bj][m][1]; u32x4 w; w.x = cvt_pk_bf16(o0[0], o0[1]); w.y = cvt_pk_bf16(o0[2], o0[3]); w.z = cvt_pk_bf16(o1[0], o1[1]); w.w = cvt_pk_bf16(o1[2], o1[3]);
                    *(u32x4*)(mixb + r * 1024 + c) = w; } } }
    }
};
template <bool F8>
struct EpiResidT {
    static constexpr bool PERM = false, HALF_M = false, FP8 = F8;
    const float* base; float* out; const bf16_t* add; float sc;
    __device__ __forceinline__ void operator()(const Acc& acc, const Unit& u, int wr, int wc, int fr, int fq) const {
        const int row0 = u.pm * BM + wr * 64 + fr, col0 = u.pn * BM + wc * 32 + 4 * fq;
#pragma unroll
        for (int ai = 0; ai < 2; ++ai)
#pragma unroll
            for (int m = 0; m < 4; ++m) { const size_t off = (size_t)(row0 + ai * HALF + m * 16) * 1024 + col0;
#pragma unroll
                for (int bj = 0; bj < 2; ++bj)
#pragma unroll
                    for (int n = 0; n < 2; ++n) { const size_t o = off + bj * HALF + n * 16; const f32x4 bs = *(const f32x4*)(base + o); f32x4 v = bs * ALPHA + acc[ai][bj][m][n] * sc;
                        if (add) { const u32x2 av = *(const u32x2*)(add + o); v[0] += __uint_as_float(av.x << 16); v[1] += __uint_as_float(av.x & 0xffff0000u); v[2] += __uint_as_float(av.y << 16); v[3] += __uint_as_float(av.y & 0xffff0000u); }
                        *(f32x4*)(out + o) = v; }
                if (m & 1) asm volatile("" ::: "memory"); }
    }
};
typedef EpiResidT<false> EpiResid;
struct EpiQ {
    static constexpr bool PERM = false, HALF_M = false, FP8 = false;
    bf16_t* Qb; const float* ropeM; const LAS float* rs;
    __device__ __forceinline__ void operator()(const Acc& acc, const Unit& u, int wr, int wc, int fr, int fq) const {
#pragma unroll
        for (int bj = 0; bj < 2; ++bj) { const int gb = u.pn * BM + bj * HALF + wc * 32; if (gb >= 384) continue;
            const int hd = gb / 96, part = (gb % 96) / 32;
#pragma unroll
            for (int ai = 0; ai < 2; ++ai)
#pragma unroll
                for (int m = 0; m < 4; ++m) { const int rl = ai * HALF + wr * 64 + m * 16 + fr, t = u.pm * BM + rl, b = t >> 11, s = t & 2047; const float sc = rs[rl] * QSCALE;
                    f32x4 x1 = acc[ai][bj][m][0] * sc, x2 = acc[ai][bj][m][1] * sc;
                    if (part == 2) { const f32x4 cs = *(const f32x4*)(ropeM + (size_t)t * 32 + 4 * fq), sn = *(const f32x4*)(ropeM + (size_t)t * 32 + 16 + 4 * fq);
                        const f32x4 o1 = x1 * cs - x2 * sn, o2 = x2 * cs + x1 * sn; x1 = o1; x2 = o2; }
                    bf16_t* qp = Qb + ((size_t)((b * 4 + hd) * SEQ + s)) * 96 + part * 32 + 4 * fq;
                    u32x2 w1, w2; w1.x = cvt_pk_bf16(x1[0], x1[1]); w1.y = cvt_pk_bf16(x1[2], x1[3]); w2.x = cvt_pk_bf16(x2[0], x2[1]); w2.y = cvt_pk_bf16(x2[2], x2[3]);
                    *(u32x2*)qp = w1; *(u32x2*)(qp + 16) = w2; asm volatile("" ::: "memory"); } }
    }
};
struct EpiKV {
    static constexpr bool PERM = false, HALF_M = false, FP8 = false;
    bf16_t* Kb; bf16_t* Vt; const LAS float* rs;
    __device__ __forceinline__ void operator()(const Acc& acc, const Unit& u, int wr, int wc, int fr, int fq) const {
#pragma unroll
        for (int bj = 0; bj < 2; ++bj) { const int gb = u.pn * BM + bj * HALF + wc * 32; const int hd = gb / 128, part = (gb % 128) / 32;
#pragma unroll
            for (int ai = 0; ai < 2; ++ai)
#pragma unroll
                for (int m = 0; m < 4; ++m) { const int rl = ai * HALF + wr * 64 + m * 16 + fr, t = u.pm * BM + rl, b = t >> 11, s = t & 2047; const float sc = rs[rl];
                    const f32x4 x1 = acc[ai][bj][m][0] * sc, x2 = acc[ai][bj][m][1] * sc;
                    if (part < 2) { bf16_t* kp = Kb + ((size_t)((b * 4 + hd) * SEQ + s)) * 96 + part * 32 + 4 * fq;
                        u32x2 w1, w2; w1.x = cvt_pk_bf16(x1[0], x1[1]); w1.y = cvt_pk_bf16(x1[2], x1[3]); w2.x = cvt_pk_bf16(x2[0], x2[1]); w2.y = cvt_pk_bf16(x2[2], x2[3]);
                        *(u32x2*)kp = w1; *(u32x2*)(kp + 16) = w2; }
                    else { bf16_t* vp = Vt + ((size_t)((b * 4 + hd) * 64 + (part - 2) * 32 + 4 * fq)) * SEQ + s;
#pragma unroll
                        for (int j = 0; j < 4; ++j) { vp[(size_t)j * SEQ] = f2bf(x1[j]); vp[(size_t)(16 + j) * SEQ] = f2bf(x2[j]); } }
                    asm volatile("" ::: "memory"); } }
    }
};
}

#define XB_TMO      128
#define XB_XCNT(j)  (256  + 64 * (j))
#define XB_XSUB(j)  (1280 + 64 * (j))
#define XB_XGEN(j)  (2304 + 64 * (j))
#define XB_TOP      3328
#define XB_TOPGEN   3392
#define XCD_BAR_WORDS 3456
#define XB_SPIN_CAP (1u << 18)
__device__ __forceinline__ unsigned xb_ld(unsigned* p)              { return __hip_atomic_load(p, __ATOMIC_RELAXED, __HIP_MEMORY_SCOPE_AGENT); }
__device__ __forceinline__ unsigned xb_add(unsigned* p, unsigned v) { return __hip_atomic_fetch_add(p, v, __ATOMIC_RELAXED, __HIP_MEMORY_SCOPE_AGENT); }
__device__ __forceinline__ unsigned xb_xcc_id() { return (unsigned)__builtin_amdgcn_s_getreg((3 << 11) | 20) & 0xFu; }
#define XB_SPIN(cond, bar) do { unsigned _sp = 0; while (cond) { __builtin_amdgcn_s_sleep(1); \
    if ((++_sp & 255u) == 0u) { if (xb_ld(&(bar)[XB_TMO])) break; if (_sp > XB_SPIN_CAP) { atomicAdd(&(bar)[XB_TMO], 1u); break; } } } } while (0)
struct XcdBarrier { unsigned* bar; unsigned x; volatile LAS unsigned* st; };
__device__ __forceinline__ XcdBarrier xcd_barrier_post(unsigned* bar, volatile LAS unsigned* st) {
    XcdBarrier b; b.bar = bar; b.x = xb_xcc_id(); b.st = st;
    if (threadIdx.x == 0) (void)xb_add(&bar[XB_XCNT(b.x)], 1u);
    return b;
}
__device__ __forceinline__ void xcd_barrier_complete(unsigned* bar, unsigned x, unsigned& nloc, unsigned& nx) {
    const unsigned G = gridDim.x * gridDim.y * gridDim.z;
    unsigned sum, cnt, mine, sp = 0u;
    for (;;) {
        sum = 0u; cnt = 0u; mine = 0u;
#pragma unroll
        for (unsigned j = 0; j < 16; ++j) { const unsigned c = xb_ld(&bar[XB_XCNT(j)]); sum += c; cnt += (c > 0u) ? 1u : 0u; mine = (j == x) ? c : mine; }
        if (sum == G) break;
        __builtin_amdgcn_s_sleep(1);
        if ((++sp & 255u) == 0u) { if (xb_ld(&bar[XB_TMO])) break; if (sp > XB_SPIN_CAP) { atomicAdd(&bar[XB_TMO], 1u); break; } }
    }
    nloc = mine > 0u ? mine : 1u; nx = cnt > 0u ? cnt : 1u;
}
__device__ __forceinline__ void xcd_barrier(const XcdBarrier& b) {
    asm volatile("s_waitcnt vmcnt(0)" ::: "memory");
    __syncthreads();
    if (threadIdx.x == 0) {
        unsigned* bar = b.bar;
        __builtin_amdgcn_s_waitcnt(0);
        unsigned nloc = b.st[0], nx = b.st[1];
        if (nloc == 0u) { xcd_barrier_complete(bar, b.x, nloc, nx); b.st[0] = nloc; b.st[1] = nx; }
        const unsigned old = xb_add(&bar[XB_XSUB(b.x)], 1u);
        const unsigned gen = old / nloc;
        if (old + 1u == (gen + 1u) * nloc) {
            __builtin_amdgcn_fence(__ATOMIC_RELEASE, "agent");
            asm volatile("s_waitcnt vmcnt(0)" ::: "memory");
            const unsigned og = xb_add(&bar[XB_TOP], 1u);
            const unsigned tg = og / nx;
            if (og + 1u == (tg + 1u) * nx) xb_add(&bar[XB_TOPGEN], 1u);
            else XB_SPIN(xb_ld(&bar[XB_TOPGEN]) == tg, bar);
            __builtin_amdgcn_fence(__ATOMIC_ACQUIRE, "agent");
            xb_add(&bar[XB_XGEN(b.x)], 1u);
            asm volatile("s_waitcnt vmcnt(0)" ::: "memory");
        } else {
            XB_SPIN(xb_ld(&bar[XB_XGEN(b.x)]) == gen, bar);
            __builtin_amdgcn_fence(__ATOMIC_ACQUIRE, "agent");
            asm volatile("s_waitcnt vmcnt(0)" ::: "memory");
        }
    }
    __syncthreads();
}

__device__ __forceinline__ int vzero() { int z; asm volatile("v_mov_b32 %0, 0" : "=v"(z)); return z; }
__device__ __forceinline__ int opaque0() { int z; asm volatile("s_mov_b32 %0, 0" : "=s"(z)); return z; }
struct Args { const void* in[36]; float* out; unsigned char* ws; int ph_lo, ph_hi, bar_region, variant; };
struct Frame {
    LAS unsigned char* lds;
    unsigned char* ws;
    const void* const* in;
    float* out;
    int tid, lane, wave, G, bid, gw, NGW;
};
__device__ __forceinline__ Frame reframe(const Frame& F) {
    Frame P = F; const int z = opaque0(), vz = vzero();
    P.ws = F.ws + z; P.out = F.out + z; P.lds = F.lds + z; P.bid = F.bid + z; P.G = F.G + z; P.wave = F.wave + z; P.gw = P.bid * 8 + P.wave; P.NGW = P.G * 8; P.tid = F.tid + vz; P.lane = F.lane + vz;
    return P;
}
#define IN_F(k) ((const float*)F.in[k])
#define WSP(T_, off) ((T_*)(F.ws + (off)))

__device__ __forceinline__ void tr_item(const float* W, int N, bf16_t* WT, int ldd, int drow0, int k0, int n0, const float* kscale, LAS float* scr, int lane) {
#pragma unroll 8
    for (int i = 0; i < 32; ++i) { const int kk = 2 * i + (lane >> 5); scr[kk * 33 + (lane & 31)] = W[(size_t)(k0 + kk) * N + n0 + (lane & 31)]; }
    WSYNC();
    const int c = lane & 7;
    float ks[8];
#pragma unroll
    for (int q = 0; q < 8; ++q) ks[q] = kscale ? kscale[k0 + 8 * c + q] : 1.0f;
#pragma unroll
    for (int j = 0; j < 4; ++j) { const int n = (lane >> 3) + 8 * j; const LAS float* s = scr + (8 * c) * 33 + n;
        u32x4 o; o.x = cvt_pk_bf16(s[0 * 33] * ks[0], s[1 * 33] * ks[1]); o.y = cvt_pk_bf16(s[2 * 33] * ks[2], s[3 * 33] * ks[3]); o.z = cvt_pk_bf16(s[4 * 33] * ks[4], s[5 * 33] * ks[5]); o.w = cvt_pk_bf16(s[6 * 33] * ks[6], s[7 * 33] * ks[7]);
        *(u32x4*)(WT + (size_t)(drow0 + n) * ldd + k0 + 8 * c) = o; }
    WSYNC();
}
__device__ __forceinline__ void tr_item8(const float* W, int N, unsigned char* WT, int ldd, int drow0, int k0, int n0, float scale, LAS float* scr, int lane) {
#pragma unroll 8
    for (int i = 0; i < 32; ++i) { const int kk = 2 * i + (lane >> 5); scr[kk * 33 + (lane & 31)] = W[(size_t)(k0 + kk) * N + n0 + (lane & 31)]; }
    WSYNC();
    const int c = lane & 3;
#pragma unroll
    for (int j = 0; j < 2; ++j) { const int n = (lane >> 2) + 16 * j; const LAS float* s = scr + (16 * c) * 33 + n;
        u32x4 o;
        o.x = cvt4_fp8(s[0 * 33] * scale, s[1 * 33] * scale, s[2 * 33] * scale, s[3 * 33] * scale); o.y = cvt4_fp8(s[4 * 33] * scale, s[5 * 33] * scale, s[6 * 33] * scale, s[7 * 33] * scale);
        o.z = cvt4_fp8(s[8 * 33] * scale, s[9 * 33] * scale, s[10 * 33] * scale, s[11 * 33] * scale); o.w = cvt4_fp8(s[12 * 33] * scale, s[13 * 33] * scale, s[14 * 33] * scale, s[15 * 33] * scale);
        *(u32x4*)(WT + (size_t)(drow0 + n) * ldd + k0 + 16 * c) = o; }
    WSYNC();
}
template <int MAP>
__device__ __forceinline__ bool tr_job8(int& r, const float* W, int batch, int K, int N, unsigned char* dst, size_t dstride, int ldd, float scale, LAS float* scr, int lane) {
    const int nkb = K / 64, nnb = N / 32, per = nkb * nnb, total = per * batch;
    if (r >= total) { r -= total; return false; }
    const int bi = r / per, q = r % per, kb = q / nnb, nb = q % nnb, n0 = nb * 32;
    int drow0;
    if (MAP == 0) drow0 = n0; else drow0 = (n0 >> 7) * 256 + (n0 & 127) + (MAP == 3 ? 128 : 0);
    tr_item8(W + (size_t)bi * K * N, N, dst + (size_t)bi * dstride, ldd, drow0, kb * 64, n0, scale, scr, lane);
    return true;
}
__device__ __forceinline__ int win_map(int n) {
    if (n < 448) return n;
    if (n < 576) return C_CKV + (n - 448);
    if (n < 608) return C_KR + (n - 576);
    return C_HQ + (n - 608);
}
template <int MAP>
__device__ __forceinline__ bool tr_job(int& r, const float* W, int batch, int K, int N, bf16_t* dst, size_t dstride, int ldd, const float* kscale, int ksstride, LAS float* scr, int lane) {
    const int nkb = K / 64, nnb = N / 32, per = nkb * nnb, total = per * batch;
    if (r >= total) { r -= total; return false; }
    const int bi = r / per, q = r % per, kb = q / nnb, nb = q % nnb, n0 = nb * 32;
    int drow0;
    if (MAP == 0) drow0 = n0; else if (MAP == 1) drow0 = win_map(n0); else drow0 = (n0 >> 7) * 256 + (n0 & 127) + (MAP == 3 ? 128 : 0);
    tr_item(W + (size_t)bi * K * N, N, dst + (size_t)bi * dstride, ldd, drow0, kb * 64, n0, kscale ? kscale + bi * ksstride : nullptr, scr, lane);
    return true;
}
__device__ __forceinline__ void p0_prologue(const Frame& F) {
    LAS float* scr = (LAS float*)(F.lds + LDS_STAGE + F.wave * 16384);
    const int lane = F.lane;
    constexpr int NITEMS = 4 * 16 * 211 + 4 * 4 * 8 + 4 * 3 * 12 + 4 * 2 * 16 + 16 * 4 * 32 + 4 * 16 * 32 + 2 * 2 * 16 * 112 + 2 * 56 * 32 + 2 * 16 * 16 * 112 + 16 * 56 * 32 + 4 * 16 * 32 + 4 * 4 * 32;
    for (int it = F.gw; it < NITEMS; it += F.NGW) {
        int r = it;
        if (tr_job8<2>(r, IN_F(29), 16, 1024, DFF, WSP(unsigned char, WS_WMU), (size_t)7168 * 1024, 1024, 64.0f, scr, lane)) continue;
        if (tr_job8<3>(r, IN_F(30), 16, 1024, DFF, WSP(unsigned char, WS_WMU), (size_t)7168 * 1024, 1024, 64.0f, scr, lane)) continue;
        if (tr_job8<0>(r, IN_F(31), 16, DFF, 1024, WSP(unsigned char, WS_WMD), (size_t)1024 * DFF, DFF, 128.0f, scr, lane)) continue;
        if (tr_job<1>(r, IN_F(3), 4, 1024, 6752, WSP(bf16_t, WS_WIN), (size_t)HP * 1024, 1024, nullptr, 0, scr, lane)) continue;
        if (tr_job8<2>(r, IN_F(25), 2, 1024, DFF, WSP(unsigned char, WS_WFFU), (size_t)7168 * 1024, 1024, 64.0f, scr, lane)) continue;
        if (tr_job8<3>(r, IN_F(26), 2, 1024, DFF, WSP(unsigned char, WS_WFFU), (size_t)7168 * 1024, 1024, 64.0f, scr, lane)) continue;
        if (tr_job8<0>(r, IN_F(27), 2, DFF, 1024, WSP(unsigned char, WS_WFFD), (size_t)1024 * DFF, DFF, 128.0f, scr, lane)) continue;
        if (tr_job<0>(r, IN_F(21), 16, 256, 1024, WSP(bf16_t, WS_WB), (size_t)1024 * 256, 256, nullptr, 0, scr, lane)) continue;
        if (tr_job<0>(r, IN_F(22), 4, 1024, 1024, WSP(bf16_t, WS_WO), (size_t)1024 * 1024, 1024, nullptr, 0, scr, lane)) continue;
        if (tr_job<0>(r, IN_F(32), 4, 1024, 1024, WSP(bf16_t, WS_WPG), (size_t)1024 * 1024, 1024, nullptr, 0, scr, lane)) continue;
        if (tr_job<0>(r, IN_F(33), 4, 256, 1024, WSP(bf16_t, WS_WPP), (size_t)1024 * 256, 256, nullptr, 0, scr, lane)) continue;
        if (tr_job<0>(r, IN_F(12), 4, 256, 256, WSP(bf16_t, WS_WGLU), (size_t)256 * 256, 256, nullptr, 0, scr, lane)) continue;
        if (tr_job<0>(r, IN_F(15), 4, 192, 384, WSP(bf16_t, WS_WUQ), (size_t)512 * 256, 256, IN_F(13), 192, scr, lane)) continue;
        tr_job<0>(r, IN_F(16), 4, 128, 512, WSP(bf16_t, WS_WUKV), (size_t)512 * 256, 256, IN_F(14), 128, scr, lane);
    }
    const int gt = F.bid * 512 + F.tid, NT_ = F.G * 512;
    { bf16_t* uq = WSP(bf16_t, WS_WUQ); bf16_t* ukv = WSP(bf16_t, WS_WUKV);
      for (int i = gt; i < 4 * 512 * 256; i += NT_) { const int n = (i >> 8) & 511, k = i & 255; if (n >= 384 || k >= 192) uq[i] = 0; if (k >= 128) ukv[i] = 0; }
      bf16_t* win = WSP(bf16_t, WS_WIN);
      for (int i = gt; i < 4 * 160 * 1024; i += NT_) { const int l = i / (160 * 1024), q = i % (160 * 1024), rr = q >> 10, k = q & 1023; const int row = rr < 64 ? 448 + rr : 672 + (rr - 64); win[((size_t)l * HP + row) * 1024 + k] = 0; } }
    { const f32x4* x4 = (const f32x4*)IN_F(0); u32x2* xb = WSP(u32x2, WS_XB);
      for (int i = gt; i < T * D / 4; i += NT_) { const f32x4 v = x4[i]; u32x2 w; w.x = cvt_pk_bf16(v[0], v[1]); w.y = cvt_pk_bf16(v[2], v[3]); xb[i] = w; }
      const f32x4* p4 = (const f32x4*)IN_F(1); u32x2* pb = WSP(u32x2, WS_PB);
      for (int i = gt; i < DEPTH * T * 256 / 4; i += NT_) { const f32x4 v = p4[i]; u32x2 w; w.x = cvt_pk_bf16(v[0], v[1]); w.y = cvt_pk_bf16(v[2], v[3]); pb[i] = w; } }
    { const int* pos = (const int*)F.in[2]; float* rm = WSP(float, WS_ROPEM); float* rr = WSP(float, WS_ROPER);
      for (int i = gt; i < T * 48; i += NT_) { const int t = i / 48, j = i % 48; const bool isM = j < 16; const int jj = isM ? j : j - 16; const float half = isM ? 16.f : 32.f;
          const float inv = exp2f(-(float)jj / half * 13.287712379549449f);
          const float ang = (float)pos[t] * inv;
          const double ad = (double)ang, k2 = __builtin_rint(ad * 0.15915494309189535); const float red = (float)(ad - k2 * 6.283185307179586);
          const float c = __cosf(red), s = __sinf(red);
          if (isM) { rm[t * 32 + jj] = c; rm[t * 32 + 16 + jj] = s; } else { rr[t * 64 + jj] = c; rr[t * 64 + 32 + jj] = s; } } }
    { float* abar = (float*)(F.ws + WS_S5P + S5P_ABAR); bf16_t* Bm = (bf16_t*)(F.ws + WS_S5P + S5P_BM); bf16_t* Cm = (bf16_t*)(F.ws + WS_S5P + S5P_CM);
      for (int i = gt; i < DEPTH * 16 * 64; i += NT_) { const int lg = i >> 6, p = i & 63;
          const float dt = __expf(IN_F(6)[lg]), lr = IN_F(4)[i], li = IN_F(5)[i];
          const float mag = __expf(lr * dt); const double ad = (double)(li * dt), k2 = __builtin_rint(ad * 0.15915494309189535); const float red = (float)(ad - k2 * 6.283185307179586);
          const float are = mag * __cosf(red), aim = mag * __sinf(red);
          abar[i * 2] = are; abar[i * 2 + 1] = aim;
          const float den = lr * lr + li * li, nre = are - 1.0f, nim = aim;
          const float cre = (nre * lr + nim * li) / den, cim = (nim * lr - nre * li) / den;
          const float* br = IN_F(7) + (size_t)i * 16; const float* bi = IN_F(8) + (size_t)i * 16;
#pragma unroll
          for (int c = 0; c < 16; ++c) { Bm[((size_t)lg * 128 + p) * 16 + c] = f2bf(cre * br[c] - cim * bi[c]); Bm[((size_t)lg * 128 + 64 + p) * 16 + c] = f2bf(cre * bi[c] + cim * br[c]); }
#pragma unroll
          for (int c = 0; c < 16; ++c) { Cm[((size_t)lg * 16 + c) * 128 + p] = f2bf(IN_F(9)[((size_t)lg * 16 + c) * 64 + p]); Cm[((size_t)lg * 16 + c) * 128 + 64 + p] = f2bf(-IN_F(10)[((size_t)lg * 16 + c) * 64 + p]); } }
      float* lb = (float*)(F.ws + WS_S5P + S5P_LB);
      for (int i = gt; i < 256; i += NT_) { float r0 = IN_F(17)[i], r1 = IN_F(17)[256 + i], r2 = IN_F(17)[512 + i], r3 = IN_F(17)[768 + i]; const float mx = fmaxf(fmaxf(r0, r1), fmaxf(r2, r3));
          const float e0 = __expf(r0 - mx), e1 = __expf(r1 - mx), e2 = __expf(r2 - mx), e3 = __expf(r3 - mx), s = e0 + e1 + e2 + e3;
          lb[i] = 0.f; lb[256 + i] = e1 / s; lb[512 + i] = (e1 + e2) / s; lb[768 + i] = (e1 + e2 + e3) / s; } }
}

template <bool OUT>
__device__ __forceinline__ void s5_item(const Frame& F, int layer, int idx, LAS unsigned char* scr) {
    const int lane = F.lane + vzero(), r16 = lane & 15, g4 = lane >> 4;
    const int bg = idx >> 5, n = idx & 31, b = bg >> 4, g = bg & 15;
    LAS float* bu = (LAS float*)scr;
    LAS bf16_t* xs = (LAS bf16_t*)(scr + 8448);
    const float* abar = (const float*)(F.ws + WS_S5P + S5P_ABAR) + ((size_t)(layer * 16 + g) * 64 + lane) * 2;
    const float ar = abar[0], ai = abar[1];
    const bf16_t* Bm = (const bf16_t*)(F.ws + WS_S5P + S5P_BM) + (size_t)(layer * 16 + g) * 128 * 16;
    const bf16_t* Cm = (const bf16_t*)(F.ws + WS_S5P + S5P_CM) + (size_t)(layer * 16 + g) * 16 * 128;
    const bf16_t* H = WSP(const bf16_t, WS_H);
    Frag zf; zf.q = (u32x4){0u, 0u, 0u, 0u};
    bf16x8 bfr[8];
#pragma unroll
    for (int nb = 0; nb < 8; ++nb) bfr[nb] = (g4 < 2) ? *(const bf16x8*)(Bm + (nb * 16 + r16) * 16 + 8 * g4) : zf.v;
    bf16x8 cfr[4];
    if (OUT) {
#pragma unroll
        for (int ks = 0; ks < 4; ++ks) cfr[ks] = *(const bf16x8*)(Cm + r16 * 128 + 32 * ks + 8 * g4); }
    float xr = 0.f, xi = 0.f;
    if (OUT) { const float* ci = WSP(const float, WS_S5C) + ((size_t)(bg * 32 + n) * 64 + lane) * 2; xr = ci[0]; xi = ci[1]; }
    const float dsk = OUT ? IN_F(11)[layer * 256 + g * 16 + r16] : 0.f;
    const size_t tok0 = (size_t)b * SEQ + n * 64;
    bf16x8 afr_n = (g4 < 2) ? *(const bf16x8*)(H + (tok0 + r16) * HP + C_US5 + g * 16 + 8 * g4) : zf.v;
    bf16_t un[4] = {0, 0, 0, 0};
    if (OUT) {
#pragma unroll
        for (int r = 0; r < 4; ++r) un[r] = H[(tok0 + 4 * g4 + r) * HP + C_US5 + g * 16 + r16]; }
#pragma unroll 1
    for (int sub = 0; sub < 4; ++sub) {
        const size_t t0 = tok0 + sub * 16;
        const bf16x8 afr = afr_n; bf16_t uc[4];
#pragma unroll
        for (int r = 0; r < 4; ++r) uc[r] = un[r];
        if (sub < 3) { afr_n = (g4 < 2) ? *(const bf16x8*)(H + (t0 + 16 + r16) * HP + C_US5 + g * 16 + 8 * g4) : zf.v;
            if (OUT) {
#pragma unroll
                for (int r = 0; r < 4; ++r) un[r] = H[(t0 + 16 + 4 * g4 + r) * HP + C_US5 + g * 16 + r16]; } }
#pragma unroll
        for (int nb = 0; nb < 8; ++nb) { const f32x4 c = mfma16(afr, bfr[nb], (f32x4){0.f, 0.f, 0.f, 0.f});
#pragma unroll
            for (int r = 0; r < 4; ++r) bu[(4 * g4 + r) * 132 + nb * 16 + r16] = c[r]; }
        WSYNC();
#pragma unroll
        for (int tk = 0; tk < 16; ++tk) { const float bre = bu[tk * 132 + lane], bim = bu[tk * 132 + 64 + lane];
            const float nr = ar * xr - ai * xi + bre, ni = ar * xi + ai * xr + bim; xr = nr; xi = ni;
            if (OUT) { xs[tk * 136 + lane] = f2bf(xr); xs[tk * 136 + 64 + lane] = f2bf(xi); } }
        if (OUT) {
            WSYNC();
            f32x4 y = (f32x4){0.f, 0.f, 0.f, 0.f};
#pragma unroll
            for (int ks = 0; ks < 4; ++ks) { const bf16x8 a = *(const LAS bf16x8*)(xs + r16 * 136 + 32 * ks + 8 * g4); y = mfma16(a, cfr[ks], y); }
            bf16_t* pre = WSP(bf16_t, WS_S5PRE);
#pragma unroll
            for (int r = 0; r < 4; ++r) { const size_t t = t0 + 4 * g4 + r; pre[t * 256 + g * 16 + r16] = f2bf(gelu_tanh(y[r] + dsk * bf2f(uc[r]))); }
        }
        WSYNC();
    }
    if (!OUT) { float* e = WSP(float, WS_S5E) + ((size_t)(bg * 32 + n) * 64 + lane) * 2; e[0] = xr; e[1] = xi; }
}
__device__ __forceinline__ void s5_carry(const Frame& F, int layer) {
    const int gt = F.bid * 512 + F.tid;
    if (gt >= NBATCH * 16 * 64) return;
    const int bg = gt >> 6, p = gt & 63, g = bg & 15;
    const float* abar = (const float*)(F.ws + WS_S5P + S5P_ABAR) + ((size_t)(layer * 16 + g) * 64 + p) * 2;
    float pr = abar[0], pi = abar[1];
#pragma unroll
    for (int i = 0; i < 6; ++i) { const float nr = pr * pr - pi * pi, ni = 2.f * pr * pi; pr = nr; pi = ni; }
    const float* E = WSP(const float, WS_S5E); float* C = WSP(float, WS_S5C);
    float er[32], ei[32];
#pragma unroll
    for (int n = 0; n < 32; ++n) { const size_t o = ((size_t)(bg * 32 + n) * 64 + p) * 2; er[n] = E[o]; ei[n] = E[o + 1]; }
    float cr = 0.f, ci = 0.f;
#pragma unroll
    for (int n = 0; n < 32; ++n) { const float nr = pr * cr - pi * ci + er[n], ni = pr * ci + pi * cr + ei[n]; er[n] = cr; ei[n] = ci; cr = nr; ci = ni; }
#pragma unroll
    for (int n = 0; n < 32; ++n) { const size_t o = ((size_t)(bg * 32 + n) * 64 + p) * 2; C[o] = er[n]; C[o + 1] = ei[n]; }
}

template <bool OUT>
__device__ __forceinline__ void hg_item(const Frame& F, int layer, int idx, LAS unsigned char* scr) {
    const int lane = F.lane + vzero(), r16 = lane & 15, g4 = lane >> 4;
    const int bh = idx >> 5, sc = idx & 31, b = bh >> 2, h = bh & 3;
    LAS bf16_t* Qt = (LAS bf16_t*)scr;
    LAS bf16_t* Kt = (LAS bf16_t*)(scr + 2304);
    LAS bf16_t* Vs = (LAS bf16_t*)(scr + 4608);
    LAS float* dec = (LAS float*)(scr + 6656);
    const bf16_t* H = WSP(const bf16_t, WS_H);
    const float lbv = ((const float*)(F.ws + WS_S5P + S5P_LB))[layer * 256 + h * 64 + lane], oml = 1.0f - lbv;
    f32x4 S[4][4];
    if (OUT) { const float* si = WSP(const float, WS_HGI) + (size_t)(bh * 32 + sc) * 4096;
#pragma unroll
        for (int mb = 0; mb < 4; ++mb)
#pragma unroll
            for (int vb = 0; vb < 4; ++vb)
#pragma unroll
                for (int r = 0; r < 4; ++r) S[mb][vb][r] = si[(16 * mb + 4 * g4 + r) * 64 + 16 * vb + r16];
    } else {
#pragma unroll
        for (int mb = 0; mb < 4; ++mb)
#pragma unroll
            for (int vb = 0; vb < 4; ++vb) S[mb][vb] = (f32x4){0.f, 0.f, 0.f, 0.f};
    }
    float ltot = 0.f;
    const size_t tbase = (size_t)b * SEQ + sc * 64;
    unsigned rf[8], ri[8], rq[8]; u32x2 rg[4];
#define HG_LOAD(t0_) do { _Pragma("unroll") for (int p = 0; p < 8; ++p) { const bf16_t* r0 = H + ((t0_) + 2 * p) * HP + h * 64 + lane; const bf16_t* r1 = r0 + HP; \
            rf[p] = (unsigned)r0[C_HF] | ((unsigned)r1[C_HF] << 16); ri[p] = (unsigned)r0[C_HI] | ((unsigned)r1[C_HI] << 16); if (OUT) rq[p] = (unsigned)r0[C_HQ] | ((unsigned)r1[C_HQ] << 16); } \
        if (OUT) { _Pragma("unroll") for (int vb = 0; vb < 4; ++vb) rg[vb] = *(const u32x2*)(H + ((t0_) + r16) * HP + C_HG + h * 64 + 16 * vb + 4 * g4); } } while (0)
    HG_LOAD(tbase);
#pragma unroll 1
    for (int ch = 0; ch < 4; ++ch) {
        const size_t t0 = tbase + ch * 16;
        float bcum = 0.f;
#pragma unroll
        for (int tk = 0; tk < 16; ++tk) { const unsigned wf = rf[tk >> 1], wi = ri[tk >> 1];
            const float fv = (tk & 1) ? __uint_as_float(wf & 0xffff0000u) : __uint_as_float(wf << 16);
            const float sg = 1.0f / (1.0f + __expf(-fv)); const float forget = lbv + oml * sg; bcum += __logf(forget);
            const float kv_ = oml * (1.0f - sg), e = __expf(fmaxf(bcum, -80.0f));
            Kt[tk * 72 + lane] = f2bf(kv_ * __builtin_amdgcn_rcpf(e));
            if (OUT) { const unsigned wq = rq[tk >> 1]; const float qv = (tk & 1) ? __uint_as_float(wq & 0xffff0000u) : __uint_as_float(wq << 16); Qt[tk * 72 + lane] = f2bf(siluf_(qv) * e); }
            Vs[tk * 64 + lane] = (bf16_t)((tk & 1) ? (wi >> 16) : (wi & 0xffffu)); }
        dec[lane] = __expf(bcum); ltot += bcum;
        u32x2 gcur[4];
        if (OUT) {
#pragma unroll
            for (int vb = 0; vb < 4; ++vb) gcur[vb] = rg[vb]; }
        if (ch < 3) HG_LOAD(t0 + 16);
        WSYNC();
        Frag vfr[4], kfr[4];
#pragma unroll
        for (int vb = 0; vb < 4; ++vb) { vfr[vb].q = (u32x4){0u, 0u, 0u, 0u};
#pragma unroll
            for (int j = 0; j < 4; ++j) vfr[vb].h[j] = Vs[(4 * g4 + j) * 64 + 16 * vb + r16]; }
#pragma unroll
        for (int mb = 0; mb < 4; ++mb) { kfr[mb].q = (u32x4){0u, 0u, 0u, 0u};
#pragma unroll
            for (int j = 0; j < 4; ++j) kfr[mb].h[j] = Kt[(4 * g4 + j) * 72 + 16 * mb + r16]; }
        if (OUT) {
            f32x4 at = (f32x4){0.f, 0.f, 0.f, 0.f};
#pragma unroll
            for (int ks = 0; ks < 2; ++ks) { const bf16x8 a = *(const LAS bf16x8*)(Kt + r16 * 72 + 32 * ks + 8 * g4), bq = *(const LAS bf16x8*)(Qt + r16 * 72 + 32 * ks + 8 * g4); at = mfma16(a, bq, at); }
#pragma unroll
            for (int r = 0; r < 4; ++r) if (4 * g4 + r > r16) at[r] = 0.f;
            Frag pfr; pfr.q = (u32x4){0u, 0u, 0u, 0u}; pfr.u[0] = cvt_pk_bf16(at[0], at[1]); pfr.u[1] = cvt_pk_bf16(at[2], at[3]);
            Frag qfr[2];
#pragma unroll
            for (int ks = 0; ks < 2; ++ks) { qfr[ks].d[0] = *(const LAS u32x2*)(Qt + r16 * 72 + 32 * ks + 4 * g4); qfr[ks].d[1] = *(const LAS u32x2*)(Qt + r16 * 72 + 32 * ks + 16 + 4 * g4); }
            f32x4 o[4]; float ss = 0.f;
#pragma unroll
            for (int vb = 0; vb < 4; ++vb) { f32x4 a = (f32x4){0.f, 0.f, 0.f, 0.f};
#pragma unroll
                for (int ks = 0; ks < 2; ++ks) { Frag sf; sf.u[0] = cvt_pk_bf16(S[2 * ks][vb][0], S[2 * ks][vb][1]); sf.u[1] = cvt_pk_bf16(S[2 * ks][vb][2], S[2 * ks][vb][3]);
                    sf.u[2] = cvt_pk_bf16(S[2 * ks + 1][vb][0], S[2 * ks + 1][vb][1]); sf.u[3] = cvt_pk_bf16(S[2 * ks + 1][vb][2], S[2 * ks + 1][vb][3]); a = mfma16(sf.v, qfr[ks].v, a); }
                a = mfma16(vfr[vb].v, pfr.v, a); o[vb] = a; ss += a[0] * a[0] + a[1] * a[1] + a[2] * a[2] + a[3] * a[3]; }
            ss += __shfl_xor(ss, 16); ss += __shfl_xor(ss, 32);
            const float rs = rsqrtf(ss * (1.0f / 64.0f) + EPS);
            const size_t t = t0 + r16; bf16_t* Y = WSP(bf16_t, WS_Y);
#pragma unroll
            for (int vb = 0; vb < 4; ++vb) { const int vi0 = h * 64 + 16 * vb + 4 * g4; const u32x2 gv = gcur[vb]; const f32x4 ng = *(const f32x4*)(IN_F(18) + layer * 256 + vi0);
                const float g0 = __uint_as_float(gv.x << 16), g1 = __uint_as_float(gv.x & 0xffff0000u), g2 = __uint_as_float(gv.y << 16), g3 = __uint_as_float(gv.y & 0xffff0000u);
                u32x2 w; w.x = cvt_pk_bf16(o[vb][0] * rs * ng[0] * siluf_(g0), o[vb][1] * rs * ng[1] * siluf_(g1)); w.y = cvt_pk_bf16(o[vb][2] * rs * ng[2] * siluf_(g2), o[vb][3] * rs * ng[3] * siluf_(g3));
                *(u32x2*)(Y + t * 1024 + 512 + vi0) = w; }
        }
#pragma unroll
        for (int mb = 0; mb < 4; ++mb) { const f32x4 dv = *(const LAS f32x4*)(dec + 16 * mb + 4 * g4);
#pragma unroll
            for (int vb = 0; vb < 4; ++vb) S[mb][vb] = mfma16(kfr[mb].v, vfr[vb].v, S[mb][vb]) * dv; }
        WSYNC();
    }
#undef HG_LOAD
    if (!OUT) { float* se = WSP(float, WS_HGE) + (size_t)(bh * 32 + sc) * 4096;
#pragma unroll
        for (int mb = 0; mb < 4; ++mb)
#pragma unroll
            for (int vb = 0; vb < 4; ++vb)
#pragma unroll
                for (int r = 0; r < 4; ++r) se[(16 * mb + 4 * g4 + r) * 64 + 16 * vb + r16] = S[mb][vb][r];
        WSP(float, WS_HGD)[(size_t)(bh * 32 + sc) * 64 + lane] = __expf(ltot); }
}
__device__ __forceinline__ void hg_carry(const Frame& F) {
    const int gt = F.bid * 512 + F.tid; if (gt >= 32 * 4096) return;
    const int bh = gt >> 12, kv = gt & 4095, k = kv >> 6;
    const float* E = WSP(const float, WS_HGE); const float* Dt = WSP(const float, WS_HGD); float* I = WSP(float, WS_HGI);
    float e[32], d[32];
#pragma unroll
    for (int sc = 0; sc < 32; ++sc) { e[sc] = E[(size_t)(bh * 32 + sc) * 4096 + kv]; d[sc] = Dt[(size_t)(bh * 32 + sc) * 64 + k]; }
    float s = 0.f;
#pragma unroll
    for (int sc = 0; sc < 32; ++sc) { const float nx = d[sc] * s + e[sc]; e[sc] = s; s = nx; }
#pragma unroll
    for (int sc = 0; sc < 32; ++sc) I[(size_t)(bh * 32 + sc) * 4096 + kv] = e[sc];
}

__device__ __forceinline__ float ret_l2g(int h) { return __log2f(1.0f - exp2f(-5.0f - (float)h)); }
__device__ __forceinline__ void ret_item1(const Frame& F, int idx, LAS unsigned char* scr) {
    const int lane = F.lane + vzero(), r16 = lane & 15, g4 = lane >> 4;
    const int bh = idx >> 5, n = idx & 31, b = bh >> 2, h = bh & 3;
    LAS bf16_t* Kd = (LAS bf16_t*)scr;
    LAS bf16_t* Vs = (LAS bf16_t*)(scr + 8192);
    const bf16_t* H = WSP(const bf16_t, WS_H); const float* rope = WSP(const float, WS_ROPER);
    bf16_t* QR = WSP(bf16_t, WS_QR); bf16_t* KR = WSP(bf16_t, WS_KR);
    const float l2g = ret_l2g(h);
    const size_t t0 = (size_t)b * SEQ + n * 64;
#pragma unroll 1
    for (int tb = 0; tb < 4; ++tb) {
        bf16_t kx[16], qx[16], vx[16]; float cs[16], sn[16];
#pragma unroll
        for (int j = 0; j < 16; ++j) { const size_t t = t0 + tb * 16 + j; const bf16_t* row = H + t * HP + h * 64 + lane; kx[j] = row[C_RK]; qx[j] = row[C_RQ]; vx[j] = row[C_RV]; cs[j] = rope[t * 64 + (lane & 31)]; sn[j] = rope[t * 64 + 32 + (lane & 31)]; }
#pragma unroll
        for (int j = 0; j < 16; ++j) { const int tk = tb * 16 + j; const size_t t = t0 + tk;
            const float kf_ = bf2f(kx[j]), qf_ = bf2f(qx[j]); const float kp = __shfl_xor(kf_, 32), qp = __shfl_xor(qf_, 32);
            const float kh = lane < 32 ? kf_ * cs[j] - kp * sn[j] : kf_ * cs[j] + kp * sn[j], qh = (lane < 32 ? qf_ * cs[j] - qp * sn[j] : qf_ * cs[j] + qp * sn[j]) * 0.125f;
            KR[t * 256 + h * 64 + lane] = f2bf(kh); QR[t * 256 + h * 64 + lane] = f2bf(qh);
            Kd[tk * 64 + lane] = f2bf(kh * exp2f((float)(63 - tk) * l2g)); Vs[tk * 64 + lane] = vx[j]; }
    }
    WSYNC();
    Frag vfr[4][2];
#pragma unroll
    for (int vb = 0; vb < 4; ++vb)
#pragma unroll
        for (int ks = 0; ks < 2; ++ks)
#pragma unroll
            for (int j = 0; j < 8; ++j) vfr[vb][ks].h[j] = Vs[(32 * ks + 8 * g4 + j) * 64 + 16 * vb + r16];
    float* E = WSP(float, WS_RTE) + (size_t)(bh * 32 + n) * 4096;
#pragma unroll
    for (int mb = 0; mb < 4; ++mb) { Frag kf[2];
#pragma unroll
        for (int ks = 0; ks < 2; ++ks)
#pragma unroll
            for (int j = 0; j < 8; ++j) kf[ks].h[j] = Kd[(32 * ks + 8 * g4 + j) * 64 + 16 * mb + r16];
#pragma unroll
        for (int vb = 0; vb < 4; ++vb) { f32x4 a = (f32x4){0.f, 0.f, 0.f, 0.f};
#pragma unroll
            for (int ks = 0; ks < 2; ++ks) a = mfma16(kf[ks].v, vfr[vb][ks].v, a);
            *(f32x4*)(E + (16 * vb + r16) * 64 + 16 * mb + 4 * g4) = a; } }
    WSYNC();
}
__device__ __forceinline__ void ret_carry(const Frame& F) {
    const int gt = F.bid * 512 + F.tid; if (gt >= 32 * 4096) return;
    const int bh = gt >> 12, vk = gt & 4095, h = bh & 3;
    const float g64 = exp2f(64.0f * ret_l2g(h));
    const float* E = WSP(const float, WS_RTE); float* I = WSP(float, WS_RTI);
    float e[32];
#pragma unroll
    for (int n = 0; n < 32; ++n) e[n] = E[(size_t)(bh * 32 + n) * 4096 + vk];
    float s = 0.f;
#pragma unroll
    for (int n = 0; n < 32; ++n) { const float nx = g64 * s + e[n]; e[n] = s; s = nx; }
#pragma unroll
    for (int n = 0; n < 32; ++n) I[(size_t)(bh * 32 + n) * 4096 + vk] = e[n];
}
__device__ __forceinline__ void ret_item3(const Frame& F, int layer, int idx, LAS unsigned char* scr) {
    const int lane = F.lane + vzero(), r16 = lane & 15, g4 = lane >> 4;
    const int bh = idx >> 5, n = idx & 31, b = bh >> 2, h = bh & 3;
    LAS bf16_t* Vs = (LAS bf16_t*)scr;
    const bf16_t* H = WSP(const bf16_t, WS_H); const bf16_t* QR = WSP(const bf16_t, WS_QR); const bf16_t* KR = WSP(const bf16_t, WS_KR);
    const float l2g = ret_l2g(h);
    const size_t t0 = (size_t)b * SEQ + n * 64;
#pragma unroll
    for (int tk = 0; tk < 64; ++tk) Vs[tk * 64 + lane] = H[(t0 + tk) * HP + C_RV + h * 64 + lane];
    Frag sfr[4][2];
    { const float* si = WSP(const float, WS_RTI) + (size_t)(bh * 32 + n) * 4096;
#pragma unroll
      for (int vb = 0; vb < 4; ++vb)
#pragma unroll
        for (int ks = 0; ks < 2; ++ks) { const f32x4 a = *(const f32x4*)(si + (16 * vb + r16) * 64 + 32 * ks + 8 * g4), c = *(const f32x4*)(si + (16 * vb + r16) * 64 + 32 * ks + 8 * g4 + 4);
            sfr[vb][ks].u[0] = cvt_pk_bf16(a[0], a[1]); sfr[vb][ks].u[1] = cvt_pk_bf16(a[2], a[3]); sfr[vb][ks].u[2] = cvt_pk_bf16(c[0], c[1]); sfr[vb][ks].u[3] = cvt_pk_bf16(c[2], c[3]); } }
    bf16_t* Y = WSP(bf16_t, WS_Y);
    bf16x8 kfa[4][2], qfa[4][2]; u32x2 gva[4][4];
#pragma unroll
    for (int sb = 0; sb < 4; ++sb)
#pragma unroll
        for (int ks = 0; ks < 2; ++ks) { kfa[sb][ks] = *(const bf16x8*)(KR + (t0 + 16 * sb + r16) * 256 + h * 64 + 32 * ks + 8 * g4); qfa[sb][ks] = *(const bf16x8*)(QR + (t0 + 16 * sb + r16) * 256 + h * 64 + 32 * ks + 8 * g4); }
#pragma unroll
    for (int tb = 0; tb < 4; ++tb)
#pragma unroll
        for (int vb = 0; vb < 4; ++vb) gva[tb][vb] = *(const u32x2*)(H + (t0 + 16 * tb + r16) * HP + C_RG + h * 64 + 16 * vb + 4 * g4);
    WSYNC();
    Frag vfr[4][2];
#pragma unroll
    for (int vb = 0; vb < 4; ++vb)
#pragma unroll
        for (int ks = 0; ks < 2; ++ks)
#pragma unroll
            for (int j = 0; j < 8; ++j) vfr[vb][ks].h[j] = Vs[(32 * ks + 16 * (j >> 2) + 4 * g4 + (j & 3)) * 64 + 16 * vb + r16];
#pragma unroll
    for (int tb = 0; tb < 4; ++tb) {
        const int tl = 16 * tb + r16; const size_t t = t0 + tl;
        Frag pfr[2]; pfr[0].q = (u32x4){0u, 0u, 0u, 0u}; pfr[1].q = (u32x4){0u, 0u, 0u, 0u};
#pragma unroll
        for (int sb = 0; sb < 4; ++sb) { if (sb > tb) continue;
            f32x4 sc = (f32x4){0.f, 0.f, 0.f, 0.f};
#pragma unroll
            for (int ks = 0; ks < 2; ++ks) sc = mfma16(kfa[sb][ks], qfa[tb][ks], sc);
#pragma unroll
            for (int r = 0; r < 4; ++r) { const int rel = tl - (16 * sb + 4 * g4 + r); sc[r] = rel >= 0 ? sc[r] * exp2f((float)rel * l2g) : 0.f; }
            pfr[sb >> 1].u[(sb & 1) * 2] = cvt_pk_bf16(sc[0], sc[1]); pfr[sb >> 1].u[(sb & 1) * 2 + 1] = cvt_pk_bf16(sc[2], sc[3]); }
        const float qd = exp2f((float)(tl + 1) * l2g);
        f32x4 o[4]; float s1 = 0.f;
#pragma unroll
        for (int vb = 0; vb < 4; ++vb) { f32x4 a = (f32x4){0.f, 0.f, 0.f, 0.f};
#pragma unroll
            for (int ks = 0; ks < 2; ++ks) a = mfma16(sfr[vb][ks].v, qfa[tb][ks], a);
            a = a * qd;
            a = mfma16(vfr[vb][0].v, pfr[0].v, a);
            if (tb >= 2) a = mfma16(vfr[vb][1].v, pfr[1].v, a);
            o[vb] = a; s1 += (a[0] + a[1]) + (a[2] + a[3]); }
        s1 += __shfl_xor(s1, 16); s1 += __shfl_xor(s1, 32);
        const float mean = s1 * (1.0f / 64.0f); float s2 = 0.f;
#pragma unroll
        for (int vb = 0; vb < 4; ++vb) { const f32x4 d = o[vb] - mean; s2 += d[0] * d[0] + d[1] * d[1] + d[2] * d[2] + d[3] * d[3]; }
        s2 += __shfl_xor(s2, 16); s2 += __shfl_xor(s2, 32);
        const float rstd = rsqrtf(s2 * (1.0f / 64.0f) + EPS);
#pragma unroll
        for (int vb = 0; vb < 4; ++vb) { const int vi0 = h * 64 + 16 * vb + 4 * g4; const u32x2 gv = gva[tb][vb];
            const f32x4 gg = *(const f32x4*)(IN_F(19) + layer * 256 + vi0), gb = *(const f32x4*)(IN_F(20) + layer * 256 + vi0);
            const float g0 = __uint_as_float(gv.x << 16), g1 = __uint_as_float(gv.x & 0xffff0000u), g2 = __uint_as_float(gv.y << 16), g3 = __uint_as_float(gv.y & 0xffff0000u);
            u32x2 w; w.x = cvt_pk_bf16(((o[vb][0] - mean) * rstd * gg[0] + gb[0]) * siluf_(g0), ((o[vb][1] - mean) * rstd * gg[1] + gb[1]) * siluf_(g1));
            w.y = cvt_pk_bf16(((o[vb][2] - mean) * rstd * gg[2] + gb[2]) * siluf_(g2), ((o[vb][3] - mean) * rstd * gg[3] + gb[3]) * siluf_(g3));
            *(u32x2*)(Y + t * 1024 + 768 + vi0) = w; }
    }
    WSYNC();
}

__device__ __forceinline__ void attn_unit(const Frame& F, int bh, int qt) {
    const int vz = vzero(); const int lane = F.lane + vz, r16 = lane & 15, g4 = lane >> 4, w = F.wave, tid = F.tid + vz;
    LAS bf16_t* Kt = (LAS bf16_t*)(F.lds + LDS_STAGE);
    LAS bf16_t* Vl = (LAS bf16_t*)(F.lds + LDS_STAGE + 13312);
    const bf16_t* Qb = WSP(const bf16_t, WS_Q) + (size_t)bh * SEQ * 96; const bf16_t* Kb = WSP(const bf16_t, WS_K) + (size_t)bh * SEQ * 96; const bf16_t* Vt = WSP(const bf16_t, WS_VT) + (size_t)bh * 64 * SEQ;
    const int q0 = qt * 128, qrow = q0 + 16 * w + r16;
    bf16x8 qfr[3];
#pragma unroll
    for (int ks = 0; ks < 3; ++ks) qfr[ks] = *(const bf16x8*)(Qb + (size_t)qrow * 96 + 32 * ks + 8 * g4);
    float mrun = -1e30f, lrun = 0.f;
    f32x4 O[4];
#pragma unroll
    for (int db = 0; db < 4; ++db) O[db] = (f32x4){0.f, 0.f, 0.f, 0.f};
    const int nkt = 2 * qt + 2;
    const int kkey0 = tid / 12, kpart0 = tid % 12, kkey1 = (tid + 512) / 12, kpart1 = (tid + 512) % 12; const bool k1 = tid < 256;
    const int vdv = tid >> 3, vpart = tid & 7;
    u32x4 rk0, rk1, rv;
    rk1 = (u32x4){0u, 0u, 0u, 0u};
    rk0 = *(const u32x4*)(Kb + (size_t)kkey0 * 96 + kpart0 * 8); if (k1) rk1 = *(const u32x4*)(Kb + (size_t)kkey1 * 96 + kpart1 * 8);
    rv = *(const u32x4*)(Vt + (size_t)vdv * SEQ + vpart * 8);
#pragma unroll 1
    for (int kt = 0; kt < nkt; ++kt) {
        __syncthreads();
        *(LAS u32x4*)(Kt + kkey0 * 104 + kpart0 * 8) = rk0; if (k1) *(LAS u32x4*)(Kt + kkey1 * 104 + kpart1 * 8) = rk1;
        *(LAS u32x4*)(Vl + vdv * 72 + vpart * 8) = rv;
        __syncthreads();
        if (kt + 1 < nkt) { const size_t kb = (size_t)(kt + 1) * 64;
            rk0 = *(const u32x4*)(Kb + (kb + kkey0) * 96 + kpart0 * 8); if (k1) rk1 = *(const u32x4*)(Kb + (kb + kkey1) * 96 + kpart1 * 8);
            rv = *(const u32x4*)(Vt + (size_t)vdv * SEQ + kb + vpart * 8); }
        f32x4 sc[4]; float mx = -1e30f;
#pragma unroll
        for (int kb = 0; kb < 4; ++kb) { f32x4 s = (f32x4){0.f, 0.f, 0.f, 0.f};
#pragma unroll
            for (int ks = 0; ks < 3; ++ks) { const bf16x8 a = *(const LAS bf16x8*)(Kt + (16 * kb + r16) * 104 + 32 * ks + 8 * g4); s = mfma16(a, qfr[ks], s); }
            if (kt >= 2 * qt) {
#pragma unroll
                for (int r = 0; r < 4; ++r) if (kt * 64 + 16 * kb + 4 * g4 + r > qrow) s[r] = -1e30f; }
            sc[kb] = s; mx = fmaxf(mx, fmaxf(fmaxf(s[0], s[1]), fmaxf(s[2], s[3]))); }
        mx = fmaxf(mx, __shfl_xor(mx, 16)); mx = fmaxf(mx, __shfl_xor(mx, 32));
        const float mnew = fmaxf(mrun, mx), alpha = exp2f(mrun - mnew); mrun = mnew;
        float ls = 0.f;
#pragma unroll
        for (int kb = 0; kb < 4; ++kb)
#pragma unroll
            for (int r = 0; r < 4; ++r) { const float p = exp2f(sc[kb][r] - mnew); sc[kb][r] = p; ls += p; }
        lrun = lrun * alpha + ls;
        Frag pf[2];
#pragma unroll
        for (int ks = 0; ks < 2; ++ks) { pf[ks].u[0] = cvt_pk_bf16(sc[2 * ks][0], sc[2 * ks][1]); pf[ks].u[1] = cvt_pk_bf16(sc[2 * ks][2], sc[2 * ks][3]); pf[ks].u[2] = cvt_pk_bf16(sc[2 * ks + 1][0], sc[2 * ks + 1][1]); pf[ks].u[3] = cvt_pk_bf16(sc[2 * ks + 1][2], sc[2 * ks + 1][3]); }
#pragma unroll
        for (int db = 0; db < 4; ++db) { f32x4 o = O[db] * alpha;
#pragma unroll
            for (int ks = 0; ks < 2; ++ks) { Frag vf; vf.d[0] = *(const LAS u32x2*)(Vl + (16 * db + r16) * 72 + 32 * ks + 4 * g4); vf.d[1] = *(const LAS u32x2*)(Vl + (16 * db + r16) * 72 + 32 * ks + 16 + 4 * g4); o = mfma16(vf.v, pf[ks].v, o); }
            O[db] = o; }
    }
    lrun += __shfl_xor(lrun, 16); lrun += __shfl_xor(lrun, 32);
    const float inv = 1.0f / lrun;
    const int b = bh >> 2, h = bh & 3; bf16_t* Y = WSP(bf16_t, WS_Y) + ((size_t)b * SEQ + qrow) * 1024 + 256 + h * 64;
#pragma unroll
    for (int db = 0; db < 4; ++db) { u32x2 wv; wv.x = cvt_pk_bf16(O[db][0] * inv, O[db][1] * inv); wv.y = cvt_pk_bf16(O[db][2] * inv, O[db][3] * inv); *(u32x2*)(Y + 16 * db + 4 * g4) = wv; }
}

__device__ __forceinline__ void ln_row_write(f32x4 (&v)[4], const float* g, const float* bta, float* of, bf16_t* ob, int lane, unsigned char* o8 = nullptr) {
    float s = 0.f;
#pragma unroll
    for (int j = 0; j < 4; ++j) s += (v[j][0] + v[j][1]) + (v[j][2] + v[j][3]);
    const float mean = wave_sum(s) * (1.0f / 1024.0f); float s2 = 0.f;
#pragma unroll
    for (int j = 0; j < 4; ++j) { v[j] = v[j] - mean; s2 += (v[j][0] * v[j][0] + v[j][1] * v[j][1]) + (v[j][2] * v[j][2] + v[j][3] * v[j][3]); }
    const float rstd = rsqrtf(wave_sum(s2) * (1.0f / 1024.0f) + EPS);
#pragma unroll
    for (int j = 0; j < 4; ++j) { const f32x4 gg = *(const f32x4*)(g + 4 * lane + 256 * j), bb = *(const f32x4*)(bta + 4 * lane + 256 * j); v[j] = v[j] * rstd * gg + bb;
        *(f32x4*)(of + 4 * lane + 256 * j) = v[j]; u32x2 w; w.x = cvt_pk_bf16(v[j][0], v[j][1]); w.y = cvt_pk_bf16(v[j][2], v[j][3]); *(u32x2*)(ob + 4 * lane + 256 * j) = w;
        if (o8) *(unsigned*)(o8 + 4 * lane + 256 * j) = cvt4_fp8(v[j][0], v[j][1], v[j][2], v[j][3]); }
}
template <bool MOE>
__device__ __forceinline__ void ln1_phase(const Frame& F, int layer) {
    const int lane = F.lane; bf16_t* XB = WSP(bf16_t, WS_XB);
    LAS int* lcnt = (LAS int*)(F.lds + LDS_MISC);
    LAS int* rinfo = (LAS int*)(F.lds + LDS_MISC + 64);
    LAS float* rw = (LAS float*)(F.lds + LDS_MISC + 64 + 4096);
    if (MOE) { if (F.tid < 16) lcnt[F.tid] = 0; __syncthreads(); }
    const int rows_per_blk = T / F.G;
    const float* wr_ = MOE ? IN_F(28) + (size_t)(layer >> 1) * 1024 * 8 : nullptr;
    f32x4 nv[4];
    if (F.wave < rows_per_blk) { const float* x0 = F.out + (size_t)(F.bid * rows_per_blk + F.wave) * 1024;
#pragma unroll
        for (int j = 0; j < 4; ++j) nv[j] = *(const f32x4*)(x0 + 4 * lane + 256 * j); }
    for (int lr = F.wave; lr < rows_per_blk; lr += 8) { const int t = F.bid * rows_per_blk + lr;
        float* xr = F.out + (size_t)t * 1024; f32x4 v[4];
#pragma unroll
        for (int j = 0; j < 4; ++j) v[j] = nv[j];
        if (lr + 8 < rows_per_blk) {
#pragma unroll
            for (int j = 0; j < 4; ++j) nv[j] = *(const f32x4*)(xr + 8 * 1024 + 4 * lane + 256 * j); }
        ln_row_write(v, IN_F(23) + layer * 1024, IN_F(24) + layer * 1024, xr, XB + (size_t)t * 1024, lane, WSP(unsigned char, WS_X8) + (size_t)t * 1024);
        if (MOE) {
            float lg[8];
#pragma unroll
            for (int e = 0; e < 8; ++e) lg[e] = 0.f;
#pragma unroll
            for (int j = 0; j < 4; ++j)
#pragma unroll
                for (int q = 0; q < 4; ++q) { const float xv = v[j][q]; const float* wrow = wr_ + (size_t)(4 * lane + 256 * j + q) * 8; const f32x4 w0 = *(const f32x4*)wrow, w1 = *(const f32x4*)(wrow + 4);
                    lg[0] += xv * w0[0]; lg[1] += xv * w0[1]; lg[2] += xv * w0[2]; lg[3] += xv * w0[3]; lg[4] += xv * w1[0]; lg[5] += xv * w1[1]; lg[6] += xv * w1[2]; lg[7] += xv * w1[3]; }
#pragma unroll
            for (int e = 0; e < 8; ++e) lg[e] = wave_sum(lg[e]);
            int e0 = 0; float v0 = lg[0];
#pragma unroll
            for (int e = 1; e < 8; ++e) if (lg[e] > v0) { v0 = lg[e]; e0 = e; }
            int e1 = -1; float v1 = -3.0e38f;
#pragma unroll
            for (int e = 0; e < 8; ++e) if (e != e0 && lg[e] > v1) { v1 = lg[e]; e1 = e; }
            if (lane == 0) { const float w0 = 1.0f / (1.0f + __expf(v1 - v0)); const int p0 = __hip_atomic_fetch_add(&lcnt[e0], 1, __ATOMIC_RELAXED, __HIP_MEMORY_SCOPE_WORKGROUP), p1 = __hip_atomic_fetch_add(&lcnt[e1], 1, __ATOMIC_RELAXED, __HIP_MEMORY_SCOPE_WORKGROUP);
                rinfo[lr * 4 + 0] = e0; rinfo[lr * 4 + 1] = e1; rinfo[lr * 4 + 2] = p0; rinfo[lr * 4 + 3] = p1; rw[lr * 2] = w0; rw[lr * 2 + 1] = 1.0f - w0; }
        }
    }
    if (MOE) {
        __syncthreads();
        unsigned* gcnt = WSP(unsigned, WS_CTL) + CW_MOE + (layer >> 1) * 64;
        if (F.tid < 8) lcnt[8 + F.tid] = (int)__hip_atomic_fetch_add(gcnt + F.tid, (unsigned)lcnt[F.tid], __ATOMIC_RELAXED, __HIP_MEMORY_SCOPE_AGENT);
        __syncthreads();
        int* te = (int*)(F.ws + WS_TOK + TOK_E); int* tp = (int*)(F.ws + WS_TOK + TOK_POS); float* tw = (float*)(F.ws + WS_TOK + TOK_W);
        for (int i = F.tid; i < rows_per_blk * 2; i += 512) { const int lr = i >> 1, k = i & 1, t = F.bid * rows_per_blk + lr; const int e = rinfo[lr * 4 + k];
            te[t * 2 + k] = e; tp[t * 2 + k] = lcnt[8 + e] + rinfo[lr * 4 + 2 + k]; tw[t * 2 + k] = rw[lr * 2 + k]; }
    }
}
struct MoeOff { int ts0, ts1, ts2, ts3, ts4, ts5, ts6, ts7, ts8; };
__device__ __forceinline__ MoeOff moe_offsets(const Frame& F, int layer, int* cnt_out  ) {
    const unsigned* gcnt = WSP(const unsigned, WS_CTL) + CW_MOE + (layer >> 1) * 64;
    MoeOff o; int c[8];
#pragma unroll
    for (int e = 0; e < 8; ++e) c[e] = (int)__hip_atomic_load(gcnt + e, __ATOMIC_RELAXED, __HIP_MEMORY_SCOPE_AGENT);
    o.ts0 = 0; o.ts1 = o.ts0 + ((c[0] + 255) >> 8); o.ts2 = o.ts1 + ((c[1] + 255) >> 8); o.ts3 = o.ts2 + ((c[2] + 255) >> 8); o.ts4 = o.ts3 + ((c[3] + 255) >> 8);
    o.ts5 = o.ts4 + ((c[4] + 255) >> 8); o.ts6 = o.ts5 + ((c[5] + 255) >> 8); o.ts7 = o.ts6 + ((c[6] + 255) >> 8); o.ts8 = o.ts7 + ((c[7] + 255) >> 8);
    if (cnt_out) {
#pragma unroll
        for (int e = 0; e < 8; ++e) cnt_out[e] = c[e]; }
    return o;
}
__device__ __forceinline__ int moe_ts(const MoeOff& o, int e) { return e == 0 ? o.ts0 : e == 1 ? o.ts1 : e == 2 ? o.ts2 : e == 3 ? o.ts3 : e == 4 ? o.ts4 : e == 5 ? o.ts5 : e == 6 ? o.ts6 : o.ts7; }
__device__ __forceinline__ void moe_gather(const Frame& F, int layer) {
    int cnt[8]; const MoeOff o = moe_offsets(F, layer, cnt);
    const int lane = F.lane; const unsigned char* X8 = WSP(const unsigned char, WS_X8); unsigned char* XG = WSP(unsigned char, WS_XG);
    const int* te = (const int*)(F.ws + WS_TOK + TOK_E); const int* tp = (const int*)(F.ws + WS_TOK + TOK_POS); int* tsl = (int*)(F.ws + WS_TOK + TOK_SLOT);
    for (int i0 = F.gw * 4; i0 < T * 2; i0 += F.NGW * 4) {
        int ee[4], pp[4]; u32x4 a[4];
#pragma unroll
        for (int q = 0; q < 4; ++q) { ee[q] = te[i0 + q]; pp[q] = tp[i0 + q]; a[q] = ((const u32x4*)(X8 + (size_t)((i0 + q) >> 1) * 1024))[lane]; }
#pragma unroll
        for (int q = 0; q < 4; ++q) { const int slot = moe_ts(o, ee[q]) * 256 + pp[q]; ((u32x4*)(XG + (size_t)slot * 1024))[lane] = a[q]; if (lane == 0) tsl[i0 + q] = slot; }
    }
    int npad_pre = 0;
#pragma unroll
    for (int e = 0; e < 8; ++e) { const int start = moe_ts(o, e) * 256 + cnt[e], end = (e == 7 ? o.ts8 : moe_ts(o, e + 1)) * 256, np = end - start;
        for (int i = F.gw; i < np; i += F.NGW) ((u32x4*)(XG + (size_t)(start + i) * 1024))[lane] = (u32x4){0u, 0u, 0u, 0u};
        npad_pre += np; }
    (void)npad_pre;
}
template <bool MOE>
__device__ __forceinline__ void ln2_phase(const Frame& F, int layer) {
    const int lane = F.lane; bf16_t* XB = WSP(bf16_t, WS_XB);
    const bf16_t* YM = WSP(const bf16_t, WS_YM); const bf16_t* PLE = WSP(const bf16_t, WS_PLE);
    const int* tsl = (const int*)(F.ws + WS_TOK + TOK_SLOT); const float* tw = (const float*)(F.ws + WS_TOK + TOK_W);
    f32x4 nx[4]; u32x2 na[4], nc[4], np_[4]; float nw0 = 0.f, nw1 = 0.f;
#define LN2_LOAD(t_) do { const int tt_ = (t_); const float* xr_ = F.out + (size_t)tt_ * 1024; \
        _Pragma("unroll") for (int j = 0; j < 4; ++j) nx[j] = *(const f32x4*)(xr_ + 4 * lane + 256 * j); \
        if (MOE) { const int s0_ = tsl[tt_ * 2], s1_ = tsl[tt_ * 2 + 1]; nw0 = tw[tt_ * 2]; nw1 = tw[tt_ * 2 + 1]; \
            _Pragma("unroll") for (int j = 0; j < 4; ++j) { na[j] = *(const u32x2*)(YM + (size_t)s0_ * 1024 + 4 * lane + 256 * j); nc[j] = *(const u32x2*)(YM + (size_t)s1_ * 1024 + 4 * lane + 256 * j); np_[j] = *(const u32x2*)(PLE + (size_t)tt_ * 1024 + 4 * lane + 256 * j); } } } while (0)
    if (F.gw < T) LN2_LOAD(F.gw);
    for (int t = F.gw; t < T; t += F.NGW) { float* xr = F.out + (size_t)t * 1024; f32x4 v[4];
#pragma unroll
        for (int j = 0; j < 4; ++j) v[j] = nx[j];
        if (MOE) { const float w0 = nw0, w1 = nw1;
#pragma unroll
            for (int j = 0; j < 4; ++j) { const u32x2 a = na[j], c = nc[j], p = np_[j];
                f32x4 f;
                f[0] = w0 * __uint_as_float(a.x << 16) + w1 * __uint_as_float(c.x << 16) + __uint_as_float(p.x << 16);
                f[1] = w0 * __uint_as_float(a.x & 0xffff0000u) + w1 * __uint_as_float(c.x & 0xffff0000u) + __uint_as_float(p.x & 0xffff0000u);
                f[2] = w0 * __uint_as_float(a.y << 16) + w1 * __uint_as_float(c.y << 16) + __uint_as_float(p.y << 16);
                f[3] = w0 * __uint_as_float(a.y & 0xffff0000u) + w1 * __uint_as_float(c.y & 0xffff0000u) + __uint_as_float(p.y & 0xffff0000u);
                v[j] = v[j] * ALPHA + f; } }
        if (t + F.NGW < T) LN2_LOAD(t + F.NGW);
        ln_row_write(v, IN_F(34) + layer * 1024, IN_F(35) + layer * 1024, xr, XB + (size_t)t * 1024, lane);
    }
#undef LN2_LOAD
}

constexpr int PH_PER_LAYER = 12, N_PHASES = 1 + DEPTH * PH_PER_LAYER;
__global__ void __launch_bounds__(512, 2) hybrid_fwd(Args args) {
    extern __shared__ __attribute__((aligned(16))) unsigned char lds_raw[];
    Frame F0;
    F0.lds = (LAS unsigned char*)lds_raw; F0.ws = args.ws; F0.in = args.in; F0.out = args.out;
    F0.tid = threadIdx.x; F0.lane = F0.tid & 63; F0.wave = __builtin_amdgcn_readfirstlane(F0.tid >> 6); F0.G = gridDim.x; F0.bid = blockIdx.x; F0.gw = F0.bid * 8 + F0.wave; F0.NGW = F0.G * 8;
    volatile LAS unsigned* ctlw = (volatile LAS unsigned*)(F0.lds + LDS_CTLW);
    if (F0.tid < 16) ctlw[F0.tid] = 0u;
    __syncthreads();
    const int lo = args.ph_lo, hi = args.ph_hi; const int VAR = args.variant;
    XcdBarrier bar; bar.bar = (unsigned*)(F0.ws + WS_CTL) + CW_BAR + args.bar_region * XCD_BAR_WORDS; bar.x = 0; bar.st = ctlw;
    if (hi - lo > 1) bar = xcd_barrier_post((unsigned*)(F0.ws + WS_CTL) + CW_BAR + args.bar_region * XCD_BAR_WORDS, ctlw);
#define IN_PH(k) (lo <= (k) && (k) < hi)
#define SEAM(k) do { if ((k) + 1 < hi) { XcdBarrier bb_ = bar; bb_.bar = bar.bar + opaque0(); xcd_barrier(bb_); } } while (0)

    if (PHON(12) && IN_PH(0)) { const Frame F = reframe(F0); p0_prologue(F); SEAM(0); }

    for (int layer = 0; layer < DEPTH; ++layer) {
        const int pb = 1 + layer * PH_PER_LAYER;
        const bool moe = (layer & 1) != 0;
        if (PHON(0) && IN_PH(pb + 0)) { const Frame F = reframe(F0); const int L = layer + opaque0(); LAS unsigned char* stage = F.lds + LDS_STAGE; LAS unsigned char* wscr = F.lds + LDS_STAGE + F.wave * 16384; (void)wscr; (void)stage;
            { pg8::Gemm g{WSP(const bf16_t, WS_XB), WSP(const bf16_t, WS_WIN) + (size_t)L * HP * 1024, 1024, 1024, 1024, VAR};
              pg8::OrderStd S; S.init(T / 256, HP / 256, F.G, F.bid); pg8::EpiBf16 E{WSP(bf16_t, WS_H), HP, HP / 256, 1.0f};
              pg8::gemm_phase(stage, g, S, E); }
            { const int L2 = L + opaque0(); pg8::Gemm g{WSP(const bf16_t, WS_PB) + (size_t)L2 * T * 256, WSP(const bf16_t, WS_WPP) + (size_t)L2 * 1024 * 256, 256, 256, 256, VAR};
              const int nshort = F.G - (1728 % F.G); pg8::OrderLin S{(F.G == 256) ? F.bid - 192 : F.bid, (F.G == 256) ? 64 : F.G, 256, 4}; (void)nshort;
              pg8::EpiBf16 E{WSP(bf16_t, WS_PP), 1024, 4, 1.0f};
              pg8::gemm_phase(stage, g, S, E); }
            SEAM(pb + 0);
        }
        if (PHON(1) && IN_PH(pb + 1)) { const Frame F = reframe(F0); const int L = layer + opaque0(); LAS unsigned char* stage = F.lds + LDS_STAGE; LAS unsigned char* wscr = F.lds + LDS_STAGE + F.wave * 16384; (void)wscr; (void)stage;
            const bf16_t* H = WSP(const bf16_t, WS_H);
            LAS float* rs = (LAS float*)(F.lds + LDS_MISC);
            if (!(VAR & 16)) { const int vb = F.bid;
                const int pm = vb >> 2, kind = (vb >> 1) & 1, pn = vb & 1;
                __syncthreads();
                { const int lr = F.tid >> 1, hf = F.tid & 1; const int nper = kind ? 64 : 96;
                  const u32x4* src = (const u32x4*)(H + (size_t)(pm * 256 + lr) * HP + (kind ? C_CKV : C_CQ) + hf * nper);
                  u32x4 v[12];
#pragma unroll
                  for (int q = 0; q < 12; ++q) v[q] = (q < 8 || kind == 0) ? src[q] : (u32x4){0u, 0u, 0u, 0u};
                  float ss = 0.f;
#pragma unroll
                  for (int q = 0; q < 12; ++q)
#pragma unroll
                      for (int j = 0; j < 4; ++j) { const float lo = __uint_as_float(v[q][j] << 16), hi = __uint_as_float(v[q][j] & 0xffff0000u); ss += lo * lo + hi * hi; }
                  ss += __shfl_xor(ss, 1);
                  if (hf == 0) rs[lr] = rsqrtf(ss / (kind ? 128.0f : 192.0f) + EPS); }
                __syncthreads();
                if (kind == 0) { pg8::Gemm g{H + C_CQ, WSP(const bf16_t, WS_WUQ) + (size_t)L * 512 * 256, HP, 256, 256, VAR}; pg8::OrderOne S{pm, pn, true};
                    pg8::EpiQ E{WSP(bf16_t, WS_Q), WSP(const float, WS_ROPEM), rs}; pg8::gemm_phase(stage, g, S, E); }
                else { pg8::Gemm g{H + C_CKV, WSP(const bf16_t, WS_WUKV) + (size_t)L * 512 * 256, HP, 256, 256, VAR}; pg8::OrderOne S{pm, pn, true};
                    pg8::EpiKV E{WSP(bf16_t, WS_K), WSP(bf16_t, WS_VT), rs}; pg8::gemm_phase(stage, g, S, E);
                    if (pn == 0) { const float* rope = WSP(const float, WS_ROPEM); bf16_t* Kb = WSP(bf16_t, WS_K);
#pragma unroll
                        for (int i8 = 0; i8 < 8; ++i8) { const int i = F.tid + i8 * 512; const int lr = i >> 4, j = i & 15, t = pm * 256 + lr, b = t >> 11, s = t & 2047;
                            const float x1 = bf2f(H[(size_t)t * HP + C_KR + j]), x2 = bf2f(H[(size_t)t * HP + C_KR + 16 + j]), c = rope[t * 32 + j], sn = rope[t * 32 + 16 + j];
                            const bf16_t o1 = f2bf(x1 * c - x2 * sn), o2 = f2bf(x2 * c + x1 * sn);
#pragma unroll
                            for (int hd = 0; hd < 4; ++hd) { bf16_t* kp = Kb + ((size_t)((b * 4 + hd) * SEQ + s)) * 96; kp[64 + j] = o1; kp[80 + j] = o2; } } } }
            }
            __syncthreads();
            for (int it = F.gw; it < 1024 + 1024 + 4096; it += F.NGW) {
                if (it < 1024) { if (!(VAR & 2)) hg_item<false>(F, L, it, wscr); }
                else if (it < 2048) { if (!(VAR & 4)) ret_item1(F, it - 1024, wscr); }
                else { if (!(VAR & 8)) s5_item<false>(F, L, it - 2048, wscr); }
            }
            SEAM(pb + 1);
        }
        if (PHON(2) && IN_PH(pb + 2)) { const Frame F = reframe(F0); const int L = layer + opaque0(); LAS unsigned char* stage = F.lds + LDS_STAGE; LAS unsigned char* wscr = F.lds + LDS_STAGE + F.wave * 16384; (void)wscr; (void)stage; s5_carry(F, L); hg_carry(F); ret_carry(F); SEAM(pb + 2); }
        if (PHON(3) && IN_PH(pb + 3)) { const Frame F = reframe(F0); const int L = layer + opaque0(); LAS unsigned char* stage = F.lds + LDS_STAGE; LAS unsigned char* wscr = F.lds + LDS_STAGE + F.wave * 16384; (void)wscr; (void)stage;
            if (!(VAR & 16)) { const int vb = F.bid; const int bh = vb >> 3, j = vb & 7; attn_unit(F, bh, 15 - j); attn_unit(F, bh, j); }
            __syncthreads();
            for (int it = F.gw; it < 1024 + 1024 + 4096; it += F.NGW) {
                if (it < 1024) { if (!(VAR & 2)) hg_item<true>(F, L, it, wscr); }
                else if (it < 2048) { if (!(VAR & 4)) ret_item3(F, L, it - 1024, wscr); }
                else { if (!(VAR & 8)) s5_item<true>(F, L, it - 2048, wscr); }
            }
            SEAM(pb + 3);
        }
        if (PHON(4) && IN_PH(pb + 4)) { const Frame F = reframe(F0); const int L = layer + opaque0(); LAS unsigned char* stage = F.lds + LDS_STAGE; LAS unsigned char* wscr = F.lds + LDS_STAGE + F.wave * 16384; (void)wscr; (void)stage;
            pg8::Gemm g{WSP(const bf16_t, WS_S5PRE), WSP(const bf16_t, WS_WGLU) + (size_t)L * 256 * 256, 256, 256, 256, VAR};
            pg8::OrderLin S{F.bid, F.G, 64, 1}; pg8::EpiSigMul E{WSP(bf16_t, WS_Y), 1024, WSP(const bf16_t, WS_S5PRE), 256};
            pg8::gemm_phase(stage, g, S, E);
            SEAM(pb + 4);
        }
        if (PHON(5) && IN_PH(pb + 5)) { const Frame F = reframe(F0); const int L = layer + opaque0(); LAS unsigned char* stage = F.lds + LDS_STAGE; LAS unsigned char* wscr = F.lds + LDS_STAGE + F.wave * 16384; (void)wscr; (void)stage;
            pg8::Gemm g{WSP(const bf16_t, WS_Y), WSP(const bf16_t, WS_WB) + (size_t)L * 4 * 1024 * 256, 1024, 256, 256, VAR};
            pg8::OrderBranch S{F.bid, F.G}; pg8::EpiBranchH E{WSP(const bf16_t, WS_H) + C_GATE, WSP(bf16_t, WS_MIXB)};
            pg8::gemm_phase(stage, g, S, E);
            SEAM(pb + 5);
        }
        if (PHON(6) && IN_PH(pb + 6)) { const Frame F = reframe(F0); const int L = layer + opaque0(); LAS unsigned char* stage = F.lds + LDS_STAGE; LAS unsigned char* wscr = F.lds + LDS_STAGE + F.wave * 16384; (void)wscr; (void)stage;
            pg8::Gemm g{WSP(const bf16_t, WS_MIXB), WSP(const bf16_t, WS_WO) + (size_t)L * 1024 * 1024, 1024, 1024, 1024, VAR};
            pg8::OrderStd S; S.init(T / 256, 4, F.G, F.bid); pg8::EpiResid E{L == 0 ? IN_F(0) : (const float*)F.out, F.out, nullptr, 1.0f};
            pg8::gemm_phase(stage, g, S, E);
            SEAM(pb + 6);
        }
        if (PHON(7) && IN_PH(pb + 7)) { const Frame F = reframe(F0); const int L = layer + opaque0(); LAS unsigned char* stage = F.lds + LDS_STAGE; LAS unsigned char* wscr = F.lds + LDS_STAGE + F.wave * 16384; (void)wscr; (void)stage; if (moe) ln1_phase<true>(F, L); else ln1_phase<false>(F, L); SEAM(pb + 7); }
        if (!moe) {
            if (PHON(8) && IN_PH(pb + 8)) { const Frame F = reframe(F0); const int L = layer + opaque0(); LAS unsigned char* stage = F.lds + LDS_STAGE; LAS unsigned char* wscr = F.lds + LDS_STAGE + F.wave * 16384; (void)wscr; (void)stage;
                { pg8::Gemm g{WSP(const unsigned char, WS_X8), WSP(const unsigned char, WS_WFFU) + (size_t)(L >> 1) * 7168 * 1024, 1024, 1024, 1024, VAR};
                  pg8::OrderStd S; S.init(T / 256, 28, F.G, F.bid); pg8::EpiSwiglu8 E{WSP(unsigned char, WS_HFF), DFF, 28};
                  pg8::gemm_phase(stage, g, S, E); }
                { const int L2 = L + opaque0(); pg8::Gemm g{WSP(const bf16_t, WS_XB), WSP(const bf16_t, WS_WPG) + (size_t)L2 * 1024 * 1024, 1024, 1024, 1024, VAR};
                  pg8::OrderStd S; S.init(T / 256, 4, F.G, F.bid); pg8::EpiSigMul E{WSP(bf16_t, WS_PLE), 1024, WSP(const bf16_t, WS_PP), 1024};
                  pg8::gemm_phase(stage, g, S, E); }
                SEAM(pb + 8);
            }
            if (PHON(9) && IN_PH(pb + 9)) { const Frame F = reframe(F0); const int L = layer + opaque0(); LAS unsigned char* stage = F.lds + LDS_STAGE; LAS unsigned char* wscr = F.lds + LDS_STAGE + F.wave * 16384; (void)wscr; (void)stage;
                pg8::Gemm g{WSP(const unsigned char, WS_HFF), WSP(const unsigned char, WS_WFFD) + (size_t)(L >> 1) * 1024 * DFF, DFF, DFF, DFF, VAR};
                pg8::OrderStd S; S.init(T / 256, 4, F.G, F.bid); pg8::EpiResidT<true> E{(const float*)F.out, F.out, WSP(const bf16_t, WS_PLE), 0.00048828125f};
                pg8::gemm_phase(stage, g, S, E);
                SEAM(pb + 9);
            }
            if (PHON(10) && IN_PH(pb + 10)) { const Frame F = reframe(F0); const int L = layer + opaque0(); LAS unsigned char* stage = F.lds + LDS_STAGE; LAS unsigned char* wscr = F.lds + LDS_STAGE + F.wave * 16384; (void)wscr; (void)stage; ln2_phase<false>(F, L); if (hi > pb + 12) { XcdBarrier bb_ = bar; bb_.bar = bar.bar + opaque0(); xcd_barrier(bb_); } }
        } else {
            if (PHON(8) && IN_PH(pb + 8)) { const Frame F = reframe(F0); const int L = layer + opaque0(); LAS unsigned char* stage = F.lds + LDS_STAGE; LAS unsigned char* wscr = F.lds + LDS_STAGE + F.wave * 16384; (void)wscr; (void)stage;
                moe_gather(F, L);
                { const int L2 = L + opaque0(); pg8::Gemm g{WSP(const bf16_t, WS_XB), WSP(const bf16_t, WS_WPG) + (size_t)L2 * 1024 * 1024, 1024, 1024, 1024, VAR};
                  pg8::OrderStd S; S.init(T / 256, 4, F.G, F.bid); pg8::EpiSigMul E{WSP(bf16_t, WS_PLE), 1024, WSP(const bf16_t, WS_PP), 1024};
                  pg8::gemm_phase(stage, g, S, E); }
                SEAM(pb + 8);
            }
            if (PHON(9) && IN_PH(pb + 9)) { const Frame F = reframe(F0); const int L = layer + opaque0(); LAS unsigned char* stage = F.lds + LDS_STAGE; LAS unsigned char* wscr = F.lds + LDS_STAGE + F.wave * 16384; (void)wscr; (void)stage;
                const MoeOff o = moe_offsets(F, L, nullptr);
                pg8::Gemm g{WSP(const unsigned char, WS_XG), WSP(const unsigned char, WS_WMU) + (size_t)(L >> 1) * 8 * 7168 * 1024, 1024, 1024, 1024, VAR};
                pg8::OrderMoe S{o.ts8, 28, F.G, F.bid, o.ts1, o.ts2, o.ts3, o.ts4, o.ts5, o.ts6, o.ts7}; pg8::EpiSwiglu8 E{WSP(unsigned char, WS_HM), DFF, 28};
                pg8::gemm_phase(stage, g, S, E);
                SEAM(pb + 9);
            }
            if (PHON(10) && IN_PH(pb + 10)) { const Frame F = reframe(F0); const int L = layer + opaque0(); LAS unsigned char* stage = F.lds + LDS_STAGE; LAS unsigned char* wscr = F.lds + LDS_STAGE + F.wave * 16384; (void)wscr; (void)stage;
                const MoeOff o = moe_offsets(F, L, nullptr);
                pg8::Gemm g{WSP(const unsigned char, WS_HM), WSP(const unsigned char, WS_WMD) + (size_t)(L >> 1) * 8 * 1024 * DFF, DFF, DFF, DFF, VAR};
                pg8::OrderMoe S{o.ts8, 4, F.G, F.bid, o.ts1, o.ts2, o.ts3, o.ts4, o.ts5, o.ts6, o.ts7}; pg8::EpiBf16T<true> E{WSP(bf16_t, WS_YM), 1024, 4, 0.00048828125f};
                pg8::gemm_phase(stage, g, S, E);
                SEAM(pb + 10);
            }
            if (PHON(11) && IN_PH(pb + 11)) { const Frame F = reframe(F0); const int L = layer + opaque0(); LAS unsigned char* stage = F.lds + LDS_STAGE; LAS unsigned char* wscr = F.lds + LDS_STAGE + F.wave * 16384; (void)wscr; (void)stage; ln2_phase<true>(F, L); SEAM(pb + 11); }
        }
    }
#undef IN_PH
#undef SEAM
}

extern "C" void kernel_launch(void* const* d_in, const int* in_sizes, int n_in, void* d_out, int out_size, void* d_ws, size_t ws_size, hipStream_t stream) {
    static int grid = 0;
    if (grid == 0) {
        if (n_in != 36 || out_size != T * D || ws_size < WS_END) { fprintf(stderr, "kernel_launch: unexpected problem (n_in %d, out %d, ws %zu < %zu)\n", n_in, out_size, ws_size, (size_t)WS_END); grid = -1; return; }
        int dev = 0, cus = 0, per_cu = 0;
        if (hipGetDevice(&dev) != hipSuccess || hipDeviceGetAttribute(&cus, hipDeviceAttributeMultiprocessorCount, dev) != hipSuccess) { grid = -1; return; }
        if (hipFuncSetAttribute((const void*)hybrid_fwd, hipFuncAttributeMaxDynamicSharedMemorySize, LDS_BYTES) != hipSuccess) { fprintf(stderr, "kernel_launch: hipFuncSetAttribute failed\n"); grid = -1; return; }
        if (hipOccupancyMaxActiveBlocksPerMultiprocessor(&per_cu, (const void*)hybrid_fwd, 512, LDS_BYTES) != hipSuccess || per_cu < 1) fprintf(stderr, "kernel_launch: occupancy query says %d\n", per_cu);
        (void)hipGetLastError();
        if (cus != 256) { fprintf(stderr, "kernel_launch: built for 256 CUs, device has %d\n", cus); }
        grid = 256;
    }
    if (grid < 0) return;
    (void)hipMemsetAsync((char*)d_ws + WS_CTL, 0, CTL_BYTES, stream);
    Args a{};
    for (int i = 0; i < 36; ++i) a.in[i] = d_in[i];
    a.out = (float*)d_out; a.ws = (unsigned char*)d_ws;
    if (DUP_PHASE >= 0) {
        a.ph_lo = 0; a.ph_hi = DUP_PHASE + 1; a.bar_region = 0; hipLaunchKernelGGL(hybrid_fwd, dim3(grid), dim3(512), LDS_BYTES, stream, a);
        for (int n = 0; n < DUP_N; ++n) { a.ph_lo = DUP_PHASE; a.ph_hi = DUP_PHASE + 1; a.bar_region = 1; a.variant = DUP_VARIANT; hipLaunchKernelGGL(hybrid_fwd, dim3(grid), dim3(512), LDS_BYTES, stream, a); }
        a.variant = 0;
        if (DUP_PHASE + 1 < N_PHASES) { a.ph_lo = DUP_PHASE + 1; a.ph_hi = N_PHASES; a.bar_region = 2; hipLaunchKernelGGL(hybrid_fwd, dim3(grid), dim3(512), LDS_BYTES, stream, a); }
    } else if (MK_N_LAUNCHES == 1) {
        a.ph_lo = 0; a.ph_hi = N_PHASES;
        hipLaunchKernelGGL(hybrid_fwd, dim3(grid), dim3(512), LDS_BYTES, stream, a);
    } else {
        for (int p = 0; p < N_PHASES; ++p) { a.ph_lo = p; a.ph_hi = p + 1; hipLaunchKernelGGL(hybrid_fwd, dim3(grid), dim3(512), LDS_BYTES, stream, a); }
    }
    const hipError_t le = hipPeekAtLastError();
    if (le != hipSuccess) fprintf(stderr, "kernel_launch: launch failed: %s\n", hipGetErrorName(le));
}
```

```cpp
#include <hip/hip_runtime.h>
#include <cstdio>
#include <cstdint>

#ifndef MK_N_LAUNCHES
#define MK_N_LAUNCHES 1
#endif
#ifndef DUP_PHASE
#define DUP_PHASE -1
#endif
#define DUP_N 4
#ifndef DUP_VARIANT
#define DUP_VARIANT 0
#endif
#ifndef PHMASK
#define PHMASK 0xFFFF
#endif
#define PHON(k) (((PHMASK) >> (k)) & 1)
#ifndef ITMASK
#define ITMASK 15
#endif

#define LAS __attribute__((address_space(3)))
typedef unsigned short bf16_t;
typedef short bf16x8 __attribute__((ext_vector_type(8)));
typedef float f32x4 __attribute__((ext_vector_type(4)));
typedef float f32x2 __attribute__((ext_vector_type(2)));
typedef unsigned u32x4 __attribute__((ext_vector_type(4)));
typedef unsigned u32x2 __attribute__((ext_vector_type(2)));

constexpr int T = 16384, D = 1024, SEQ = 2048, NBATCH = 8, DEPTH = 4, DFF = 3584, NEXP = 8;
constexpr int HP = 2816;
constexpr int C_US5 = 0, C_CQ = 256, C_CKV = 512, C_KR = 640, C_HQ = 768, C_HF = 1024, C_HI = 1280, C_HG = 1536, C_RQ = 1792, C_RK = 2048, C_RV = 2304, C_RG = 2560, C_GATE = 2816;
constexpr float ALPHA = 1.6817928305074290f;
constexpr float EPS = 1e-5f;
constexpr float QSCALE = 0.10206207261596575f * 1.4426950408889634f;
constexpr int MOE_MAXT = 136;

constexpr size_t MiB = (size_t)1 << 20;
constexpr size_t WS_CTL = 0, CTL_BYTES = 1 * MiB;
constexpr size_t WS_WIN = 1 * MiB, WS_WB = 55 * MiB, WS_WO = 63 * MiB, WS_WPG = 71 * MiB, WS_WPP = 79 * MiB, WS_WFFU = 81 * MiB, WS_WFFD = 109 * MiB;
constexpr size_t WS_WMU = 123 * MiB, WS_WMD = 347 * MiB, WS_WUQ = 459 * MiB, WS_WUKV = 460 * MiB, WS_WGLU = 461 * MiB;
constexpr size_t WS_ROPEM = 462 * MiB, WS_ROPER = 464 * MiB, WS_S5P = 468 * MiB, WS_TOK = 469 * MiB;
constexpr size_t WS_XB = 470 * MiB, WS_PB = 502 * MiB, WS_PP = 534 * MiB, WS_PLE = 566 * MiB, WS_STAGE = 598 * MiB;
constexpr size_t WS_H = WS_STAGE, WS_Y = WS_STAGE + 216 * MiB, WS_S5PRE = WS_STAGE + 248 * MiB, WS_MIXB = WS_STAGE + 256 * MiB, WS_TMP = WS_STAGE + 288 * MiB;
constexpr size_t WS_Q = WS_STAGE + 288 * MiB, WS_K = WS_STAGE + 300 * MiB, WS_VT = WS_STAGE + 312 * MiB, WS_QR = WS_STAGE + 320 * MiB, WS_KR = WS_STAGE + 328 * MiB;
constexpr size_t WS_S5E = WS_STAGE + 336 * MiB, WS_S5C = WS_STAGE + 338 * MiB, WS_HGD = WS_STAGE + 340 * MiB, WS_HGE = WS_STAGE + 341 * MiB, WS_HGI = WS_STAGE + 357 * MiB;
constexpr size_t WS_RTE = WS_STAGE + 373 * MiB, WS_RTI = WS_STAGE + 389 * MiB;
constexpr size_t WS_HFF = WS_STAGE, WS_XG = WS_STAGE, WS_HM = WS_STAGE + 68 * MiB, WS_YM = WS_STAGE + 306 * MiB;
constexpr size_t WS_END = WS_STAGE + 405 * MiB;
constexpr size_t WS_WIN8 = 252 * MiB;
constexpr size_t WS_G8 = WS_STAGE + 96 * MiB;
constexpr size_t WS_X8 = 236 * MiB;
constexpr size_t S5P_ABAR = 0, S5P_BM = 64 * 1024, S5P_CM = 384 * 1024, S5P_LB = 704 * 1024;
constexpr size_t TOK_E = 0, TOK_POS = 128 * 1024, TOK_W = 256 * 1024, TOK_SLOT = 384 * 1024;
constexpr int CW_BAR = 4096, CW_MOE = 32768;

constexpr int LDS_BYTES = 160 * 1024;
constexpr int LDS_STAGE = 0;
constexpr int LDS_MISC = 128 * 1024;
constexpr int LDS_CTLW = 160 * 1024 - 64;

__device__ __forceinline__ float bf2f(bf16_t b) { return __uint_as_float(((unsigned)b) << 16); }
__device__ __forceinline__ unsigned cvt_pk_bf16(float lo, float hi) { unsigned r; asm volatile("v_cvt_pk_bf16_f32 %0, %1, %2" : "=v"(r) : "v"(lo), "v"(hi)); return r; }
__device__ __forceinline__ bf16_t f2bf(float f) { return (bf16_t)(cvt_pk_bf16(f, 0.f) & 0xffffu); }
__device__ __forceinline__ unsigned cvt4_fp8(float a, float b, float c, float d) { int w = 0; w = __builtin_amdgcn_cvt_pk_fp8_f32(a, b, w, false); w = __builtin_amdgcn_cvt_pk_fp8_f32(c, d, w, true); return (unsigned)w; }
__device__ __forceinline__ float sigmoidf_(float x) { return 1.0f / (1.0f + __expf(-x)); }
__device__ __forceinline__ float siluf_(float x) { return x / (1.0f + __expf(-x)); }
__device__ __forceinline__ float gelu_tanh(float v) { const float z = 0.7978845608028654f * (v + 0.044715f * v * v * v); const float th = 1.0f - 2.0f / (__expf(2.0f * z) + 1.0f); return 0.5f * v * (1.0f + th); }
__device__ __forceinline__ f32x4 mfma16(bf16x8 a, bf16x8 b, f32x4 c) { return __builtin_amdgcn_mfma_f32_16x16x32_bf16(a, b, c, 0, 0, 0); }
typedef int i32x8 __attribute__((ext_vector_type(8)));
typedef int i32x4 __attribute__((ext_vector_type(4)));
union Frag { bf16x8 v; unsigned u[4]; u32x2 d[2]; u32x4 q; unsigned short h[8]; };
#define WSYNC() asm volatile("s_waitcnt lgkmcnt(0)" ::: "memory")
#define VM_WAIT() asm volatile("s_waitcnt vmcnt(0)" ::: "memory")
__device__ __forceinline__ float wave_sum(float v) {
#pragma unroll
    for (int o = 1; o < 64; o <<= 1) v += __shfl_xor(v, o);
    return v;
}

namespace pg8 {
constexpr int BM = 256, BK = 64, HALF = 128, HTB = HALF * BK * 2, STAGE_BYTES = 8 * HTB, NXCD = 8, WGM = 8;
__host__ __device__ __forceinline__ int lds_byte(int r, int c) { const int st = (r >> 4) * 2 + (c >> 5), rr = r & 15, cc = c & 31, ob = rr * 64 + cc * 2; return st * 1024 + (ob ^ (((ob >> 9) & 1) << 5)); }
__host__ __device__ __forceinline__ void stage_rc(int b, int& R, int& C) { const int st = b / 1024, sb = b % 1024, swz = sb ^ (((sb >> 9) & 1) << 5); R = (st >> 1) * 16 + swz / 64; C = (st & 1) * 32 + (swz % 64) / 2; }
__host__ __device__ __forceinline__ int perm32(int rho) { const int n = rho >> 4, i = rho & 15; return 8 * (i >> 2) + 4 * n + (i & 3); }

struct Unit { int pm, pn, ak; };
struct Gemm { const void* A; const void* Bt; int lda, ldb, K, flags; };

struct OrderStd {
    int nM, nN, nwg, G, c;
    __device__ void init(int nM_, int nN_, int G_, int c_) { nM = nM_; nN = nN_; nwg = nM * nN; G = G_; c = c_; }
    __device__ bool next(int i, Unit& u) const {
        const long L = (long)i * G + c; if (L >= nwg) return false;
        int wgid = (int)L; { const int q = nwg / NXCD, r = nwg % NXCD, xcd = wgid % NXCD, off = wgid / NXCD; wgid = (xcd < r ? xcd * (q + 1) : r * (q + 1) + (xcd - r) * q) + off; }
        const int nig = WGM * nN, gid = wgid / nig, fm = gid * WGM, gsz = (nM - fm) < WGM ? (nM - fm) : WGM;
        u.pm = fm + ((wgid % nig) % gsz); u.pn = (wgid % nig) / gsz; u.ak = 0; return true;
    }
};
struct OrderLin {
    int c, G, total, nN;
    __device__ bool next(int i, Unit& u) const { if (c < 0) return false; const int L = i * G + c; if (L >= total) return false; u.pm = L / nN; u.pn = L % nN; u.ak = 0; return true; }
};
struct OrderOne {
    int pm, pn; bool has;
    __device__ bool next(int i, Unit& u) const { if (i > 0 || !has) return false; u.pm = pm; u.pn = pn; u.ak = 0; return true; }
};
struct OrderBranch {
    int c, G;
    __device__ bool next(int i, Unit& u) const { const int t = (i >> 2) * G + c, n = i & 3; if (t >= 512) return false; u.pm = t >> 2; u.pn = n * 4 + (t & 3); u.ak = n * 256; return true; }
};
struct OrderMoe {
    int nT, ncol, G, c, t1, t2, t3, t4, t5, t6, t7;
    __device__ bool next(int i, Unit& u) const {
        const long L = (long)i * G + c; if (L >= (long)nT * ncol) return false;
        const int wg = (int)L, nig = WGM * ncol, gid = wg / nig, fm = gid * WGM, gsz = (nT - fm) < WGM ? (nT - fm) : WGM;
        const int pm = fm + ((wg % nig) % gsz), ct = (wg % nig) / gsz;
        const int e = (pm >= t1) + (pm >= t2) + (pm >= t3) + (pm >= t4) + (pm >= t5) + (pm >= t6) + (pm >= t7);
        u.pm = pm; u.pn = e * ncol + ct; u.ak = 0; return true;
    }
};

template <class Epi, class Sched, bool ALIGN_EPI = true, bool SP2 = true>
__device__ __forceinline__ void gemm_phase(LAS unsigned char* lds, const Gemm g, const Sched& S, const Epi& E) {
    int oz_; asm volatile("s_mov_b32 %0, 0" : "=s"(oz_));
    const int tid = threadIdx.x + oz_, wid = __builtin_amdgcn_readfirstlane(tid >> 6), lane = tid & 63, wr = wid >> 2, wc = wid & 3, fr = lane & 15, fq = lane >> 4;
    constexpr int ESZ = Epi::FP8 ? 1 : 2;
    const int nt = (g.K * ESZ + oz_) / (BK * 2);
    unsigned voffA[2], voffB[2]; const unsigned hoffA = Epi::HALF_M ? 0u : (unsigned)(HALF * g.lda * ESZ), hoffB = (unsigned)(HALF * g.ldb * ESZ);
#pragma unroll
    for (int i = 0; i < 2; ++i) { int R, C; stage_rc(tid * 16 + i * 8192, R, C); const int Rb = Epi::PERM ? ((R & ~31) + perm32(R & 31)) : R;
        voffA[i] = (unsigned)(R * g.lda * ESZ + C * 2); voffB[i] = (unsigned)(Rb * g.ldb * ESZ + C * 2); }
    const size_t kstep = (size_t)(BK * 2);
    const size_t hstepA = (size_t)HALF * g.lda * ESZ, hstepB = (size_t)HALF * g.ldb * ESZ;
    static_assert(!Epi::HALF_M || SP2, "HALF_M needs the SP2 loop");
    const size_t tstepA = Epi::HALF_M ? hstepA : 2 * hstepA, tstepB = 2 * hstepB;
    const size_t hA2 = Epi::HALF_M ? 0 : hstepA;
    const unsigned ldsw = (unsigned)wid * 1024u;
    const int aoff = lds_byte(wr * 64 + fr, fq * 8), boff = lds_byte(wc * 32 + fr, fq * 8);
#define PG8_SA(b, h) (((b) * 2 + (h)) * HTB)
#define PG8_SB(b, h) ((4 + (b) * 2 + (h)) * HTB)
#define voffAh voffA, hoffA
#define voffBh voffB, hoffB
#define PG8_STAGE(...) PG8_STAGE_(__VA_ARGS__, 0u)
#define PG8_STAGE_(bufoff, gbase, voff, hoff, ...) do { _Pragma("unroll") for (int _i = 0; _i < 2; ++_i) { unsigned vo_ = (voff)[_i] + (hoff); asm volatile("" : "+v"(vo_)); \
        __builtin_amdgcn_global_load_lds((const unsigned*)((const char*)(gbase) + vo_), (LAS unsigned*)(lds + (bufoff) + ldsw + _i * 8192), 16, 0, 0); } } while (0)
#define PG8_LDA(dst, b, h) do { if constexpr (Epi::FP8) { _Pragma("unroll") for (int m = 0; m < 4; ++m) { const i32x4 lo_ = *(const LAS i32x4*)(lds + PG8_SA(b, h) + aoff + m * 2048), hi_ = *(const LAS i32x4*)(lds + PG8_SA(b, h) + aoff + m * 2048 + 1024); dst##8[m] = __builtin_shufflevector(lo_, hi_, 0, 1, 2, 3, 4, 5, 6, 7); } } \
        else { _Pragma("unroll") for (int m = 0; m < 4; ++m) _Pragma("unroll") for (int k = 0; k < 2; ++k) dst[m][k] = *(const LAS bf16x8*)(lds + PG8_SA(b, h) + aoff + m * 2048 + k * 1024); } } while (0)
#define PG8_LDB(dst, b, h) do { if constexpr (Epi::FP8) { _Pragma("unroll") for (int n = 0; n < 2; ++n) { const i32x4 lo_ = *(const LAS i32x4*)(lds + PG8_SB(b, h) + boff + n * 2048), hi_ = *(const LAS i32x4*)(lds + PG8_SB(b, h) + boff + n * 2048 + 1024); dst##8[n] = __builtin_shufflevector(lo_, hi_, 0, 1, 2, 3, 4, 5, 6, 7); } } \
        else { _Pragma("unroll") for (int n = 0; n < 2; ++n) _Pragma("unroll") for (int k = 0; k < 2; ++k) dst[n][k] = *(const LAS bf16x8*)(lds + PG8_SB(b, h) + boff + n * 2048 + k * 1024); } } while (0)
#define PG8_MMA(ai, bj, At, Bt) do { __builtin_amdgcn_s_setprio(1); if constexpr (Epi::FP8) { _Pragma("unroll") for (int m = 0; m < 4; ++m) _Pragma("unroll") for (int n = 0; n < 2; ++n) \
            asm volatile("v_mfma_scale_f32_16x16x128_f8f6f4 %0, %1, %2, %0, %3, %3 op_sel_hi:[0,0,0]" : "+v"(acc[ai][bj][m][n]) : "v"(Bt##8[n]), "v"(At##8[m]), "v"(scl8)); } \
        else { _Pragma("unroll") for (int m = 0; m < 4; ++m) _Pragma("unroll") for (int n = 0; n < 2; ++n) _Pragma("unroll") for (int k = 0; k < 2; ++k) \
            acc[ai][bj][m][n] = __builtin_amdgcn_mfma_f32_16x16x32_bf16(Bt[n][k], At[m][k], acc[ai][bj][m][n], 0, 0, 0); } __builtin_amdgcn_s_setprio(0); } while (0)
#define PG8_WAIT_V(n) asm volatile("s_waitcnt vmcnt(" #n ")" ::: "memory")
#define PG8_WAIT_L(n) asm volatile("s_waitcnt lgkmcnt(" #n ")" ::: "memory")
#define PG8_BAR __builtin_amdgcn_s_barrier()
#define PG8_SCHED __builtin_amdgcn_sched_barrier(0)
    Unit cur, nxt; int ui = 0;
    if (!S.next(0, cur)) return;
    f32x4 acc[2][2][4][2];
#pragma unroll
    for (int a = 0; a < 2; ++a)
#pragma unroll
        for (int b = 0; b < 2; ++b)
#pragma unroll
            for (int m = 0; m < 4; ++m)
#pragma unroll
                for (int n = 0; n < 2; ++n) acc[a][b][m][n] = (f32x4){0.f, 0.f, 0.f, 0.f};
    bf16x8 At[4][2], B0[2][2], B1[2][2]; i32x8 At8[4], B08[2], B18[2]; const int scl8 = 0x7f7f7f7f;
    const char* cA = (const char*)g.A + (size_t)cur.pm * tstepA + (size_t)cur.ak * ESZ; const char* cB = (const char*)g.Bt + (size_t)cur.pn * tstepB;
    if constexpr (SP2) {
        PG8_STAGE(PG8_SB(0, 0), cB, voffB); PG8_STAGE(PG8_SB(0, 1), cB, voffBh); PG8_STAGE(PG8_SA(0, 0), cA, voffA); PG8_STAGE(PG8_SA(0, 1), cA, voffAh);
        if (wr == 1) PG8_BAR;
        PG8_WAIT_V(2); PG8_BAR;
        PG8_STAGE(PG8_SB(1, 0), cB + kstep, voffB); PG8_STAGE(PG8_SA(1, 0), cA + kstep, voffA); PG8_STAGE(PG8_SB(1, 1), cB + kstep, voffBh);
        PG8_WAIT_V(6); PG8_BAR;
    } else {
        PG8_STAGE(PG8_SB(0, 0), cB, voffB); PG8_STAGE(PG8_SA(0, 0), cA, voffA); PG8_STAGE(PG8_SB(0, 1), cB, voffBh); PG8_STAGE(PG8_SA(0, 1), cA, voffAh);
        if (wr == 1) PG8_BAR;
        PG8_WAIT_V(4); PG8_BAR;
        PG8_STAGE(PG8_SB(1, 0), cB + kstep, voffB); PG8_STAGE(PG8_SA(1, 0), cA + kstep, voffA); PG8_STAGE(PG8_SB(1, 1), cB + kstep, voffBh);
        PG8_WAIT_V(6); PG8_BAR;
    }
    for (;;) {
        const bool has_next = S.next(ui + 1, nxt);
        const char* nA = has_next ? (const char*)g.A + (size_t)nxt.pm * tstepA + (size_t)nxt.ak * ESZ : cA; const char* nB = has_next ? (const char*)g.Bt + (size_t)nxt.pn * tstepB : cB;
        for (int t = 0; t < nt; t += 2) {
            const bool last = (t == nt - 2);
            const char* a1 = cA + (size_t)(t + 1) * kstep;
            const char* a2 = last ? nA : cA + (size_t)(t + 2) * kstep; const char* b2 = last ? nB : cB + (size_t)(t + 2) * kstep;
            const char* a3 = a2 + kstep; const char* b3 = b2 + kstep;
            if constexpr (SP2) {
            PG8_LDB(B0, 0, 0); PG8_LDB(B1, 0, 1); PG8_SCHED; PG8_LDA(At, 0, 0); PG8_STAGE(PG8_SA(1, 1), a1, voffAh);
            PG8_WAIT_V(8); PG8_WAIT_L(0); PG8_BAR; PG8_MMA(0, 0, At, B0); PG8_MMA(0, 1, At, B1); PG8_BAR; PG8_SCHED;
            if constexpr (!Epi::HALF_M) PG8_LDA(At, 0, 1); PG8_STAGE(PG8_SB(0, 0), b2, voffB); PG8_STAGE(PG8_SB(0, 1), b2, voffBh); PG8_STAGE(PG8_SA(0, 0), a2, voffA);
            PG8_WAIT_V(8); PG8_WAIT_L(0); PG8_BAR; if constexpr (!Epi::HALF_M) { PG8_MMA(1, 0, At, B0); PG8_MMA(1, 1, At, B1); } PG8_BAR; PG8_SCHED;
            PG8_LDB(B0, 1, 0); PG8_LDB(B1, 1, 1); PG8_SCHED; PG8_LDA(At, 1, 0); PG8_STAGE(PG8_SA(0, 1), a2, voffAh);
            PG8_WAIT_V(8); PG8_WAIT_L(0); PG8_BAR; PG8_MMA(0, 0, At, B0); PG8_MMA(0, 1, At, B1); PG8_BAR; PG8_SCHED;
            if constexpr (!Epi::HALF_M) PG8_LDA(At, 1, 1); PG8_STAGE(PG8_SB(1, 0), b3, voffB); PG8_STAGE(PG8_SB(1, 1), b3, voffBh); PG8_STAGE(PG8_SA(1, 0), a3, voffA);
            PG8_WAIT_V(8); PG8_WAIT_L(0); PG8_BAR; if constexpr (!Epi::HALF_M) { PG8_MMA(1, 0, At, B0); PG8_MMA(1, 1, At, B1); } PG8_BAR; PG8_SCHED;
            } else {
            PG8_LDB(B0, 0, 0); PG8_SCHED; PG8_LDA(At, 0, 0); PG8_STAGE(PG8_SA(1, 1), a1, voffAh);
            PG8_WAIT_L(8); PG8_BAR; PG8_WAIT_L(0); PG8_MMA(0, 0, At, B0); PG8_BAR; PG8_SCHED;
            PG8_LDB(B1, 0, 1); PG8_STAGE(PG8_SB(0, 0), b2, voffB);
            PG8_BAR; PG8_WAIT_L(0); PG8_MMA(0, 1, At, B1); PG8_BAR;
            PG8_LDA(At, 0, 1); PG8_STAGE(PG8_SA(0, 0), a2, voffA);
            PG8_BAR; PG8_WAIT_L(0); PG8_MMA(1, 0, At, B0); PG8_BAR; PG8_SCHED;
            PG8_STAGE(PG8_SB(0, 1), b2, voffBh);
            PG8_WAIT_V(6); PG8_BAR; PG8_MMA(1, 1, At, B1); PG8_BAR;
            PG8_LDB(B0, 1, 0); PG8_SCHED; PG8_LDA(At, 1, 0); PG8_STAGE(PG8_SA(0, 1), a2, voffAh);
            PG8_WAIT_L(8); PG8_BAR; PG8_WAIT_L(0); PG8_MMA(0, 0, At, B0); PG8_BAR; PG8_SCHED;
            PG8_LDB(B1, 1, 1); PG8_STAGE(PG8_SB(1, 0), b3, voffB);
            PG8_BAR; PG8_WAIT_L(0); PG8_MMA(0, 1, At, B1); PG8_BAR;
            PG8_LDA(At, 1, 1); PG8_STAGE(PG8_SA(1, 0), a3, voffA);
            PG8_BAR; PG8_WAIT_L(0); PG8_MMA(1, 0, At, B0); PG8_BAR; PG8_SCHED;
            PG8_STAGE(PG8_SB(1, 1), b3, voffBh);
            PG8_WAIT_V(6); PG8_BAR; PG8_MMA(1, 1, At, B1); PG8_BAR;
            }
        }
        if constexpr (ALIGN_EPI) { if (wr == 0) PG8_BAR; }
        if constexpr (Epi::FP8) { asm volatile("s_nop 15\n\ts_nop 15\n\ts_nop 15" ::: "memory"); }
        { int vz_; asm volatile("v_mov_b32 %0, 0" : "=v"(vz_)); if (!(g.flags & 1)) E(acc, cur, wr, wc, fr + vz_, fq); }
        if (!has_next) break;
#pragma unroll
        for (int a = 0; a < (Epi::HALF_M ? 1 : 2); ++a)
#pragma unroll
            for (int b = 0; b < 2; ++b)
#pragma unroll
                for (int m = 0; m < 4; ++m)
#pragma unroll
                    for (int n = 0; n < 2; ++n) acc[a][b][m][n] = (f32x4){0.f, 0.f, 0.f, 0.f};
        cur = nxt; cA = nA; cB = nB; ++ui;
        if constexpr (ALIGN_EPI) { if (wr == 1) PG8_BAR; }
    }
    PG8_WAIT_V(0);
    if constexpr (!ALIGN_EPI) { if (wr == 0) PG8_BAR; }
    PG8_BAR;
#undef PG8_SA
#undef PG8_SB
#undef PG8_STAGE
#undef PG8_STAGE_
#undef voffAh
#undef voffBh
#undef PG8_LDA
#undef PG8_LDB
#undef PG8_MMA
#undef PG8_WAIT_V
#undef PG8_WAIT_L
#undef PG8_BAR
#undef PG8_SCHED
}

typedef f32x4 Acc[2][2][4][2];
template <bool F8>
struct EpiBf16T {
    static constexpr bool PERM = true, HALF_M = false, FP8 = F8;
    bf16_t* O; int ldc; int ncol; float sc;
    __device__ __forceinline__ void operator()(const Acc& acc, const Unit& u, int wr, int wc, int fr, int fq) const {
        const int row0 = u.pm * BM + wr * 64 + fr, col0 = (u.pn % ncol) * BM + wc * 32 + 8 * fq;
#pragma unroll
        for (int ai = 0; ai < 2; ++ai)
#pragma unroll
            for (int m = 0; m < 4; ++m) { bf16_t* rowp = O + (size_t)(row0 + ai * HALF + m * 16) * ldc + col0;
#pragma unroll
                for (int bj = 0; bj < 2; ++bj) { const f32x4 v0 = acc[ai][bj][m][0] * sc, v1 = acc[ai][bj][m][1] * sc;
                    u32x4 w; w.x = cvt_pk_bf16(v0[0], v0[1]); w.y = cvt_pk_bf16(v0[2], v0[3]); w.z = cvt_pk_bf16(v1[0], v1[1]); w.w = cvt_pk_bf16(v1[2], v1[3]);
                    *(u32x4*)(rowp + bj * HALF) = w; } }
    }
};
typedef EpiBf16T<false> EpiBf16;
struct EpiSwiglu8 {
    static constexpr bool PERM = true, HALF_M = false, FP8 = true;
    unsigned char* O; int ldc; int ncol;
    __device__ __forceinline__ void operator()(const Acc& acc, const Unit& u, int wr, int wc, int fr, int fq) const {
        const int row0 = u.pm * BM + wr * 64 + fr, col0 = (u.pn % ncol) * HALF + wc * 32 + 8 * fq;
#pragma unroll
        for (int ai = 0; ai < 2; ++ai)
#pragma unroll
            for (int m = 0; m < 4; ++m) { unsigned char* rowp = O + (size_t)(row0 + ai * HALF + m * 16) * ldc + col0;
                float o[8];
#pragma unroll
                for (int n = 0; n < 2; ++n)
#pragma unroll
                    for (int j = 0; j < 4; ++j) o[n * 4 + j] = siluf_(acc[ai][0][m][n][j] * 0.015625f) * (acc[ai][1][m][n][j] * 0.25f);
                u32x2 w; w.x = cvt4_fp8(o[0], o[1], o[2], o[3]); w.y = cvt4_fp8(o[4], o[5], o[6], o[7]);
                *(u32x2*)rowp = w; }
    }
};
struct EpiSigMul {
    static constexpr bool PERM = true, HALF_M = false, FP8 = false;
    bf16_t* O; int ldc; const bf16_t* P; int ldp;
    __device__ __forceinline__ void operator()(const Acc& acc, const Unit& u, int wr, int wc, int fr, int fq) const {
        const int row0 = u.pm * BM + wr * 64 + fr, col0 = u.pn * BM + wc * 32 + 8 * fq;
#pragma unroll
        for (int ai = 0; ai < 2; ++ai)
#pragma unroll
            for (int m = 0; m < 4; ++m) { const size_t r = (size_t)(row0 + ai * HALF + m * 16);
#pragma unroll
                for (int bj = 0; bj < 2; ++bj) { const u32x4 pv = *(const u32x4*)(P + r * ldp + col0 + bj * HALF); const f32x4 v0 = acc[ai][bj][m][0], v1 = acc[ai][bj][m][1];
                    float o[8];
#pragma unroll
                    for (int j = 0; j < 4; ++j) { const unsigned pw = pv[j]; const float plo = __uint_as_float(pw << 16), phi = __uint_as_float(pw & 0xffff0000u);
                        const float a = (j < 2) ? v0[2 * j] : v1[2 * j - 4], b = (j < 2) ? v0[2 * j + 1] : v1[2 * j - 3];
                        o[2 * j] = sigmoidf_(a) * plo; o[2 * j + 1] = sigmoidf_(b) * phi; }
                    u32x4 w; w.x = cvt_pk_bf16(o[0], o[1]); w.y = cvt_pk_bf16(o[2], o[3]); w.z = cvt_pk_bf16(o[4], o[5]); w.w = cvt_pk_bf16(o[6], o[7]);
                    *(u32x4*)(O + r * ldc + col0 + bj * HALF) = w; }
                if (m == 3) asm volatile("" ::: "memory"); }
    }
};
struct EpiBranch {
    static constexpr bool PERM = true, HALF_M = false, FP8 = false;
    const bf16_t* Hg; float* tmp; bf16_t* mixb;
    __device__ __forceinline__ void operator()(const Acc& acc, const Unit& u, int wr, int wc, int fr, int fq) const {
        const int n4 = u.pn >> 2, ct = u.pn & 3;
        const int row0 = u.pm * BM + wr * 64 + fr, col0 = ct * BM + wc * 32 + 8 * fq;
#pragma unroll
        for (int ai = 0; ai < 2; ++ai)
#pragma unroll
            for (int m = 0; m < 4; ++m) { const size_t r = (size_t)(row0 + ai * HALF + m * 16);
#pragma unroll
                for (int bj = 0; bj < 2; ++bj) { const int c = col0 + bj * HALF;
                    const u32x4 gv = *(const u32x4*)(Hg + r * HP + n4 * 1024 + c); const f32x4 v0 = acc[ai][bj][m][0], v1 = acc[ai][bj][m][1];
                    float o[8];
#pragma unroll
                    for (int j = 0; j < 4; ++j) { const unsigned gw = gv[j]; const float glo = __uint_as_float(gw << 16), ghi = __uint_as_float(gw & 0xffff0000u);
                        const float a = (j < 2) ? v0[2 * j] : v1[2 * j - 4], b = (j < 2) ? v0[2 * j + 1] : v1[2 * j - 3];
                        o[2 * j] = sigmoidf_(glo) * a; o[2 * j + 1] = sigmoidf_(ghi) * b; }
                    float* tp = tmp + r * 1024 + c;
                    if (n4 > 0) { const f32x4 p0 = *(const f32x4*)tp, p1 = *(const f32x4*)(tp + 4);
#pragma unroll
                        for (int j = 0; j < 4; ++j) { o[j] += p0[j]; o[4 + j] += p1[j]; } }
                    if (n4 < 3) { *(f32x4*)tp = (f32x4){o[0], o[1], o[2], o[3]}; *(f32x4*)(tp + 4) = (f32x4){o[4], o[5], o[6], o[7]}; }
                    else { u32x4 w; w.x = cvt_pk_bf16(o[0], o[1]); w.y = cvt_pk_bf16(o[2], o[3]); w.z = cvt_pk_bf16(o[4], o[5]); w.w = cvt_pk_bf16(o[6], o[7]); *(u32x4*)(mixb + r * 1024 + c) = w; } }
                if (m & 1) asm volatile("" ::: "memory"); }
    }
};
struct EpiGate8 {
    static constexpr bool PERM = true, HALF_M = false, FP8 = true;
    unsigned char* O;
    __device__ __forceinline__ void operator()(const Acc& acc, const Unit& u, int wr, int wc, int fr, int fq) const {
        const int row0 = u.pm * BM + wr * 64 + fr, col0 = u.pn * BM + wc * 32 + 8 * fq;
#pragma unroll
        for (int ai = 0; ai < 2; ++ai)
#pragma unroll
            for (int m = 0; m < 4; ++m) { unsigned char* rowp = O + (size_t)(row0 + ai * HALF + m * 16) * 4096 + col0;
#pragma unroll
                for (int bj = 0; bj < 2; ++bj) { unsigned w[2];
#pragma unroll
                    for (int n = 0; n < 2; ++n) { const f32x4 v = acc[ai][bj][m][n]; unsigned q = 0;
#pragma unroll
                        for (int j = 0; j < 4; ++j) q |= (unsigned)(255.0f * sigmoidf_(v[j] * 0.03125f) + 0.5f) << (8 * j);
                        w[n] = q; }
                    *(u32x2*)(rowp + bj * HALF) = (u32x2){w[0], w[1]}; } }
    }
};
struct EpiBranchH {
    static constexpr bool PERM = true, HALF_M = true, FP8 = false;
    const unsigned char* G8; bf16_t* mixb;
    __device__ __forceinline__ void operator()(Acc& acc, const Unit& u, int wr, int wc, int fr, int fq) const {
        const int n4 = u.pn >> 2, ct = u.pn & 3;
        const int row0 = u.pm * HALF + wr * 64 + fr, col0 = ct * BM + wc * 32 + 8 * fq;
#pragma unroll
        for (int m = 0; m < 4; ++m) { const size_t r = (size_t)(row0 + m * 16);
#pragma unroll
            for (int bj = 0; bj < 2; ++bj) { const int c = col0 + bj * HALF;
                const u32x2 gv = *(const u32x2*)(G8 + r * 4096 + n4 * 1024 + c);
                f32x4 g0, g1; const float k255 = 1.0f / 255.0f;
                g0[0] = (float)(gv.x & 0xffu) * k255; g0[1] = (float)((gv.x >> 8) & 0xffu) * k255; g0[2] = (float)((gv.x >> 16) & 0xffu) * k255; g0[3] = (float)(gv.x >> 24) * k255;
                g1[0] = (float)(gv.y & 0xffu) * k255; g1[1] = (float)((gv.y >> 8) & 0xffu) * k255; g1[2] = (float)((gv.y >> 16) & 0xffu) * k255; g1[3] = (float)(gv.y >> 24) * k255;
                const f32x4 p0 = g0 * acc[0][bj][m][0], p1 = g1 * acc[0][bj][m][1];
                if (n4 == 0) { acc[1][bj][m][0] = p0; acc[1][bj][m][1] = p1; } else { acc[1][bj][m][0] += p0; acc[1][bj][m][1] += p1; }
                if (n4 == 3) { const f32x4 o0 = acc[1][bj][m][0], o1 = acc[1][bj][m][1]; u32x4 w; w.x = cvt_pk_bf16(o0[0], o0[1]); w.y = cvt_pk_bf16(o0[2], o0[3]); w.z = cvt_pk_bf16(o1[0], o1[1]); w.w = cvt_pk_bf16(o1[2], o1[3]);
                    *(u32x4*)(mixb + r * 1024 + c) = w; } } }
    }
};
template <bool F8>
struct EpiResidT {
    static constexpr bool PERM = false, HALF_M = false, FP8 = F8;
    const float* base; float* out; const bf16_t* add; float sc;
    __device__ __forceinline__ void operator()(const Acc& acc, const Unit& u, int wr, int wc, int fr, int fq) const {
        const int row0 = u.pm * BM + wr * 64 + fr, col0 = u.pn * BM + wc * 32 + 4 * fq;
#pragma unroll
        for (int ai = 0; ai < 2; ++ai)
#pragma unroll
            for (int m = 0; m < 4; ++m) { const size_t off = (size_t)(row0 + ai * HALF + m * 16) * 1024 + col0;
#pragma unroll
                for (int bj = 0; bj < 2; ++bj)
#pragma unroll
                    for (int n = 0; n < 2; ++n) { const size_t o = off + bj * HALF + n * 16; const f32x4 bs = *(const f32x4*)(base + o); f32x4 v = bs * ALPHA + acc[ai][bj][m][n] * sc;
                        if (add) { const u32x2 av = *(const u32x2*)(add + o); v[0] += __uint_as_float(av.x << 16); v[1] += __uint_as_float(av.x & 0xffff0000u); v[2] += __uint_as_float(av.y << 16); v[3] += __uint_as_float(av.y & 0xffff0000u); }
                        *(f32x4*)(out + o) = v; }
                if (m & 1) asm volatile("" ::: "memory"); }
    }
};
typedef EpiResidT<false> EpiResid;
struct EpiQ {
    static constexpr bool PERM = false, HALF_M = false, FP8 = false;
    bf16_t* Qb; const float* ropeM; const LAS float* rs;
    __device__ __forceinline__ void operator()(const Acc& acc, const Unit& u, int wr, int wc, int fr, int fq) const {
#pragma unroll
        for (int bj = 0; bj < 2; ++bj) { const int gb = u.pn * BM + bj * HALF + wc * 32; if (gb >= 384) continue;
            const int hd = gb / 96, part = (gb % 96) / 32;
#pragma unroll
            for (int ai = 0; ai < 2; ++ai)
#pragma unroll
                for (int m = 0; m < 4; ++m) { const int rl = ai * HALF + wr * 64 + m * 16 + fr, t = u.pm * BM + rl, b = t >> 11, s = t & 2047; const float sc = rs[rl] * QSCALE;
                    f32x4 x1 = acc[ai][bj][m][0] * sc, x2 = acc[ai][bj][m][1] * sc;
                    if (part == 2) { const f32x4 cs = *(const f32x4*)(ropeM + (size_t)t * 32 + 4 * fq), sn = *(const f32x4*)(ropeM + (size_t)t * 32 + 16 + 4 * fq);
                        const f32x4 o1 = x1 * cs - x2 * sn, o2 = x2 * cs + x1 * sn; x1 = o1; x2 = o2; }
                    bf16_t* qp = Qb + ((size_t)((b * 4 + hd) * SEQ + s)) * 96 + part * 32 + 4 * fq;
                    u32x2 w1, w2; w1.x = cvt_pk_bf16(x1[0], x1[1]); w1.y = cvt_pk_bf16(x1[2], x1[3]); w2.x = cvt_pk_bf16(x2[0], x2[1]); w2.y = cvt_pk_bf16(x2[2], x2[3]);
                    *(u32x2*)qp = w1; *(u32x2*)(qp + 16) = w2; asm volatile("" ::: "memory"); } }
    }
};
struct EpiKV {
    static constexpr bool PERM = false, HALF_M = false, FP8 = false;
    bf16_t* Kb; bf16_t* Vt; const LAS float* rs;
    __device__ __forceinline__ void operator()(const Acc& acc, const Unit& u, int wr, int wc, int fr, int fq) const {
#pragma unroll
        for (int bj = 0; bj < 2; ++bj) { const int gb = u.pn * BM + bj * HALF + wc * 32; const int hd = gb / 128, part = (gb % 128) / 32;
#pragma unroll
            for (int ai = 0; ai < 2; ++ai)
#pragma unroll
                for (int m = 0; m < 4; ++m) { const int rl = ai * HALF + wr * 64 + m * 16 + fr, t = u.pm * BM + rl, b = t >> 11, s = t & 2047; const float sc = rs[rl];
                    const f32x4 x1 = acc[ai][bj][m][0] * sc, x2 = acc[ai][bj][m][1] * sc;
                    if (part < 2) { bf16_t* kp = Kb + ((size_t)((b * 4 + hd) * SEQ + s)) * 96 + part * 32 + 4 * fq;
                        u32x2 w1, w2; w1.x = cvt_pk_bf16(x1[0], x1[1]); w1.y = cvt_pk_bf16(x1[2], x1[3]); w2.x = cvt_pk_bf16(x2[0], x2[1]); w2.y = cvt_pk_bf16(x2[2], x2[3]);
                        *(u32x2*)kp = w1; *(u32x2*)(kp + 16) = w2; }
                    else { bf16_t* vp = Vt + ((size_t)((b * 4 + hd) * 64 + (part - 2) * 32 + 4 * fq)) * SEQ + s;
#pragma unroll
                        for (int j = 0; j < 4; ++j) { vp[(size_t)j * SEQ] = f2bf(x1[j]); vp[(size_t)(16 + j) * SEQ] = f2bf(x2[j]); } }
                    asm volatile("" ::: "memory"); } }
    }
};
}

#define XB_TMO      128
#define XB_XCNT(j)  (256  + 64 * (j))
#define XB_XSUB(j)  (1280 + 64 * (j))
#define XB_XGEN(j)  (2304 + 64 * (j))
#define XB_TOP      3328
#define XB_TOPGEN   3392
#define XCD_BAR_WORDS 3456
#define XB_SPIN_CAP (1u << 18)
__device__ __forceinline__ unsigned xb_ld(unsigned* p)              { return __hip_atomic_load(p, __ATOMIC_RELAXED, __HIP_MEMORY_SCOPE_AGENT); }
__device__ __forceinline__ unsigned xb_add(unsigned* p, unsigned v) { return __hip_atomic_fetch_add(p, v, __ATOMIC_RELAXED, __HIP_MEMORY_SCOPE_AGENT); }
__device__ __forceinline__ unsigned xb_xcc_id() { return (unsigned)__builtin_amdgcn_s_getreg((3 << 11) | 20) & 0xFu; }
#define XB_SPIN(cond, bar) do { unsigned _sp = 0; while (cond) { __builtin_amdgcn_s_sleep(1); \
    if ((++_sp & 255u) == 0u) { if (xb_ld(&(bar)[XB_TMO])) break; if (_sp > XB_SPIN_CAP) { atomicAdd(&(bar)[XB_TMO], 1u); break; } } } } while (0)
struct XcdBarrier { unsigned* bar; unsigned x; volatile LAS unsigned* st; };
__device__ __forceinline__ XcdBarrier xcd_barrier_post(unsigned* bar, volatile LAS unsigned* st) {
    XcdBarrier b; b.bar = bar; b.x = xb_xcc_id(); b.st = st;
    if (threadIdx.x == 0) (void)xb_add(&bar[XB_XCNT(b.x)], 1u);
    return b;
}
__device__ __forceinline__ void xcd_barrier_complete(unsigned* bar, unsigned x, unsigned& nloc, unsigned& nx) {
    const unsigned G = gridDim.x * gridDim.y * gridDim.z;
    unsigned sum, cnt, mine, sp = 0u;
    for (;;) {
        sum = 0u; cnt = 0u; mine = 0u;
#pragma unroll
        for (unsigned j = 0; j < 16; ++j) { const unsigned c = xb_ld(&bar[XB_XCNT(j)]); sum += c; cnt += (c > 0u) ? 1u : 0u; mine = (j == x) ? c : mine; }
        if (sum == G) break;
        __builtin_amdgcn_s_sleep(1);
        if ((++sp & 255u) == 0u) { if (xb_ld(&bar[XB_TMO])) break; if (sp > XB_SPIN_CAP) { atomicAdd(&bar[XB_TMO], 1u); break; } }
    }
    nloc = mine > 0u ? mine : 1u; nx = cnt > 0u ? cnt : 1u;
}
__device__ __forceinline__ void xcd_barrier(const XcdBarrier& b) {
    asm volatile("s_waitcnt vmcnt(0)" ::: "memory");
    __syncthreads();
    if (threadIdx.x == 0) {
        unsigned* bar = b.bar;
        __builtin_amdgcn_s_waitcnt(0);
        unsigned nloc = b.st[0], nx = b.st[1];
        if (nloc == 0u) { xcd_barrier_complete(bar, b.x, nloc, nx); b.st[0] = nloc; b.st[1] = nx; }
        const unsigned old = xb_add(&bar[XB_XSUB(b.x)], 1u);
        const unsigned gen = old / nloc;
        if (old + 1u == (gen + 1u) * nloc) {
            __builtin_amdgcn_fence(__ATOMIC_RELEASE, "agent");
            asm volatile("s_waitcnt vmcnt(0)" ::: "memory");
            const unsigned og = xb_add(&bar[XB_TOP], 1u);
            const unsigned tg = og / nx;
            if (og + 1u == (tg + 1u) * nx) xb_add(&bar[XB_TOPGEN], 1u);
            else XB_SPIN(xb_ld(&bar[XB_TOPGEN]) == tg, bar);
            __builtin_amdgcn_fence(__ATOMIC_ACQUIRE, "agent");
            xb_add(&bar[XB_XGEN(b.x)], 1u);
            asm volatile("s_waitcnt vmcnt(0)" ::: "memory");
        } else {
            XB_SPIN(xb_ld(&bar[XB_XGEN(b.x)]) == gen, bar);
            __builtin_amdgcn_fence(__ATOMIC_ACQUIRE, "agent");
            asm volatile("s_waitcnt vmcnt(0)" ::: "memory");
        }
    }
    __syncthreads();
}

__device__ __forceinline__ int vzero() { int z; asm volatile("v_mov_b32 %0, 0" : "=v"(z)); return z; }
__device__ __forceinline__ int opaque0() { int z; asm volatile("s_mov_b32 %0, 0" : "=s"(z)); return z; }
struct Args { const void* in[36]; float* out; unsigned char* ws; int ph_lo, ph_hi, bar_region, variant; };
struct Frame {
    LAS unsigned char* lds;
    unsigned char* ws;
    const void* const* in;
    float* out;
    int tid, lane, wave, G, bid, gw, NGW;
};
__device__ __forceinline__ Frame reframe(const Frame& F) {
    Frame P = F; const int z = opaque0(), vz = vzero();
    P.ws = F.ws + z; P.out = F.out + z; P.lds = F.lds + z; P.bid = F.bid + z; P.G = F.G + z; P.wave = F.wave + z; P.gw = P.bid * 8 + P.wave; P.NGW = P.G * 8; P.tid = F.tid + vz; P.lane = F.lane + vz;
    return P;
}
#define IN_F(k) ((const float*)F.in[k])
#define WSP(T_, off) ((T_*)(F.ws + (off)))

__device__ __forceinline__ void tr_item(const float* W, int N, bf16_t* WT, int ldd, int drow0, int k0, int n0, const float* kscale, LAS float* scr, int lane) {
#pragma unroll 8
    for (int i = 0; i < 32; ++i) { const int kk = 2 * i + (lane >> 5); scr[kk * 33 + (lane & 31)] = W[(size_t)(k0 + kk) * N + n0 + (lane & 31)]; }
    WSYNC();
    const int c = lane & 7;
    float ks[8];
#pragma unroll
    for (int q = 0; q < 8; ++q) ks[q] = kscale ? kscale[k0 + 8 * c + q] : 1.0f;
#pragma unroll
    for (int j = 0; j < 4; ++j) { const int n = (lane >> 3) + 8 * j; const LAS float* s = scr + (8 * c) * 33 + n;
        u32x4 o; o.x = cvt_pk_bf16(s[0 * 33] * ks[0], s[1 * 33] * ks[1]); o.y = cvt_pk_bf16(s[2 * 33] * ks[2], s[3 * 33] * ks[3]); o.z = cvt_pk_bf16(s[4 * 33] * ks[4], s[5 * 33] * ks[5]); o.w = cvt_pk_bf16(s[6 * 33] * ks[6], s[7 * 33] * ks[7]);
        *(u32x4*)(WT + (size_t)(drow0 + n) * ldd + k0 + 8 * c) = o; }
    WSYNC();
}
__device__ __forceinline__ void tr_item8(const float* W, int N, unsigned char* WT, int ldd, int drow0, int k0, int n0, float scale, LAS float* scr, int lane) {
#pragma unroll 8
    for (int i = 0; i < 32; ++i) { const int kk = 2 * i + (lane >> 5); scr[kk * 33 + (lane & 31)] = W[(size_t)(k0 + kk) * N + n0 + (lane & 31)]; }
    WSYNC();
    const int c = lane & 3;
#pragma unroll
    for (int j = 0; j < 2; ++j) { const int n = (lane >> 2) + 16 * j; const LAS float* s = scr + (16 * c) * 33 + n;
        u32x4 o;
        o.x = cvt4_fp8(s[0 * 33] * scale, s[1 * 33] * scale, s[2 * 33] * scale, s[3 * 33] * scale); o.y = cvt4_fp8(s[4 * 33] * scale, s[5 * 33] * scale, s[6 * 33] * scale, s[7 * 33] * scale);
        o.z = cvt4_fp8(s[8 * 33] * scale, s[9 * 33] * scale, s[10 * 33] * scale, s[11 * 33] * scale); o.w = cvt4_fp8(s[12 * 33] * scale, s[13 * 33] * scale, s[14 * 33] * scale, s[15 * 33] * scale);
        *(u32x4*)(WT + (size_t)(drow0 + n) * ldd + k0 + 16 * c) = o; }
    WSYNC();
}
template <int MAP>
__device__ __forceinline__ bool tr_job8(int& r, const float* W, int batch, int K, int N, unsigned char* dst, size_t dstride, int ldd, float scale, LAS float* scr, int lane, int ncols = 0) {
    const int nkb = K / 64, nnb = (ncols ? ncols : N) / 32, per = nkb * nnb, total = per * batch;
    if (r >= total) { r -= total; return false; }
    const int bi = r / per, q = r % per, kb = q / nnb, nb = q % nnb, n0 = nb * 32;
    int drow0;
    if (MAP == 0) drow0 = n0; else drow0 = (n0 >> 7) * 256 + (n0 & 127) + (MAP == 3 ? 128 : 0);
    tr_item8(W + (size_t)bi * K * N, N, dst + (size_t)bi * dstride, ldd, drow0, kb * 64, n0, scale, scr, lane);
    return true;
}
__device__ __forceinline__ int win_map(int n) {
    if (n < 448) return n;
    if (n < 576) return C_CKV + (n - 448);
    if (n < 608) return C_KR + (n - 576);
    return C_HQ + (n - 608);
}
template <int MAP>
__device__ __forceinline__ bool tr_job(int& r, const float* W, int batch, int K, int N, bf16_t* dst, size_t dstride, int ldd, const float* kscale, int ksstride, LAS float* scr, int lane, int ncols = 0) {
    const int nkb = K / 64, nnb = (ncols ? ncols : N) / 32, per = nkb * nnb, total = per * batch;
    if (r >= total) { r -= total; return false; }
    const int bi = r / per, q = r % per, kb = q / nnb, nb = q % nnb, n0 = nb * 32;
    int drow0;
    if (MAP == 0) drow0 = n0; else if (MAP == 1) drow0 = win_map(n0); else drow0 = (n0 >> 7) * 256 + (n0 & 127) + (MAP == 3 ? 128 : 0);
    tr_item(W + (size_t)bi * K * N, N, dst + (size_t)bi * dstride, ldd, drow0, kb * 64, n0, kscale ? kscale + bi * ksstride : nullptr, scr, lane);
    return true;
}
__device__ __forceinline__ void p0_prologue(const Frame& F) {
    LAS float* scr = (LAS float*)(F.lds + LDS_STAGE + F.wave * 16384);
    const int lane = F.lane;
    constexpr int NITEMS = 4 * 16 * 211 + 4 * 4 * 8 + 4 * 3 * 12 + 4 * 2 * 16 + 16 * 4 * 32 + 4 * 16 * 32 + 2 * 2 * 16 * 112 + 2 * 56 * 32 + 2 * 16 * 16 * 112 + 16 * 56 * 32 + 4 * 16 * 32 + 4 * 4 * 32;
    for (int it = F.gw; it < NITEMS; it += F.NGW) {
        int r = it;
        if (tr_job8<2>(r, IN_F(29), 16, 1024, DFF, WSP(unsigned char, WS_WMU), (size_t)7168 * 1024, 1024, 64.0f, scr, lane)) continue;
        if (tr_job8<3>(r, IN_F(30), 16, 1024, DFF, WSP(unsigned char, WS_WMU), (size_t)7168 * 1024, 1024, 64.0f, scr, lane)) continue;
        if (tr_job8<0>(r, IN_F(31), 16, DFF, 1024, WSP(unsigned char, WS_WMD), (size_t)1024 * DFF, DFF, 128.0f, scr, lane)) continue;
        if (tr_job<1>(r, IN_F(3), 4, 1024, 6752, WSP(bf16_t, WS_WIN), (size_t)HP * 1024, 1024, nullptr, 0, scr, lane, 2656)) continue;
        if (tr_job8<0>(r, IN_F(3) + 2656, 4, 1024, 6752, WSP(unsigned char, WS_WIN8), (size_t)4096 * 1024, 1024, 32.0f, scr, lane, 4096)) continue;
        if (tr_job8<2>(r, IN_F(25), 2, 1024, DFF, WSP(unsigned char, WS_WFFU), (size_t)7168 * 1024, 1024, 64.0f, scr, lane)) continue;
        if (tr_job8<3>(r, IN_F(26), 2, 1024, DFF, WSP(unsigned char, WS_WFFU), (size_t)7168 * 1024, 1024, 64.0f, scr, lane)) continue;
        if (tr_job8<0>(r, IN_F(27), 2, DFF, 1024, WSP(unsigned char, WS_WFFD), (size_t)1024 * DFF, DFF, 128.0f, scr, lane)) continue;
        if (tr_job<0>(r, IN_F(21), 16, 256, 1024, WSP(bf16_t, WS_WB), (size_t)1024 * 256, 256, nullptr, 0, scr, lane)) continue;
        if (tr_job<0>(r, IN_F(22), 4, 1024, 1024, WSP(bf16_t, WS_WO), (size_t)1024 * 1024, 1024, nullptr, 0, scr, lane)) continue;
        if (tr_job<0>(r, IN_F(32), 4, 1024, 1024, WSP(bf16_t, WS_WPG), (size_t)1024 * 1024, 1024, nullptr, 0, scr, lane)) continue;
        if (tr_job<0>(r, IN_F(33), 4, 256, 1024, WSP(bf16_t, WS_WPP), (size_t)1024 * 256, 256, nullptr, 0, scr, lane)) continue;
        if (tr_job<0>(r, IN_F(12), 4, 256, 256, WSP(bf16_t, WS_WGLU), (size_t)256 * 256, 256, nullptr, 0, scr, lane)) continue;
        if (tr_job<0>(r, IN_F(15), 4, 192, 384, WSP(bf16_t, WS_WUQ), (size_t)512 * 256, 256, IN_F(13), 192, scr, lane)) continue;
        tr_job<0>(r, IN_F(16), 4, 128, 512, WSP(bf16_t, WS_WUKV), (size_t)512 * 256, 256, IN_F(14), 128, scr, lane);
    }
    const int gt = F.bid * 512 + F.tid, NT_ = F.G * 512;
    { bf16_t* uq = WSP(bf16_t, WS_WUQ); bf16_t* ukv = WSP(bf16_t, WS_WUKV);
      for (int i = gt; i < 4 * 512 * 256; i += NT_) { const int n = (i >> 8) & 511, k = i & 255; if (n >= 384 || k >= 192) uq[i] = 0; if (k >= 128) ukv[i] = 0; }
      bf16_t* win = WSP(bf16_t, WS_WIN);
      for (int i = gt; i < 4 * 160 * 1024; i += NT_) { const int l = i / (160 * 1024), q = i % (160 * 1024), rr = q >> 10, k = q & 1023; const int row = rr < 64 ? 448 + rr : 672 + (rr - 64); win[((size_t)l * HP + row) * 1024 + k] = 0; } }
    { const f32x4* x4 = (const f32x4*)IN_F(0); u32x2* xb = WSP(u32x2, WS_XB);
      unsigned* x8 = WSP(unsigned, WS_X8);
      for (int i = gt; i < T * D / 4; i += NT_) { const f32x4 v = x4[i]; u32x2 w; w.x = cvt_pk_bf16(v[0], v[1]); w.y = cvt_pk_bf16(v[2], v[3]); xb[i] = w; x8[i] = cvt4_fp8(v[0], v[1], v[2], v[3]); }
      const f32x4* p4 = (const f32x4*)IN_F(1); u32x2* pb = WSP(u32x2, WS_PB);
      for (int i = gt; i < DEPTH * T * 256 / 4; i += NT_) { const f32x4 v = p4[i]; u32x2 w; w.x = cvt_pk_bf16(v[0], v[1]); w.y = cvt_pk_bf16(v[2], v[3]); pb[i] = w; } }
    { const int* pos = (const int*)F.in[2]; float* rm = WSP(float, WS_ROPEM); float* rr = WSP(float, WS_ROPER);
      for (int i = gt; i < T * 48; i += NT_) { const int t = i / 48, j = i % 48; const bool isM = j < 16; const int jj = isM ? j : j - 16; const float half = isM ? 16.f : 32.f;
          const float inv = exp2f(-(float)jj / half * 13.287712379549449f);
          const float ang = (float)pos[t] * inv;
          const double ad = (double)ang, k2 = __builtin_rint(ad * 0.15915494309189535); const float red = (float)(ad - k2 * 6.283185307179586);
          const float c = __cosf(red), s = __sinf(red);
          if (isM) { rm[t * 32 + jj] = c; rm[t * 32 + 16 + jj] = s; } else { rr[t * 64 + jj] = c; rr[t * 64 + 32 + jj] = s; } } }
    { float* abar = (float*)(F.ws + WS_S5P + S5P_ABAR); bf16_t* Bm = (bf16_t*)(F.ws + WS_S5P + S5P_BM); bf16_t* Cm = (bf16_t*)(F.ws + WS_S5P + S5P_CM);
      for (int i = gt; i < DEPTH * 16 * 64; i += NT_) { const int lg = i >> 6, p = i & 63;
          const float dt = __expf(IN_F(6)[lg]), lr = IN_F(4)[i], li = IN_F(5)[i];
          const float mag = __expf(lr * dt); const double ad = (double)(li * dt), k2 = __builtin_rint(ad * 0.15915494309189535); const float red = (float)(ad - k2 * 6.283185307179586);
          const float are = mag * __cosf(red), aim = mag * __sinf(red);
          abar[i * 2] = are; abar[i * 2 + 1] = aim;
          const float den = lr * lr + li * li, nre = are - 1.0f, nim = aim;
          const float cre = (nre * lr + nim * li) / den, cim = (nim * lr - nre * li) / den;
          const float* br = IN_F(7) + (size_t)i * 16; const float* bi = IN_F(8) + (size_t)i * 16;
#pragma unroll
          for (int c = 0; c < 16; ++c) { Bm[((size_t)lg * 128 + p) * 16 + c] = f2bf(cre * br[c] - cim * bi[c]); Bm[((size_t)lg * 128 + 64 + p) * 16 + c] = f2bf(cre * bi[c] + cim * br[c]); }
#pragma unroll
          for (int c = 0; c < 16; ++c) { Cm[((size_t)lg * 16 + c) * 128 + p] = f2bf(IN_F(9)[((size_t)lg * 16 + c) * 64 + p]); Cm[((size_t)lg * 16 + c) * 128 + 64 + p] = f2bf(-IN_F(10)[((size_t)lg * 16 + c) * 64 + p]); } }
      float* lb = (float*)(F.ws + WS_S5P + S5P_LB);
      for (int i = gt; i < 256; i += NT_) { float r0 = IN_F(17)[i], r1 = IN_F(17)[256 + i], r2 = IN_F(17)[512 + i], r3 = IN_F(17)[768 + i]; const float mx = fmaxf(fmaxf(r0, r1), fmaxf(r2, r3));
          const float e0 = __expf(r0 - mx), e1 = __expf(r1 - mx), e2 = __expf(r2 - mx), e3 = __expf(r3 - mx), s = e0 + e1 + e2 + e3;
          lb[i] = 0.f; lb[256 + i] = e1 / s; lb[512 + i] = (e1 + e2) / s; lb[768 + i] = (e1 + e2 + e3) / s; } }
}

template <bool OUT>
__device__ __forceinline__ void s5_item(const Frame& F, int layer, int idx, LAS unsigned char* scr) {
    const int lane = F.lane + vzero(), r16 = lane & 15, g4 = lane >> 4;
    const int bg = idx >> 5, n = idx & 31, b = bg >> 4, g = bg & 15;
    LAS float* bu = (LAS float*)scr;
    LAS bf16_t* xs = (LAS bf16_t*)(scr + 8448);
    const float* abar = (const float*)(F.ws + WS_S5P + S5P_ABAR) + ((size_t)(layer * 16 + g) * 64 + lane) * 2;
    const float ar = abar[0], ai = abar[1];
    const bf16_t* Bm = (const bf16_t*)(F.ws + WS_S5P + S5P_BM) + (size_t)(layer * 16 + g) * 128 * 16;
    const bf16_t* Cm = (const bf16_t*)(F.ws + WS_S5P + S5P_CM) + (size_t)(layer * 16 + g) * 16 * 128;
    const bf16_t* H = WSP(const bf16_t, WS_H);
    Frag zf; zf.q = (u32x4){0u, 0u, 0u, 0u};
    bf16x8 bfr[8];
#pragma unroll
    for (int nb = 0; nb < 8; ++nb) bfr[nb] = (g4 < 2) ? *(const bf16x8*)(Bm + (nb * 16 + r16) * 16 + 8 * g4) : zf.v;
    bf16x8 cfr[4];
    if (OUT) {
#pragma unroll
        for (int ks = 0; ks < 4; ++ks) cfr[ks] = *(const bf16x8*)(Cm + r16 * 128 + 32 * ks + 8 * g4); }
    float xr = 0.f, xi = 0.f;
    if (OUT) { const float* ci = WSP(const float, WS_S5C) + ((size_t)(bg * 32 + n) * 64 + lane) * 2; xr = ci[0]; xi = ci[1]; }
    const float dsk = OUT ? IN_F(11)[layer * 256 + g * 16 + r16] : 0.f;
    const size_t tok0 = (size_t)b * SEQ + n * 64;
    bf16x8 afr_n = (g4 < 2) ? *(const bf16x8*)(H + (tok0 + r16) * HP + C_US5 + g * 16 + 8 * g4) : zf.v;
    bf16_t un[4] = {0, 0, 0, 0};
    if (OUT) {
#pragma unroll
        for (int r = 0; r < 4; ++r) un[r] = H[(tok0 + 4 * g4 + r) * HP + C_US5 + g * 16 + r16]; }
#pragma unroll 1
    for (int sub = 0; sub < 4; ++sub) {
        const size_t t0 = tok0 + sub * 16;
        const bf16x8 afr = afr_n; bf16_t uc[4];
#pragma unroll
        for (int r = 0; r < 4; ++r) uc[r] = un[r];
        if (sub < 3) { afr_n = (g4 < 2) ? *(const bf16x8*)(H + (t0 + 16 + r16) * HP + C_US5 + g * 16 + 8 * g4) : zf.v;
            if (OUT) {
#pragma unroll
                for (int r = 0; r < 4; ++r) un[r] = H[(t0 + 16 + 4 * g4 + r) * HP + C_US5 + g * 16 + r16]; } }
#pragma unroll
        for (int nb = 0; nb < 8; ++nb) { const f32x4 c = mfma16(afr, bfr[nb], (f32x4){0.f, 0.f, 0.f, 0.f});
#pragma unroll
            for (int r = 0; r < 4; ++r) bu[(4 * g4 + r) * 132 + nb * 16 + r16] = c[r]; }
        WSYNC();
#pragma unroll
        for (int tk = 0; tk < 16; ++tk) { const float bre = bu[tk * 132 + lane], bim = bu[tk * 132 + 64 + lane];
            const float nr = ar * xr - ai * xi + bre, ni = ar * xi + ai * xr + bim; xr = nr; xi = ni;
            if (OUT) { xs[tk * 136 + lane] = f2bf(xr); xs[tk * 136 + 64 + lane] = f2bf(xi); } }
        if (OUT) {
            WSYNC();
            f32x4 y = (f32x4){0.f, 0.f, 0.f, 0.f};
#pragma unroll
            for (int ks = 0; ks < 4; ++ks) { const bf16x8 a = *(const LAS bf16x8*)(xs + r16 * 136 + 32 * ks + 8 * g4); y = mfma16(a, cfr[ks], y); }
            bf16_t* pre = WSP(bf16_t, WS_S5PRE);
#pragma unroll
            for (int r = 0; r < 4; ++r) { const size_t t = t0 + 4 * g4 + r; pre[t * 256 + g * 16 + r16] = f2bf(gelu_tanh(y[r] + dsk * bf2f(uc[r]))); }
        }
        WSYNC();
    }
    if (!OUT) { float* e = WSP(float, WS_S5E) + ((size_t)(bg * 32 + n) * 64 + lane) * 2; e[0] = xr; e[1] = xi; }
}
__device__ __forceinline__ void s5_carry(const Frame& F, int layer) {
    const int gt = F.bid * 512 + F.tid;
    if (gt >= NBATCH * 16 * 64) return;
    const int bg = gt >> 6, p = gt & 63, g = bg & 15;
    const float* abar = (const float*)(F.ws + WS_S5P + S5P_ABAR) + ((size_t)(layer * 16 + g) * 64 + p) * 2;
    float pr = abar[0], pi = abar[1];
#pragma unroll
    for (int i = 0; i < 6; ++i) { const float nr = pr * pr - pi * pi, ni = 2.f * pr * pi; pr = nr; pi = ni; }
    const float* E = WSP(const float, WS_S5E); float* C = WSP(float, WS_S5C);
    float er[32], ei[32];
#pragma unroll
    for (int n = 0; n < 32; ++n) { const size_t o = ((size_t)(bg * 32 + n) * 64 + p) * 2; er[n] = E[o]; ei[n] = E[o + 1]; }
    float cr = 0.f, ci = 0.f;
#pragma unroll
    for (int n = 0; n < 32; ++n) { const float nr = pr * cr - pi * ci + er[n], ni = pr * ci + pi * cr + ei[n]; er[n] = cr; ei[n] = ci; cr = nr; ci = ni; }
#pragma unroll
    for (int n = 0; n < 32; ++n) { const size_t o = ((size_t)(bg * 32 + n) * 64 + p) * 2; C[o] = er[n]; C[o + 1] = ei[n]; }
}

template <bool OUT>
__device__ __forceinline__ void hg_item(const Frame& F, int layer, int idx, LAS unsigned char* scr) {
    const int lane = F.lane + vzero(), r16 = lane & 15, g4 = lane >> 4;
    const int bh = idx >> 5, sc = idx & 31, b = bh >> 2, h = bh & 3;
    LAS bf16_t* Qt = (LAS bf16_t*)scr;
    LAS bf16_t* Kt = (LAS bf16_t*)(scr + 2304);
    LAS bf16_t* Vs = (LAS bf16_t*)(scr + 4608);
    LAS float* dec = (LAS float*)(scr + 6656);
    const bf16_t* H = WSP(const bf16_t, WS_H);
    const float lbv = ((const float*)(F.ws + WS_S5P + S5P_LB))[layer * 256 + h * 64 + lane], oml = 1.0f - lbv;
    f32x4 S[4][4];
    if (OUT) { const float* si = WSP(const float, WS_HGI) + (size_t)(bh * 32 + sc) * 4096;
#pragma unroll
        for (int mb = 0; mb < 4; ++mb)
#pragma unroll
            for (int vb = 0; vb < 4; ++vb)
#pragma unroll
                for (int r = 0; r < 4; ++r) S[mb][vb][r] = si[(16 * mb + 4 * g4 + r) * 64 + 16 * vb + r16];
    } else {
#pragma unroll
        for (int mb = 0; mb < 4; ++mb)
#pragma unroll
            for (int vb = 0; vb < 4; ++vb) S[mb][vb] = (f32x4){0.f, 0.f, 0.f, 0.f};
    }
    float ltot = 0.f;
    const size_t tbase = (size_t)b * SEQ + sc * 64;
    unsigned rf[8], ri[8], rq[8]; u32x2 rg[4];
#define HG_LOAD(t0_) do { _Pragma("unroll") for (int p = 0; p < 8; ++p) { const bf16_t* r0 = H + ((t0_) + 2 * p) * HP + h * 64 + lane; const bf16_t* r1 = r0 + HP; \
            rf[p] = (unsigned)r0[C_HF] | ((unsigned)r1[C_HF] << 16); ri[p] = (unsigned)r0[C_HI] | ((unsigned)r1[C_HI] << 16); if (OUT) rq[p] = (unsigned)r0[C_HQ] | ((unsigned)r1[C_HQ] << 16); } \
        if (OUT) { _Pragma("unroll") for (int vb = 0; vb < 4; ++vb) rg[vb] = *(const u32x2*)(H + ((t0_) + r16) * HP + C_HG + h * 64 + 16 * vb + 4 * g4); } } while (0)
    HG_LOAD(tbase);
#pragma unroll 1
    for (int ch = 0; ch < 4; ++ch) {
        const size_t t0 = tbase + ch * 16;
        float bcum = 0.f;
#pragma unroll
        for (int tk = 0; tk < 16; ++tk) { const unsigned wf = rf[tk >> 1], wi = ri[tk >> 1];
            const float fv = (tk & 1) ? __uint_as_float(wf & 0xffff0000u) : __uint_as_float(wf << 16);
            const float sg = 1.0f / (1.0f + __expf(-fv)); const float forget = lbv + oml * sg; bcum += __logf(forget);
            const float kv_ = oml * (1.0f - sg), e = __expf(fmaxf(bcum, -80.0f));
            Kt[tk * 72 + lane] = f2bf(kv_ * __builtin_amdgcn_rcpf(e));
            if (OUT) { const unsigned wq = rq[tk >> 1]; const float qv = (tk & 1) ? __uint_as_float(wq & 0xffff0000u) : __uint_as_float(wq << 16); Qt[tk * 72 + lane] = f2bf(siluf_(qv) * e); }
            Vs[tk * 64 + lane] = (bf16_t)((tk & 1) ? (wi >> 16) : (wi & 0xffffu)); }
        dec[lane] = __expf(bcum); ltot += bcum;
        u32x2 gcur[4];
        if (OUT) {
#pragma unroll
            for (int vb = 0; vb < 4; ++vb) gcur[vb] = rg[vb]; }
        if (ch < 3) HG_LOAD(t0 + 16);
        WSYNC();
        Frag vfr[4], kfr[4];
#pragma unroll
        for (int vb = 0; vb < 4; ++vb) { vfr[vb].q = (u32x4){0u, 0u, 0u, 0u};
#pragma unroll
            for (int j = 0; j < 4; ++j) vfr[vb].h[j] = Vs[(4 * g4 + j) * 64 + 16 * vb + r16]; }
#pragma unroll
        for (int mb = 0; mb < 4; ++mb) { kfr[mb].q = (u32x4){0u, 0u, 0u, 0u};
#pragma unroll
            for (int j = 0; j < 4; ++j) kfr[mb].h[j] = Kt[(4 * g4 + j) * 72 + 16 * mb + r16]; }
        if (OUT) {
            f32x4 at = (f32x4){0.f, 0.f, 0.f, 0.f};
#pragma unroll
            for (int ks = 0; ks < 2; ++ks) { const bf16x8 a = *(const LAS bf16x8*)(Kt + r16 * 72 + 32 * ks + 8 * g4), bq = *(const LAS bf16x8*)(Qt + r16 * 72 + 32 * ks + 8 * g4); at = mfma16(a, bq, at); }
#pragma unroll
            for (int r = 0; r < 4; ++r) if (4 * g4 + r > r16) at[r] = 0.f;
            Frag pfr; pfr.q = (u32x4){0u, 0u, 0u, 0u}; pfr.u[0] = cvt_pk_bf16(at[0], at[1]); pfr.u[1] = cvt_pk_bf16(at[2], at[3]);
            Frag qfr[2];
#pragma unroll
            for (int ks = 0; ks < 2; ++ks) { qfr[ks].d[0] = *(const LAS u32x2*)(Qt + r16 * 72 + 32 * ks + 4 * g4); qfr[ks].d[1] = *(const LAS u32x2*)(Qt + r16 * 72 + 32 * ks + 16 + 4 * g4); }
            f32x4 o[4]; float ss = 0.f;
#pragma unroll
            for (int vb = 0; vb < 4; ++vb) { f32x4 a = (f32x4){0.f, 0.f, 0.f, 0.f};
#pragma unroll
                for (int ks = 0; ks < 2; ++ks) { Frag sf; sf.u[0] = cvt_pk_bf16(S[2 * ks][vb][0], S[2 * ks][vb][1]); sf.u[1] = cvt_pk_bf16(S[2 * ks][vb][2], S[2 * ks][vb][3]);
                    sf.u[2] = cvt_pk_bf16(S[2 * ks + 1][vb][0], S[2 * ks + 1][vb][1]); sf.u[3] = cvt_pk_bf16(S[2 * ks + 1][vb][2], S[2 * ks + 1][vb][3]); a = mfma16(sf.v, qfr[ks].v, a); }
                a = mfma16(vfr[vb].v, pfr.v, a); o[vb] = a; ss += a[0] * a[0] + a[1] * a[1] + a[2] * a[2] + a[3] * a[3]; }
            ss += __shfl_xor(ss, 16); ss += __shfl_xor(ss, 32);
            const float rs = rsqrtf(ss * (1.0f / 64.0f) + EPS);
            const size_t t = t0 + r16; bf16_t* Y = WSP(bf16_t, WS_Y);
#pragma unroll
            for (int vb = 0; vb < 4; ++vb) { const int vi0 = h * 64 + 16 * vb + 4 * g4; const u32x2 gv = gcur[vb]; const f32x4 ng = *(const f32x4*)(IN_F(18) + layer * 256 + vi0);
                const float g0 = __uint_as_float(gv.x << 16), g1 = __uint_as_float(gv.x & 0xffff0000u), g2 = __uint_as_float(gv.y << 16), g3 = __uint_as_float(gv.y & 0xffff0000u);
                u32x2 w; w.x = cvt_pk_bf16(o[vb][0] * rs * ng[0] * siluf_(g0), o[vb][1] * rs * ng[1] * siluf_(g1)); w.y = cvt_pk_bf16(o[vb][2] * rs * ng[2] * siluf_(g2), o[vb][3] * rs * ng[3] * siluf_(g3));
                *(u32x2*)(Y + t * 1024 + 512 + vi0) = w; }
        }
#pragma unroll
        for (int mb = 0; mb < 4; ++mb) { const f32x4 dv = *(const LAS f32x4*)(dec + 16 * mb + 4 * g4);
#pragma unroll
            for (int vb = 0; vb < 4; ++vb) S[mb][vb] = mfma16(kfr[mb].v, vfr[vb].v, S[mb][vb]) * dv; }
        WSYNC();
    }
#undef HG_LOAD
    if (!OUT) { float* se = WSP(float, WS_HGE) + (size_t)(bh * 32 + sc) * 4096;
#pragma unroll
        for (int mb = 0; mb < 4; ++mb)
#pragma unroll
            for (int vb = 0; vb < 4; ++vb)
#pragma unroll
                for (int r = 0; r < 4; ++r) se[(16 * mb + 4 * g4 + r) * 64 + 16 * vb + r16] = S[mb][vb][r];
        WSP(float, WS_HGD)[(size_t)(bh * 32 + sc) * 64 + lane] = __expf(ltot); }
}
__device__ __forceinline__ void hg_carry(const Frame& F) {
    const int gt = F.bid * 512 + F.tid; if (gt >= 32 * 4096) return;
    const int bh = gt >> 12, kv = gt & 4095, k = kv >> 6;
    const float* E = WSP(const float, WS_HGE); const float* Dt = WSP(const float, WS_HGD); float* I = WSP(float, WS_HGI);
    float e[32], d[32];
#pragma unroll
    for (int sc = 0; sc < 32; ++sc) { e[sc] = E[(size_t)(bh * 32 + sc) * 4096 + kv]; d[sc] = Dt[(size_t)(bh * 32 + sc) * 64 + k]; }
    float s = 0.f;
#pragma unroll
    for (int sc = 0; sc < 32; ++sc) { const float nx = d[sc] * s + e[sc]; e[sc] = s; s = nx; }
#pragma unroll
    for (int sc = 0; sc < 32; ++sc) I[(size_t)(bh * 32 + sc) * 4096 + kv] = e[sc];
}

__device__ __forceinline__ float ret_l2g(int h) { return __log2f(1.0f - exp2f(-5.0f - (float)h)); }
__device__ __forceinline__ void ret_item1(const Frame& F, int idx, LAS unsigned char* scr) {
    const int lane = F.lane + vzero(), r16 = lane & 15, g4 = lane >> 4;
    const int bh = idx >> 5, n = idx & 31, b = bh >> 2, h = bh & 3;
    LAS bf16_t* Kd = (LAS bf16_t*)scr;
    LAS bf16_t* Vs = (LAS bf16_t*)(scr + 8192);
    const bf16_t* H = WSP(const bf16_t, WS_H); const float* rope = WSP(const float, WS_ROPER);
    bf16_t* QR = WSP(bf16_t, WS_QR); bf16_t* KR = WSP(bf16_t, WS_KR);
    const float l2g = ret_l2g(h);
    const size_t t0 = (size_t)b * SEQ + n * 64;
#pragma unroll 1
    for (int tb = 0; tb < 4; ++tb) {
        bf16_t kx[16], qx[16], vx[16]; float cs[16], sn[16];
#pragma unroll
        for (int j = 0; j < 16; ++j) { const size_t t = t0 + tb * 16 + j; const bf16_t* row = H + t * HP + h * 64 + lane; kx[j] = row[C_RK]; qx[j] = row[C_RQ]; vx[j] = row[C_RV]; cs[j] = rope[t * 64 + (lane & 31)]; sn[j] = rope[t * 64 + 32 + (lane & 31)]; }
#pragma unroll
        for (int j = 0; j < 16; ++j) { const int tk = tb * 16 + j; const size_t t = t0 + tk;
            const float kf_ = bf2f(kx[j]), qf_ = bf2f(qx[j]); const float kp = __shfl_xor(kf_, 32), qp = __shfl_xor(qf_, 32);
            const float kh = lane < 32 ? kf_ * cs[j] - kp * sn[j] : kf_ * cs[j] + kp * sn[j], qh = (lane < 32 ? qf_ * cs[j] - qp * sn[j] : qf_ * cs[j] + qp * sn[j]) * 0.125f;
            KR[t * 256 + h * 64 + lane] = f2bf(kh); QR[t * 256 + h * 64 + lane] = f2bf(qh);
            Kd[tk * 64 + lane] = f2bf(kh * exp2f((float)(63 - tk) * l2g)); Vs[tk * 64 + lane] = vx[j]; }
    }
    WSYNC();
    Frag vfr[4][2];
#pragma unroll
    for (int vb = 0; vb < 4; ++vb)
#pragma unroll
        for (int ks = 0; ks < 2; ++ks)
#pragma unroll
            for (int j = 0; j < 8; ++j) vfr[vb][ks].h[j] = Vs[(32 * ks + 8 * g4 + j) * 64 + 16 * vb + r16];
    float* E = WSP(float, WS_RTE) + (size_t)(bh * 32 + n) * 4096;
#pragma unroll
    for (int mb = 0; mb < 4; ++mb) { Frag kf[2];
#pragma unroll
        for (int ks = 0; ks < 2; ++ks)
#pragma unroll
            for (int j = 0; j < 8; ++j) kf[ks].h[j] = Kd[(32 * ks + 8 * g4 + j) * 64 + 16 * mb + r16];
#pragma unroll
        for (int vb = 0; vb < 4; ++vb) { f32x4 a = (f32x4){0.f, 0.f, 0.f, 0.f};
#pragma unroll
            for (int ks = 0; ks < 2; ++ks) a = mfma16(kf[ks].v, vfr[vb][ks].v, a);
            *(f32x4*)(E + (16 * vb + r16) * 64 + 16 * mb + 4 * g4) = a; } }
    WSYNC();
}
__device__ __forceinline__ void ret_carry(const Frame& F) {
    const int gt = F.bid * 512 + F.tid; if (gt >= 32 * 4096) return;
    const int bh = gt >> 12, vk = gt & 4095, h = bh & 3;
    const float g64 = exp2f(64.0f * ret_l2g(h));
    const float* E = WSP(const float, WS_RTE); float* I = WSP(float, WS_RTI);
    float e[32];
#pragma unroll
    for (int n = 0; n < 32; ++n) e[n] = E[(size_t)(bh * 32 + n) * 4096 + vk];
    float s = 0.f;
#pragma unroll
    for (int n = 0; n < 32; ++n) { const float nx = g64 * s + e[n]; e[n] = s; s = nx; }
#pragma unroll
    for (int n = 0; n < 32; ++n) I[(size_t)(bh * 32 + n) * 4096 + vk] = e[n];
}
__device__ __forceinline__ void ret_item3(const Frame& F, int layer, int idx, LAS unsigned char* scr) {
    const int lane = F.lane + vzero(), r16 = lane & 15, g4 = lane >> 4;
    const int bh = idx >> 5, n = idx & 31, b = bh >> 2, h = bh & 3;
    LAS bf16_t* Vs = (LAS bf16_t*)scr;
    const bf16_t* H = WSP(const bf16_t, WS_H); const bf16_t* QR = WSP(const bf16_t, WS_QR); const bf16_t* KR = WSP(const bf16_t, WS_KR);
    const float l2g = ret_l2g(h);
    const size_t t0 = (size_t)b * SEQ + n * 64;
#pragma unroll
    for (int tk = 0; tk < 64; ++tk) Vs[tk * 64 + lane] = H[(t0 + tk) * HP + C_RV + h * 64 + lane];
    Frag sfr[4][2];
    { const float* si = WSP(const float, WS_RTI) + (size_t)(bh * 32 + n) * 4096;
#pragma unroll
      for (int vb = 0; vb < 4; ++vb)
#pragma unroll
        for (int ks = 0; ks < 2; ++ks) { const f32x4 a = *(const f32x4*)(si + (16 * vb + r16) * 64 + 32 * ks + 8 * g4), c = *(const f32x4*)(si + (16 * vb + r16) * 64 + 32 * ks + 8 * g4 + 4);
            sfr[vb][ks].u[0] = cvt_pk_bf16(a[0], a[1]); sfr[vb][ks].u[1] = cvt_pk_bf16(a[2], a[3]); sfr[vb][ks].u[2] = cvt_pk_bf16(c[0], c[1]); sfr[vb][ks].u[3] = cvt_pk_bf16(c[2], c[3]); } }
    bf16_t* Y = WSP(bf16_t, WS_Y);
    bf16x8 kfa[4][2], qfa[4][2]; u32x2 gva[4][4];
#pragma unroll
    for (int sb = 0; sb < 4; ++sb)
#pragma unroll
        for (int ks = 0; ks < 2; ++ks) { kfa[sb][ks] = *(const bf16x8*)(KR + (t0 + 16 * sb + r16) * 256 + h * 64 + 32 * ks + 8 * g4); qfa[sb][ks] = *(const bf16x8*)(QR + (t0 + 16 * sb + r16) * 256 + h * 64 + 32 * ks + 8 * g4); }
#pragma unroll
    for (int tb = 0; tb < 4; ++tb)
#pragma unroll
        for (int vb = 0; vb < 4; ++vb) gva[tb][vb] = *(const u32x2*)(H + (t0 + 16 * tb + r16) * HP + C_RG + h * 64 + 16 * vb + 4 * g4);
    WSYNC();
    Frag vfr[4][2];
#pragma unroll
    for (int vb = 0; vb < 4; ++vb)
#pragma unroll
        for (int ks = 0; ks < 2; ++ks)
#pragma unroll
            for (int j = 0; j < 8; ++j) vfr[vb][ks].h[j] = Vs[(32 * ks + 16 * (j >> 2) + 4 * g4 + (j & 3)) * 64 + 16 * vb + r16];
#pragma unroll
    for (int tb = 0; tb < 4; ++tb) {
        const int tl = 16 * tb + r16; const size_t t = t0 + tl;
        Frag pfr[2]; pfr[0].q = (u32x4){0u, 0u, 0u, 0u}; pfr[1].q = (u32x4){0u, 0u, 0u, 0u};
#pragma unroll
        for (int sb = 0; sb < 4; ++sb) { if (sb > tb) continue;
            f32x4 sc = (f32x4){0.f, 0.f, 0.f, 0.f};
#pragma unroll
            for (int ks = 0; ks < 2; ++ks) sc = mfma16(kfa[sb][ks], qfa[tb][ks], sc);
#pragma unroll
            for (int r = 0; r < 4; ++r) { const int rel = tl - (16 * sb + 4 * g4 + r); sc[r] = rel >= 0 ? sc[r] * exp2f((float)rel * l2g) : 0.f; }
            pfr[sb >> 1].u[(sb & 1) * 2] = cvt_pk_bf16(sc[0], sc[1]); pfr[sb >> 1].u[(sb & 1) * 2 + 1] = cvt_pk_bf16(sc[2], sc[3]); }
        const float qd = exp2f((float)(tl + 1) * l2g);
        f32x4 o[4]; float s1 = 0.f;
#pragma unroll
        for (int vb = 0; vb < 4; ++vb) { f32x4 a = (f32x4){0.f, 0.f, 0.f, 0.f};
#pragma unroll
            for (int ks = 0; ks < 2; ++ks) a = mfma16(sfr[vb][ks].v, qfa[tb][ks], a);
            a = a * qd;
            a = mfma16(vfr[vb][0].v, pfr[0].v, a);
            if (tb >= 2) a = mfma16(vfr[vb][1].v, pfr[1].v, a);
            o[vb] = a; s1 += (a[0] + a[1]) + (a[2] + a[3]); }
        s1 += __shfl_xor(s1, 16); s1 += __shfl_xor(s1, 32);
        const float mean = s1 * (1.0f / 64.0f); float s2 = 0.f;
#pragma unroll
        for (int vb = 0; vb < 4; ++vb) { const f32x4 d = o[vb] - mean; s2 += d[0] * d[0] + d[1] * d[1] + d[2] * d[2] + d[3] * d[3]; }
        s2 += __shfl_xor(s2, 16); s2 += __shfl_xor(s2, 32);
        const float rstd = rsqrtf(s2 * (1.0f / 64.0f) + EPS);
#pragma unroll
        for (int vb = 0; vb < 4; ++vb) { const int vi0 = h * 64 + 16 * vb + 4 * g4; const u32x2 gv = gva[tb][vb];
            const f32x4 gg = *(const f32x4*)(IN_F(19) + layer * 256 + vi0), gb = *(const f32x4*)(IN_F(20) + layer * 256 + vi0);
            const float g0 = __uint_as_float(gv.x << 16), g1 = __uint_as_float(gv.x & 0xffff0000u), g2 = __uint_as_float(gv.y << 16), g3 = __uint_as_float(gv.y & 0xffff0000u);
            u32x2 w; w.x = cvt_pk_bf16(((o[vb][0] - mean) * rstd * gg[0] + gb[0]) * siluf_(g0), ((o[vb][1] - mean) * rstd * gg[1] + gb[1]) * siluf_(g1));
            w.y = cvt_pk_bf16(((o[vb][2] - mean) * rstd * gg[2] + gb[2]) * siluf_(g2), ((o[vb][3] - mean) * rstd * gg[3] + gb[3]) * siluf_(g3));
            *(u32x2*)(Y + t * 1024 + 768 + vi0) = w; }
    }
    WSYNC();
}

__device__ __forceinline__ void attn_unit(const Frame& F, int bh, int qt) {
    const int vz = vzero(); const int lane = F.lane + vz, r16 = lane & 15, g4 = lane >> 4, w = F.wave, tid = F.tid + vz;
    LAS bf16_t* Kt = (LAS bf16_t*)(F.lds + LDS_STAGE);
    LAS bf16_t* Vl = (LAS bf16_t*)(F.lds + LDS_STAGE + 13312);
    const bf16_t* Qb = WSP(const bf16_t, WS_Q) + (size_t)bh * SEQ * 96; const bf16_t* Kb = WSP(const bf16_t, WS_K) + (size_t)bh * SEQ * 96; const bf16_t* Vt = WSP(const bf16_t, WS_VT) + (size_t)bh * 64 * SEQ;
    const int q0 = qt * 128, qrow = q0 + 16 * w + r16;
    bf16x8 qfr[3];
#pragma unroll
    for (int ks = 0; ks < 3; ++ks) qfr[ks] = *(const bf16x8*)(Qb + (size_t)qrow * 96 + 32 * ks + 8 * g4);
    float mrun = -1e30f, lrun = 0.f;
    f32x4 O[4];
#pragma unroll
    for (int db = 0; db < 4; ++db) O[db] = (f32x4){0.f, 0.f, 0.f, 0.f};
    const int nkt = 2 * qt + 2;
    const int kkey0 = tid / 12, kpart0 = tid % 12, kkey1 = (tid + 512) / 12, kpart1 = (tid + 512) % 12; const bool k1 = tid < 256;
    const int vdv = tid >> 3, vpart = tid & 7;
    u32x4 rk0, rk1, rv;
    rk1 = (u32x4){0u, 0u, 0u, 0u};
    rk0 = *(const u32x4*)(Kb + (size_t)kkey0 * 96 + kpart0 * 8); if (k1) rk1 = *(const u32x4*)(Kb + (size_t)kkey1 * 96 + kpart1 * 8);
    rv = *(const u32x4*)(Vt + (size_t)vdv * SEQ + vpart * 8);
#pragma unroll 1
    for (int kt = 0; kt < nkt; ++kt) {
        __syncthreads();
        *(LAS u32x4*)(Kt + kkey0 * 104 + kpart0 * 8) = rk0; if (k1) *(LAS u32x4*)(Kt + kkey1 * 104 + kpart1 * 8) = rk1;
        *(LAS u32x4*)(Vl + vdv * 72 + vpart * 8) = rv;
        __syncthreads();
        if (kt + 1 < nkt) { const size_t kb = (size_t)(kt + 1) * 64;
            rk0 = *(const u32x4*)(Kb + (kb + kkey0) * 96 + kpart0 * 8); if (k1) rk1 = *(const u32x4*)(Kb + (kb + kkey1) * 96 + kpart1 * 8);
            rv = *(const u32x4*)(Vt + (size_t)vdv * SEQ + kb + vpart * 8); }
        f32x4 sc[4]; float mx = -1e30f;
#pragma unroll
        for (int kb = 0; kb < 4; ++kb) { f32x4 s = (f32x4){0.f, 0.f, 0.f, 0.f};
#pragma unroll
            for (int ks = 0; ks < 3; ++ks) { const bf16x8 a = *(const LAS bf16x8*)(Kt + (16 * kb + r16) * 104 + 32 * ks + 8 * g4); s = mfma16(a, qfr[ks], s); }
            if (kt >= 2 * qt) {
#pragma unroll
                for (int r = 0; r < 4; ++r) if (kt * 64 + 16 * kb + 4 * g4 + r > qrow) s[r] = -1e30f; }
            sc[kb] = s; mx = fmaxf(mx, fmaxf(fmaxf(s[0], s[1]), fmaxf(s[2], s[3]))); }
        mx = fmaxf(mx, __shfl_xor(mx, 16)); mx = fmaxf(mx, __shfl_xor(mx, 32));
        const float mnew = fmaxf(mrun, mx), alpha = exp2f(mrun - mnew); mrun = mnew;
        float ls = 0.f;
#pragma unroll
        for (int kb = 0; kb < 4; ++kb)
#pragma unroll
            for (int r = 0; r < 4; ++r) { const float p = exp2f(sc[kb][r] - mnew); sc[kb][r] = p; ls += p; }
        lrun = lrun * alpha + ls;
        Frag pf[2];
#pragma unroll
        for (int ks = 0; ks < 2; ++ks) { pf[ks].u[0] = cvt_pk_bf16(sc[2 * ks][0], sc[2 * ks][1]); pf[ks].u[1] = cvt_pk_bf16(sc[2 * ks][2], sc[2 * ks][3]); pf[ks].u[2] = cvt_pk_bf16(sc[2 * ks + 1][0], sc[2 * ks + 1][1]); pf[ks].u[3] = cvt_pk_bf16(sc[2 * ks + 1][2], sc[2 * ks + 1][3]); }
#pragma unroll
        for (int db = 0; db < 4; ++db) { f32x4 o = O[db] * alpha;
#pragma unroll
            for (int ks = 0; ks < 2; ++ks) { Frag vf; vf.d[0] = *(const LAS u32x2*)(Vl + (16 * db + r16) * 72 + 32 * ks + 4 * g4); vf.d[1] = *(const LAS u32x2*)(Vl + (16 * db + r16) * 72 + 32 * ks + 16 + 4 * g4); o = mfma16(vf.v, pf[ks].v, o); }
            O[db] = o; }
    }
    lrun += __shfl_xor(lrun, 16); lrun += __shfl_xor(lrun, 32);
    const float inv = 1.0f / lrun;
    const int b = bh >> 2, h = bh & 3; bf16_t* Y = WSP(bf16_t, WS_Y) + ((size_t)b * SEQ + qrow) * 1024 + 256 + h * 64;
#pragma unroll
    for (int db = 0; db < 4; ++db) { u32x2 wv; wv.x = cvt_pk_bf16(O[db][0] * inv, O[db][1] * inv); wv.y = cvt_pk_bf16(O[db][2] * inv, O[db][3] * inv); *(u32x2*)(Y + 16 * db + 4 * g4) = wv; }
}

__device__ __forceinline__ void ln_row_write(f32x4 (&v)[4], const float* g, const float* bta, float* of, bf16_t* ob, int lane, unsigned char* o8 = nullptr) {
    float s = 0.f;
#pragma unroll
    for (int j = 0; j < 4; ++j) s += (v[j][0] + v[j][1]) + (v[j][2] + v[j][3]);
    const float mean = wave_sum(s) * (1.0f / 1024.0f); float s2 = 0.f;
#pragma unroll
    for (int j = 0; j < 4; ++j) { v[j] = v[j] - mean; s2 += (v[j][0] * v[j][0] + v[j][1] * v[j][1]) + (v[j][2] * v[j][2] + v[j][3] * v[j][3]); }
    const float rstd = rsqrtf(wave_sum(s2) * (1.0f / 1024.0f) + EPS);
#pragma unroll
    for (int j = 0; j < 4; ++j) { const f32x4 gg = *(const f32x4*)(g + 4 * lane + 256 * j), bb = *(const f32x4*)(bta + 4 * lane + 256 * j); v[j] = v[j] * rstd * gg + bb;
        *(f32x4*)(of + 4 * lane + 256 * j) = v[j]; u32x2 w; w.x = cvt_pk_bf16(v[j][0], v[j][1]); w.y = cvt_pk_bf16(v[j][2], v[j][3]); *(u32x2*)(ob + 4 * lane + 256 * j) = w;
        if (o8) *(unsigned*)(o8 + 4 * lane + 256 * j) = cvt4_fp8(v[j][0], v[j][1], v[j][2], v[j][3]); }
}
template <bool MOE>
__device__ __forceinline__ void ln1_phase(const Frame& F, int layer) {
    const int lane = F.lane; bf16_t* XB = WSP(bf16_t, WS_XB);
    LAS int* lcnt = (LAS int*)(F.lds + LDS_MISC);
    LAS int* rinfo = (LAS int*)(F.lds + LDS_MISC + 64);
    LAS float* rw = (LAS float*)(F.lds + LDS_MISC + 64 + 4096);
    if (MOE) { if (F.tid < 16) lcnt[F.tid] = 0; __syncthreads(); }
    const int rows_per_blk = T / F.G;
    const float* wr_ = MOE ? IN_F(28) + (size_t)(layer >> 1) * 1024 * 8 : nullptr;
    f32x4 nv[4];
    if (F.wave < rows_per_blk) { const float* x0 = F.out + (size_t)(F.bid * rows_per_blk + F.wave) * 1024;
#pragma unroll
        for (int j = 0; j < 4; ++j) nv[j] = *(const f32x4*)(x0 + 4 * lane + 256 * j); }
    for (int lr = F.wave; lr < rows_per_blk; lr += 8) { const int t = F.bid * rows_per_blk + lr;
        float* xr = F.out + (size_t)t * 1024; f32x4 v[4];
#pragma unroll
        for (int j = 0; j < 4; ++j) v[j] = nv[j];
        if (lr + 8 < rows_per_blk) {
#pragma unroll
            for (int j = 0; j < 4; ++j) nv[j] = *(const f32x4*)(xr + 8 * 1024 + 4 * lane + 256 * j); }
        ln_row_write(v, IN_F(23) + layer * 1024, IN_F(24) + layer * 1024, xr, XB + (size_t)t * 1024, lane, WSP(unsigned char, WS_X8) + (size_t)t * 1024);
        if (MOE) {
            float lg[8];
#pragma unroll
            for (int e = 0; e < 8; ++e) lg[e] = 0.f;
#pragma unroll
            for (int j = 0; j < 4; ++j)
#pragma unroll
                for (int q = 0; q < 4; ++q) { const float xv = v[j][q]; const float* wrow = wr_ + (size_t)(4 * lane + 256 * j + q) * 8; const f32x4 w0 = *(const f32x4*)wrow, w1 = *(const f32x4*)(wrow + 4);
                    lg[0] += xv * w0[0]; lg[1] += xv * w0[1]; lg[2] += xv * w0[2]; lg[3] += xv * w0[3]; lg[4] += xv * w1[0]; lg[5] += xv * w1[1]; lg[6] += xv * w1[2]; lg[7] += xv * w1[3]; }
#pragma unroll
            for (int e = 0; e < 8; ++e) lg[e] = wave_sum(lg[e]);
            int e0 = 0; float v0 = lg[0];
#pragma unroll
            for (int e = 1; e < 8; ++e) if (lg[e] > v0) { v0 = lg[e]; e0 = e; }
            int e1 = -1; float v1 = -3.0e38f;
#pragma unroll
            for (int e = 0; e < 8; ++e) if (e != e0 && lg[e] > v1) { v1 = lg[e]; e1 = e; }
            if (lane == 0) { const float w0 = 1.0f / (1.0f + __expf(v1 - v0)); const int p0 = __hip_atomic_fetch_add(&lcnt[e0], 1, __ATOMIC_RELAXED, __HIP_MEMORY_SCOPE_WORKGROUP), p1 = __hip_atomic_fetch_add(&lcnt[e1], 1, __ATOMIC_RELAXED, __HIP_MEMORY_SCOPE_WORKGROUP);
                rinfo[lr * 4 + 0] = e0; rinfo[lr * 4 + 1] = e1; rinfo[lr * 4 + 2] = p0; rinfo[lr * 4 + 3] = p1; rw[lr * 2] = w0; rw[lr * 2 + 1] = 1.0f - w0; }
        }
    }
    if (MOE) {
        __syncthreads();
        unsigned* gcnt = WSP(unsigned, WS_CTL) + CW_MOE + (layer >> 1) * 64;
        if (F.tid < 8) lcnt[8 + F.tid] = (int)__hip_atomic_fetch_add(gcnt + F.tid, (unsigned)lcnt[F.tid], __ATOMIC_RELAXED, __HIP_MEMORY_SCOPE_AGENT);
        __syncthreads();
        int* te = (int*)(F.ws + WS_TOK + TOK_E); int* tp = (int*)(F.ws + WS_TOK + TOK_POS); float* tw = (float*)(F.ws + WS_TOK + TOK_W);
        for (int i = F.tid; i < rows_per_blk * 2; i += 512) { const int lr = i >> 1, k = i & 1, t = F.bid * rows_per_blk + lr; const int e = rinfo[lr * 4 + k];
            te[t * 2 + k] = e; tp[t * 2 + k] = lcnt[8 + e] + rinfo[lr * 4 + 2 + k]; tw[t * 2 + k] = rw[lr * 2 + k]; }
    }
}
struct MoeOff { int ts0, ts1, ts2, ts3, ts4, ts5, ts6, ts7, ts8; };
__device__ __forceinline__ MoeOff moe_offsets(const Frame& F, int layer, int* cnt_out  ) {
    const unsigned* gcnt = WSP(const unsigned, WS_CTL) + CW_MOE + (layer >> 1) * 64;
    MoeOff o; int c[8];
#pragma unroll
    for (int e = 0; e < 8; ++e) c[e] = (int)__hip_atomic_load(gcnt + e, __ATOMIC_RELAXED, __HIP_MEMORY_SCOPE_AGENT);
    o.ts0 = 0; o.ts1 = o.ts0 + ((c[0] + 255) >> 8); o.ts2 = o.ts1 + ((c[1] + 255) >> 8); o.ts3 = o.ts2 + ((c[2] + 255) >> 8); o.ts4 = o.ts3 + ((c[3] + 255) >> 8);
    o.ts5 = o.ts4 + ((c[4] + 255) >> 8); o.ts6 = o.ts5 + ((c[5] + 255) >> 8); o.ts7 = o.ts6 + ((c[6] + 255) >> 8); o.ts8 = o.ts7 + ((c[7] + 255) >> 8);
    if (cnt_out) {
#pragma unroll
        for (int e = 0; e < 8; ++e) cnt_out[e] = c[e]; }
    return o;
}
__device__ __forceinline__ int moe_ts(const MoeOff& o, int e) { return e == 0 ? o.ts0 : e == 1 ? o.ts1 : e == 2 ? o.ts2 : e == 3 ? o.ts3 : e == 4 ? o.ts4 : e == 5 ? o.ts5 : e == 6 ? o.ts6 : o.ts7; }
__device__ __forceinline__ void moe_gather(const Frame& F, int layer) {
    int cnt[8]; const MoeOff o = moe_offsets(F, layer, cnt);
    const int lane = F.lane; const unsigned char* X8 = WSP(const unsigned char, WS_X8); unsigned char* XG = WSP(unsigned char, WS_XG);
    const int* te = (const int*)(F.ws + WS_TOK + TOK_E); const int* tp = (const int*)(F.ws + WS_TOK + TOK_POS); int* tsl = (int*)(F.ws + WS_TOK + TOK_SLOT);
    for (int i0 = F.gw * 4; i0 < T * 2; i0 += F.NGW * 4) {
        int ee[4], pp[4]; u32x4 a[4];
#pragma unroll
        for (int q = 0; q < 4; ++q) { ee[q] = te[i0 + q]; pp[q] = tp[i0 + q]; a[q] = ((const u32x4*)(X8 + (size_t)((i0 + q) >> 1) * 1024))[lane]; }
#pragma unroll
        for (int q = 0; q < 4; ++q) { const int slot = moe_ts(o, ee[q]) * 256 + pp[q]; ((u32x4*)(XG + (size_t)slot * 1024))[lane] = a[q]; if (lane == 0) tsl[i0 + q] = slot; }
    }
    int npad_pre = 0;
#pragma unroll
    for (int e = 0; e < 8; ++e) { const int start = moe_ts(o, e) * 256 + cnt[e], end = (e == 7 ? o.ts8 : moe_ts(o, e + 1)) * 256, np = end - start;
        for (int i = F.gw; i < np; i += F.NGW) ((u32x4*)(XG + (size_t)(start + i) * 1024))[lane] = (u32x4){0u, 0u, 0u, 0u};
        npad_pre += np; }
    (void)npad_pre;
}
template <bool MOE>
__device__ __forceinline__ void ln2_phase(const Frame& F, int layer) {
    const int lane = F.lane; bf16_t* XB = WSP(bf16_t, WS_XB);
    const bf16_t* YM = WSP(const bf16_t, WS_YM); const bf16_t* PLE = WSP(const bf16_t, WS_PLE);
    const int* tsl = (const int*)(F.ws + WS_TOK + TOK_SLOT); const float* tw = (const float*)(F.ws + WS_TOK + TOK_W);
    f32x4 nx[4]; u32x2 na[4], nc[4], np_[4]; float nw0 = 0.f, nw1 = 0.f;
#define LN2_LOAD(t_) do { const int tt_ = (t_); const float* xr_ = F.out + (size_t)tt_ * 1024; \
        _Pragma("unroll") for (int j = 0; j < 4; ++j) nx[j] = *(const f32x4*)(xr_ + 4 * lane + 256 * j); \
        if (MOE) { const int s0_ = tsl[tt_ * 2], s1_ = tsl[tt_ * 2 + 1]; nw0 = tw[tt_ * 2]; nw1 = tw[tt_ * 2 + 1]; \
            _Pragma("unroll") for (int j = 0; j < 4; ++j) { na[j] = *(const u32x2*)(YM + (size_t)s0_ * 1024 + 4 * lane + 256 * j); nc[j] = *(const u32x2*)(YM + (size_t)s1_ * 1024 + 4 * lane + 256 * j); np_[j] = *(const u32x2*)(PLE + (size_t)tt_ * 1024 + 4 * lane + 256 * j); } } } while (0)
    if (F.gw < T) LN2_LOAD(F.gw);
    for (int t = F.gw; t < T; t += F.NGW) { float* xr = F.out + (size_t)t * 1024; f32x4 v[4];
#pragma unroll
        for (int j = 0; j < 4; ++j) v[j] = nx[j];
        if (MOE) { const float w0 = nw0, w1 = nw1;
#pragma unroll
            for (int j = 0; j < 4; ++j) { const u32x2 a = na[j], c = nc[j], p = np_[j];
                f32x4 f;
                f[0] = w0 * __uint_as_float(a.x << 16) + w1 * __uint_as_float(c.x << 16) + __uint_as_float(p.x << 16);
                f[1] = w0 * __uint_as_float(a.x & 0xffff0000u) + w1 * __uint_as_float(c.x & 0xffff0000u) + __uint_as_float(p.x & 0xffff0000u);
                f[2] = w0 * __uint_as_float(a.y << 16) + w1 * __uint_as_float(c.y << 16) + __uint_as_float(p.y << 16);
                f[3] = w0 * __uint_as_float(a.y & 0xffff0000u) + w1 * __uint_as_float(c.y & 0xffff0000u) + __uint_as_float(p.y & 0xffff0000u);
                v[j] = v[j] * ALPHA + f; } }
        if (t + F.NGW < T) LN2_LOAD(t + F.NGW);
        ln_row_write(v, IN_F(34) + layer * 1024, IN_F(35) + layer * 1024, xr, XB + (size_t)t * 1024, lane, WSP(unsigned char, WS_X8) + (size_t)t * 1024);
    }
#undef LN2_LOAD
}

constexpr int PH_PER_LAYER = 12, N_PHASES = 1 + DEPTH * PH_PER_LAYER;
__global__ void __launch_bounds__(512, 2) hybrid_fwd(Args args) {
    extern __shared__ __attribute__((aligned(16))) unsigned char lds_raw[];
    Frame F0;
    F0.lds = (LAS unsigned char*)lds_raw; F0.ws = args.ws; F0.in = args.in; F0.out = args.out;
    F0.tid = threadIdx.x; F0.lane = F0.tid & 63; F0.wave = __builtin_amdgcn_readfirstlane(F0.tid >> 6); F0.G = gridDim.x; F0.bid = blockIdx.x; F0.gw = F0.bid * 8 + F0.wave; F0.NGW = F0.G * 8;
    volatile LAS unsigned* ctlw = (volatile LAS unsigned*)(F0.lds + LDS_CTLW);
    if (F0.tid < 16) ctlw[F0.tid] = 0u;
    __syncthreads();
    const int lo = args.ph_lo, hi = args.ph_hi; const int VAR = args.variant;
    XcdBarrier bar; bar.bar = (unsigned*)(F0.ws + WS_CTL) + CW_BAR + args.bar_region * XCD_BAR_WORDS; bar.x = 0; bar.st = ctlw;
    if (hi - lo > 1) bar = xcd_barrier_post((unsigned*)(F0.ws + WS_CTL) + CW_BAR + args.bar_region * XCD_BAR_WORDS, ctlw);
#define IN_PH(k) (lo <= (k) && (k) < hi)
#define SEAM(k) do { if ((k) + 1 < hi) { XcdBarrier bb_ = bar; bb_.bar = bar.bar + opaque0(); xcd_barrier(bb_); } } while (0)

    if (PHON(12) && IN_PH(0)) { const Frame F = reframe(F0); p0_prologue(F); SEAM(0); }

    for (int layer = 0; layer < DEPTH; ++layer) {
        const int pb = 1 + layer * PH_PER_LAYER;
        const bool moe = (layer & 1) != 0;
        if (PHON(0) && IN_PH(pb + 0)) { const Frame F = reframe(F0); const int L = layer + opaque0(); LAS unsigned char* stage = F.lds + LDS_STAGE; LAS unsigned char* wscr = F.lds + LDS_STAGE + F.wave * 16384; (void)wscr; (void)stage;
            { pg8::Gemm g{WSP(const bf16_t, WS_XB), WSP(const bf16_t, WS_WIN) + (size_t)L * HP * 1024, 1024, 1024, 1024, VAR};
              pg8::OrderStd S; S.init(T / 256, HP / 256, F.G, F.bid); pg8::EpiBf16 E{WSP(bf16_t, WS_H), HP, HP / 256, 1.0f};
              pg8::gemm_phase(stage, g, S, E); }
            { const int L3 = L + opaque0(); pg8::Gemm g{WSP(const unsigned char, WS_X8), WSP(const unsigned char, WS_WIN8) + (size_t)L3 * 4096 * 1024, 1024, 1024, 1024, VAR};
              pg8::OrderStd S; S.init(T / 256, 16, F.G, F.bid); pg8::EpiGate8 E{WSP(unsigned char, WS_G8)};
              pg8::gemm_phase(stage, g, S, E); }
            { const int L2 = L + opaque0(); pg8::Gemm g{WSP(const bf16_t, WS_PB) + (size_t)L2 * T * 256, WSP(const bf16_t, WS_WPP) + (size_t)L2 * 1024 * 256, 256, 256, 256, VAR};
              const int nshort = F.G - (1728 % F.G); pg8::OrderLin S{(F.G == 256) ? F.bid - 192 : F.bid, (F.G == 256) ? 64 : F.G, 256, 4}; (void)nshort;
              pg8::EpiBf16 E{WSP(bf16_t, WS_PP), 1024, 4, 1.0f};
              pg8::gemm_phase(stage, g, S, E); }
            SEAM(pb + 0);
        }
        if (PHON(1) && IN_PH(pb + 1)) { const Frame F = reframe(F0); const int L = layer + opaque0(); LAS unsigned char* stage = F.lds + LDS_STAGE; LAS unsigned char* wscr = F.lds + LDS_STAGE + F.wave * 16384; (void)wscr; (void)stage;
            const bf16_t* H = WSP(const bf16_t, WS_H);
            LAS float* rs = (LAS float*)(F.lds + LDS_MISC);
            if (!(VAR & 16)) { const int vb = F.bid;
                const int pm = vb >> 2, kind = (vb >> 1) & 1, pn = vb & 1;
                __syncthreads();
                { const int lr = F.tid >> 1, hf = F.tid & 1; const int nper = kind ? 64 : 96;
                  const u32x4* src = (const u32x4*)(H + (size_t)(pm * 256 + lr) * HP + (kind ? C_CKV : C_CQ) + hf * nper);
                  u32x4 v[12];
#pragma unroll
                  for (int q = 0; q < 12; ++q) v[q] = (q < 8 || kind == 0) ? src[q] : (u32x4){0u, 0u, 0u, 0u};
                  float ss = 0.f;
#pragma unroll
                  for (int q = 0; q < 12; ++q)
#pragma unroll
                      for (int j = 0; j < 4; ++j) { const float lo = __uint_as_float(v[q][j] << 16), hi = __uint_as_float(v[q][j] & 0xffff0000u); ss += lo * lo + hi * hi; }
                  ss += __shfl_xor(ss, 1);
                  if (hf == 0) rs[lr] = rsqrtf(ss / (kind ? 128.0f : 192.0f) + EPS); }
                __syncthreads();
                if (kind == 0) { pg8::Gemm g{H + C_CQ, WSP(const bf16_t, WS_WUQ) + (size_t)L * 512 * 256, HP, 256, 256, VAR}; pg8::OrderOne S{pm, pn, true};
                    pg8::EpiQ E{WSP(bf16_t, WS_Q), WSP(const float, WS_ROPEM), rs}; pg8::gemm_phase(stage, g, S, E); }
                else { pg8::Gemm g{H + C_CKV, WSP(const bf16_t, WS_WUKV) + (size_t)L * 512 * 256, HP, 256, 256, VAR}; pg8::OrderOne S{pm, pn, true};
                    pg8::EpiKV E{WSP(bf16_t, WS_K), WSP(bf16_t, WS_VT), rs}; pg8::gemm_phase(stage, g, S, E);
                    if (pn == 0) { const float* rope = WSP(const float, WS_ROPEM); bf16_t* Kb = WSP(bf16_t, WS_K);
#pragma unroll
                        for (int i8 = 0; i8 < 8; ++i8) { const int i = F.tid + i8 * 512; const int lr = i >> 4, j = i & 15, t = pm * 256 + lr, b = t >> 11, s = t & 2047;
                            const float x1 = bf2f(H[(size_t)t * HP + C_KR + j]), x2 = bf2f(H[(size_t)t * HP + C_KR + 16 + j]), c = rope[t * 32 + j], sn = rope[t * 32 + 16 + j];
                            const bf16_t o1 = f2bf(x1 * c - x2 * sn), o2 = f2bf(x2 * c + x1 * sn);
#pragma unroll
                            for (int hd = 0; hd < 4; ++hd) { bf16_t* kp = Kb + ((size_t)((b * 4 + hd) * SEQ + s)) * 96; kp[64 + j] = o1; kp[80 + j] = o2; } } } }
            }
            __syncthreads();
            for (int it = F.gw; it < 1024 + 1024 + 4096; it += F.NGW) {
                if (it < 1024) { if (!(VAR & 2)) hg_item<false>(F, L, it, wscr); }
                else if (it < 2048) { if (!(VAR & 4)) ret_item1(F, it - 1024, wscr); }
                else { if (!(VAR & 8)) s5_item<false>(F, L, it - 2048, wscr); }
            }
            SEAM(pb + 1);
        }
        if (PHON(2) && IN_PH(pb + 2)) { const Frame F = reframe(F0); const int L = layer + opaque0(); LAS unsigned char* stage = F.lds + LDS_STAGE; LAS unsigned char* wscr = F.lds + LDS_STAGE + F.wave * 16384; (void)wscr; (void)stage; s5_carry(F, L); hg_carry(F); ret_carry(F); SEAM(pb + 2); }
        if (PHON(3) && IN_PH(pb + 3)) { const Frame F = reframe(F0); const int L = layer + opaque0(); LAS unsigned char* stage = F.lds + LDS_STAGE; LAS unsigned char* wscr = F.lds + LDS_STAGE + F.wave * 16384; (void)wscr; (void)stage;
            if (!(VAR & 16)) { const int vb = F.bid; const int bh = vb >> 3, j = vb & 7; attn_unit(F, bh, 15 - j); attn_unit(F, bh, j); }
            __syncthreads();
            for (int it = F.gw; it < 1024 + 1024 + 4096; it += F.NGW) {
                if (it < 1024) { if (!(VAR & 2)) hg_item<true>(F, L, it, wscr); }
                else if (it < 2048) { if (!(VAR & 4)) ret_item3(F, L, it - 1024, wscr); }
                else { if (!(VAR & 8)) s5_item<true>(F, L, it - 2048, wscr); }
            }
            SEAM(pb + 3);
        }
        if (PHON(4) && IN_PH(pb + 4)) { const Frame F = reframe(F0); const int L = layer + opaque0(); LAS unsigned char* stage = F.lds + LDS_STAGE; LAS unsigned char* wscr = F.lds + LDS_STAGE + F.wave * 16384; (void)wscr; (void)stage;
            pg8::Gemm g{WSP(const bf16_t, WS_S5PRE), WSP(const bf16_t, WS_WGLU) + (size_t)L * 256 * 256, 256, 256, 256, VAR};
            pg8::OrderLin S{F.bid, F.G, 64, 1}; pg8::EpiSigMul E{WSP(bf16_t, WS_Y), 1024, WSP(const bf16_t, WS_S5PRE), 256};
            pg8::gemm_phase(stage, g, S, E);
            SEAM(pb + 4);
        }
        if (PHON(5) && IN_PH(pb + 5)) { const Frame F = reframe(F0); const int L = layer + opaque0(); LAS unsigned char* stage = F.lds + LDS_STAGE; LAS unsigned char* wscr = F.lds + LDS_STAGE + F.wave * 16384; (void)wscr; (void)stage;
            pg8::Gemm g{WSP(const bf16_t, WS_Y), WSP(const bf16_t, WS_WB) + (size_t)L * 4 * 1024 * 256, 1024, 256, 256, VAR};
            pg8::OrderBranch S{F.bid, F.G}; pg8::EpiBranchH E{WSP(const unsigned char, WS_G8), WSP(bf16_t, WS_MIXB)};
            pg8::gemm_phase(stage, g, S, E);
            SEAM(pb + 5);
        }
        if (PHON(6) && IN_PH(pb + 6)) { const Frame F = reframe(F0); const int L = layer + opaque0(); LAS unsigned char* stage = F.lds + LDS_STAGE; LAS unsigned char* wscr = F.lds + LDS_STAGE + F.wave * 16384; (void)wscr; (void)stage;
            pg8::Gemm g{WSP(const bf16_t, WS_MIXB), WSP(const bf16_t, WS_WO) + (size_t)L * 1024 * 1024, 1024, 1024, 1024, VAR};
            pg8::OrderStd S; S.init(T / 256, 4, F.G, F.bid); pg8::EpiResid E{L == 0 ? IN_F(0) : (const float*)F.out, F.out, nullptr, 1.0f};
            pg8::gemm_phase(stage, g, S, E);
            SEAM(pb + 6);
        }
        if (PHON(7) && IN_PH(pb + 7)) { const Frame F = reframe(F0); const int L = layer + opaque0(); LAS unsigned char* stage = F.lds + LDS_STAGE; LAS unsigned char* wscr = F.lds + LDS_STAGE + F.wave * 16384; (void)wscr; (void)stage; if (moe) ln1_phase<true>(F, L); else ln1_phase<false>(F, L); SEAM(pb + 7); }
        if (!moe) {
            if (PHON(8) && IN_PH(pb + 8)) { const Frame F = reframe(F0); const int L = layer + opaque0(); LAS unsigned char* stage = F.lds + LDS_STAGE; LAS unsigned char* wscr = F.lds + LDS_STAGE + F.wave * 16384; (void)wscr; (void)stage;
                { pg8::Gemm g{WSP(const unsigned char, WS_X8), WSP(const unsigned char, WS_WFFU) + (size_t)(L >> 1) * 7168 * 1024, 1024, 1024, 1024, VAR};
                  pg8::OrderStd S; S.init(T / 256, 28, F.G, F.bid); pg8::EpiSwiglu8 E{WSP(unsigned char, WS_HFF), DFF, 28};
                  pg8::gemm_phase(stage, g, S, E); }
                { const int L2 = L + opaque0(); pg8::Gemm g{WSP(const bf16_t, WS_XB), WSP(const bf16_t, WS_WPG) + (size_t)L2 * 1024 * 1024, 1024, 1024, 1024, VAR};
                  pg8::OrderStd S; S.init(T / 256, 4, F.G, F.bid); pg8::EpiSigMul E{WSP(bf16_t, WS_PLE), 1024, WSP(const bf16_t, WS_PP), 1024};
                  pg8::gemm_phase(stage, g, S, E); }
                SEAM(pb + 8);
            }
            if (PHON(9) && IN_PH(pb + 9)) { const Frame F = reframe(F0); const int L = layer + opaque0(); LAS unsigned char* stage = F.lds + LDS_STAGE; LAS unsigned char* wscr = F.lds + LDS_STAGE + F.wave * 16384; (void)wscr; (void)stage;
                pg8::Gemm g{WSP(const unsigned char, WS_HFF), WSP(const unsigned char, WS_WFFD) + (size_t)(L >> 1) * 1024 * DFF, DFF, DFF, DFF, VAR};
                pg8::OrderStd S; S.init(T / 256, 4, F.G, F.bid); pg8::EpiResidT<true> E{(const float*)F.out, F.out, WSP(const bf16_t, WS_PLE), 0.00048828125f};
                pg8::gemm_phase(stage, g, S, E);
                SEAM(pb + 9);
            }
            if (PHON(10) && IN_PH(pb + 10)) { const Frame F = reframe(F0); const int L = layer + opaque0(); LAS unsigned char* stage = F.lds + LDS_STAGE; LAS unsigned char* wscr = F.lds + LDS_STAGE + F.wave * 16384; (void)wscr; (void)stage; ln2_phase<false>(F, L); if (hi > pb + 12) { XcdBarrier bb_ = bar; bb_.bar = bar.bar + opaque0(); xcd_barrier(bb_); } }
        } else {
            if (PHON(8) && IN_PH(pb + 8)) { const Frame F = reframe(F0); const int L = layer + opaque0(); LAS unsigned char* stage = F.lds + LDS_STAGE; LAS unsigned char* wscr = F.lds + LDS_STAGE + F.wave * 16384; (void)wscr; (void)stage;
                moe_gather(F, L);
                { const int L2 = L + opaque0(); pg8::Gemm g{WSP(const bf16_t, WS_XB), WSP(const bf16_t, WS_WPG) + (size_t)L2 * 1024 * 1024, 1024, 1024, 1024, VAR};
                  pg8::OrderStd S; S.init(T / 256, 4, F.G, F.bid); pg8::EpiSigMul E{WSP(bf16_t, WS_PLE), 1024, WSP(const bf16_t, WS_PP), 1024};
                  pg8::gemm_phase(stage, g, S, E); }
                SEAM(pb + 8);
            }
            if (PHON(9) && IN_PH(pb + 9)) { const Frame F = reframe(F0); const int L = layer + opaque0(); LAS unsigned char* stage = F.lds + LDS_STAGE; LAS unsigned char* wscr = F.lds + LDS_STAGE + F.wave * 16384; (void)wscr; (void)stage;
                const MoeOff o = moe_offsets(F, L, nullptr);
                pg8::Gemm g{WSP(const unsigned char, WS_XG), WSP(const unsigned char, WS_WMU) + (size_t)(L >> 1) * 8 * 7168 * 1024, 1024, 1024, 1024, VAR};
                pg8::OrderMoe S{o.ts8, 28, F.G, F.bid, o.ts1, o.ts2, o.ts3, o.ts4, o.ts5, o.ts6, o.ts7}; pg8::EpiSwiglu8 E{WSP(unsigned char, WS_HM), DFF, 28};
                pg8::gemm_phase(stage, g, S, E);
                SEAM(pb + 9);
            }
            if (PHON(10) && IN_PH(pb + 10)) { const Frame F = reframe(F0); const int L = layer + opaque0(); LAS unsigned char* stage = F.lds + LDS_STAGE; LAS unsigned char* wscr = F.lds + LDS_STAGE + F.wave * 16384; (void)wscr; (void)stage;
                const MoeOff o = moe_offsets(F, L, nullptr);
                pg8::Gemm g{WSP(const unsigned char, WS_HM), WSP(const unsigned char, WS_WMD) + (size_t)(L >> 1) * 8 * 1024 * DFF, DFF, DFF, DFF, VAR};
                pg8::OrderMoe S{o.ts8, 4, F.G, F.bid, o.ts1, o.ts2, o.ts3, o.ts4, o.ts5, o.ts6, o.ts7}; pg8::EpiBf16T<true> E{WSP(bf16_t, WS_YM), 1024, 4, 0.00048828125f};
                pg8::gemm_phase(stage, g, S, E);
                SEAM(pb + 10);
            }
            if (PHON(11) && IN_PH(pb + 11)) { const Frame F = reframe(F0); const int L = layer + opaque0(); LAS unsigned char* stage = F.lds + LDS_STAGE; LAS unsigned char* wscr = F.lds + LDS_STAGE + F.wave * 16384; (void)wscr; (void)stage; ln2_phase<true>(F, L); SEAM(pb + 11); }
        }
    }
#undef IN_PH
#undef SEAM
}

extern "C" void kernel_launch(void* const* d_in, const int* in_sizes, int n_in, void* d_out, int out_size, void* d_ws, size_t ws_size, hipStream_t stream) {
    static int grid = 0;
    if (grid == 0) {
        if (n_in != 36 || out_size != T * D || ws_size < WS_END) { fprintf(stderr, "kernel_launch: unexpected problem (n_in %d, out %d, ws %zu < %zu)\n", n_in, out_size, ws_size, (size_t)WS_END); grid = -1; return; }
        int dev = 0, cus = 0, per_cu = 0;
        if (hipGetDevice(&dev) != hipSuccess || hipDeviceGetAttribute(&cus, hipDeviceAttributeMultiprocessorCount, dev) != hipSuccess) { grid = -1; return; }
        if (hipFuncSetAttribute((const void*)hybrid_fwd, hipFuncAttributeMaxDynamicSharedMemorySize, LDS_BYTES) != hipSuccess) { fprintf(stderr, "kernel_launch: hipFuncSetAttribute failed\n"); grid = -1; return; }
        if (hipOccupancyMaxActiveBlocksPerMultiprocessor(&per_cu, (const void*)hybrid_fwd, 512, LDS_BYTES) != hipSuccess || per_cu < 1) fprintf(stderr, "kernel_launch: occupancy query says %d\n", per_cu);
        (void)hipGetLastError();
        if (cus != 256) { fprintf(stderr, "kernel_launch: built for 256 CUs, device has %d\n", cus); }
        grid = 256;
    }
    if (grid < 0) return;
    (void)hipMemsetAsync((char*)d_ws + WS_CTL, 0, CTL_BYTES, stream);
    Args a{};
    for (int i = 0; i < 36; ++i) a.in[i] = d_in[i];
    a.out = (float*)d_out; a.ws = (unsigned char*)d_ws;
    if (DUP_PHASE >= 0) {
        a.ph_lo = 0; a.ph_hi = DUP_PHASE + 1; a.bar_region = 0; hipLaunchKernelGGL(hybrid_fwd, dim3(grid), dim3(512), LDS_BYTES, stream, a);
        for (int n = 0; n < DUP_N; ++n) { a.ph_lo = DUP_PHASE; a.ph_hi = DUP_PHASE + 1; a.bar_region = 1; a.variant = DUP_VARIANT; hipLaunchKernelGGL(hybrid_fwd, dim3(grid), dim3(512), LDS_BYTES, stream, a); }
        a.variant = 0;
        if (DUP_PHASE + 1 < N_PHASES) { a.ph_lo = DUP_PHASE + 1; a.ph_hi = N_PHASES; a.bar_region = 2; hipLaunchKernelGGL(hybrid_fwd, dim3(grid), dim3(512), LDS_BYTES, stream, a); }
    } else if (MK_N_LAUNCHES == 1) {
        a.ph_lo = 0; a.ph_hi = N_PHASES;
        hipLaunchKernelGGL(hybrid_fwd, dim3(grid), dim3(512), LDS_BYTES, stream, a);
    } else {
        for (int p = 0; p < N_PHASES; ++p) { a.ph_lo = p; a.ph_hi = p + 1; hipLaunchKernelGGL(hybrid_fwd, dim3(grid), dim3(512), LDS_BYTES, stream, a); }
    }
    const hipError_t le = hipPeekAtLastError();
    if (le != hipSuccess) fprintf(stderr, "kernel_launch: launch failed: %s\n", hipGetErrorName(le));
}
```
